# Optimizing an MI355X kernel written in HIP

```python
import math, functools
import jax, jax.numpy as jnp
from jax import lax
import numpy as np

D_MODEL = 1024
BATCH = 8
SEQ = 8192
DEPTH = 1
DEC_BATCH = 32
DEC_SEQ = 16
PAST_LEN = 4096

CHUNK = 64
EPS = 1e-6
SSD_HEADS = 16
SSD_HEAD_DIM = 64
D_SSM = SSD_HEADS * SSD_HEAD_DIM
SSD_GROUPS = 2
D_STATE = 128
CONV_W = 4
D_CONV = D_SSM + 2 * SSD_GROUPS * D_STATE
FOX_HEADS = 8
FOX_HEAD_DIM = 64
D_FOX = FOX_HEADS * FOX_HEAD_DIM
Q_BLOCK = 128
D_MIX = D_SSM + D_FOX
SPLIT_SIZES = (D_SSM, D_CONV, SSD_HEADS, D_FOX, D_FOX, D_FOX, FOX_HEADS)
D_IN_PROJ = sum(SPLIT_SIZES)
D_FF = 4 * D_MODEL

kernel_name = "hybrid_ssd_fox_streaming_step"


def rms_norm(x, g):
    xf = x.astype(jnp.float32)
    y = xf * lax.rsqrt(jnp.mean(xf * xf, axis=-1, keepdims=True) + EPS)
    return (y * g.astype(jnp.float32)).astype(x.dtype)


def split_proj(u):
    idx = [int(i) for i in np.cumsum(SPLIT_SIZES)[:-1]]
    return jnp.split(u, idx, axis=-1)


def causal_conv(xbc, conv_prev, conv_w, conv_b):
    L = xbc.shape[1]
    xp = jnp.concatenate([conv_prev.astype(xbc.dtype), xbc], axis=1)
    out = conv_b + sum(xp[:, k:k + L] * conv_w[k] for k in range(CONV_W))
    return jax.nn.silu(out), xp[:, -(CONV_W - 1):]


def ssd_scan(x, dt, A, Bm, Cm, state0):
    b, L, H, P = x.shape
    cl = min(CHUNK, L)
    nc = L // cl
    R = H // SSD_GROUPS

    def chunks(t):
        return jnp.moveaxis(t.reshape((b, nc, cl) + t.shape[2:]), 1, 0)

    xs = chunks(x.reshape(b, L, SSD_GROUPS, R, P) * dt.reshape(b, L, SSD_GROUPS, R)[..., None])
    dA = chunks((dt * A).reshape(b, L, SSD_GROUPS, R))
    Bs, Cs = chunks(Bm), chunks(Cm)
    mask = jnp.tril(jnp.ones((cl, cl), dtype=bool))[None, :, :, None, None]

    def step(state, inp):
        xc, dAc, Bc, Cc = inp
        acs = jnp.cumsum(dAc, axis=1)
        seg = acs[:, :, None] - acs[:, None, :]
        decay = jnp.exp(jnp.where(mask, seg, -jnp.inf))
        cb = jnp.einsum("blgn,bsgn->blsg", Cc, Bc)
        y_diag = jnp.einsum("blsg,blsgr,bsgrp->blgrp", cb, decay, xc)
        y_off = jnp.einsum("blgn,bgrpn,blgr->blgrp", Cc, state, jnp.exp(acs))
        tail = jnp.exp(acs[:, -1:] - acs)
        new_state = state * jnp.exp(acs[:, -1])[..., None, None] + jnp.einsum(
            "bsgn,bsgr,bsgrp->bgrpn", Bc, tail, xc)
        return new_state, y_diag + y_off

    final, ys = lax.scan(step, state0.reshape(b, SSD_GROUPS, R, P, D_STATE), (xs, dA, Bs, Cs))
    y = jnp.moveaxis(ys, 0, 1).reshape(b, L, H, P)
    return y, final.reshape(b, H, P, D_STATE)


def ssd_mixer(z, xbc, dt_raw, conv_prev, ssm_prev, conv_w, conv_b, dt_bias, A_log, D_skip, ssd_norm_w):
    b, L, _ = z.shape
    f32 = jnp.float32
    xbc_c, conv_state = causal_conv(xbc, conv_prev, conv_w, conv_b)
    xs, Bm, Cm = jnp.split(xbc_c.astype(f32), [D_SSM, D_SSM + SSD_GROUPS * D_STATE], axis=-1)
    dt = jax.nn.softplus(dt_raw.astype(f32) + dt_bias.astype(f32))
    A = -jnp.exp(A_log.astype(f32))
    x_h = xs.reshape(b, L, SSD_HEADS, SSD_HEAD_DIM)
    y, ssm_state = ssd_scan(x_h, dt, A,
                            Bm.reshape(b, L, SSD_GROUPS, D_STATE),
                            Cm.reshape(b, L, SSD_GROUPS, D_STATE),
                            ssm_prev.astype(f32))
    y = y + x_h * D_skip.astype(f32)[:, None]
    y = y.reshape(b, L, D_SSM) * jax.nn.silu(z.astype(f32))
    yg = y.reshape(b, L, SSD_GROUPS, D_SSM // SSD_GROUPS)
    yg = yg * lax.rsqrt(jnp.mean(yg * yg, axis=-1, keepdims=True) + EPS)
    y = yg.reshape(b, L, D_SSM) * ssd_norm_w.astype(f32)
    return y.astype(z.dtype), ssm_state, conv_state


def fox_project(q, k, v, f_raw, f_bias, q_norm_w, k_norm_w):
    b, L, _ = q.shape
    shp = (b, L, FOX_HEADS, FOX_HEAD_DIM)
    q = rms_norm(q.reshape(shp), q_norm_w)
    k = rms_norm(k.reshape(shp), k_norm_w)
    v = v.reshape(shp)
    logf = jax.nn.log_sigmoid(f_raw.astype(jnp.float32) + f_bias.astype(jnp.float32))
    return q, k, v, logf


def fox_attend(q, k, v, cq, ck, q_pos, k_pos):
    f32 = jnp.float32
    s = jnp.einsum("bthd,bshd->bhts", q.astype(f32), k.astype(f32)) * (FOX_HEAD_DIM ** -0.5)
    bias = jnp.transpose(cq, (0, 2, 1))[..., :, None] - jnp.transpose(ck, (0, 2, 1))[..., None, :]
    allowed = k_pos[None, :] <= q_pos[:, None]
    s = jnp.where(allowed, s + bias, -jnp.inf)
    p = jax.nn.softmax(s, axis=-1)
    return jnp.einsum("bhts,bshd->bthd", p, v.astype(f32))


def fox_prompt(q, k, v, logf):
    b, L, H, d = q.shape
    c = jnp.cumsum(logf, axis=1)
    nb = L // Q_BLOCK
    qb = jnp.moveaxis(q.reshape(b, nb, Q_BLOCK, H, d), 1, 0)
    cb = jnp.moveaxis(c.reshape(b, nb, Q_BLOCK, H), 1, 0)
    pos = jnp.arange(L)
    pb = pos.reshape(nb, Q_BLOCK)
    out = lax.map(lambda a: fox_attend(a[0], k, v, a[1], c, a[2], pos), (qb, cb, pb))
    return jnp.moveaxis(out, 0, 1).reshape(b, L, H * d)


def fox_sample(q, k, v, logf, cache_k, cache_v, cache_logf):
    b, T, H, d = q.shape
    past = cache_k.shape[1]
    k_all = jnp.concatenate([cache_k.astype(jnp.float32), k.astype(jnp.float32)], axis=1)
    v_all = jnp.concatenate([cache_v.astype(jnp.float32), v.astype(jnp.float32)], axis=1)
    c_all = jnp.cumsum(jnp.concatenate([cache_logf.astype(jnp.float32), logf], axis=1), axis=1)
    q_pos = past + jnp.arange(T)
    k_pos = jnp.arange(past + T)
    out = fox_attend(q, k_all, v_all, c_all[:, past:], c_all, q_pos, k_pos)
    return out.reshape(b, T, H * d)


def trunk_layer(x, conv_prev, ssm_prev, fox_fn, norm1_w, w_in, conv_w, conv_b, dt_bias, A_log,
                D_skip, ssd_norm_w, f_bias, q_norm_w, k_norm_w, w_out, norm2_w, w_up, w_down):
    h = rms_norm(x, norm1_w)
    u = jnp.einsum("bld,de->ble", h, w_in)
    z, xbc, dt_raw, q, k, v, f_raw = split_proj(u)
    y_ssd, ssm_state, conv_state = ssd_mixer(z, xbc, dt_raw, conv_prev, ssm_prev, conv_w, conv_b,
                                             dt_bias, A_log, D_skip, ssd_norm_w)
    q, k, v, logf = fox_project(q, k, v, f_raw, f_bias, q_norm_w, k_norm_w)
    y_fox = fox_fn(q, k, v, logf).astype(x.dtype)
    mix = jnp.concatenate([y_ssd, y_fox], axis=-1)
    x = x + jnp.einsum("ble,ed->bld", mix, w_out)
    h = rms_norm(x, norm2_w)
    x = x + jnp.einsum("blf,fd->bld", jnp.square(jax.nn.relu(jnp.einsum("bld,df->blf", h, w_up))), w_down)
    return x, (k, v, logf, ssm_state, conv_state)


def setup_inputs(seed: int = 0) -> dict:
    key = jax.random.key(seed)
    ks = jax.random.split(key, 24)
    f32 = jnp.float32

    def nrm(k, shape, scale=1.0):
        return scale * jax.random.normal(k, shape, f32)

    x_prompt = nrm(ks[0], (BATCH, SEQ, D_MODEL))
    x_sample = nrm(ks[1], (DEC_BATCH, DEC_SEQ, D_MODEL))
    cache_k = nrm(ks[2], (DEPTH, DEC_BATCH, PAST_LEN, FOX_HEADS, FOX_HEAD_DIM))
    cache_v = nrm(ks[3], (DEPTH, DEC_BATCH, PAST_LEN, FOX_HEADS, FOX_HEAD_DIM))
    cache_logf = jax.nn.log_sigmoid(2.5 + nrm(ks[4], (DEPTH, DEC_BATCH, PAST_LEN, FOX_HEADS)))
    state_ssm = nrm(ks[5], (DEPTH, DEC_BATCH, SSD_HEADS, SSD_HEAD_DIM, D_STATE), 0.1)
    state_conv = nrm(ks[6], (DEPTH, DEC_BATCH, CONV_W - 1, D_CONV))
    norm1_w = 1.0 + nrm(ks[7], (DEPTH, D_MODEL), 0.01)
    w_in = nrm(ks[8], (DEPTH, D_MODEL, D_IN_PROJ), D_MODEL ** -0.5)
    conv_w = nrm(ks[9], (DEPTH, CONV_W, D_CONV), CONV_W ** -0.5)
    conv_b = nrm(ks[10], (DEPTH, D_CONV), 0.01)
    dt_init = jnp.exp(jax.random.uniform(ks[11], (DEPTH, SSD_HEADS), f32, math.log(1e-3), math.log(1e-1)))
    dt_bias = dt_init + jnp.log(-jnp.expm1(-dt_init))
    A_log = jnp.log(jax.random.uniform(ks[12], (DEPTH, SSD_HEADS), f32, 1.0, 16.0))
    D_skip = 1.0 + nrm(ks[13], (DEPTH, SSD_HEADS), 0.01)
    ssd_norm_w = 1.0 + nrm(ks[14], (DEPTH, D_SSM), 0.01)
    f_bias = jax.random.uniform(ks[15], (DEPTH, FOX_HEADS), f32, 1.0, 4.0)
    q_norm_w = 1.0 + nrm(ks[16], (DEPTH, FOX_HEAD_DIM), 0.01)
    k_norm_w = 1.0 + nrm(ks[17], (DEPTH, FOX_HEAD_DIM), 0.01)
    w_out = nrm(ks[18], (DEPTH, D_MIX, D_MODEL), D_MIX ** -0.5)
    norm2_w = 1.0 + nrm(ks[19], (DEPTH, D_MODEL), 0.01)
    w_up = nrm(ks[20], (DEPTH, D_MODEL, D_FF), D_MODEL ** -0.5)
    w_down = nrm(ks[21], (DEPTH, D_FF, D_MODEL), D_FF ** -0.5)
    return {"x_prompt": x_prompt, "x_sample": x_sample, "cache_k": cache_k, "cache_v": cache_v,
            "cache_logf": cache_logf, "state_ssm": state_ssm, "state_conv": state_conv,
            "norm1_w": norm1_w, "w_in": w_in, "conv_w": conv_w, "conv_b": conv_b, "dt_bias": dt_bias,
            "A_log": A_log, "D_skip": D_skip, "ssd_norm_w": ssd_norm_w, "f_bias": f_bias,
            "q_norm_w": q_norm_w, "k_norm_w": k_norm_w, "w_out": w_out, "norm2_w": norm2_w,
            "w_up": w_up, "w_down": w_down}


def reference(x_prompt, x_sample, cache_k, cache_v, cache_logf, state_ssm, state_conv,
              norm1_w, w_in, conv_w, conv_b, dt_bias, A_log, D_skip, ssd_norm_w, f_bias,
              q_norm_w, k_norm_w, w_out, norm2_w, w_up, w_down):
    b_p = x_prompt.shape[0]
    y_prompt, y_sample = x_prompt, x_sample
    p_states, s_states = [], []
    for l in range(DEPTH):
        wl = (norm1_w[l], w_in[l], conv_w[l], conv_b[l], dt_bias[l], A_log[l], D_skip[l],
              ssd_norm_w[l], f_bias[l], q_norm_w[l], k_norm_w[l], w_out[l], norm2_w[l], w_up[l], w_down[l])
        conv0 = jnp.zeros((b_p, CONV_W - 1, D_CONV), x_prompt.dtype)
        ssm0 = jnp.zeros((b_p, SSD_HEADS, SSD_HEAD_DIM, D_STATE), jnp.float32)
        y_prompt, st_p = trunk_layer(y_prompt, conv0, ssm0, fox_prompt, *wl)
        p_states.append(st_p)
        fox_fn = functools.partial(fox_sample, cache_k=cache_k[l], cache_v=cache_v[l], cache_logf=cache_logf[l])
        y_sample, st_s = trunk_layer(y_sample, state_conv[l], state_ssm[l], fox_fn, *wl)
        s_states.append(st_s)
    p_k = jnp.stack([s[0] for s in p_states])
    p_v = jnp.stack([s[1] for s in p_states])
    p_logf = jnp.stack([s[2] for s in p_states])
    p_ssm = jnp.stack([s[3] for s in p_states])
    p_conv = jnp.stack([s[4] for s in p_states])
    s_k = jnp.stack([s[0] for s in s_states])
    s_v = jnp.stack([s[1] for s in s_states])
    s_logf = jnp.stack([s[2] for s in s_states])
    s_ssm = jnp.stack([s[3] for s in s_states])
    s_conv = jnp.stack([s[4] for s in s_states])
    return (y_prompt, y_sample, p_k, p_v, p_logf, p_ssm, p_conv, s_k, s_v, s_logf, s_ssm, s_conv)
```

```cpp
#include <hip/hip_runtime.h>
#include <hip/hip_cooperative_groups.h>
#include <hip/hip_bf16.h>
#include <cstdio>
#include <cstdint>
#include <cmath>
namespace cg = cooperative_groups;

constexpr int DMODEL = 1024, PSEQ = 8192, PB = 8, MP = PB * PSEQ  , SBATCH = 32, SSEQ = 16, MS = SBATCH * SSEQ  , MT = MP + MS  ;
constexpr int PAST = 4096, NIN = 4352  , DFF = 4096, DMIX = 1536, DCONV = 1536;
constexpr float EPSN = 1e-6f, L2E = 1.4426950408889634f;
constexpr size_t O_Y = 0, O_PK = 67633152, O_PV = 101187584, O_PLF = 134742016, O_PSSM = 135266304, O_PCONV = 136314880, O_SK = 136351744, O_SV = 136613888,
                 O_SLF = 136876032, O_SSSM = 136880128, O_SCONV = 141074432, O_END = 141221888;
constexpr size_t MiB = 1u << 20;
constexpr size_t WS_CTR = 1120 * 1024, WS_SS1 = 0, WS_GSS = 512 * 1024, WS_DAT = 1088 * 1024, WS_CP = 2 * MiB, WS_WIN = 4 * MiB, WS_WOUT = WS_WIN + 8704 * 1024, WS_WUP = WS_WOUT + 3 * MiB, WS_WDN = WS_WUP + 8 * MiB;
constexpr size_t WS_XN = 32 * MiB, WS_DT = 161 * MiB, WS_SL = 166 * MiB, WS_ZS = 294 * MiB, WS_XBC = 423 * MiB, WS_QB = 617 * MiB, WS_KB = 682 * MiB, WS_VB = 747 * MiB, WS_MIX = 812 * MiB,
                 WS_H = 294 * MiB, WS_HIST = 1006 * MiB, WS_GSSP = 1012 * MiB, WS_SS1P = 1014 * MiB, WS_END = 1019 * MiB;
static_assert(WS_WDN + 8 * MiB <= WS_XN && WS_XN + (size_t)MT * 1024 * 2 <= WS_DT && WS_DT + (size_t)MT * 64 <= WS_SL && WS_SL + 128 * MiB <= WS_ZS, "ws map 1");
static_assert(WS_ZS + (size_t)MT * 2048 <= WS_XBC && WS_XBC + (size_t)(MT + 64) * 3072 <= WS_QB && WS_QB + (size_t)MT * 1024 <= WS_KB && WS_KB + (size_t)MT * 1024 <= WS_VB && WS_VB + (size_t)MT * 1024 <= WS_MIX, "ws map 2");
static_assert(WS_MIX + (size_t)MT * 3072 <= WS_END && WS_H + (size_t)MT * 8192 <= WS_MIX, "ws map 3");

typedef unsigned short bf16_t;
typedef short bf16x8 __attribute__((ext_vector_type(8)));
typedef float f32x4 __attribute__((ext_vector_type(4)));
typedef float f32x16 __attribute__((ext_vector_type(16)));
typedef unsigned u32x4 __attribute__((ext_vector_type(4)));
typedef unsigned u32x2 __attribute__((ext_vector_type(2)));
typedef float f32x2_t_ __attribute__((ext_vector_type(2)));
typedef __bf16 bf16x2_t_ __attribute__((ext_vector_type(2)));
__device__ __forceinline__ unsigned cvtpk(float lo, float hi) { f32x2_t_ v = {lo, hi}; bf16x2_t_ b = __builtin_convertvector(v, bf16x2_t_); return __builtin_bit_cast(unsigned, b); }
__device__ __forceinline__ float bf2f(unsigned u16) { return __uint_as_float(u16 << 16); }
__device__ __forceinline__ float silu_f(float v) { return v * __builtin_amdgcn_rcpf(1.0f + __expf(-v)); }
__device__ __forceinline__ float softplus_f(float v) { return v > 20.f ? v : log1pf(__expf(v)); }
__device__ __forceinline__ float logsigmoid_f(float v) { return fminf(v, 0.f) - log1pf(__expf(-fabsf(v))); }
__device__ __forceinline__ int crow_(int r, int hi) { return (r & 3) + 8 * (r >> 2) + 4 * hi; }
__device__ __forceinline__ void gatomic_add(float* p, float v) { (void)__builtin_amdgcn_global_atomic_fadd_f32((__attribute__((address_space(1))) float*)p, v); }
namespace pg8 {
#define PG8_LAS __attribute__((address_space(3)))
typedef unsigned short bf16_t;
typedef short bf16x8 __attribute__((ext_vector_type(8)));
typedef float f32x4 __attribute__((ext_vector_type(4)));
typedef unsigned u32x4 __attribute__((ext_vector_type(4)));
constexpr int BM = 256, BK = 64, HALF = 128, HTB = HALF * BK * 2  , STAGE_BYTES = 8 * HTB, NXCD = 8, WGM = 8;

__host__ __device__ __forceinline__ int lds_byte(int r, int c) { const int st = (r >> 4) * 2 + (c >> 5), rr = r & 15, cc = c & 31, ob = rr * 64 + cc * 2; return st * 1024 + (ob ^ (((ob >> 9) & 1) << 5)); }
__host__ __device__ __forceinline__ void stage_rc(int b, int& R, int& C) { const int st = b / 1024, sb = b % 1024, swz = sb ^ (((sb >> 9) & 1) << 5); R = (st >> 1) * 16 + swz / 64; C = (st & 1) * 32 + (swz % 64) / 2; }
__host__ __device__ __forceinline__ int perm32(int rho) { const int n = rho >> 4, i = rho & 15; return 8 * (i >> 2) + 4 * n + (i & 3); }

struct Unit { int pm, pn, k0; };
struct Gemm { const bf16_t* A; const bf16_t* Bt; int M, N, K, nt; };

struct StaticOrder {
    int nM, nN, nwg, G, c;
    __host__ __device__ void init(int M, int N, int G_, int c_) { nM = M / BM; nN = N / BM; nwg = nM * nN; G = G_; c = c_; }
    __host__ __device__ bool next(int i, Unit& u) const {
        const long L = (long)i * G + c; if (L >= nwg) return false;
        int wgid = (int)L; { const int q = nwg / NXCD, r = nwg % NXCD, xcd = wgid % NXCD, off = wgid / NXCD; wgid = (xcd < r ? xcd * (q + 1) : r * (q + 1) + (xcd - r) * q) + off; }
        const int nig = WGM * nN, gid = wgid / nig, fm = gid * WGM, gsz = (nM - fm) < WGM ? (nM - fm) : WGM;
        u.pm = fm + ((wgid % nig) % gsz); u.pn = (wgid % nig) / gsz; u.k0 = 0; return true;
    }
    __device__ __forceinline__ void a_ready(const Unit&) const {}
    __device__ __forceinline__ void done(const Unit&) const {}
};

struct ListOrder {
    int G, c, count, ntiles, pm0, npn, ksplit;
    __device__ __forceinline__ bool next(int i, Unit& u) const { const int L = i * G + c; if (L >= count) return false; const int tile = L % ntiles, ks = L / ntiles; u.pm = pm0 + tile / npn; u.pn = tile % npn; u.k0 = ks * ksplit; return true; }
    __device__ __forceinline__ void a_ready(const Unit&) const {}
    __device__ __forceinline__ void done(const Unit&) const {}
};

__device__ __forceinline__ void st_bf16x8(bf16_t* p, f32x4 a, f32x4 b) { u32x4 w; w.x = cvtpk(a[0], a[1]); w.y = cvtpk(a[2], a[3]); w.z = cvtpk(b[0], b[1]); w.w = cvtpk(b[2], b[3]); *(u32x4*)p = w; }
struct EpiIn {
    static constexpr bool PERM = true, AFTER_DRAIN = false, KHOOK = false;
    bf16_t *Zs, *XBC, *Qb, *Kb, *Vb; float* DT; float* out; const float *dt_bias, *f_bias, *qw, *kw; bf16_t* HIST;
    __device__ __forceinline__ void operator()(const f32x4 (&acc)[2][2][4][2], const Unit& u, int wr, int wc, int fr, int fq) const {
        const int pn = u.pn; const int lc = pn * 256 + wc * 64 + fq * 8;
        if (pn < 10) {
#pragma unroll
            for (int ai = 0; ai < 2; ++ai)
#pragma unroll
                for (int m = 0; m < 4; ++m) { const int row = u.pm * BM + ai * HALF + wr * 64 + m * 16 + fr;
#pragma unroll
                    for (int bj = 0; bj < 2; ++bj) { f32x4 v0 = acc[ai][bj][m][0], v1 = acc[ai][bj][m][1];
                        if (pn < 4) {
#pragma unroll
                            for (int e = 0; e < 4; ++e) { v0[e] = silu_f(v0[e]); v1[e] = silu_f(v1[e]); }
                            st_bf16x8(Zs + row * 1024 + lc + 32 * bj, v0, v1);
                        } else { const int c = lc - 1024 + 32 * bj;
                            st_bf16x8(XBC + row * 1536 + c, v0, v1);
                            if (row < MP && (row & 127) >= 125) st_bf16x8(HIST + ((row >> 7) * 3 + ((row & 127) - 125)) * DCONV + c, v0, v1);
                            float* cs = nullptr;
                            if (row < MP) { const int t = (int)(row & (PSEQ - 1)); if (t >= PSEQ - 3) cs = out + O_PCONV + ((row >> 13) * 3 + (t - (PSEQ - 3))) * DCONV + c; }
                            else { const int sr = (int)(row - MP), t = sr & 15; if (t >= 13) cs = out + O_SCONV + ((sr >> 4) * 3 + (t - 13)) * DCONV + c; }
                            if (cs) { *(f32x4*)cs = v0; *(f32x4*)(cs + 4) = v1; } } } }
        } else if (pn < 14) {
            const bool isq = pn < 12; const float* w = isq ? qw : kw; const int hcol = lc - (isq ? 2560 : 3072);
#pragma unroll
            for (int ai = 0; ai < 2; ++ai)
#pragma unroll
                for (int m = 0; m < 4; ++m) { const int row = u.pm * BM + ai * HALF + wr * 64 + m * 16 + fr; float ss = 0.f;
#pragma unroll
                    for (int bj = 0; bj < 2; ++bj)
#pragma unroll
                        for (int n = 0; n < 2; ++n) { const f32x4 x = acc[ai][bj][m][n]; ss += (x[0] * x[0] + x[1] * x[1]) + (x[2] * x[2] + x[3] * x[3]); }
                    ss += __shfl_xor(ss, 16); ss += __shfl_xor(ss, 32);
                    const float rs = rsqrtf(ss * (1.0f / 64.0f) + EPSN); const float rq = isq ? rs * (0.125f * L2E) : rs;
#pragma unroll
                    for (int bj = 0; bj < 2; ++bj) { const f32x4 o0 = acc[ai][bj][m][0] * *(const f32x4*)(w + 32 * bj + 8 * fq), o1 = acc[ai][bj][m][1] * *(const f32x4*)(w + 32 * bj + 8 * fq + 4);
                        st_bf16x8((isq ? Qb : Kb) + row * 512 + hcol + 32 * bj, o0 * rq, o1 * rq);
                        if (!isq) { float* kp = (row < MP ? out + O_PK + row * 512 : out + O_SK + (row - MP) * 512) + hcol + 32 * bj; *(f32x4*)kp = o0 * rs; *(f32x4*)(kp + 4) = o1 * rs; } } }
        } else if (pn < 16) {
            const int hcol = lc - 3584;
#pragma unroll
            for (int ai = 0; ai < 2; ++ai)
#pragma unroll
                for (int m = 0; m < 4; ++m) { const int row = u.pm * BM + ai * HALF + wr * 64 + m * 16 + fr;
#pragma unroll
                    for (int bj = 0; bj < 2; ++bj) { const f32x4 v0 = acc[ai][bj][m][0], v1 = acc[ai][bj][m][1];
                        st_bf16x8(Vb + row * 512 + hcol + 32 * bj, v0, v1);
                        float* vp = (row < MP ? out + O_PV + row * 512 : out + O_SV + (row - MP) * 512) + hcol + 32 * bj; *(f32x4*)vp = v0; *(f32x4*)(vp + 4) = v1; } }
        } else {
            if (wc == 0 && fq < 3) {
                const f32x4 b0 = fq < 2 ? *(const f32x4*)(dt_bias + 8 * fq) : *(const f32x4*)(f_bias), b1 = fq < 2 ? *(const f32x4*)(dt_bias + 8 * fq + 4) : *(const f32x4*)(f_bias + 4);
#pragma unroll
                for (int ai = 0; ai < 2; ++ai)
#pragma unroll
                    for (int m = 0; m < 4; ++m) { const int row = u.pm * BM + ai * HALF + wr * 64 + m * 16 + fr;
                        f32x4 v0 = acc[ai][0][m][0] + b0, v1 = acc[ai][0][m][1] + b1;
                        if (fq < 2) {
#pragma unroll
                            for (int e = 0; e < 4; ++e) { v0[e] = softplus_f(v0[e]); v1[e] = softplus_f(v1[e]); }
                            float* dp = DT + row * 16 + 8 * fq; *(f32x4*)dp = v0; *(f32x4*)(dp + 4) = v1;
                        } else {
#pragma unroll
                            for (int e = 0; e < 4; ++e) { v0[e] = logsigmoid_f(v0[e]); v1[e] = logsigmoid_f(v1[e]); }
                            float* lp = (row < MP ? out + O_PLF + row * 8 : out + O_SLF + (row - MP) * 8); *(f32x4*)lp = v0; *(f32x4*)(lp + 4) = v1; } }
            }
        }
    }
};
struct EpiOut {
    static constexpr bool PERM = true, AFTER_DRAIN = false, KHOOK = true;
    const float *xp, *xs; float* Y; bf16_t* X1b; float* SS1; const float* GSS;
    __device__ __forceinline__ void khook(f32x4 (&acc)[2][2][4][2], const Unit& u, int t, int wr, int fr) const {
#pragma unroll
        for (int ai = 0; ai < 2; ++ai)
#pragma unroll
            for (int m = 0; m < 4; ++m) { const int row = u.pm * BM + ai * HALF + wr * 64 + m * 16 + fr;
                const f32x4 gp = *(const f32x4*)(GSS + (unsigned)(row * 4)); const float g0 = gp[0] + gp[1], g1 = gp[2] + gp[3];
                const float r0 = rsqrtf(g0 * (1.0f / 512.0f) + EPSN), r1 = rsqrtf(g1 * (1.0f / 512.0f) + EPSN);
                const float f = (t == 8) ? r0 / r1 : r1;
#pragma unroll
                for (int bj = 0; bj < 2; ++bj)
#pragma unroll
                    for (int n = 0; n < 2; ++n) acc[ai][bj][m][n] *= f; }
    }
    __device__ __forceinline__ void operator()(const f32x4 (&acc)[2][2][4][2], const Unit& u, int wr, int wc, int fr, int fq) const {
        const int col0 = u.pn * BM + wc * 32 + 8 * fq; float ssv[8];
#pragma unroll
        for (int ai = 0; ai < 2; ++ai)
#pragma unroll
            for (int m = 0; m < 4; ++m) { const int row = u.pm * BM + ai * HALF + wr * 64 + m * 16 + fr;
                const float* xr = row < MP ? xp + row * 1024 : xs + (row - MP) * 1024; float ss = 0.f;
#pragma unroll
                for (int bj = 0; bj < 2; ++bj) { const int c = col0 + bj * HALF;
                    const f32x4 o0 = *(const f32x4*)(xr + c) + acc[ai][bj][m][0], o1 = *(const f32x4*)(xr + c + 4) + acc[ai][bj][m][1];
                    *(f32x4*)(Y + row * 1024 + c) = o0; *(f32x4*)(Y + row * 1024 + c + 4) = o1; st_bf16x8(X1b + row * 1024 + c, o0, o1);
                    ss += (o0[0] * o0[0] + o0[1] * o0[1]) + (o0[2] * o0[2] + o0[3] * o0[3]) + (o1[0] * o1[0] + o1[1] * o1[1]) + (o1[2] * o1[2] + o1[3] * o1[3]); }
                ss += __shfl_xor(ss, 16); ss += __shfl_xor(ss, 32);
                ssv[ai * 4 + m] = ss; }
        if (fq == 0) {
#pragma unroll
            for (int ai = 0; ai < 2; ++ai)
#pragma unroll
                for (int m = 0; m < 4; ++m) SS1[(unsigned)((u.pm * BM + ai * HALF + wr * 64 + m * 16 + fr) * 16 + u.pn * 4 + wc)] = ssv[ai * 4 + m]; }
    }
};
struct EpiUp {
    static constexpr bool PERM = true, AFTER_DRAIN = false, KHOOK = false;
    const float* SS1; bf16_t* H;
    __device__ __forceinline__ void operator()(const f32x4 (&acc)[2][2][4][2], const Unit& u, int wr, int wc, int fr, int fq) const {
        const int col0 = u.pn * BM + wc * 32 + 8 * fq;
#pragma unroll
        for (int ai = 0; ai < 2; ++ai)
#pragma unroll
            for (int m = 0; m < 4; ++m) { const int row = u.pm * BM + ai * HALF + wr * 64 + m * 16 + fr;
                const f32x4 s0 = *(const f32x4*)(SS1 + (unsigned)(row * 16)), s1 = *(const f32x4*)(SS1 + (unsigned)(row * 16 + 4)), s2 = *(const f32x4*)(SS1 + (unsigned)(row * 16 + 8)), s3 = *(const f32x4*)(SS1 + (unsigned)(row * 16 + 12));
                const f32x4 st = (s0 + s1) + (s2 + s3); const float r2 = 1.0f / (((st[0] + st[1]) + (st[2] + st[3])) * (1.0f / 1024.0f) + EPSN);
#pragma unroll
                for (int bj = 0; bj < 2; ++bj) { f32x4 v0 = acc[ai][bj][m][0], v1 = acc[ai][bj][m][1];
#pragma unroll
                    for (int e = 0; e < 4; ++e) { const float a = fmaxf(v0[e], 0.f), b = fmaxf(v1[e], 0.f); v0[e] = a * a * r2; v1[e] = b * b * r2; }
                    st_bf16x8(H + row * DFF + col0 + bj * HALF, v0, v1); } }
    }
};
struct EpiDown {
    static constexpr bool PERM = true, AFTER_DRAIN = false, KHOOK = false;
    float* Y;
    __device__ __forceinline__ void operator()(const f32x4 (&acc)[2][2][4][2], const Unit& u, int wr, int wc, int fr, int fq) const {
        const int col0 = u.pn * BM + wc * 32 + 8 * fq;
#pragma unroll
        for (int ai = 0; ai < 2; ++ai)
#pragma unroll
            for (int m = 0; m < 4; ++m) { const int row = u.pm * BM + ai * HALF + wr * 64 + m * 16 + fr;
#pragma unroll
                for (int bj = 0; bj < 2; ++bj) { float* p = Y + row * 1024 + col0 + bj * HALF;
                    const f32x4 o0 = *(const f32x4*)p + acc[ai][bj][m][0], o1 = *(const f32x4*)(p + 4) + acc[ai][bj][m][1]; *(f32x4*)p = o0; *(f32x4*)(p + 4) = o1; } }
    }
};
struct EpiDownPartial {
    static constexpr bool PERM = true, AFTER_DRAIN = false, KHOOK = false;
    float* PART;
    __device__ __forceinline__ void operator()(const f32x4 (&acc)[2][2][4][2], const Unit& u, int wr, int wc, int fr, int fq) const {
        const int col0 = u.pn * BM + wc * 32 + 8 * fq;
#pragma unroll
        for (int ai = 0; ai < 2; ++ai)
#pragma unroll
            for (int m = 0; m < 4; ++m) { const int row = (u.pm - MP / 256) * BM + ai * HALF + wr * 64 + m * 16 + fr;
#pragma unroll
                for (int bj = 0; bj < 2; ++bj) { float* p = PART + (unsigned)(row * 1024 + col0 + bj * HALF); *(f32x4*)p = acc[ai][bj][m][0]; *(f32x4*)(p + 4) = acc[ai][bj][m][1]; } }
    }
};
template <class Epi, class Sched, bool ALIGN_EPI = false, bool SP2 = false>
__device__ __forceinline__ void gemm_phase(PG8_LAS unsigned char* lds, const Gemm g, const Sched& S, const Epi& E) {
    int tid_ = threadIdx.x; asm volatile("" : "+v"(tid_));
    const int tid = tid_, wid = __builtin_amdgcn_readfirstlane(tid >> 6), lane = tid & 63, wr = wid >> 2, wc = wid & 3, fr = lane & 15, fq = lane >> 4;
    const int K = g.K; int nt_ = g.nt ? g.nt : K / BK; asm volatile("" : "+s"(nt_)); const int nt = nt_;
    unsigned voffA[2], voffB[2];
#pragma unroll
    for (int i = 0; i < 2; ++i) { int R, C; stage_rc(tid * 16 + i * 8192, R, C); const int Rb = Epi::PERM ? ((R & ~31) + perm32(R & 31)) : R;
        voffA[i] = (unsigned)(R * K + C) * 2u; voffB[i] = (unsigned)(Rb * K + C) * 2u; }
    const size_t kstep = (size_t)(BK * 2);
    const size_t hstep = (size_t)HALF * K * 2;
    const size_t tstep = 2 * hstep;
    const unsigned ldsw = (unsigned)wid * 1024u;
    const int aoff = lds_byte(wr * 64 + fr, fq * 8), boff = lds_byte(wc * 32 + fr, fq * 8);
#define PG8_SA(b, h) (((b) * 2 + (h)) * HTB)
#define PG8_SB(b, h) ((4 + (b) * 2 + (h)) * HTB)
#define PG8_STAGE(bufoff, gbase, voff) do { _Pragma("unroll") for (int _i = 0; _i < 2; ++_i) \
        __builtin_amdgcn_global_load_lds((const unsigned*)((const char*)(gbase) + (voff)[_i]), (PG8_LAS unsigned*)(lds + (bufoff) + ldsw + _i * 8192), 16, 0, 0); } while (0)
#define PG8_LDA(dst, b, h) do { _Pragma("unroll") for (int m = 0; m < 4; ++m) _Pragma("unroll") for (int k = 0; k < 2; ++k) dst[m][k] = *(const PG8_LAS bf16x8*)(lds + PG8_SA(b, h) + aoff + m * 2048 + k * 1024); } while (0)
#define PG8_LDB(dst, b, h) do { _Pragma("unroll") for (int n = 0; n < 2; ++n) _Pragma("unroll") for (int k = 0; k < 2; ++k) dst[n][k] = *(const PG8_LAS bf16x8*)(lds + PG8_SB(b, h) + boff + n * 2048 + k * 1024); } while (0)
#define PG8_MMA(ai, bj, At, Bt) do { __builtin_amdgcn_s_setprio(1); _Pragma("unroll") for (int m = 0; m < 4; ++m) _Pragma("unroll") for (int n = 0; n < 2; ++n) _Pragma("unroll") for (int k = 0; k < 2; ++k) \
        acc[ai][bj][m][n] = __builtin_amdgcn_mfma_f32_16x16x32_bf16(Bt[n][k], At[m][k], acc[ai][bj][m][n], 0, 0, 0); __builtin_amdgcn_s_setprio(0); } while (0)
#define PG8_WAIT_V(n) asm volatile("s_waitcnt vmcnt(" #n ")" ::: "memory")
#define PG8_WAIT_L(n) asm volatile("s_waitcnt lgkmcnt(" #n ")" ::: "memory")
#define PG8_BAR __builtin_amdgcn_s_barrier()
#define PG8_SCHED __builtin_amdgcn_sched_barrier(0)
    Unit cur, nxt; int ui = 0;
    if (!S.next(0, cur)) return;
    f32x4 acc[2][2][4][2];
#pragma unroll
    for (int a = 0; a < 2; ++a)
#pragma unroll
        for (int b = 0; b < 2; ++b)
#pragma unroll
            for (int m = 0; m < 4; ++m)
#pragma unroll
                for (int n = 0; n < 2; ++n) acc[a][b][m][n] = (f32x4){0.f, 0.f, 0.f, 0.f};
    bf16x8 At[4][2], B0[2][2], B1[2][2];
    const char* cA = (const char*)g.A + (size_t)cur.pm * tstep + (size_t)cur.k0 * 2; const char* cB = (const char*)g.Bt + (size_t)cur.pn * tstep + (size_t)cur.k0 * 2;
    S.a_ready(cur);
    if constexpr (SP2) {
        PG8_STAGE(PG8_SB(0, 0), cB, voffB); PG8_STAGE(PG8_SB(0, 1), cB + hstep, voffB); PG8_STAGE(PG8_SA(0, 0), cA, voffA); PG8_STAGE(PG8_SA(0, 1), cA + hstep, voffA);
        if (wr == 1) PG8_BAR;
        PG8_WAIT_V(2); PG8_BAR;
        PG8_STAGE(PG8_SB(1, 0), cB + kstep, voffB); PG8_STAGE(PG8_SA(1, 0), cA + kstep, voffA); PG8_STAGE(PG8_SB(1, 1), cB + hstep + kstep, voffB);
        PG8_WAIT_V(6); PG8_BAR;
    } else {
        PG8_STAGE(PG8_SB(0, 0), cB, voffB); PG8_STAGE(PG8_SA(0, 0), cA, voffA); PG8_STAGE(PG8_SB(0, 1), cB + hstep, voffB); PG8_STAGE(PG8_SA(0, 1), cA + hstep, voffA);
        if (wr == 1) PG8_BAR;
        PG8_WAIT_V(4); PG8_BAR;
        PG8_STAGE(PG8_SB(1, 0), cB + kstep, voffB); PG8_STAGE(PG8_SA(1, 0), cA + kstep, voffA); PG8_STAGE(PG8_SB(1, 1), cB + hstep + kstep, voffB);
        PG8_WAIT_V(6); PG8_BAR;
    }
    for (;;) {
        const bool has_next = S.next(ui + 1, nxt);
        const char* nA = has_next ? (const char*)g.A + (size_t)nxt.pm * tstep + (size_t)nxt.k0 * 2 : cA; const char* nB = has_next ? (const char*)g.Bt + (size_t)nxt.pn * tstep + (size_t)nxt.k0 * 2 : cB;
        for (int t = 0; t < nt; t += 2) {
            if constexpr (Epi::KHOOK) { if (t == 8 || t == 16) E.khook(acc, cur, t, wr, fr); }
            const bool last = (t == nt - 2);
            const char* a1 = cA + (size_t)(t + 1) * kstep;
            const char* a2 = last ? nA : cA + (size_t)(t + 2) * kstep; const char* b2 = last ? nB : cB + (size_t)(t + 2) * kstep;
            const char* a3 = a2 + kstep; const char* b3 = b2 + kstep;
            if (last && has_next) S.a_ready(nxt);
            if constexpr (SP2) {
            PG8_LDB(B0, 0, 0); PG8_LDB(B1, 0, 1); PG8_SCHED; PG8_LDA(At, 0, 0); PG8_STAGE(PG8_SA(1, 1), a1 + hstep, voffA);
            PG8_WAIT_V(8); PG8_WAIT_L(0); PG8_BAR; PG8_MMA(0, 0, At, B0); PG8_MMA(0, 1, At, B1); PG8_BAR; PG8_SCHED;
            PG8_LDA(At, 0, 1); PG8_STAGE(PG8_SB(0, 0), b2, voffB); PG8_STAGE(PG8_SB(0, 1), b2 + hstep, voffB); PG8_STAGE(PG8_SA(0, 0), a2, voffA);
            PG8_WAIT_V(8); PG8_WAIT_L(0); PG8_BAR; PG8_MMA(1, 0, At, B0); PG8_MMA(1, 1, At, B1); PG8_BAR; PG8_SCHED;
            PG8_LDB(B0, 1, 0); PG8_LDB(B1, 1, 1); PG8_SCHED; PG8_LDA(At, 1, 0); PG8_STAGE(PG8_SA(0, 1), a2 + hstep, voffA);
            PG8_WAIT_V(8); PG8_WAIT_L(0); PG8_BAR; PG8_MMA(0, 0, At, B0); PG8_MMA(0, 1, At, B1); PG8_BAR; PG8_SCHED;
            PG8_LDA(At, 1, 1); PG8_STAGE(PG8_SB(1, 0), b3, voffB); PG8_STAGE(PG8_SB(1, 1), b3 + hstep, voffB); PG8_STAGE(PG8_SA(1, 0), a3, voffA);
            PG8_WAIT_V(8); PG8_WAIT_L(0); PG8_BAR; PG8_MMA(1, 0, At, B0); PG8_MMA(1, 1, At, B1); PG8_BAR; PG8_SCHED;
            } else {
            PG8_LDB(B0, 0, 0); PG8_SCHED; PG8_LDA(At, 0, 0); PG8_STAGE(PG8_SA(1, 1), a1 + hstep, voffA);
            PG8_WAIT_L(8); PG8_BAR; PG8_WAIT_L(0); PG8_MMA(0, 0, At, B0); PG8_BAR; PG8_SCHED;
            PG8_LDB(B1, 0, 1); PG8_STAGE(PG8_SB(0, 0), b2, voffB);
            PG8_BAR; PG8_WAIT_L(0); PG8_MMA(0, 1, At, B1); PG8_BAR;
            PG8_LDA(At, 0, 1); PG8_STAGE(PG8_SA(0, 0), a2, voffA);
            PG8_BAR; PG8_WAIT_L(0); PG8_MMA(1, 0, At, B0); PG8_BAR; PG8_SCHED;
            PG8_STAGE(PG8_SB(0, 1), b2 + hstep, voffB);
            PG8_WAIT_V(6); PG8_BAR; PG8_MMA(1, 1, At, B1); PG8_BAR;
            PG8_LDB(B0, 1, 0); PG8_SCHED; PG8_LDA(At, 1, 0); PG8_STAGE(PG8_SA(0, 1), a2 + hstep, voffA);
            PG8_WAIT_L(8); PG8_BAR; PG8_WAIT_L(0); PG8_MMA(0, 0, At, B0); PG8_BAR; PG8_SCHED;
            PG8_LDB(B1, 1, 1); PG8_STAGE(PG8_SB(1, 0), b3, voffB);
            PG8_BAR; PG8_WAIT_L(0); PG8_MMA(0, 1, At, B1); PG8_BAR;
            PG8_LDA(At, 1, 1); PG8_STAGE(PG8_SA(1, 0), a3, voffA);
            PG8_BAR; PG8_WAIT_L(0); PG8_MMA(1, 0, At, B0); PG8_BAR; PG8_SCHED;
            PG8_STAGE(PG8_SB(1, 1), b3 + hstep, voffB);
            PG8_WAIT_V(6); PG8_BAR; PG8_MMA(1, 1, At, B1); PG8_BAR;
            }
        }
        if constexpr (ALIGN_EPI) { if (wr == 0) PG8_BAR; }
        if constexpr (!Epi::AFTER_DRAIN) { E(acc, cur, wr, wc, fr, fq); S.done(cur); }
        if (!has_next) break;
#pragma unroll
        for (int a = 0; a < 2; ++a)
#pragma unroll
            for (int b = 0; b < 2; ++b)
#pragma unroll
                for (int m = 0; m < 4; ++m)
#pragma unroll
                    for (int n = 0; n < 2; ++n) acc[a][b][m][n] = (f32x4){0.f, 0.f, 0.f, 0.f};
        cur = nxt; cA = nA; cB = nB; ++ui;
        if constexpr (ALIGN_EPI) { if (wr == 1) PG8_BAR; }
    }
    PG8_WAIT_V(0);
    if constexpr (!ALIGN_EPI) { if (wr == 0) PG8_BAR; }
    PG8_BAR;
    if constexpr (Epi::AFTER_DRAIN) { E.fused(acc, cur, wr, wc, fr, fq, lds, wid, lane); S.done(cur); }
#undef PG8_SA
#undef PG8_SB
#undef PG8_STAGE
#undef PG8_LDA
#undef PG8_LDB
#undef PG8_MMA
#undef PG8_WAIT_V
#undef PG8_WAIT_L
#undef PG8_BAR
#undef PG8_SCHED
}
}
#include <hip/hip_bf16.h>
#include <cmath>
namespace attn_body {
using bf16=__hip_bfloat16;
using bf16x8=__attribute__((ext_vector_type(8)))short;
using s16x4=__attribute__((ext_vector_type(4)))short;
using f32x16=__attribute__((ext_vector_type(16)))float;
using u32x4=__attribute__((ext_vector_type(4)))unsigned;
constexpr int BATCH=8,NHEAD=8,SEQ=8192,D=64,DM=NHEAD*D,OP=1536;
constexpr int NW=8,QBLK=32,QB=QBLK*NW,KVBLK=64,NQB=SEQ/QB;
constexpr int ATTN_PITCH=DM, ATTN_UNIT_ROWS=QB;
__device__ __forceinline__ int crow(int r,int hi){return (r&3)+8*(r>>2)+4*hi;}
#define SBAR() __builtin_amdgcn_sched_barrier(0)
__device__ __forceinline__ void cmask(f32x16&p0,f32x16&p1,int jb,int qrel,int hi){
  const float NEG=-INFINITY; int kb=64*jb+4*hi;
  #pragma unroll
  for(int r=0;r<16;++r){int kv=kb+(r&3)+8*(r>>2); if(kv>qrel)p0[r]=NEG; if(kv+32>qrel)p1[r]=NEG;}
}

constexpr int NSLOT=3, SLOTB=8192;
constexpr int LDS_K=0, LDS_V=NSLOT*SLOTB, LDS_WS=2*NSLOT*SLOTB, LDS_OST=LDS_WS+NW*64*4, LDS_C=LDS_OST+NW*4096, LDS_BYTES=LDS_C+SEQ*4;
constexpr float SKIP_L2=64.0f*1.4426950408889634f;
constexpr float C2=0.125f*1.4426950408889634f;
__device__ __forceinline__ void glds16(const void*gsrc,unsigned lds_dst){unsigned keep;
  asm volatile("s_mov_b32 %0, m0\n\ts_mov_b32 m0, %2\n\ts_nop 0\n\tglobal_load_lds_dwordx4 %1, off\n\ts_mov_b32 m0, %0":"=&s"(keep):"v"(gsrc),"s"(lds_dst):"memory");}
__device__ __forceinline__ float max3f(float a,float b,float c){float r;asm("v_max3_f32 %0, %1, %2, %3":"=v"(r):"v"(a),"v"(b),"v"(c));return r;}
__device__ __forceinline__ float max2f(float a,float b){float r;asm("v_max_f32_e32 %0, %1, %2":"=v"(r):"v"(a),"v"(b));return r;}
__device__ __forceinline__ float fadd_s(float a,float b){float r;asm("v_add_f32_e32 %0, %1, %2":"=v"(r):"v"(a),"v"(b));return r;}
__device__ __forceinline__ float fsub_s(float a,float b){float r;asm("v_sub_f32_e32 %0, %1, %2":"=v"(r):"v"(a),"v"(b));return r;}
typedef float f32x2_t __attribute__((ext_vector_type(2))); typedef __bf16 bf16x2_t __attribute__((ext_vector_type(2)));
__device__ __forceinline__ unsigned cvtpk_s(float lo,float hi){f32x2_t v={lo,hi};bf16x2_t b=__builtin_convertvector(v,bf16x2_t);return __builtin_bit_cast(unsigned,b);}
#define WAIT_BAR(N) asm volatile("s_waitcnt vmcnt(" #N ") lgkmcnt(0)\n\ts_barrier":::"memory")

__device__ __forceinline__ void qkt(f32x16&p0,f32x16&p1,const char*Kslot,const bf16x8*qr,const f32x16&cin0,const f32x16&cin1,int r32,int hi){
  const char*kb=Kslot+hi*1024+r32*16;
  #pragma unroll
  for(int d0=0;d0<4;++d0){
    const bf16x8 b0=*reinterpret_cast<const bf16x8*>(kb+d0*2048);
    const bf16x8 b1=*reinterpret_cast<const bf16x8*>(kb+d0*2048+512);
    if(d0==0){p0=__builtin_amdgcn_mfma_f32_32x32x16_bf16(b0,qr[0],cin0,0,0,0);p1=__builtin_amdgcn_mfma_f32_32x32x16_bf16(b1,qr[0],cin1,0,0,0);}
    else{p0=__builtin_amdgcn_mfma_f32_32x32x16_bf16(b0,qr[d0],p0,0,0,0);p1=__builtin_amdgcn_mfma_f32_32x32x16_bf16(b1,qr[d0],p1,0,0,0);}}
}
typedef __attribute__((address_space(3))) const char* lds_cptr;
typedef short v4i16_t __attribute__((ext_vector_type(4)));
__device__ __forceinline__ void kload8(bf16x8*kf,lds_cptr kp){
  kf[0]=*(const __attribute__((address_space(3))) bf16x8*)(kp);      kf[1]=*(const __attribute__((address_space(3))) bf16x8*)(kp+512);
  kf[2]=*(const __attribute__((address_space(3))) bf16x8*)(kp+2048); kf[3]=*(const __attribute__((address_space(3))) bf16x8*)(kp+2560);
  kf[4]=*(const __attribute__((address_space(3))) bf16x8*)(kp+4096); kf[5]=*(const __attribute__((address_space(3))) bf16x8*)(kp+4608);
  kf[6]=*(const __attribute__((address_space(3))) bf16x8*)(kp+6144); kf[7]=*(const __attribute__((address_space(3))) bf16x8*)(kp+6656);
}
__device__ __forceinline__ void kload2(bf16x8*kf,lds_cptr kp,int j){ kf[2*j]=*(const __attribute__((address_space(3))) bf16x8*)(kp+j*2048); kf[2*j+1]=*(const __attribute__((address_space(3))) bf16x8*)(kp+j*2048+512); }
__device__ __forceinline__ s16x4 vtr(lds_cptr p){ return __builtin_bit_cast(s16x4,__builtin_amdgcn_ds_read_tr16_b64_v4i16((__attribute__((address_space(3))) v4i16_t*)p)); }
__device__ __forceinline__ float rowmax(const f32x16&p0,const f32x16&p1){
  float a=max3f(p0[0],p0[1],p1[0]),b=max3f(p0[2],p0[3],p1[1]);a=max3f(a,p1[2],p1[3]);
  #pragma unroll
  for(int r=4;r<16;r+=4){a=max3f(a,p0[r],p0[r+1]);b=max3f(b,p0[r+2],p0[r+3]);a=max3f(a,p1[r],p1[r+1]);b=max3f(b,p1[r+2],p1[r+3]);}
  const float m=max2f(a,b);
  auto rr=__builtin_amdgcn_permlane32_swap(__float_as_uint(m),__float_as_uint(m),false,false);
  return max2f(__uint_as_float(rr[0]),__uint_as_float(rr[1]));
}
__device__ __forceinline__ void pv(f32x16*o,int vb,bf16x8 pa0,bf16x8 pa1,bf16x8 pa2,bf16x8 pa3){
  #pragma unroll
  for(int d0=0;d0<2;++d0){s16x4 lo[4],hi[4];
    #pragma unroll
    for(int ks=0;ks<4;++ks){
      asm volatile("ds_read_b64_tr_b16 %0,%1 offset:%c2":"=&v"(lo[ks]):"v"(vb),"i"(d0*4096+ks*1024):"memory");
      asm volatile("ds_read_b64_tr_b16 %0,%1 offset:%c2":"=&v"(hi[ks]):"v"(vb),"i"(d0*4096+ks*1024+512):"memory");}
    asm volatile("s_waitcnt lgkmcnt(0)":::"memory");SBAR();
    #define PK(k) (bf16x8){lo[k][0],lo[k][1],lo[k][2],lo[k][3],hi[k][0],hi[k][1],hi[k][2],hi[k][3]}
    o[d0]=__builtin_amdgcn_mfma_f32_32x32x16_bf16(pa0,PK(0),o[d0],0,0,0);
    o[d0]=__builtin_amdgcn_mfma_f32_32x32x16_bf16(pa1,PK(1),o[d0],0,0,0);
    o[d0]=__builtin_amdgcn_mfma_f32_32x32x16_bf16(pa2,PK(2),o[d0],0,0,0);
    o[d0]=__builtin_amdgcn_mfma_f32_32x32x16_bf16(pa3,PK(3),o[d0],0,0,0);
    #undef PK
  }
}

#ifndef ATTN_STORE16
#define ATTN_STORE16(p,v) (*(u32x4*)(p)=(v))
#endif
template<int THRL> __device__ __forceinline__ void attn_unit(int b,int h,int qb,const bf16*Q,const bf16*__restrict__ K,const bf16*__restrict__ V,bf16*O,const float*__restrict__ CPL,char*shm){
  int tid_=threadIdx.x; asm volatile("":"+v"(tid_)); const int tid=tid_,lane=tid&63,r32=lane&31,hi=lane>>5; const int wid=__builtin_amdgcn_readfirstlane(tid>>6);
  const long rowbase=(long)b*SEQ; const int q0=qb*QB;
  const bf16*Qw=Q+(rowbase+q0+wid*QBLK)*DM+h*D;
  const float*cg=CPL+((long)(b*NHEAD+h))*SEQ; const int NTF=(q0+QB)/KVBLK; int tst;
  { const float c0=cg[q0]; const int t1=lane,t2=lane+64;
    const bool s1=(t1<NTF-4)&&((c0-cg[64*t1+63])<-SKIP_L2), s2=(t2<NTF-4)&&((c0-cg[64*t2+63])<-SKIP_L2);
    tst=(__builtin_popcountll(__ballot(s1))+__builtin_popcountll(__ballot(s2)))&~1; tst=__builtin_amdgcn_readfirstlane(tst); }
  const bf16*Kh=K+(rowbase+(long)tst*KVBLK)*DM+h*D,*Vh=V+(rowbase+(long)tst*KVBLK)*DM+h*D;
  const unsigned lds0=(unsigned)(uintptr_t)shm;
  float*wsf=(float*)(shm+LDS_WS)+wid*64;
  const bf16*ksrc=Kh+(long)lane*DM+wid*8;
  const bf16*vsrc=Vh+(long)(16*(wid&3)+(lane>>2))*DM+(wid>>2)*32+(lane&3)*8;
  const unsigned kdst=lds0+LDS_K+wid*1024, vdst=lds0+LDS_V+wid*1024;
  #define DMA_K(t,slot) glds16(ksrc+(long)(t)*KVBLK*DM,(unsigned)__builtin_amdgcn_readfirstlane(kdst+(slot)))
  #define DMA_V(t,slot) glds16(vsrc+(long)(t)*KVBLK*DM,(unsigned)__builtin_amdgcn_readfirstlane(vdst+(slot)))
  const int vb0=(int)(lds0+LDS_V)+((lane>>4)&1)*32+(lane&3)*8+(4*hi+((lane&15)>>2))*64;
  const char*Kbase=shm+LDS_K; bf16x8 kf[8];
  const lds_cptr shm3=(lds_cptr)shm; const lds_cptr kp0=shm3+LDS_K+hi*1024+r32*16; const lds_cptr vp0=shm3+LDS_V+((lane>>4)&1)*32+(lane&3)*8+(4*hi+((lane&15)>>2))*64;
  const int NT=NTF-tst;
  float*cL=(float*)(shm+LDS_C);
  for(int i=tid;i<NT*KVBLK/4;i+=NW*64){ *(float4*)(cL+4*i)=*(const float4*)(cg+tst*KVBLK+4*i); }
  const float cq=cg[q0+wid*QBLK+r32]; float qm=cq;
  asm volatile("s_waitcnt vmcnt(0) lgkmcnt(0)":::"memory");
  DMA_K(0,0);DMA_V(0,0);DMA_K(1,SLOTB);
  bf16x8 qr[4];
  #pragma unroll
  for(int d0=0;d0<4;++d0)qr[d0]=*reinterpret_cast<const bf16x8*>(&Qw[(long)r32*DM+d0*16+hi*8]);
  float mhat=0.f,l_reg=0.f;f32x16 o[2];o[0]=f32x16{};o[1]=f32x16{};f32x16 cb0,cb1;
  const int qrel=wid*QBLK+r32;
  #define CBIAS(t) do{ const float*cp_=cL+(t)*KVBLK+4*hi; \
    _Pragma("unroll") for(int i_=0;i_<4;++i_){ const float4 u0_=*(const float4*)(cp_+8*i_), u1_=*(const float4*)(cp_+32+8*i_); \
      cb0[4*i_]=qm-u0_.x;cb0[4*i_+1]=qm-u0_.y;cb0[4*i_+2]=qm-u0_.z;cb0[4*i_+3]=qm-u0_.w; \
      cb1[4*i_]=qm-u1_.x;cb1[4*i_+1]=qm-u1_.y;cb1[4*i_+2]=qm-u1_.z;cb1[4*i_+3]=qm-u1_.w; } }while(0)
  #define CMASK(P0,P1,t) do{int jb_=(t)-(NT-4); if(jb_>=0)cmask(P0,P1,jb_,qrel,hi);}while(0)
  bool resc=false;
  #define START(P0,P1) do{ const float rm=rowmax(P0,P1); resc=false; \
    { const float dl=rm; mhat=fadd_s(mhat,dl); \
      _Pragma("unroll") for(int r=0;r<16;++r){P0[r]=fsub_s(P0[r],dl);P1[r]=fsub_s(P1[r],dl);} \
      qm=cq-mhat; } \
    _Pragma("unroll") for(int r=0;r<16;++r)P0[r]=__builtin_amdgcn_exp2f(P0[r]); }while(0)
  #define RESC() do{ if(resc){ asm volatile("s_waitcnt lgkmcnt(0)":::"memory"); \
      _Pragma("unroll") for(int d_=0;d_<2;++d_) _Pragma("unroll") for(int r=0;r<16;++r)o[d_][r]*=wsf[crow(r,hi)]; } }while(0)
  f32x16 pA0,pA1,pB0,pB1;
  int sl_prev=0,sl_cur=0,sl_next=SLOTB;
  #define ROT() do{sl_prev=sl_cur;sl_cur=sl_next;sl_next=(sl_next==(NSLOT-1)*SLOTB)?0:sl_next+SLOTB;}while(0)
  DMA_K(2,2*SLOTB);
  WAIT_BAR(3);
  CBIAS(0); qkt(pA0,pA1,Kbase,qr,cb0,cb1,r32,hi);asm volatile("s_nop 15\n\ts_nop 7":"+v"(pA0),"+v"(pA1));CMASK(pA0,pA1,0);
  START(pA0,pA1);
  _Pragma("unroll") for(int r=0;r<16;++r)pA1[r]=__builtin_amdgcn_exp2f(pA1[r]);
  WAIT_BAR(0);
  DMA_K(3,0);DMA_V(1,SLOTB);
  ROT();
  kload8(kf,kp0+sl_cur);
  WAIT_BAR(2);
  s16x4 vlo[8],vhi[8]; u32x4 pw0,pw1,pw2,pw3;
  #define PKW(P,B) cvtpk_s(P[B],P[B+1])
  #define PAF(k) __builtin_bit_cast(bf16x8,pw##k)
  #define VFR(i) (bf16x8){vlo[i][0],vlo[i][1],vlo[i][2],vlo[i][3],vhi[i][0],vhi[i][1],vhi[i][2],vhi[i][3]}
  #define PIN(x) asm volatile("":"+v"(x))
  #define MX3(a,b,c) __builtin_fmaxf(__builtin_fmaxf((a),(b)),(c))
  #define GAPA(MF,A0,A1,A2,A3,W0,W1,PW) do{ MF; sacc+=A0; sacc+=A1; sacc+=A2; sacc+=A3; PIN(sacc); W0; W1; PIN(PW); SBAR(); }while(0)
  #define EX(v) __builtin_amdgcn_exp2f(v)
  #define GAPB(MF,X,B) do{ MF; X[B]=EX(X[B]); X[B+1]=EX(X[B+1]); X[B+2]=EX(X[B+2]); X[B+3]=EX(X[B+3]); PIN(X); SBAR(); }while(0)
  #define VRD(i) do{ vlo[i]=vtr(vp_+(((i)>>2)*4096+((i)&3)*1024)); vhi[i]=vtr(vp_+(((i)>>2)*4096+((i)&3)*1024+512)); }while(0)
  #define KRD(G,j) do{ if(G){ kload2(kf,kp0+sl_next,j); SBAR(); } }while(0)
  #define STEP(C0,C1,P0,P1,t,GK,GV,GL) do{ SBAR(); CBIAS(t); SBAR(); \
    const lds_cptr vp_=vp0+sl_prev; \
    VRD(0); SBAR(); float sacc=(P0[0]+P0[1]); \
    GAPA(C0=__builtin_amdgcn_mfma_f32_32x32x16_bf16(kf[0],qr[0],cb0,0,0,0), P0[2],P0[3],P0[4],P0[5],     pw0[0]=PKW(P0,0), pw0[1]=PKW(P0,2), pw0); \
    VRD(4); SBAR(); GAPA(C1=__builtin_amdgcn_mfma_f32_32x32x16_bf16(kf[1],qr[0],cb1,0,0,0), P0[6],P0[7],P0[8],P0[9],     pw0[2]=PKW(P0,4), pw0[3]=PKW(P0,6), pw0); \
    VRD(1); SBAR(); GAPA(C0=__builtin_amdgcn_mfma_f32_32x32x16_bf16(kf[2],qr[1],C0,0,0,0),   P0[10],P0[11],P0[12],P0[13], pw1[0]=PKW(P0,8), pw1[1]=PKW(P0,10), pw1); \
    VRD(5); SBAR(); GAPA(C1=__builtin_amdgcn_mfma_f32_32x32x16_bf16(kf[3],qr[1],C1,0,0,0),   P0[14],P0[15],P1[0],P1[1],   pw1[2]=PKW(P0,12),pw1[3]=PKW(P0,14), pw1); \
    VRD(2); SBAR(); GAPA(C0=__builtin_amdgcn_mfma_f32_32x32x16_bf16(kf[4],qr[2],C0,0,0,0),   P1[2],P1[3],P1[4],P1[5],     pw2[0]=PKW(P1,0), pw2[1]=PKW(P1,2), pw2); \
    VRD(6); SBAR(); GAPA(C1=__builtin_amdgcn_mfma_f32_32x32x16_bf16(kf[5],qr[2],C1,0,0,0),   P1[6],P1[7],P1[8],P1[9],     pw2[2]=PKW(P1,4), pw2[3]=PKW(P1,6), pw2); \
    VRD(3); SBAR(); GAPA(C0=__builtin_amdgcn_mfma_f32_32x32x16_bf16(kf[6],qr[3],C0,0,0,0),   P1[10],P1[11],P1[12],P1[13], pw3[0]=PKW(P1,8), pw3[1]=PKW(P1,10), pw3); \
    VRD(7); SBAR(); GAPA(C1=__builtin_amdgcn_mfma_f32_32x32x16_bf16(kf[7],qr[3],C1,0,0,0),   P1[14],P1[15],0.f,0.f,       pw3[2]=PKW(P1,12),pw3[3]=PKW(P1,14), pw3); \
    l_reg+=sacc; \
    if(GK){DMA_K((t)+3,sl_cur);} if(GV){DMA_V((t)+1,sl_next);} \
    CMASK(C0,C1,t); \
    { float a=MX3(C0[0],C0[1],C1[0]),b=MX3(C0[2],C0[3],C1[1]); a=MX3(a,C1[2],C1[3]); \
      _Pragma("unroll") for(int r=4;r<16;r+=4){a=MX3(a,C0[r],C0[r+1]);b=MX3(b,C0[r+2],C0[r+3]);a=MX3(a,C1[r],C1[r+1]);b=MX3(b,C1[r+2],C1[r+3]);} \
      float rm=__builtin_fmaxf(a,b); { auto rr=__builtin_amdgcn_permlane32_swap(__float_as_uint(rm),__float_as_uint(rm),false,false); rm=__builtin_fmaxf(__uint_as_float(rr[0]),__uint_as_float(rr[1])); } \
      resc=false; \
      if(__builtin_expect(__any(rm>(float)THRL),0)){ const float dl=__builtin_fmaxf(rm,0.f); mhat+=dl; \
        _Pragma("unroll") for(int r=0;r<16;++r){C0[r]-=dl;C1[r]-=dl;} \
        qm=cq-mhat; \
        const float f=__builtin_amdgcn_exp2f(-dl); l_reg*=f; if(hi==0)wsf[r32]=f; resc=true; } } \
    SBAR(); \
    GAPB(o[0]=__builtin_amdgcn_mfma_f32_32x32x16_bf16(PAF(0),VFR(0),o[0],0,0,0), C0,0); \
    GAPB(o[1]=__builtin_amdgcn_mfma_f32_32x32x16_bf16(PAF(0),VFR(4),o[1],0,0,0), C0,4); \
    KRD(GL,0); GAPB(o[0]=__builtin_amdgcn_mfma_f32_32x32x16_bf16(PAF(1),VFR(1),o[0],0,0,0), C0,8); \
    KRD(GL,1); GAPB(o[1]=__builtin_amdgcn_mfma_f32_32x32x16_bf16(PAF(1),VFR(5),o[1],0,0,0), C0,12); \
    KRD(GL,2); GAPB(o[0]=__builtin_amdgcn_mfma_f32_32x32x16_bf16(PAF(2),VFR(2),o[0],0,0,0), C1,0); \
    KRD(GL,3); GAPB(o[1]=__builtin_amdgcn_mfma_f32_32x32x16_bf16(PAF(2),VFR(6),o[1],0,0,0), C1,4); \
    GAPB(o[0]=__builtin_amdgcn_mfma_f32_32x32x16_bf16(PAF(3),VFR(3),o[0],0,0,0), C1,8); \
    GAPB(o[1]=__builtin_amdgcn_mfma_f32_32x32x16_bf16(PAF(3),VFR(7),o[1],0,0,0), C1,12); \
    }while(0)
  int t=1;
  #undef CMASK
  #define CMASK(P0,P1,t) do{}while(0)
  for(;t+5<NT;t+=2){
    STEP(pB0,pB1,pA0,pA1,t,true,true,true);     WAIT_BAR(2); RESC(); ROT();
    STEP(pA0,pA1,pB0,pB1,t+1,true,true,true);   WAIT_BAR(2); RESC(); ROT();
  }
  #undef CMASK
  #define CMASK(P0,P1,t) do{int jb_=(t)-(NT-4); if(jb_>=0)cmask(P0,P1,jb_,qrel,hi);}while(0)
  #define ENDW(tt) do{ if((tt)+3<NT){WAIT_BAR(2);} else if((tt)+2<NT){WAIT_BAR(1);} else {WAIT_BAR(0);} }while(0)
  for(;t+1<NT;t+=2){
    STEP(pB0,pB1,pA0,pA1,t,(t+3<NT),(t+1<NT),(t+1<NT));       ENDW(t);   RESC(); ROT();
    STEP(pA0,pA1,pB0,pB1,t+1,(t+4<NT),(t+2<NT),(t+2<NT));     ENDW(t+1); RESC(); ROT();
  }
  STEP(pB0,pB1,pA0,pA1,NT-1,false,false,false); RESC();
  { float sacc=pB0[0]+pB0[1]; _Pragma("unroll") for(int r=2;r<16;++r)sacc+=pB0[r]; _Pragma("unroll") for(int r=0;r<16;++r)sacc+=pB1[r]; l_reg+=sacc;
    pw0=(u32x4){PKW(pB0,0),PKW(pB0,2),PKW(pB0,4),PKW(pB0,6)};pw1=(u32x4){PKW(pB0,8),PKW(pB0,10),PKW(pB0,12),PKW(pB0,14)};pw2=(u32x4){PKW(pB1,0),PKW(pB1,2),PKW(pB1,4),PKW(pB1,6)};pw3=(u32x4){PKW(pB1,8),PKW(pB1,10),PKW(pB1,12),PKW(pB1,14)};
    SBAR(); pv(o,vb0+sl_cur,PAF(0),PAF(1),PAF(2),PAF(3)); }
  #undef PKW
  #undef PAF
  #undef VFR
  #undef PIN
  #undef MX3
  #undef GAPA
  #undef GAPB
  #undef EX
  #undef VRD
  #undef KRD
  #undef STEP
  #undef ENDW
  {auto rr=__builtin_amdgcn_permlane32_swap(__float_as_uint(l_reg),__float_as_uint(l_reg),false,false);l_reg=__uint_as_float(rr[0])+__uint_as_float(rr[1]);}
  if(hi==0)wsf[32+r32]=l_reg;asm volatile("s_waitcnt lgkmcnt(0)":::"memory");
  float rli[16];
  #pragma unroll
  for(int r=0;r<16;++r)rli[r]=__builtin_amdgcn_rcpf(wsf[32+crow(r,hi)]);
  bf16*Ow=O+(rowbase+q0+wid*QBLK)*OP+h*D;
  { bf16*stg=(bf16*)(shm+LDS_OST)+wid*2048;
    #pragma unroll
    for(int r=0;r<16;++r){const int orow=crow(r,hi);
      #pragma unroll
      for(int d0=0;d0<2;++d0)stg[orow*64+d0*32+r32]=__float2bfloat16(o[d0][r]*rli[r]);}
    asm volatile("s_waitcnt lgkmcnt(0)":::"memory");
    #pragma unroll
    for(int i=0;i<4;++i){const int row=i*8+(lane>>3),ch=lane&7; const u32x4 v=*(const u32x4*)(stg+row*64+ch*8); ATTN_STORE16(Ow+(long)row*OP+ch*8,v);} }
  asm volatile("s_waitcnt lgkmcnt(0)\n\ts_barrier":::"memory");
  #undef DMA_K
  #undef DMA_V
  #undef CMASK
  #undef START
  #undef RESC
  #undef ROT
  #undef CBIAS
}
constexpr int ATTN_LDS_BYTES=LDS_BYTES;
#undef SBAR
#undef WAIT_BAR
}

namespace ssd {
constexpr int BP = 136, TP = 72, CBP = 68, SP = 136;
constexpr int L_BC = 0, L_CC = 17408, L_BT = 34816, L_CB = 53248, L_ACS = 70656, L_DT = 71680, L_ST = 72704, ST_BYTES = 8704, L_RS = L_ST + 8 * ST_BYTES, L_END = L_RS + 2048;
struct Ptrs { const bf16_t* XBC; const bf16_t* Zs; const float* DT; const float* conv_w; const float* conv_b; const float* A_log; const float* D_skip;
              const float* state_conv; const float* state_ssm; float* SL; float* dAtot; float* GSS; bf16_t* Mix; float* out; };
#define MFMA32(a, b, c) __builtin_amdgcn_mfma_f32_32x32x16_bf16((a), (b), (c), 0, 0, 0)
#define LDSFENCE() asm volatile("s_waitcnt lgkmcnt(0)" ::: "memory")

template <int MODE> __device__ __forceinline__ void unit(const Ptrs& P, unsigned char* lds, int b, int blk, int hq) {
    int tid_ = threadIdx.x; asm volatile("" : "+v"(tid_));
    const int tid = tid_, lane = tid & 63, wid = __builtin_amdgcn_readfirstlane(tid >> 6), r32 = lane & 31, hi = lane >> 5;
    const int g = hq >> 1, hl = wid >> 1, ph = wid & 1, h = hq * 4 + hl;
    constexpr int NSUB = (MODE == 2) ? 1 : 4;
    constexpr int nvalid = (MODE == 2) ? 16 : 256;
    const int row0 = (MODE == 2) ? MP + b * 16 : b * PSEQ + blk * 256;
    bf16_t* Bc = (bf16_t*)(lds + L_BC); bf16_t* Cc = (bf16_t*)(lds + L_CC); bf16_t* BT = (bf16_t*)(lds + L_BT); float* CB = (float*)(lds + L_CB);
    float* rsL = (float*)(lds + L_RS); float* acsL = (float*)(lds + L_ACS); float* dtL = (float*)(lds + L_DT); bf16_t* St = (bf16_t*)(lds + L_ST + wid * ST_BYTES);
    const int xcol = h * 64 + ph * 32 + r32;
    const int cp = tid & 127, seg = tid >> 7, ch = 2 * cp; const int scol = (ch < 128) ? 1024 + 128 * g + ch : 1280 + 128 * g + (ch - 128);
    const float Asc = -__expf(P.A_log[hq * 4 + (wid & 3)]);
    const float Dh = P.D_skip[h];
    f32x16 st[4];
    if (MODE == 0) {
#pragma unroll
        for (int nb = 0; nb < 4; ++nb) st[nb] = f32x16{};
    } else if (MODE == 1) {
        const float* sp = P.SL + ((size_t)((b * 32 + blk) * 16 + h)) * 8192 + (size_t)(ph * 4) * 1024 + lane;
#pragma unroll
        for (int nb = 0; nb < 4; ++nb)
#pragma unroll
            for (int r = 0; r < 16; ++r) st[nb][r] = sp[(nb * 16 + r) * 64];
    } else {
        const float* sp = P.state_ssm + ((size_t)(b * 16 + h) * 64 + ph * 32 + r32) * 128 + 4 * hi;
#pragma unroll
        for (int nb = 0; nb < 4; ++nb)
#pragma unroll
            for (int q4 = 0; q4 < 4; ++q4) { const f32x4 v = *(const f32x4*)(sp + 32 * nb + 8 * q4); st[nb][4 * q4] = v[0]; st[nb][4 * q4 + 1] = v[1]; st[nb][4 * q4 + 2] = v[2]; st[nb][4 * q4 + 3] = v[3]; }
    }
    float dasum = 0.f;
#pragma unroll 1
    for (int sc = 0; sc < NSUB; ++sc) {
        const int tb = 64 * sc;
        unsigned xvp[4][4];
        {
            const bf16_t* xp = P.XBC + (unsigned)((row0 + tb + 8 * hi) * DCONV + xcol);
#pragma unroll
            for (int ks = 0; ks < 4; ++ks)
#pragma unroll
                for (int i = 0; i < 4; ++i) { unsigned lo = xp[(16 * ks + 2 * i) * DCONV], hi16 = xp[(16 * ks + 2 * i + 1) * DCONV];
                    if (MODE == 2) { asm volatile("" : "+v"(lo), "+v"(hi16));     if (tb + 16 * ks + 8 * hi + 2 * i >= nvalid) lo = 0u; if (tb + 16 * ks + 8 * hi + 2 * i + 1 >= nvalid) hi16 = 0u; }
                    xvp[ks][i] = lo | (hi16 << 16); }
        }
        if (MODE != 0 || ch < 128) {
            const int t0 = tb + 16 * seg;
            const bf16_t* sp = P.XBC + (unsigned)((row0 + t0) * DCONV + scol);
            unsigned uu[16];
#pragma unroll
            for (int i = 0; i < 16; ++i) { uu[i] = *(const unsigned*)(sp + i * DCONV); if (MODE == 2) { asm volatile("" : "+v"(uu[i])); if (t0 + i >= nvalid) uu[i] = 0u; } }
            bf16_t* nat = ((ch < 128) ? Bc : Cc) + (ch & 127);
#pragma unroll
            for (int i = 0; i < 16; ++i) *(unsigned*)(nat + (16 * seg + i) * BP) = uu[i];
            if (ch < 128) {
                unsigned bt0[8], bt1[8];
#pragma unroll
                for (int i = 0; i < 8; ++i) { bt0[i] = (uu[2 * i] & 0xffffu) | (uu[2 * i + 1] << 16); bt1[i] = (uu[2 * i] >> 16) | (uu[2 * i + 1] & 0xffff0000u); }
                *(u32x4*)(BT + ch * TP + 16 * seg) = (u32x4){bt0[0], bt0[1], bt0[2], bt0[3]}; *(u32x4*)(BT + ch * TP + 16 * seg + 8) = (u32x4){bt0[4], bt0[5], bt0[6], bt0[7]};
                *(u32x4*)(BT + (ch + 1) * TP + 16 * seg) = (u32x4){bt1[0], bt1[1], bt1[2], bt1[3]}; *(u32x4*)(BT + (ch + 1) * TP + 16 * seg + 8) = (u32x4){bt1[4], bt1[5], bt1[6], bt1[7]};
            }
        }
        if (wid < 4) {
            const int t = tb + lane; const float dt = (t < nvalid) ? P.DT[(unsigned)((row0 + t) * 16 + hq * 4 + wid)] : 0.f;
            float a = dt * Asc;
#pragma unroll
            for (int o = 1; o < 64; o <<= 1) { const float v = __shfl_up(a, o); if (lane >= o) a += v; }
            acsL[wid * 64 + lane] = a; dtL[wid * 64 + lane] = dt; dasum += __shfl(a, 63);
        }
#define XV(ks, j) (((j) & 1) ? __uint_as_float(xvp[ks][(j) >> 1] & 0xffff0000u) : __uint_as_float(xvp[ks][(j) >> 1] << 16))
        __syncthreads();
        if (MODE != 0) {
            if (wid < 3) { const int lb = wid > 0 ? 1 : 0, sb = wid > 1 ? 1 : 0; f32x16 cacc = f32x16{};
#pragma unroll
                for (int ks = 0; ks < 8; ++ks) { const bf16x8 av = *(const bf16x8*)(Cc + (32 * lb + r32) * BP + 16 * ks + 8 * hi), bv = *(const bf16x8*)(Bc + (32 * sb + r32) * BP + 16 * ks + 8 * hi); cacc = MFMA32(av, bv, cacc); }
#pragma unroll
                for (int r = 0; r < 16; ++r) CB[(32 * lb + crow_(r, hi)) * CBP + 32 * sb + r32] = cacc[r]; }
            __syncthreads();
        }
        const float* acsH = acsL + hl * 64; const float* dtH = dtL + hl * 64;
        const float acs_last = acsH[63];
        if (MODE != 0) {
#pragma unroll
            for (int nb = 0; nb < 4; ++nb)
#pragma unroll
                for (int q4 = 0; q4 < 4; ++q4) *(u32x2*)(St + r32 * SP + 32 * nb + 8 * q4 + 4 * hi) = (u32x2){cvtpk(st[nb][4 * q4], st[nb][4 * q4 + 1]), cvtpk(st[nb][4 * q4 + 2], st[nb][4 * q4 + 3])};
            LDSFENCE();
#pragma unroll 1
            for (int lb = 0; lb < 2; ++lb) { if (MODE == 2 && lb == 1) continue;
                f32x16 y = f32x16{};
                unsigned short zr[16];
#pragma unroll
                for (int q4 = 0; q4 < 4; ++q4)
#pragma unroll
                    for (int e = 0; e < 4; ++e) { const int lr = 32 * lb + 8 * q4 + 4 * hi + e; const int row = row0 + tb + lr; zr[4 * q4 + e] = P.Zs[(unsigned)(row * 1024 + xcol)]; }
#pragma unroll
                for (int ks = 0; ks < 8; ++ks) { const bf16x8 av = *(const bf16x8*)(Cc + (32 * lb + r32) * BP + 16 * ks + 8 * hi), bv = *(const bf16x8*)(St + r32 * SP + 16 * ks + 8 * hi); y = MFMA32(av, bv, y); }
#pragma unroll
                for (int q4 = 0; q4 < 4; ++q4) { const f32x4 a4 = *(const f32x4*)(acsH + 32 * lb + 8 * q4 + 4 * hi);
#pragma unroll
                    for (int e = 0; e < 4; ++e) y[4 * q4 + e] *= __expf(a4[e]); }
                const int l = 32 * lb + r32; const float al = acsH[l];
#pragma unroll
                for (int ks = 0; ks < 4; ++ks) { if (ks > 2 * lb + 1) continue;
                    const int s0 = 16 * ks + 8 * hi;
                    const f32x4 c0 = *(const f32x4*)(CB + l * CBP + s0), c1 = *(const f32x4*)(CB + l * CBP + s0 + 4);
                    const f32x4 s4a = *(const f32x4*)(acsH + s0), s4b = *(const f32x4*)(acsH + s0 + 4), d4a = *(const f32x4*)(dtH + s0), d4b = *(const f32x4*)(dtH + s0 + 4);
                    float gg[8], xa[8];
#pragma unroll
                    for (int j = 0; j < 8; ++j) { const float cbv = j < 4 ? c0[j] : c1[j - 4], as = j < 4 ? s4a[j] : s4b[j - 4], dv = j < 4 ? d4a[j] : d4b[j - 4];
                        gg[j] = (s0 + j <= l) ? cbv * __expf(al - as) : 0.f; xa[j] = XV(ks, j) * dv; }
                    const u32x4 gp = {cvtpk(gg[0], gg[1]), cvtpk(gg[2], gg[3]), cvtpk(gg[4], gg[5]), cvtpk(gg[6], gg[7])};
                    const u32x4 xp = {cvtpk(xa[0], xa[1]), cvtpk(xa[2], xa[3]), cvtpk(xa[4], xa[5]), cvtpk(xa[6], xa[7])};
                    y = MFMA32(__builtin_bit_cast(bf16x8, gp), __builtin_bit_cast(bf16x8, xp), y);
                    if (ks >= 2 * lb) { float di[8];
#pragma unroll
                        for (int j = 0; j < 8; ++j) di[j] = (s0 + j == l) ? Dh : 0.f;
                        const u32x4 dp = {cvtpk(di[0], di[1]), cvtpk(di[2], di[3]), cvtpk(di[4], di[5]), cvtpk(di[6], di[7])};
                        const u32x4 xr = {xvp[ks][0], xvp[ks][1], xvp[ks][2], xvp[ks][3]};
                        y = MFMA32(__builtin_bit_cast(bf16x8, dp), __builtin_bit_cast(bf16x8, xr), y); } }
                float s2v[16];
#pragma unroll
                for (int q4 = 0; q4 < 4; ++q4)
#pragma unroll
                    for (int e = 0; e < 4; ++e) { const int r = 4 * q4 + e; const int lr = 32 * lb + 8 * q4 + 4 * hi + e; const int row = row0 + tb + lr;
                        const float yv = y[r] * bf2f(zr[r]);
                        if (MODE != 2 || q4 < 2) P.Mix[(unsigned)(row * DMIX + xcol)] = (bf16_t)(cvtpk(yv, 0.f) & 0xffffu);
                        float s2 = yv * yv;
                        s2 += __shfl_xor(s2, 1); s2 += __shfl_xor(s2, 2); s2 += __shfl_xor(s2, 4); s2 += __shfl_xor(s2, 8); s2 += __shfl_xor(s2, 16);
                        s2v[r] = s2; }
                asm volatile("" ::: "memory");
                if (r32 == 0) {
#pragma unroll
                    for (int q4 = 0; q4 < 4; ++q4)
#pragma unroll
                        for (int e = 0; e < 4; ++e) rsL[wid * 64 + 32 * lb + 8 * q4 + 4 * hi + e] = s2v[4 * q4 + e];
                }
            }
        }
        {
            const float dec = __expf(acs_last);
#pragma unroll
            for (int nb = 0; nb < 4; ++nb) st[nb] *= dec;
#pragma unroll
            for (int ks = 0; ks < 4; ++ks) { const int s0 = 16 * ks + 8 * hi;
                const f32x4 s4a = *(const f32x4*)(acsH + s0), s4b = *(const f32x4*)(acsH + s0 + 4), d4a = *(const f32x4*)(dtH + s0), d4b = *(const f32x4*)(dtH + s0 + 4);
                float xb[8];
#pragma unroll
                for (int j = 0; j < 8; ++j) { const float as = j < 4 ? s4a[j] : s4b[j - 4], dv = j < 4 ? d4a[j] : d4b[j - 4]; xb[j] = XV(ks, j) * dv * __expf(acs_last - as); }
                const u32x4 xp = {cvtpk(xb[0], xb[1]), cvtpk(xb[2], xb[3]), cvtpk(xb[4], xb[5]), cvtpk(xb[6], xb[7])};
#pragma unroll
                for (int nb = 0; nb < 4; ++nb) { const bf16x8 av = *(const bf16x8*)(BT + (32 * nb + r32) * TP + 16 * ks + 8 * hi); st[nb] = MFMA32(av, __builtin_bit_cast(bf16x8, xp), st[nb]); } }
        }
        __syncthreads();
        if (MODE != 0) { if (tid < ((MODE == 2) ? 16 : 64)) { float s = 0.f;
#pragma unroll
                for (int w = 0; w < 8; ++w) s += rsL[w * 64 + tid];
                P.GSS[(unsigned)((row0 + tb + tid) * 4 + hq)] = s; } }
    }
    if (MODE == 0) {
        float* sp = P.SL + ((size_t)((b * 32 + blk) * 16 + h)) * 8192 + (size_t)(ph * 4) * 1024 + lane;
#pragma unroll
        for (int nb = 0; nb < 4; ++nb)
#pragma unroll
            for (int r = 0; r < 16; ++r) sp[(nb * 16 + r) * 64] = st[nb][r];
        if (wid < 4 && lane == 0) P.dAtot[(b * 32 + blk) * 16 + hq * 4 + wid] = dasum;
    } else if (MODE == 2 || blk == 31) {
        float* sp = P.out + (MODE == 2 ? O_SSSM : O_PSSM) + ((size_t)(b * 16 + h) * 64 + ph * 32 + r32) * 128 + 4 * hi;
#pragma unroll
        for (int nb = 0; nb < 4; ++nb)
#pragma unroll
            for (int q4 = 0; q4 < 4; ++q4) *(f32x4*)(sp + 32 * nb + 8 * q4) = (f32x4){st[nb][4 * q4], st[nb][4 * q4 + 1], st[nb][4 * q4 + 2], st[nb][4 * q4 + 3]};
    }
}
#undef XV
}

namespace sattn {
constexpr int L_C = 0, L_M = 16640, L_L = L_M + 512, L_O = L_L + 512, OPITCH = 17, L_SCAN = L_O + 8 * 64 * OPITCH * 4, L_END = L_SCAN + 64;
struct Ptrs { const float* cache_k; const float* cache_v; const float* cache_logf; const bf16_t* Qb; const bf16_t* Kb; const bf16_t* Vb; const float* out; bf16_t* Mix; };
__device__ __forceinline__ void unit(const Ptrs& P, unsigned char* lds, int b, int h) {
    int tid_ = threadIdx.x; asm volatile("" : "+v"(tid_));
    const int tid = tid_, lane = tid & 63, wid = __builtin_amdgcn_readfirstlane(tid >> 6), r32 = lane & 31, hi = lane >> 5;
    float* cL = (float*)(lds + L_C); float* mW = (float*)(lds + L_M); float* lW = (float*)(lds + L_L); float* OW = (float*)(lds + L_O); float* wtot = (float*)(lds + L_SCAN);
    constexpr int NK = PAST + SSEQ;
    {
        float v[16]; float run = 0.f; const int s0 = 16 * tid;
#pragma unroll
        for (int i = 0; i < 16; ++i) v[i] = 0.f;
        if (tid < PAST / 16) { const float* lp = P.cache_logf + ((size_t)b * PAST + s0) * 8 + h;
#pragma unroll
            for (int i = 0; i < 16; ++i) v[i] = lp[i * 8];
        } else if (tid == PAST / 16) { const float* lp = P.out + O_SLF + ((size_t)b * 16) * 8 + h;
#pragma unroll
            for (int i = 0; i < 16; ++i) v[i] = lp[i * 8];
        }
#pragma unroll
        for (int i = 0; i < 16; ++i) run += v[i];
        float inc = run;
#pragma unroll
        for (int o = 1; o < 64; o <<= 1) { const float t = __shfl_up(inc, o); if (lane >= o) inc += t; }
        if (lane == 63) wtot[wid] = inc;
        __syncthreads();
        float off = inc - run;
        for (int w = 0; w < wid; ++w) off += wtot[w];
#pragma unroll
        for (int i = 0; i < 16; ++i) { off += v[i]; const int s = s0 + i; if (s < NK + 16) cL[s] = off * L2E; }
        __syncthreads();
    }
    const int q = r32 & 15; const long qrow = (long)MP + b * 16 + q;
    bf16x8 qf[4];
#pragma unroll
    for (int ks = 0; ks < 4; ++ks) qf[ks] = *(const bf16x8*)(P.Qb + qrow * 512 + h * 64 + 16 * ks + 8 * hi);
    const float cq = cL[PAST + q];
    float m = -1e30f, l = 0.f; f32x16 o[2]; o[0] = f32x16{}; o[1] = f32x16{};
    int tile0;
    { const float c0 = cL[PAST]; const int t1 = lane, t2 = lane + 64;
      const bool s1 = (c0 - cL[32 * t1 + 31]) < -(64.0f * L2E), s2 = (c0 - cL[32 * t2 + 31]) < -(64.0f * L2E);
      tile0 = __builtin_amdgcn_readfirstlane(__builtin_popcountll(__ballot(s1)) + __builtin_popcountll(__ballot(s2))); }
    for (int tile = tile0 + wid; tile < 129; tile += 8) {
        const int key0 = 32 * tile; const bool isnew = tile == 128;
        bf16x8 kf[4];
        if (!isnew) { const float* kp = P.cache_k + (((size_t)b * PAST + key0 + r32) * 8 + h) * 64 + 8 * hi;
#pragma unroll
            for (int ks = 0; ks < 4; ++ks) { const f32x4 a = *(const f32x4*)(kp + 16 * ks), c = *(const f32x4*)(kp + 16 * ks + 4);
                const u32x4 w = {cvtpk(a[0], a[1]), cvtpk(a[2], a[3]), cvtpk(c[0], c[1]), cvtpk(c[2], c[3])}; kf[ks] = __builtin_bit_cast(bf16x8, w); }
        } else {
#pragma unroll
            for (int ks = 0; ks < 4; ++ks) kf[ks] = *(const bf16x8*)(P.Kb + ((long)MP + b * 16 + (r32 & 15)) * 512 + h * 64 + 16 * ks + 8 * hi);
        }
        float vall[2][2][8];
        if (!isnew) {
#pragma unroll
            for (int db = 0; db < 2; ++db)
#pragma unroll
                for (int s2 = 0; s2 < 2; ++s2)
#pragma unroll
                    for (int j = 0; j < 8; ++j) { const int kv = crow_(8 * s2 + j, hi); vall[db][s2][j] = P.cache_v[(((size_t)b * PAST + key0 + kv) * 8 + h) * 64 + 32 * db + r32]; }
        } else {
#pragma unroll
            for (int db = 0; db < 2; ++db)
#pragma unroll
                for (int s2 = 0; s2 < 2; ++s2)
#pragma unroll
                    for (int j = 0; j < 8; ++j) { const int kv = crow_(8 * s2 + j, hi); vall[db][s2][j] = bf2f(P.Vb[((long)MP + b * 16 + (kv & 15)) * 512 + h * 64 + 32 * db + r32]) * (kv < 16 ? 1.f : 0.f); }
        }
        f32x16 s = f32x16{};
#pragma unroll
        for (int ks = 0; ks < 4; ++ks) s = MFMA32(kf[ks], qf[ks], s);
        float mt = -1e30f;
#pragma unroll
        for (int q4 = 0; q4 < 4; ++q4) { const f32x4 c4 = *(const f32x4*)(cL + key0 + 8 * q4 + 4 * hi);
#pragma unroll
            for (int e = 0; e < 4; ++e) { const int r = 4 * q4 + e; const int kv = 8 * q4 + 4 * hi + e; float x = s[r] + (cq - c4[e]);
                if (isnew && (kv >= 16 || kv > q)) x = -1e30f;
                s[r] = x; mt = fmaxf(mt, x); } }
        mt = fmaxf(mt, __shfl_xor(mt, 32));
        const float mn = fmaxf(m, mt), alpha = __builtin_amdgcn_exp2f(m - mn); m = mn;
        float ls = 0.f;
#pragma unroll
        for (int r = 0; r < 16; ++r) { const float p = __builtin_amdgcn_exp2f(s[r] - mn); s[r] = p; ls += p; }
        l = l * alpha + ls;
#pragma unroll
        for (int db = 0; db < 2; ++db) o[db] *= alpha;
        bf16x8 pf[2];
#pragma unroll
        for (int s2 = 0; s2 < 2; ++s2) { const u32x4 w = {cvtpk(s[8 * s2], s[8 * s2 + 1]), cvtpk(s[8 * s2 + 2], s[8 * s2 + 3]), cvtpk(s[8 * s2 + 4], s[8 * s2 + 5]), cvtpk(s[8 * s2 + 6], s[8 * s2 + 7])}; pf[s2] = __builtin_bit_cast(bf16x8, w); }
#pragma unroll
        for (int db = 0; db < 2; ++db)
#pragma unroll
            for (int s2 = 0; s2 < 2; ++s2) { const float* vv = vall[db][s2];
                const u32x4 w = {cvtpk(vv[0], vv[1]), cvtpk(vv[2], vv[3]), cvtpk(vv[4], vv[5]), cvtpk(vv[6], vv[7])};
                o[db] = MFMA32(__builtin_bit_cast(bf16x8, w), pf[s2], o[db]); }
    }
    l += __shfl_xor(l, 32);
    if (r32 < 16) { if (hi == 0) { mW[wid * 16 + r32] = m; lW[wid * 16 + r32] = l; }
#pragma unroll
        for (int db = 0; db < 2; ++db)
#pragma unroll
            for (int r = 0; r < 16; ++r) OW[(wid * 64 + 32 * db + crow_(r, hi)) * OPITCH + r32] = o[db][r]; }
    __syncthreads();
#pragma unroll
    for (int it = 0; it < 2; ++it) { const int idx = tid + 512 * it, d = idx & 63, qq = idx >> 6;
        float M = -1e30f;
#pragma unroll
        for (int w = 0; w < 8; ++w) M = fmaxf(M, mW[w * 16 + qq]);
        float L = 0.f, acc = 0.f;
#pragma unroll
        for (int w = 0; w < 8; ++w) { const float f = __builtin_amdgcn_exp2f(mW[w * 16 + qq] - M); L += lW[w * 16 + qq] * f; acc += OW[(w * 64 + d) * OPITCH + qq] * f; }
        P.Mix[((long)MP + b * 16 + qq) * DMIX + 1024 + h * 64 + d] = (bf16_t)(cvtpk(acc / L, 0.f) & 0xffffu); }
    __syncthreads();
}
}

constexpr int NWAVES = 8, LDS_BYTES = 147456;
#define LAS __attribute__((address_space(3)))
struct Args {
    const float *x_prompt, *x_sample, *cache_k, *cache_v, *cache_logf, *state_ssm, *state_conv, *norm1_w, *w_in, *conv_w, *conv_b, *dt_bias, *A_log, *D_skip, *ssd_norm_w, *f_bias,
                *q_norm_w, *k_norm_w, *w_out, *norm2_w, *w_up, *w_down;
    float* out; unsigned char* ws;
};
__device__ __forceinline__ unsigned pk2(float lo, float hi) { return cvtpk(lo, hi); }
template <int MAP> __device__ __forceinline__ void transpose_item(const float* W, int K, int Nsrc, int Nphys, bf16_t* WT, const float* ksc, int ksc_n, float* scr, int item, int lane) {
    const int nblk = Nphys / 32, kb = item / nblk, nb = item % nblk, k0 = 64 * kb, n0 = 32 * nb;
    const int n = n0 + (lane & 31); int src = n;
    if (MAP == 1) { const int L = (n & ~255) + ((n >> 5) & 3) * 64 + ((n >> 7) & 1) * 32 + (n & 31);
        if (L < 2560) src = L; else if (L < 4096) src = L + 16; else if (L < 4112) src = 2560 + (L - 4096); else if (L < 4120) src = L; else src = -1; }
#pragma unroll 8
    for (int i = 0; i < 32; ++i) { const int kk = 2 * i + (lane >> 5); float v = (src >= 0) ? W[(size_t)(k0 + kk) * Nsrc + src] : 0.f; if (ksc && (k0 + kk) < ksc_n) v *= ksc[k0 + kk]; scr[kk * 33 + (lane & 31)] = v; }
    asm volatile("s_waitcnt lgkmcnt(0)" ::: "memory");
    const int c = lane & 7;
#pragma unroll
    for (int j = 0; j < 4; ++j) { const int nn = (lane >> 3) + 8 * j; const float* s = scr + (8 * c) * 33 + nn;
        u32x4 o; o.x = pk2(s[0 * 33], s[1 * 33]); o.y = pk2(s[2 * 33], s[3 * 33]); o.z = pk2(s[4 * 33], s[5 * 33]); o.w = pk2(s[6 * 33], s[7 * 33]);
        *(u32x4*)(WT + (size_t)(n0 + nn) * K + k0 + 8 * c) = o; }
    asm volatile("s_waitcnt lgkmcnt(0)" ::: "memory");
}
__device__ __forceinline__ float wave_sum(float v) {
#pragma unroll
    for (int o = 1; o < 64; o <<= 1) v += __shfl_xor(v, o);
    return v;
}
__device__ __forceinline__ void rms_row_to_bf16(const float* xrow, bf16_t* orow, int lane) {
    const f32x4* xr = (const f32x4*)xrow + lane; f32x4 v[4]; float s = 0.f;
#pragma unroll
    for (int j = 0; j < 4; ++j) { v[j] = xr[64 * j]; s += (v[j][0] * v[j][0] + v[j][1] * v[j][1]) + (v[j][2] * v[j][2] + v[j][3] * v[j][3]); }
    const float rs = rsqrtf(wave_sum(s) * (1.0f / 1024.0f) + EPSN);
    u32x2* o8 = (u32x2*)orow + lane;
#pragma unroll
    for (int j = 0; j < 4; ++j) o8[64 * j] = (u32x2){pk2(v[j][0] * rs, v[j][1] * rs), pk2(v[j][2] * rs, v[j][3] * rs)};
}

template <int PH> __device__ __forceinline__ void run_phase(const Args& a, unsigned char* lds) {
    int tid_ = threadIdx.x; asm volatile("" : "+v"(tid_));
    const int tid = tid_, lane = tid & 63, wave = __builtin_amdgcn_readfirstlane(tid >> 6);
    int G_ = gridDim.x, bx_ = blockIdx.x; asm volatile("" : "+s"(G_), "+s"(bx_));
    const int G = G_, bx = bx_;
    unsigned char* ws = a.ws; float* out = a.out;
    float* SS1 = (float*)(ws + WS_SS1P); float* GSS = (float*)(ws + WS_GSSP); float* DAT = (float*)(ws + WS_DAT); float* CP = (float*)(ws + WS_CP);
    bf16_t* WinT = (bf16_t*)(ws + WS_WIN); bf16_t* WoutT = (bf16_t*)(ws + WS_WOUT); bf16_t* WupT = (bf16_t*)(ws + WS_WUP); bf16_t* WdnT = (bf16_t*)(ws + WS_WDN);
    bf16_t* XN = (bf16_t*)(ws + WS_XN); float* DT = (float*)(ws + WS_DT); float* SL = (float*)(ws + WS_SL); bf16_t* Zs = (bf16_t*)(ws + WS_ZS); bf16_t* XBC = (bf16_t*)(ws + WS_XBC);
    bf16_t* Qb = (bf16_t*)(ws + WS_QB); bf16_t* Kb = (bf16_t*)(ws + WS_KB); bf16_t* Vb = (bf16_t*)(ws + WS_VB); bf16_t* Mix = (bf16_t*)(ws + WS_MIX); bf16_t* Hb = (bf16_t*)(ws + WS_H);
    (void)tid; (void)lane; (void)wave; (void)SS1; (void)GSS; (void)DAT; (void)CP; (void)WinT; (void)WoutT; (void)WupT; (void)WdnT; (void)XN; (void)DT; (void)SL; (void)Zs; (void)XBC; (void)Qb; (void)Kb; (void)Vb; (void)Mix; (void)Hb; (void)out;
    if constexpr (PH == 0) {
    {
        float* scr = (float*)(lds + wave * 16384);
        const int gw = bx * NWAVES + wave, NGW = G * NWAVES;
        constexpr int I_IN = (1024 / 64) * (NIN / 32), I_OUT = (1536 / 64) * (1024 / 32), I_UP = (1024 / 64) * (4096 / 32), I_DN = (4096 / 64) * (1024 / 32);
        for (int it = gw; it < I_IN + I_OUT + I_UP + I_DN; it += NGW) {
            int r = it;
            if (r < I_IN) { transpose_item<1>(a.w_in, 1024, 4120, NIN, WinT, a.norm1_w, 1024, scr, r, lane); continue; } r -= I_IN;
            if (r < I_OUT) { transpose_item<0>(a.w_out, 1536, 1024, 1024, WoutT, a.ssd_norm_w, 1024, scr, r, lane); continue; } r -= I_OUT;
            if (r < I_UP) { transpose_item<0>(a.w_up, 1024, 4096, 4096, WupT, a.norm2_w, 1024, scr, r, lane); continue; } r -= I_UP;
            transpose_item<0>(a.w_down, 4096, 1024, 1024, WdnT, nullptr, 0, scr, r, lane);
        }
        for (int m0 = gw; m0 < MT; m0 += 4 * NGW) {
            f32x4 v[4][4]; float s[4];
#pragma unroll
            for (int r = 0; r < 4; ++r) { const int m = m0 + r * NGW; const int mc = m < MT ? m : MT - 1;
                const f32x4* xr = (const f32x4*)(mc < MP ? a.x_prompt + (size_t)mc * 1024 : a.x_sample + (size_t)(mc - MP) * 1024) + lane; s[r] = 0.f;
#pragma unroll
                for (int j = 0; j < 4; ++j) { v[r][j] = xr[64 * j]; } }
#pragma unroll
            for (int r = 0; r < 4; ++r) {
#pragma unroll
                for (int j = 0; j < 4; ++j) s[r] += (v[r][j][0] * v[r][j][0] + v[r][j][1] * v[r][j][1]) + (v[r][j][2] * v[r][j][2] + v[r][j][3] * v[r][j][3]);
                const float rs = rsqrtf(wave_sum(s[r]) * (1.0f / 1024.0f) + EPSN); const int m = m0 + r * NGW;
                if (m < MT) { u32x2* o8 = (u32x2*)(XN + (size_t)m * 1024) + lane;
#pragma unroll
                    for (int j = 0; j < 4; ++j) o8[64 * j] = (u32x2){pk2(v[r][j][0] * rs, v[r][j][1] * rs), pk2(v[r][j][2] * rs, v[r][j][3] * rs)}; } }
        }
        if (bx == 0 && tid < 64) ((unsigned*)(ws + WS_CTR))[tid] = 0u;
    }
    }
    if constexpr (PH == 1) {
    {
        pg8::Gemm g{XN, WinT, MT, NIN, 1024, 0}; pg8::StaticOrder S; S.init(MT, NIN, G, bx);
        pg8::EpiIn E{Zs, XBC, Qb, Kb, Vb, DT, out, a.dt_bias, a.f_bias, a.q_norm_w, a.k_norm_w, (bf16_t*)(ws + WS_HIST)};
        pg8::gemm_phase<pg8::EpiIn, pg8::StaticOrder, true, true>((PG8_LAS unsigned char*)lds, g, S, E);
    }
    }
    if constexpr (PH == 9) {
    {
        const bf16_t* HIST = (const bf16_t*)(ws + WS_HIST);
        constexpr int NSEG = MP / 128, NPAIR = DCONV / 2, NTASK = (NSEG + SBATCH) * NPAIR;
        for (int task = bx * 512 + tid; task < NTASK; task += G * 512) {
            const int seg = task / NPAIR, col = 2 * (task - seg * NPAIR);
            float w0[4], w1[4];
#pragma unroll
            for (int k = 0; k < 4; ++k) { w0[k] = a.conv_w[k * DCONV + col]; w1[k] = a.conv_w[k * DCONV + col + 1]; }
            const float b0 = a.conv_b[col], b1 = a.conv_b[col + 1];
            float a3 = 0.f, c3 = 0.f, a2 = 0.f, c2 = 0.f, a1 = 0.f, c1 = 0.f; int row0, n;
            if (seg < NSEG) { row0 = seg * 128; n = 128;
                if (seg & 63) { const bf16_t* hp = HIST + (unsigned)((seg - 1) * 3 * DCONV + col);
                    const unsigned u3 = *(const unsigned*)hp, u2 = *(const unsigned*)(hp + DCONV), u1 = *(const unsigned*)(hp + 2 * DCONV);
                    a3 = bf2f(u3 & 0xffffu); c3 = bf2f(u3 >> 16); a2 = bf2f(u2 & 0xffffu); c2 = bf2f(u2 >> 16); a1 = bf2f(u1 & 0xffffu); c1 = bf2f(u1 >> 16); }
            } else { const int s = seg - NSEG; row0 = MP + s * 16; n = 16; const float* hp = a.state_conv + (unsigned)(s * 3 * DCONV + col);
                a3 = hp[0]; c3 = hp[1]; a2 = hp[DCONV]; c2 = hp[DCONV + 1]; a1 = hp[2 * DCONV]; c1 = hp[2 * DCONV + 1]; }
            bf16_t* xp = XBC + (unsigned)(row0 * DCONV + col);
            for (int i0 = 0; i0 < n; i0 += 16) {
                unsigned uu[16];
#pragma unroll
                for (int i = 0; i < 16; ++i) uu[i] = *(const unsigned*)(xp + (i0 + i) * DCONV);
#pragma unroll
                for (int i = 0; i < 16; ++i) { const float a0 = bf2f(uu[i] & 0xffffu), c0 = bf2f(uu[i] >> 16);
                    const float o0 = silu_f(b0 + w0[0] * a3 + w0[1] * a2 + w0[2] * a1 + w0[3] * a0), o1 = silu_f(b1 + w1[0] * c3 + w1[1] * c2 + w1[2] * c1 + w1[3] * c0);
                    *(unsigned*)(xp + (i0 + i) * DCONV) = cvtpk(o0, o1);
                    a3 = a2; c3 = c2; a2 = a1; c2 = c1; a1 = a0; c1 = c0; }
            }
        }
        sattn::Ptrs Q{a.cache_k, a.cache_v, a.cache_logf, Qb, Kb, Vb, out, Mix};
        for (int u = G - 1 - bx; u < SBATCH * 8; u += G) sattn::unit(Q, lds, u >> 3, u & 7);
    }
    }
    if constexpr (PH == 12) {
    {
        if (G >= 128) { const f32x4* part = (const f32x4*)(ws + WS_MIX); f32x4* y = (f32x4*)(out + O_Y + (size_t)MP * 1024);
            for (int i = bx * 512 + tid; i < MS * 1024 / 4; i += G * 512) { f32x4 s = y[i];
#pragma unroll
                for (int k = 0; k < 16; ++k) s += part[(size_t)k * (MS * 1024 / 4) + i];
                y[i] = s; } }
    }
    }
    if constexpr (PH == 10) {
    {
        const int ks = bx >> 3;
        pg8::Gemm g2{Hb + ks * 256, WdnT + ks * 256, MT, 1024, DFF, 4}; pg8::ListOrder S2{G, bx, G >= 128 ? 128 : 0, 8, MP / 256, 4, 0};
        pg8::EpiDownPartial E2{(float*)(ws + WS_MIX) + (size_t)ks * (MS * 1024)};
        pg8::gemm_phase<pg8::EpiDownPartial, pg8::ListOrder, true, true>((PG8_LAS unsigned char*)lds, g2, S2, E2);
    }
    }
    if constexpr (PH == 11) {
    {
        {
            pg8::Gemm g{Mix, WoutT, MT, 1024, DMIX, 0}; pg8::ListOrder S{G, bx, 8, 8, MP / 256, 4, 0};
            pg8::EpiOut E{a.x_prompt, a.x_sample, out + O_Y, XN, SS1, GSS};
            pg8::gemm_phase<pg8::EpiOut, pg8::ListOrder, true, true>((PG8_LAS unsigned char*)lds, g, S, E);
        }
    }
    }
    if constexpr (PH == 2) {
    {
        ssd::Ptrs P{XBC, Zs, DT, a.conv_w, a.conv_b, a.A_log, a.D_skip, a.state_conv, a.state_ssm, SL, DAT, GSS, Mix, out};
        for (int u = bx; u < PB * 32 * 4; u += G) ssd::unit<0>(P, lds, u >> 7, (u >> 2) & 31, u & 3);
        for (int u = bx; u < SBATCH * 4; u += G) ssd::unit<2>(P, lds, u >> 2, 0, u & 3);
    }
    }
    if constexpr (PH == 3) {
    {
        for (int item = bx * 512 + tid; item < PB * 16 * 8192; item += G * 512) {
            const int bh = item >> 13, b = bh >> 4, h = bh & 15, e = item & 8191; float s = 0.f;
            float* sp = SL + ((size_t)(b * 32 * 16 + h)) * 8192 + e; const float* dp = DAT + b * 32 * 16 + h; float loc[32], dec[32];
#pragma unroll
            for (int blk = 0; blk < 32; ++blk) { loc[blk] = sp[(size_t)blk * 16 * 8192]; dec[blk] = dp[blk * 16]; }
#pragma unroll
            for (int blk = 0; blk < 32; ++blk) { sp[(size_t)blk * 16 * 8192] = s; s = s * __expf(dec[blk]) + loc[blk]; } }
        float* wtot = (float*)lds;
        for (int bh = bx; bh < PB * 8; bh += G) { const int b = bh >> 3, h = bh & 7;
            float v[16]; float run = 0.f; const int s0 = 16 * tid;
#pragma unroll
            for (int i = 0; i < 16; ++i) { v[i] = out[O_PLF + ((size_t)b * PSEQ + s0 + i) * 8 + h]; run += v[i]; }
            float inc = run;
#pragma unroll
            for (int o = 1; o < 64; o <<= 1) { const float t = __shfl_up(inc, o); if (lane >= o) inc += t; }
            __syncthreads();
            if (lane == 63) wtot[wave] = inc;
            __syncthreads();
            float off = inc - run;
            for (int w = 0; w < wave; ++w) off += wtot[w];
#pragma unroll
            for (int i = 0; i < 16; ++i) { off += v[i]; CP[(size_t)bh * PSEQ + s0 + i] = off * L2E; } }
    }
    }
    if constexpr (PH == 4) {
    {
        ssd::Ptrs P{XBC, Zs, DT, a.conv_w, a.conv_b, a.A_log, a.D_skip, a.state_conv, a.state_ssm, SL, DAT, GSS, Mix, out};
        for (int u = bx; u < PB * 32 * 4; u += G) ssd::unit<1>(P, lds, u >> 7, (u >> 2) & 31, u & 3);
    }
    }
    if constexpr (PH == 8) {
    {
        const attn_body::bf16* Qa = (const attn_body::bf16*)Qb; const attn_body::bf16* Ka = (const attn_body::bf16*)Kb; const attn_body::bf16* Va = (const attn_body::bf16*)Vb;
        attn_body::bf16* Oa = (attn_body::bf16*)(Mix + 1024);
        unsigned* ctr = (unsigned*)(ws + WS_CTR); int* slot = (int*)(lds + 147000);
        for (;;) {
            if (tid == 0) *slot = (int)atomicAdd(ctr, 1u);
            __syncthreads();
            const int u = *slot;
            __syncthreads();
            if (u >= PB * 8 * 32) break;
            const int qb = 31 - (u >> 6), bh = u & 63;
            attn_body::attn_unit<8>(bh >> 3, bh & 7, qb, Qa, Ka, Va, Oa, CP, (char*)lds);
        }
    }
    }
    if constexpr (PH == 5) {
    {
        pg8::Gemm g{Mix, WoutT, MP, 1024, DMIX, 0}; pg8::StaticOrder S; S.init(MP, 1024, G, bx);
        pg8::EpiOut E{a.x_prompt, a.x_sample, out + O_Y, XN, SS1, GSS};
        pg8::gemm_phase<pg8::EpiOut, pg8::StaticOrder, true, true>((PG8_LAS unsigned char*)lds, g, S, E);
    }
    }
    if constexpr (PH == 6) {
    {
        pg8::Gemm g{XN, WupT, MT, DFF, 1024, 0}; pg8::StaticOrder S; S.init(MT, DFF, G, bx);
        pg8::EpiUp E{SS1, Hb};
        pg8::gemm_phase<pg8::EpiUp, pg8::StaticOrder, true, true>((PG8_LAS unsigned char*)lds, g, S, E);
    }
    }
    if constexpr (PH == 7) {
    {
        const int Mrows = G >= 128 ? MP : MT;
        pg8::Gemm g{Hb, WdnT, Mrows, 1024, DFF, 0}; pg8::StaticOrder S; S.init(Mrows, 1024, G, bx);
        pg8::EpiDown E{out + O_Y};
        pg8::gemm_phase<pg8::EpiDown, pg8::StaticOrder, true, true>((PG8_LAS unsigned char*)lds, g, S, E);
    }
    }
}
template <int PH> __global__ void __launch_bounds__(NWAVES * 64, 2) phase_kernel(Args a) {
    extern __shared__ __attribute__((aligned(16))) unsigned char lds[];
    run_phase<PH>(a, lds);
}
#ifndef ONE_LAUNCH
#define ONE_LAUNCH 1
#endif
#if ONE_LAUNCH
#define RUN_PHASE(k) do { const __attribute__((address_space(4))) Args* p_ = (const __attribute__((address_space(4))) Args*)__builtin_amdgcn_kernarg_segment_ptr(); asm volatile("" : "+s"(p_)); Args la_; { const __attribute__((address_space(4))) unsigned long long* q_ = (const __attribute__((address_space(4))) unsigned long long*)p_; unsigned long long* d_ = (unsigned long long*)&la_; _Pragma("unroll") for (int i_ = 0; i_ < (int)(sizeof(Args) / 8); ++i_) d_[i_] = q_[i_]; } run_phase<k>(la_, lds); } while (0)
__global__ void __launch_bounds__(NWAVES * 64, 2) fwd_megakernel(Args a) {
    extern __shared__ __attribute__((aligned(16))) unsigned char lds[];
    cg::grid_group grid = cg::this_grid();
    RUN_PHASE(0); grid.sync();
    RUN_PHASE(1); grid.sync();
    RUN_PHASE(9); grid.sync();
    RUN_PHASE(2); grid.sync();
    RUN_PHASE(3); grid.sync();
    RUN_PHASE(4); __syncthreads(); RUN_PHASE(11); __syncthreads(); RUN_PHASE(8); grid.sync();
    RUN_PHASE(5); grid.sync();
    RUN_PHASE(6); grid.sync();
    RUN_PHASE(7); __syncthreads(); RUN_PHASE(10); grid.sync();
    RUN_PHASE(12);
}
#endif
extern "C" void kernel_launch(void* const* d_in, const int* in_sizes, int n_in, void* d_out, int out_size, void* d_ws, size_t ws_size, hipStream_t stream) {
    static int grid = 0;
    if (grid == 0) {
        if (n_in != 22 || (size_t)out_size != O_END || ws_size < WS_END) { fprintf(stderr, "kernel_launch: unexpected shapes: n_in %d out %d ws %zu (need %zu)\n", n_in, out_size, ws_size, (size_t)WS_END); grid = -1; return; }
        int dev = 0, cus = 0, per_cu = 0;
        (void)hipGetDevice(&dev); (void)hipDeviceGetAttribute(&cus, hipDeviceAttributeMultiprocessorCount, dev);
        bool okattr = true;
#if ONE_LAUNCH
        okattr = hipFuncSetAttribute((const void*)fwd_megakernel, hipFuncAttributeMaxDynamicSharedMemorySize, LDS_BYTES) == hipSuccess;
#endif
#if !ONE_LAUNCH
        okattr = okattr && hipFuncSetAttribute((const void*)phase_kernel<0>, hipFuncAttributeMaxDynamicSharedMemorySize, LDS_BYTES) == hipSuccess && hipFuncSetAttribute((const void*)phase_kernel<1>, hipFuncAttributeMaxDynamicSharedMemorySize, LDS_BYTES) == hipSuccess
              && hipFuncSetAttribute((const void*)phase_kernel<2>, hipFuncAttributeMaxDynamicSharedMemorySize, LDS_BYTES) == hipSuccess && hipFuncSetAttribute((const void*)phase_kernel<3>, hipFuncAttributeMaxDynamicSharedMemorySize, LDS_BYTES) == hipSuccess
              && hipFuncSetAttribute((const void*)phase_kernel<4>, hipFuncAttributeMaxDynamicSharedMemorySize, LDS_BYTES) == hipSuccess && hipFuncSetAttribute((const void*)phase_kernel<5>, hipFuncAttributeMaxDynamicSharedMemorySize, LDS_BYTES) == hipSuccess
              && hipFuncSetAttribute((const void*)phase_kernel<6>, hipFuncAttributeMaxDynamicSharedMemorySize, LDS_BYTES) == hipSuccess && hipFuncSetAttribute((const void*)phase_kernel<7>, hipFuncAttributeMaxDynamicSharedMemorySize, LDS_BYTES) == hipSuccess && hipFuncSetAttribute((const void*)phase_kernel<8>, hipFuncAttributeMaxDynamicSharedMemorySize, LDS_BYTES) == hipSuccess && hipFuncSetAttribute((const void*)phase_kernel<9>, hipFuncAttributeMaxDynamicSharedMemorySize, LDS_BYTES) == hipSuccess && hipFuncSetAttribute((const void*)phase_kernel<10>, hipFuncAttributeMaxDynamicSharedMemorySize, LDS_BYTES) == hipSuccess && hipFuncSetAttribute((const void*)phase_kernel<11>, hipFuncAttributeMaxDynamicSharedMemorySize, LDS_BYTES) == hipSuccess && hipFuncSetAttribute((const void*)phase_kernel<12>, hipFuncAttributeMaxDynamicSharedMemorySize, LDS_BYTES) == hipSuccess;
#endif
        if (!okattr) { fprintf(stderr, "kernel_launch: hipFuncSetAttribute failed\n"); grid = -1; return; }
        (void)hipGetLastError();
        grid = cus;
    }
    if (grid < 0) return;
    Args a{};
    a.x_prompt = (const float*)d_in[0]; a.x_sample = (const float*)d_in[1]; a.cache_k = (const float*)d_in[2]; a.cache_v = (const float*)d_in[3]; a.cache_logf = (const float*)d_in[4];
    a.state_ssm = (const float*)d_in[5]; a.state_conv = (const float*)d_in[6]; a.norm1_w = (const float*)d_in[7]; a.w_in = (const float*)d_in[8]; a.conv_w = (const float*)d_in[9];
    a.conv_b = (const float*)d_in[10]; a.dt_bias = (const float*)d_in[11]; a.A_log = (const float*)d_in[12]; a.D_skip = (const float*)d_in[13]; a.ssd_norm_w = (const float*)d_in[14];
    a.f_bias = (const float*)d_in[15]; a.q_norm_w = (const float*)d_in[16]; a.k_norm_w = (const float*)d_in[17]; a.w_out = (const float*)d_in[18]; a.norm2_w = (const float*)d_in[19];
    a.w_up = (const float*)d_in[20]; a.w_down = (const float*)d_in[21]; a.out = (float*)d_out; a.ws = (unsigned char*)d_ws;
#if ONE_LAUNCH
    void* args[] = {&a};
    hipError_t e = hipLaunchCooperativeKernel((const void*)fwd_megakernel, dim3(grid), dim3(NWAVES * 64), args, LDS_BYTES, stream);
    if (e != hipSuccess) fprintf(stderr, "kernel_launch: cooperative launch failed: %s (grid %d)\n", hipGetErrorString(e), grid);
#else
    hipLaunchKernelGGL(phase_kernel<0>, dim3(grid), dim3(NWAVES * 64), LDS_BYTES, stream, a);
    hipLaunchKernelGGL(phase_kernel<1>, dim3(grid), dim3(NWAVES * 64), LDS_BYTES, stream, a);
    hipLaunchKernelGGL(phase_kernel<9>, dim3(grid), dim3(NWAVES * 64), LDS_BYTES, stream, a);
    hipLaunchKernelGGL(phase_kernel<2>, dim3(grid), dim3(NWAVES * 64), LDS_BYTES, stream, a);
    hipLaunchKernelGGL(phase_kernel<3>, dim3(grid), dim3(NWAVES * 64), LDS_BYTES, stream, a);
    hipLaunchKernelGGL(phase_kernel<4>, dim3(grid), dim3(NWAVES * 64), LDS_BYTES, stream, a);
    hipLaunchKernelGGL(phase_kernel<11>, dim3(grid), dim3(NWAVES * 64), LDS_BYTES, stream, a);
    hipLaunchKernelGGL(phase_kernel<8>, dim3(grid), dim3(NWAVES * 64), LDS_BYTES, stream, a);
    hipLaunchKernelGGL(phase_kernel<5>, dim3(grid), dim3(NWAVES * 64), LDS_BYTES, stream, a);
    hipLaunchKernelGGL(phase_kernel<6>, dim3(grid), dim3(NWAVES * 64), LDS_BYTES, stream, a);
    hipLaunchKernelGGL(phase_kernel<7>, dim3(grid), dim3(NWAVES * 64), LDS_BYTES, stream, a);
    hipLaunchKernelGGL(phase_kernel<10>, dim3(grid), dim3(NWAVES * 64), LDS_BYTES, stream, a);
    hipLaunchKernelGGL(phase_kernel<12>, dim3(grid), dim3(NWAVES * 64), LDS_BYTES, stream, a);
#endif
}
```

```cpp
#include <hip/hip_runtime.h>
#include <hip/hip_cooperative_groups.h>
#include <hip/hip_bf16.h>
#include <cstdio>
#include <cstdint>
#include <cmath>
namespace cg = cooperative_groups;

constexpr int DMODEL = 1024, PSEQ = 8192, PB = 8, MP = PB * PSEQ  , SBATCH = 32, SSEQ = 16, MS = SBATCH * SSEQ  , MT = MP + MS  ;
constexpr int PAST = 4096, NIN = 4352  , DFF = 4096, DMIX = 1536, DCONV = 1536;
constexpr float EPSN = 1e-6f, L2E = 1.4426950408889634f;
constexpr size_t O_Y = 0, O_PK = 67633152, O_PV = 101187584, O_PLF = 134742016, O_PSSM = 135266304, O_PCONV = 136314880, O_SK = 136351744, O_SV = 136613888,
                 O_SLF = 136876032, O_SSSM = 136880128, O_SCONV = 141074432, O_END = 141221888;
constexpr size_t MiB = 1u << 20;
constexpr size_t WS_CTR = 1120 * 1024, WS_SS1 = 0, WS_GSS = 512 * 1024, WS_DAT = 1088 * 1024, WS_CP = 2 * MiB, WS_WIN = 4 * MiB, WS_WOUT = WS_WIN + 8704 * 1024, WS_WUP = WS_WOUT + 3 * MiB, WS_WDN = WS_WUP + 8 * MiB;
constexpr size_t WS_XN = 32 * MiB, WS_DT = 161 * MiB, WS_SL = 166 * MiB, WS_ZS = 294 * MiB, WS_XBC = 423 * MiB, WS_QB = 617 * MiB, WS_KB = 682 * MiB, WS_VB = 747 * MiB, WS_MIX = 812 * MiB,
                 WS_H = 294 * MiB, WS_HIST = 1006 * MiB, WS_GSSP = 1012 * MiB, WS_SS1P = 1014 * MiB, WS_END = 1019 * MiB;
static_assert(WS_WDN + 8 * MiB <= WS_XN && WS_XN + (size_t)MT * 1024 * 2 <= WS_DT && WS_DT + (size_t)MT * 64 <= WS_SL && WS_SL + 128 * MiB <= WS_ZS, "ws map 1");
static_assert(WS_ZS + (size_t)MT * 2048 <= WS_XBC && WS_XBC + (size_t)(MT + 64) * 3072 <= WS_QB && WS_QB + (size_t)MT * 1024 <= WS_KB && WS_KB + (size_t)MT * 1024 <= WS_VB && WS_VB + (size_t)MT * 1024 <= WS_MIX, "ws map 2");
static_assert(WS_MIX + (size_t)MT * 3072 <= WS_END && WS_H + (size_t)MT * 8192 <= WS_MIX, "ws map 3");

typedef unsigned short bf16_t;
typedef short bf16x8 __attribute__((ext_vector_type(8)));
typedef float f32x4 __attribute__((ext_vector_type(4)));
typedef float f32x16 __attribute__((ext_vector_type(16)));
typedef unsigned u32x4 __attribute__((ext_vector_type(4)));
typedef unsigned u32x2 __attribute__((ext_vector_type(2)));
typedef float f32x2_t_ __attribute__((ext_vector_type(2)));
typedef __bf16 bf16x2_t_ __attribute__((ext_vector_type(2)));
__device__ __forceinline__ unsigned cvtpk(float lo, float hi) { f32x2_t_ v = {lo, hi}; bf16x2_t_ b = __builtin_convertvector(v, bf16x2_t_); return __builtin_bit_cast(unsigned, b); }
__device__ __forceinline__ float bf2f(unsigned u16) { return __uint_as_float(u16 << 16); }
__device__ __forceinline__ float silu_f(float v) { return v * __builtin_amdgcn_rcpf(1.0f + __expf(-v)); }
__device__ __forceinline__ float softplus_f(float v) { return v > 20.f ? v : log1pf(__expf(v)); }
__device__ __forceinline__ float logsigmoid_f(float v) { return fminf(v, 0.f) - log1pf(__expf(-fabsf(v))); }
__device__ __forceinline__ int crow_(int r, int hi) { return (r & 3) + 8 * (r >> 2) + 4 * hi; }
__device__ __forceinline__ void gatomic_add(float* p, float v) { (void)__builtin_amdgcn_global_atomic_fadd_f32((__attribute__((address_space(1))) float*)p, v); }
namespace pg8 {
#define PG8_LAS __attribute__((address_space(3)))
typedef unsigned short bf16_t;
typedef short bf16x8 __attribute__((ext_vector_type(8)));
typedef float f32x4 __attribute__((ext_vector_type(4)));
typedef unsigned u32x4 __attribute__((ext_vector_type(4)));
constexpr int BM = 256, BK = 64, HALF = 128, HTB = HALF * BK * 2  , STAGE_BYTES = 8 * HTB, NXCD = 8, WGM = 8;

__host__ __device__ __forceinline__ int lds_byte(int r, int c) { const int st = (r >> 4) * 2 + (c >> 5), rr = r & 15, cc = c & 31, ob = rr * 64 + cc * 2; return st * 1024 + (ob ^ (((ob >> 9) & 1) << 5)); }
__host__ __device__ __forceinline__ void stage_rc(int b, int& R, int& C) { const int st = b / 1024, sb = b % 1024, swz = sb ^ (((sb >> 9) & 1) << 5); R = (st >> 1) * 16 + swz / 64; C = (st & 1) * 32 + (swz % 64) / 2; }
__host__ __device__ __forceinline__ int perm32(int rho) { const int n = rho >> 4, i = rho & 15; return 8 * (i >> 2) + 4 * n + (i & 3); }

struct Unit { int pm, pn, k0; };
struct Gemm { const bf16_t* A; const bf16_t* Bt; int M, N, K, nt; };

struct StaticOrder {
    int nM, nN, nwg, G, c;
    __host__ __device__ void init(int M, int N, int G_, int c_) { nM = M / BM; nN = N / BM; nwg = nM * nN; G = G_; c = c_; }
    __host__ __device__ bool next(int i, Unit& u) const {
        const long L = (long)i * G + c; if (L >= nwg) return false;
        int wgid = (int)L; { const int q = nwg / NXCD, r = nwg % NXCD, xcd = wgid % NXCD, off = wgid / NXCD; wgid = (xcd < r ? xcd * (q + 1) : r * (q + 1) + (xcd - r) * q) + off; }
        const int nig = WGM * nN, gid = wgid / nig, fm = gid * WGM, gsz = (nM - fm) < WGM ? (nM - fm) : WGM;
        u.pm = fm + ((wgid % nig) % gsz); u.pn = (wgid % nig) / gsz; u.k0 = 0; return true;
    }
    __device__ __forceinline__ void a_ready(const Unit&) const {}
    __device__ __forceinline__ void done(const Unit&) const {}
};

struct ListOrder {
    int G, c, count, ntiles, pm0, npn, ksplit;
    __device__ __forceinline__ bool next(int i, Unit& u) const { const int L = i * G + c; if (L >= count) return false; const int tile = L % ntiles, ks = L / ntiles; u.pm = pm0 + tile / npn; u.pn = tile % npn; u.k0 = ks * ksplit; return true; }
    __device__ __forceinline__ void a_ready(const Unit&) const {}
    __device__ __forceinline__ void done(const Unit&) const {}
};

__device__ __forceinline__ void st_bf16x8(bf16_t* p, f32x4 a, f32x4 b) { u32x4 w; w.x = cvtpk(a[0], a[1]); w.y = cvtpk(a[2], a[3]); w.z = cvtpk(b[0], b[1]); w.w = cvtpk(b[2], b[3]); *(u32x4*)p = w; }
struct EpiIn {
    static constexpr bool PERM = true, AFTER_DRAIN = false, KHOOK = false;
    bf16_t *Zs, *XBC, *Qb, *Kb, *Vb; float* DT; float* out; const float *dt_bias, *f_bias, *qw, *kw; bf16_t* HIST;
    __device__ __forceinline__ void operator()(const f32x4 (&acc)[2][2][4][2], const Unit& u, int wr, int wc, int fr, int fq) const {
        const int pn = u.pn; const int lc = pn * 256 + wc * 64 + fq * 8;
        if (pn < 10) {
#pragma unroll
            for (int ai = 0; ai < 2; ++ai)
#pragma unroll
                for (int m = 0; m < 4; ++m) { const int row = u.pm * BM + ai * HALF + wr * 64 + m * 16 + fr;
#pragma unroll
                    for (int bj = 0; bj < 2; ++bj) { f32x4 v0 = acc[ai][bj][m][0], v1 = acc[ai][bj][m][1];
                        if (pn < 4) {
#pragma unroll
                            for (int e = 0; e < 4; ++e) { v0[e] = silu_f(v0[e]); v1[e] = silu_f(v1[e]); }
                            st_bf16x8(Zs + row * 1024 + lc + 32 * bj, v0, v1);
                        } else { const int c = lc - 1024 + 32 * bj;
                            st_bf16x8(XBC + row * 1536 + c, v0, v1);
                            if (row < MP && (row & 127) >= 125) st_bf16x8(HIST + ((row >> 7) * 3 + ((row & 127) - 125)) * DCONV + c, v0, v1);
                            float* cs = nullptr;
                            if (row < MP) { const int t = (int)(row & (PSEQ - 1)); if (t >= PSEQ - 3) cs = out + O_PCONV + ((row >> 13) * 3 + (t - (PSEQ - 3))) * DCONV + c; }
                            else { const int sr = (int)(row - MP), t = sr & 15; if (t >= 13) cs = out + O_SCONV + ((sr >> 4) * 3 + (t - 13)) * DCONV + c; }
                            if (cs) { *(f32x4*)cs = v0; *(f32x4*)(cs + 4) = v1; } } } }
        } else if (pn < 14) {
            const bool isq = pn < 12; const float* w = isq ? qw : kw; const int hcol = lc - (isq ? 2560 : 3072);
#pragma unroll
            for (int ai = 0; ai < 2; ++ai)
#pragma unroll
                for (int m = 0; m < 4; ++m) { const int row = u.pm * BM + ai * HALF + wr * 64 + m * 16 + fr; float ss = 0.f;
#pragma unroll
                    for (int bj = 0; bj < 2; ++bj)
#pragma unroll
                        for (int n = 0; n < 2; ++n) { const f32x4 x = acc[ai][bj][m][n]; ss += (x[0] * x[0] + x[1] * x[1]) + (x[2] * x[2] + x[3] * x[3]); }
                    ss += __shfl_xor(ss, 16); ss += __shfl_xor(ss, 32);
                    const float rs = rsqrtf(ss * (1.0f / 64.0f) + EPSN); const float rq = isq ? rs * (0.125f * L2E) : rs;
#pragma unroll
                    for (int bj = 0; bj < 2; ++bj) { const f32x4 o0 = acc[ai][bj][m][0] * *(const f32x4*)(w + 32 * bj + 8 * fq), o1 = acc[ai][bj][m][1] * *(const f32x4*)(w + 32 * bj + 8 * fq + 4);
                        st_bf16x8((isq ? Qb : Kb) + row * 512 + hcol + 32 * bj, o0 * rq, o1 * rq);
                        if (!isq) { float* kp = (row < MP ? out + O_PK + row * 512 : out + O_SK + (row - MP) * 512) + hcol + 32 * bj; *(f32x4*)kp = o0 * rs; *(f32x4*)(kp + 4) = o1 * rs; } } }
        } else if (pn < 16) {
            const int hcol = lc - 3584;
#pragma unroll
            for (int ai = 0; ai < 2; ++ai)
#pragma unroll
                for (int m = 0; m < 4; ++m) { const int row = u.pm * BM + ai * HALF + wr * 64 + m * 16 + fr;
#pragma unroll
                    for (int bj = 0; bj < 2; ++bj) { const f32x4 v0 = acc[ai][bj][m][0], v1 = acc[ai][bj][m][1];
                        st_bf16x8(Vb + row * 512 + hcol + 32 * bj, v0, v1);
                        float* vp = (row < MP ? out + O_PV + row * 512 : out + O_SV + (row - MP) * 512) + hcol + 32 * bj; *(f32x4*)vp = v0; *(f32x4*)(vp + 4) = v1; } }
        } else {
            if (wc == 0 && fq < 3) {
                const f32x4 b0 = fq < 2 ? *(const f32x4*)(dt_bias + 8 * fq) : *(const f32x4*)(f_bias), b1 = fq < 2 ? *(const f32x4*)(dt_bias + 8 * fq + 4) : *(const f32x4*)(f_bias + 4);
#pragma unroll
                for (int ai = 0; ai < 2; ++ai)
#pragma unroll
                    for (int m = 0; m < 4; ++m) { const int row = u.pm * BM + ai * HALF + wr * 64 + m * 16 + fr;
                        f32x4 v0 = acc[ai][0][m][0] + b0, v1 = acc[ai][0][m][1] + b1;
                        if (fq < 2) {
#pragma unroll
                            for (int e = 0; e < 4; ++e) { v0[e] = softplus_f(v0[e]); v1[e] = softplus_f(v1[e]); }
                            float* dp = DT + row * 16 + 8 * fq; *(f32x4*)dp = v0; *(f32x4*)(dp + 4) = v1;
                        } else {
#pragma unroll
                            for (int e = 0; e < 4; ++e) { v0[e] = logsigmoid_f(v0[e]); v1[e] = logsigmoid_f(v1[e]); }
                            float* lp = (row < MP ? out + O_PLF + row * 8 : out + O_SLF + (row - MP) * 8); *(f32x4*)lp = v0; *(f32x4*)(lp + 4) = v1; } }
            }
        }
    }
};
struct EpiOut {
    static constexpr bool PERM = true, AFTER_DRAIN = false, KHOOK = true;
    const float *xp, *xs; float* Y; bf16_t* X1b; float* SS1; const float* GSS;
    __device__ __forceinline__ void khook(f32x4 (&acc)[2][2][4][2], const Unit& u, int t, int wr, int fr) const {
#pragma unroll
        for (int ai = 0; ai < 2; ++ai)
#pragma unroll
            for (int m = 0; m < 4; ++m) { const int row = u.pm * BM + ai * HALF + wr * 64 + m * 16 + fr;
                const f32x4 gp = *(const f32x4*)(GSS + (unsigned)(row * 4)); const float g0 = gp[0] + gp[1], g1 = gp[2] + gp[3];
                const float r0 = rsqrtf(g0 * (1.0f / 512.0f) + EPSN), r1 = rsqrtf(g1 * (1.0f / 512.0f) + EPSN);
                const float f = (t == 8) ? r0 / r1 : r1;
#pragma unroll
                for (int bj = 0; bj < 2; ++bj)
#pragma unroll
                    for (int n = 0; n < 2; ++n) acc[ai][bj][m][n] *= f; }
    }
    __device__ __forceinline__ void operator()(const f32x4 (&acc)[2][2][4][2], const Unit& u, int wr, int wc, int fr, int fq) const {
        const int col0 = u.pn * BM + wc * 32 + 8 * fq; float ssv[8];
#pragma unroll
        for (int ai = 0; ai < 2; ++ai)
#pragma unroll
            for (int m = 0; m < 4; ++m) { const int row = u.pm * BM + ai * HALF + wr * 64 + m * 16 + fr;
                const float* xr = row < MP ? xp + row * 1024 : xs + (row - MP) * 1024; float ss = 0.f;
#pragma unroll
                for (int bj = 0; bj < 2; ++bj) { const int c = col0 + bj * HALF;
                    const f32x4 o0 = *(const f32x4*)(xr + c) + acc[ai][bj][m][0], o1 = *(const f32x4*)(xr + c + 4) + acc[ai][bj][m][1];
                    *(f32x4*)(Y + row * 1024 + c) = o0; *(f32x4*)(Y + row * 1024 + c + 4) = o1; st_bf16x8(X1b + row * 1024 + c, o0, o1);
                    ss += (o0[0] * o0[0] + o0[1] * o0[1]) + (o0[2] * o0[2] + o0[3] * o0[3]) + (o1[0] * o1[0] + o1[1] * o1[1]) + (o1[2] * o1[2] + o1[3] * o1[3]); }
                ss += __shfl_xor(ss, 16); ss += __shfl_xor(ss, 32);
                ssv[ai * 4 + m] = ss; }
        if (fq == 0) {
#pragma unroll
            for (int ai = 0; ai < 2; ++ai)
#pragma unroll
                for (int m = 0; m < 4; ++m) SS1[(unsigned)((u.pm * BM + ai * HALF + wr * 64 + m * 16 + fr) * 16 + u.pn * 4 + wc)] = ssv[ai * 4 + m]; }
    }
};
struct EpiUp {
    static constexpr bool PERM = true, AFTER_DRAIN = false, KHOOK = false;
    const float* SS1; bf16_t* H;
    __device__ __forceinline__ void operator()(const f32x4 (&acc)[2][2][4][2], const Unit& u, int wr, int wc, int fr, int fq) const {
        const int col0 = u.pn * BM + wc * 32 + 8 * fq;
#pragma unroll
        for (int ai = 0; ai < 2; ++ai)
#pragma unroll
            for (int m = 0; m < 4; ++m) { const int row = u.pm * BM + ai * HALF + wr * 64 + m * 16 + fr;
                const f32x4 s0 = *(const f32x4*)(SS1 + (unsigned)(row * 16)), s1 = *(const f32x4*)(SS1 + (unsigned)(row * 16 + 4)), s2 = *(const f32x4*)(SS1 + (unsigned)(row * 16 + 8)), s3 = *(const f32x4*)(SS1 + (unsigned)(row * 16 + 12));
                const f32x4 st = (s0 + s1) + (s2 + s3); const float r2 = 1.0f / (((st[0] + st[1]) + (st[2] + st[3])) * (1.0f / 1024.0f) + EPSN);
#pragma unroll
                for (int bj = 0; bj < 2; ++bj) { f32x4 v0 = acc[ai][bj][m][0], v1 = acc[ai][bj][m][1];
#pragma unroll
                    for (int e = 0; e < 4; ++e) { const float a = fmaxf(v0[e], 0.f), b = fmaxf(v1[e], 0.f); v0[e] = a * a * r2; v1[e] = b * b * r2; }
                    st_bf16x8(H + row * DFF + col0 + bj * HALF, v0, v1); } }
    }
};
struct EpiDown {
    static constexpr bool PERM = true, AFTER_DRAIN = false, KHOOK = false;
    float* Y;
    __device__ __forceinline__ void operator()(const f32x4 (&acc)[2][2][4][2], const Unit& u, int wr, int wc, int fr, int fq) const {
        const int col0 = u.pn * BM + wc * 32 + 8 * fq;
#pragma unroll
        for (int ai = 0; ai < 2; ++ai)
#pragma unroll
            for (int m = 0; m < 4; ++m) { const int row = u.pm * BM + ai * HALF + wr * 64 + m * 16 + fr;
#pragma unroll
                for (int bj = 0; bj < 2; ++bj) { float* p = Y + row * 1024 + col0 + bj * HALF;
                    const f32x4 o0 = *(const f32x4*)p + acc[ai][bj][m][0], o1 = *(const f32x4*)(p + 4) + acc[ai][bj][m][1]; *(f32x4*)p = o0; *(f32x4*)(p + 4) = o1; } }
    }
};
struct EpiDownPartial {
    static constexpr bool PERM = true, AFTER_DRAIN = false, KHOOK = false;
    float* PART;
    __device__ __forceinline__ void operator()(const f32x4 (&acc)[2][2][4][2], const Unit& u, int wr, int wc, int fr, int fq) const {
        const int col0 = u.pn * BM + wc * 32 + 8 * fq;
#pragma unroll
        for (int ai = 0; ai < 2; ++ai)
#pragma unroll
            for (int m = 0; m < 4; ++m) { const int row = (u.pm - MP / 256) * BM + ai * HALF + wr * 64 + m * 16 + fr;
#pragma unroll
                for (int bj = 0; bj < 2; ++bj) { float* p = PART + (unsigned)(row * 1024 + col0 + bj * HALF); *(f32x4*)p = acc[ai][bj][m][0]; *(f32x4*)(p + 4) = acc[ai][bj][m][1]; } }
    }
};
template <class Epi, class Sched, bool ALIGN_EPI = false, bool SP2 = false>
__device__ __forceinline__ void gemm_phase(PG8_LAS unsigned char* lds, const Gemm g, const Sched& S, const Epi& E) {
    int tid_ = threadIdx.x; asm volatile("" : "+v"(tid_));
    const int tid = tid_, wid = __builtin_amdgcn_readfirstlane(tid >> 6), lane = tid & 63, wr = wid >> 2, wc = wid & 3, fr = lane & 15, fq = lane >> 4;
    const int K = g.K; int nt_ = g.nt ? g.nt : K / BK; asm volatile("" : "+s"(nt_)); const int nt = nt_;
    unsigned voffA[2], voffB[2];
#pragma unroll
    for (int i = 0; i < 2; ++i) { int R, C; stage_rc(tid * 16 + i * 8192, R, C); const int Rb = Epi::PERM ? ((R & ~31) + perm32(R & 31)) : R;
        voffA[i] = (unsigned)(R * K + C) * 2u; voffB[i] = (unsigned)(Rb * K + C) * 2u; }
    const size_t kstep = (size_t)(BK * 2);
    const size_t hstep = (size_t)HALF * K * 2;
    const size_t tstep = 2 * hstep;
    const unsigned ldsw = (unsigned)wid * 1024u;
    const int aoff = lds_byte(wr * 64 + fr, fq * 8), boff = lds_byte(wc * 32 + fr, fq * 8);
#define PG8_SA(b, h) (((b) * 2 + (h)) * HTB)
#define PG8_SB(b, h) ((4 + (b) * 2 + (h)) * HTB)
#define PG8_STAGE(bufoff, gbase, voff) do { _Pragma("unroll") for (int _i = 0; _i < 2; ++_i) \
        __builtin_amdgcn_global_load_lds((const unsigned*)((const char*)(gbase) + (voff)[_i]), (PG8_LAS unsigned*)(lds + (bufoff) + ldsw + _i * 8192), 16, 0, 0); } while (0)
#define PG8_LDA(dst, b, h) do { _Pragma("unroll") for (int m = 0; m < 4; ++m) _Pragma("unroll") for (int k = 0; k < 2; ++k) dst[m][k] = *(const PG8_LAS bf16x8*)(lds + PG8_SA(b, h) + aoff + m * 2048 + k * 1024); } while (0)
#define PG8_LDB(dst, b, h) do { _Pragma("unroll") for (int n = 0; n < 2; ++n) _Pragma("unroll") for (int k = 0; k < 2; ++k) dst[n][k] = *(const PG8_LAS bf16x8*)(lds + PG8_SB(b, h) + boff + n * 2048 + k * 1024); } while (0)
#define PG8_MMA(ai, bj, At, Bt) do { __builtin_amdgcn_s_setprio(1); _Pragma("unroll") for (int m = 0; m < 4; ++m) _Pragma("unroll") for (int n = 0; n < 2; ++n) _Pragma("unroll") for (int k = 0; k < 2; ++k) \
        acc[ai][bj][m][n] = __builtin_amdgcn_mfma_f32_16x16x32_bf16(Bt[n][k], At[m][k], acc[ai][bj][m][n], 0, 0, 0); __builtin_amdgcn_s_setprio(0); } while (0)
#define PG8_WAIT_V(n) asm volatile("s_waitcnt vmcnt(" #n ")" ::: "memory")
#define PG8_WAIT_L(n) asm volatile("s_waitcnt lgkmcnt(" #n ")" ::: "memory")
#define PG8_BAR __builtin_amdgcn_s_barrier()
#define PG8_SCHED __builtin_amdgcn_sched_barrier(0)
    Unit cur, nxt; int ui = 0;
    if (!S.next(0, cur)) return;
    f32x4 acc[2][2][4][2];
#pragma unroll
    for (int a = 0; a < 2; ++a)
#pragma unroll
        for (int b = 0; b < 2; ++b)
#pragma unroll
            for (int m = 0; m < 4; ++m)
#pragma unroll
                for (int n = 0; n < 2; ++n) acc[a][b][m][n] = (f32x4){0.f, 0.f, 0.f, 0.f};
    bf16x8 At[4][2], B0[2][2], B1[2][2];
    const char* cA = (const char*)g.A + (size_t)cur.pm * tstep + (size_t)cur.k0 * 2; const char* cB = (const char*)g.Bt + (size_t)cur.pn * tstep + (size_t)cur.k0 * 2;
    S.a_ready(cur);
    if constexpr (SP2) {
        PG8_STAGE(PG8_SB(0, 0), cB, voffB); PG8_STAGE(PG8_SB(0, 1), cB + hstep, voffB); PG8_STAGE(PG8_SA(0, 0), cA, voffA); PG8_STAGE(PG8_SA(0, 1), cA + hstep, voffA);
        if (wr == 1) PG8_BAR;
        PG8_WAIT_V(2); PG8_BAR;
        PG8_STAGE(PG8_SB(1, 0), cB + kstep, voffB); PG8_STAGE(PG8_SA(1, 0), cA + kstep, voffA); PG8_STAGE(PG8_SB(1, 1), cB + hstep + kstep, voffB);
        PG8_WAIT_V(6); PG8_BAR;
    } else {
        PG8_STAGE(PG8_SB(0, 0), cB, voffB); PG8_STAGE(PG8_SA(0, 0), cA, voffA); PG8_STAGE(PG8_SB(0, 1), cB + hstep, voffB); PG8_STAGE(PG8_SA(0, 1), cA + hstep, voffA);
        if (wr == 1) PG8_BAR;
        PG8_WAIT_V(4); PG8_BAR;
        PG8_STAGE(PG8_SB(1, 0), cB + kstep, voffB); PG8_STAGE(PG8_SA(1, 0), cA + kstep, voffA); PG8_STAGE(PG8_SB(1, 1), cB + hstep + kstep, voffB);
        PG8_WAIT_V(6); PG8_BAR;
    }
    for (;;) {
        const bool has_next = S.next(ui + 1, nxt);
        const char* nA = has_next ? (const char*)g.A + (size_t)nxt.pm * tstep + (size_t)nxt.k0 * 2 : cA; const char* nB = has_next ? (const char*)g.Bt + (size_t)nxt.pn * tstep + (size_t)nxt.k0 * 2 : cB;
        for (int t = 0; t < nt; t += 2) {
            if constexpr (Epi::KHOOK) { if (t == 8 || t == 16) E.khook(acc, cur, t, wr, fr); }
            const bool last = (t == nt - 2);
            const char* a1 = cA + (size_t)(t + 1) * kstep;
            const char* a2 = last ? nA : cA + (size_t)(t + 2) * kstep; const char* b2 = last ? nB : cB + (size_t)(t + 2) * kstep;
            const char* a3 = a2 + kstep; const char* b3 = b2 + kstep;
            if (last && has_next) S.a_ready(nxt);
            if constexpr (SP2) {
            PG8_LDB(B0, 0, 0); PG8_LDB(B1, 0, 1); PG8_SCHED; PG8_LDA(At, 0, 0); PG8_STAGE(PG8_SA(1, 1), a1 + hstep, voffA);
            PG8_WAIT_V(8); PG8_WAIT_L(0); PG8_BAR; PG8_MMA(0, 0, At, B0); PG8_MMA(0, 1, At, B1); PG8_BAR; PG8_SCHED;
            PG8_LDA(At, 0, 1); PG8_STAGE(PG8_SB(0, 0), b2, voffB); PG8_STAGE(PG8_SB(0, 1), b2 + hstep, voffB); PG8_STAGE(PG8_SA(0, 0), a2, voffA);
            PG8_WAIT_V(8); PG8_WAIT_L(0); PG8_BAR; PG8_MMA(1, 0, At, B0); PG8_MMA(1, 1, At, B1); PG8_BAR; PG8_SCHED;
            PG8_LDB(B0, 1, 0); PG8_LDB(B1, 1, 1); PG8_SCHED; PG8_LDA(At, 1, 0); PG8_STAGE(PG8_SA(0, 1), a2 + hstep, voffA);
            PG8_WAIT_V(8); PG8_WAIT_L(0); PG8_BAR; PG8_MMA(0, 0, At, B0); PG8_MMA(0, 1, At, B1); PG8_BAR; PG8_SCHED;
            PG8_LDA(At, 1, 1); PG8_STAGE(PG8_SB(1, 0), b3, voffB); PG8_STAGE(PG8_SB(1, 1), b3 + hstep, voffB); PG8_STAGE(PG8_SA(1, 0), a3, voffA);
            PG8_WAIT_V(8); PG8_WAIT_L(0); PG8_BAR; PG8_MMA(1, 0, At, B0); PG8_MMA(1, 1, At, B1); PG8_BAR; PG8_SCHED;
            } else {
            PG8_LDB(B0, 0, 0); PG8_SCHED; PG8_LDA(At, 0, 0); PG8_STAGE(PG8_SA(1, 1), a1 + hstep, voffA);
            PG8_WAIT_L(8); PG8_BAR; PG8_WAIT_L(0); PG8_MMA(0, 0, At, B0); PG8_BAR; PG8_SCHED;
            PG8_LDB(B1, 0, 1); PG8_STAGE(PG8_SB(0, 0), b2, voffB);
            PG8_BAR; PG8_WAIT_L(0); PG8_MMA(0, 1, At, B1); PG8_BAR;
            PG8_LDA(At, 0, 1); PG8_STAGE(PG8_SA(0, 0), a2, voffA);
            PG8_BAR; PG8_WAIT_L(0); PG8_MMA(1, 0, At, B0); PG8_BAR; PG8_SCHED;
            PG8_STAGE(PG8_SB(0, 1), b2 + hstep, voffB);
            PG8_WAIT_V(6); PG8_BAR; PG8_MMA(1, 1, At, B1); PG8_BAR;
            PG8_LDB(B0, 1, 0); PG8_SCHED; PG8_LDA(At, 1, 0); PG8_STAGE(PG8_SA(0, 1), a2 + hstep, voffA);
            PG8_WAIT_L(8); PG8_BAR; PG8_WAIT_L(0); PG8_MMA(0, 0, At, B0); PG8_BAR; PG8_SCHED;
            PG8_LDB(B1, 1, 1); PG8_STAGE(PG8_SB(1, 0), b3, voffB);
            PG8_BAR; PG8_WAIT_L(0); PG8_MMA(0, 1, At, B1); PG8_BAR;
            PG8_LDA(At, 1, 1); PG8_STAGE(PG8_SA(1, 0), a3, voffA);
            PG8_BAR; PG8_WAIT_L(0); PG8_MMA(1, 0, At, B0); PG8_BAR; PG8_SCHED;
            PG8_STAGE(PG8_SB(1, 1), b3 + hstep, voffB);
            PG8_WAIT_V(6); PG8_BAR; PG8_MMA(1, 1, At, B1); PG8_BAR;
            }
        }
        if constexpr (ALIGN_EPI) { if (wr == 0) PG8_BAR; }
        if constexpr (!Epi::AFTER_DRAIN) { E(acc, cur, wr, wc, fr, fq); S.done(cur); }
        if (!has_next) break;
#pragma unroll
        for (int a = 0; a < 2; ++a)
#pragma unroll
            for (int b = 0; b < 2; ++b)
#pragma unroll
                for (int m = 0; m < 4; ++m)
#pragma unroll
                    for (int n = 0; n < 2; ++n) acc[a][b][m][n] = (f32x4){0.f, 0.f, 0.f, 0.f};
        cur = nxt; cA = nA; cB = nB; ++ui;
        if constexpr (ALIGN_EPI) { if (wr == 1) PG8_BAR; }
    }
    PG8_WAIT_V(0);
    if constexpr (!ALIGN_EPI) { if (wr == 0) PG8_BAR; }
    PG8_BAR;
    if constexpr (Epi::AFTER_DRAIN) { E.fused(acc, cur, wr, wc, fr, fq, lds, wid, lane); S.done(cur); }
#undef PG8_SA
#undef PG8_SB
#undef PG8_STAGE
#undef PG8_LDA
#undef PG8_LDB
#undef PG8_MMA
#undef PG8_WAIT_V
#undef PG8_WAIT_L
#undef PG8_BAR
#undef PG8_SCHED
}
}
#include <hip/hip_bf16.h>
#include <cmath>
namespace attn_body {
using bf16=__hip_bfloat16;
using bf16x8=__attribute__((ext_vector_type(8)))short;
using s16x4=__attribute__((ext_vector_type(4)))short;
using f32x16=__attribute__((ext_vector_type(16)))float;
using u32x4=__attribute__((ext_vector_type(4)))unsigned;
constexpr int BATCH=8,NHEAD=8,SEQ=8192,D=64,DM=NHEAD*D,OP=1536;
constexpr int NW=8,QBLK=32,QB=QBLK*NW,KVBLK=64,NQB=SEQ/QB;
constexpr int ATTN_PITCH=DM, ATTN_UNIT_ROWS=QB;
__device__ __forceinline__ int crow(int r,int hi){return (r&3)+8*(r>>2)+4*hi;}
#define SBAR() __builtin_amdgcn_sched_barrier(0)
__device__ __forceinline__ void cmask(f32x16&p0,f32x16&p1,int jb,int qrel,int hi){
  const float NEG=-INFINITY; int kb=64*jb+4*hi;
  #pragma unroll
  for(int r=0;r<16;++r){int kv=kb+(r&3)+8*(r>>2); if(kv>qrel)p0[r]=NEG; if(kv+32>qrel)p1[r]=NEG;}
}

constexpr int NSLOT=3, SLOTB=8192;
constexpr int LDS_K=0, LDS_V=NSLOT*SLOTB, LDS_WS=2*NSLOT*SLOTB, LDS_OST=LDS_WS+NW*64*4, LDS_C=LDS_OST+NW*4096, LDS_BYTES=LDS_C+SEQ*4;
constexpr float SKIP_L2=64.0f*1.4426950408889634f;
constexpr float C2=0.125f*1.4426950408889634f;
__device__ __forceinline__ void glds16(const void*gsrc,unsigned lds_dst){unsigned keep;
  asm volatile("s_mov_b32 %0, m0\n\ts_mov_b32 m0, %2\n\ts_nop 0\n\tglobal_load_lds_dwordx4 %1, off\n\ts_mov_b32 m0, %0":"=&s"(keep):"v"(gsrc),"s"(lds_dst):"memory");}
__device__ __forceinline__ float max3f(float a,float b,float c){float r;asm("v_max3_f32 %0, %1, %2, %3":"=v"(r):"v"(a),"v"(b),"v"(c));return r;}
__device__ __forceinline__ float max2f(float a,float b){float r;asm("v_max_f32_e32 %0, %1, %2":"=v"(r):"v"(a),"v"(b));return r;}
__device__ __forceinline__ float fadd_s(float a,float b){float r;asm("v_add_f32_e32 %0, %1, %2":"=v"(r):"v"(a),"v"(b));return r;}
__device__ __forceinline__ float fsub_s(float a,float b){float r;asm("v_sub_f32_e32 %0, %1, %2":"=v"(r):"v"(a),"v"(b));return r;}
typedef float f32x2_t __attribute__((ext_vector_type(2))); typedef __bf16 bf16x2_t __attribute__((ext_vector_type(2)));
__device__ __forceinline__ unsigned cvtpk_s(float lo,float hi){f32x2_t v={lo,hi};bf16x2_t b=__builtin_convertvector(v,bf16x2_t);return __builtin_bit_cast(unsigned,b);}
#define WAIT_BAR(N) asm volatile("s_waitcnt vmcnt(" #N ") lgkmcnt(0)\n\ts_barrier":::"memory")

__device__ __forceinline__ void qkt(f32x16&p0,f32x16&p1,const char*Kslot,const bf16x8*qr,const f32x16&cin0,const f32x16&cin1,int r32,int hi){
  const char*kb=Kslot+hi*1024+r32*16;
  #pragma unroll
  for(int d0=0;d0<4;++d0){
    const bf16x8 b0=*reinterpret_cast<const bf16x8*>(kb+d0*2048);
    const bf16x8 b1=*reinterpret_cast<const bf16x8*>(kb+d0*2048+512);
    if(d0==0){p0=__builtin_amdgcn_mfma_f32_32x32x16_bf16(b0,qr[0],cin0,0,0,0);p1=__builtin_amdgcn_mfma_f32_32x32x16_bf16(b1,qr[0],cin1,0,0,0);}
    else{p0=__builtin_amdgcn_mfma_f32_32x32x16_bf16(b0,qr[d0],p0,0,0,0);p1=__builtin_amdgcn_mfma_f32_32x32x16_bf16(b1,qr[d0],p1,0,0,0);}}
}
typedef __attribute__((address_space(3))) const char* lds_cptr;
typedef short v4i16_t __attribute__((ext_vector_type(4)));
__device__ __forceinline__ void kload8(bf16x8*kf,lds_cptr kp){
  kf[0]=*(const __attribute__((address_space(3))) bf16x8*)(kp);      kf[1]=*(const __attribute__((address_space(3))) bf16x8*)(kp+512);
  kf[2]=*(const __attribute__((address_space(3))) bf16x8*)(kp+2048); kf[3]=*(const __attribute__((address_space(3))) bf16x8*)(kp+2560);
  kf[4]=*(const __attribute__((address_space(3))) bf16x8*)(kp+4096); kf[5]=*(const __attribute__((address_space(3))) bf16x8*)(kp+4608);
  kf[6]=*(const __attribute__((address_space(3))) bf16x8*)(kp+6144); kf[7]=*(const __attribute__((address_space(3))) bf16x8*)(kp+6656);
}
__device__ __forceinline__ void kload2(bf16x8*kf,lds_cptr kp,int j){ kf[2*j]=*(const __attribute__((address_space(3))) bf16x8*)(kp+j*2048); kf[2*j+1]=*(const __attribute__((address_space(3))) bf16x8*)(kp+j*2048+512); }
__device__ __forceinline__ s16x4 vtr(lds_cptr p){ return __builtin_bit_cast(s16x4,__builtin_amdgcn_ds_read_tr16_b64_v4i16((__attribute__((address_space(3))) v4i16_t*)p)); }
__device__ __forceinline__ float rowmax(const f32x16&p0,const f32x16&p1){
  float a=max3f(p0[0],p0[1],p1[0]),b=max3f(p0[2],p0[3],p1[1]);a=max3f(a,p1[2],p1[3]);
  #pragma unroll
  for(int r=4;r<16;r+=4){a=max3f(a,p0[r],p0[r+1]);b=max3f(b,p0[r+2],p0[r+3]);a=max3f(a,p1[r],p1[r+1]);b=max3f(b,p1[r+2],p1[r+3]);}
  const float m=max2f(a,b);
  auto rr=__builtin_amdgcn_permlane32_swap(__float_as_uint(m),__float_as_uint(m),false,false);
  return max2f(__uint_as_float(rr[0]),__uint_as_float(rr[1]));
}
__device__ __forceinline__ void pv(f32x16*o,int vb,bf16x8 pa0,bf16x8 pa1,bf16x8 pa2,bf16x8 pa3){
  #pragma unroll
  for(int d0=0;d0<2;++d0){s16x4 lo[4],hi[4];
    #pragma unroll
    for(int ks=0;ks<4;++ks){
      asm volatile("ds_read_b64_tr_b16 %0,%1 offset:%c2":"=&v"(lo[ks]):"v"(vb),"i"(d0*4096+ks*1024):"memory");
      asm volatile("ds_read_b64_tr_b16 %0,%1 offset:%c2":"=&v"(hi[ks]):"v"(vb),"i"(d0*4096+ks*1024+512):"memory");}
    asm volatile("s_waitcnt lgkmcnt(0)":::"memory");SBAR();
    #define PK(k) (bf16x8){lo[k][0],lo[k][1],lo[k][2],lo[k][3],hi[k][0],hi[k][1],hi[k][2],hi[k][3]}
    o[d0]=__builtin_amdgcn_mfma_f32_32x32x16_bf16(pa0,PK(0),o[d0],0,0,0);
    o[d0]=__builtin_amdgcn_mfma_f32_32x32x16_bf16(pa1,PK(1),o[d0],0,0,0);
    o[d0]=__builtin_amdgcn_mfma_f32_32x32x16_bf16(pa2,PK(2),o[d0],0,0,0);
    o[d0]=__builtin_amdgcn_mfma_f32_32x32x16_bf16(pa3,PK(3),o[d0],0,0,0);
    #undef PK
  }
}

#ifndef ATTN_STORE16
#define ATTN_STORE16(p,v) (*(u32x4*)(p)=(v))
#endif
template<int THRL> __device__ __forceinline__ void attn_unit(int b,int h,int qb,const bf16*Q,const bf16*__restrict__ K,const bf16*__restrict__ V,bf16*O,const float*__restrict__ CPL,char*shm){
  int tid_=threadIdx.x; asm volatile("":"+v"(tid_)); const int tid=tid_,lane=tid&63,r32=lane&31,hi=lane>>5; const int wid=__builtin_amdgcn_readfirstlane(tid>>6);
  const long rowbase=(long)b*SEQ; const int q0=qb*QB;
  const bf16*Qw=Q+(rowbase+q0+wid*QBLK)*DM+h*D;
  const float*cg=CPL+((long)(b*NHEAD+h))*SEQ; const int NTF=(q0+QB)/KVBLK; int tst;
  { const float c0=cg[q0]; const int t1=lane,t2=lane+64;
    const bool s1=(t1<NTF-4)&&((c0-cg[64*t1+63])<-SKIP_L2), s2=(t2<NTF-4)&&((c0-cg[64*t2+63])<-SKIP_L2);
    tst=(__builtin_popcountll(__ballot(s1))+__builtin_popcountll(__ballot(s2)))&~1; tst=__builtin_amdgcn_readfirstlane(tst); }
  const bf16*Kh=K+(rowbase+(long)tst*KVBLK)*DM+h*D,*Vh=V+(rowbase+(long)tst*KVBLK)*DM+h*D;
  const unsigned lds0=(unsigned)(uintptr_t)shm;
  float*wsf=(float*)(shm+LDS_WS)+wid*64;
  const bf16*ksrc=Kh+(long)lane*DM+wid*8;
  const bf16*vsrc=Vh+(long)(16*(wid&3)+(lane>>2))*DM+(wid>>2)*32+(lane&3)*8;
  const unsigned kdst=lds0+LDS_K+wid*1024, vdst=lds0+LDS_V+wid*1024;
  #define DMA_K(t,slot) glds16(ksrc+(long)(t)*KVBLK*DM,(unsigned)__builtin_amdgcn_readfirstlane(kdst+(slot)))
  #define DMA_V(t,slot) glds16(vsrc+(long)(t)*KVBLK*DM,(unsigned)__builtin_amdgcn_readfirstlane(vdst+(slot)))
  const int vb0=(int)(lds0+LDS_V)+((lane>>4)&1)*32+(lane&3)*8+(4*hi+((lane&15)>>2))*64;
  const char*Kbase=shm+LDS_K; bf16x8 kf[8];
  const lds_cptr shm3=(lds_cptr)shm; const lds_cptr kp0=shm3+LDS_K+hi*1024+r32*16; const lds_cptr vp0=shm3+LDS_V+((lane>>4)&1)*32+(lane&3)*8+(4*hi+((lane&15)>>2))*64;
  const int NT=NTF-tst;
  float*cL=(float*)(shm+LDS_C);
  for(int i=tid;i<NT*KVBLK/4;i+=NW*64){ *(float4*)(cL+4*i)=*(const float4*)(cg+tst*KVBLK+4*i); }
  const float cq=cg[q0+wid*QBLK+r32]; float qm=cq;
  asm volatile("s_waitcnt vmcnt(0) lgkmcnt(0)":::"memory");
  DMA_K(0,0);DMA_V(0,0);DMA_K(1,SLOTB);
  bf16x8 qr[4];
  #pragma unroll
  for(int d0=0;d0<4;++d0)qr[d0]=*reinterpret_cast<const bf16x8*>(&Qw[(long)r32*DM+d0*16+hi*8]);
  float mhat=0.f,l_reg=0.f;f32x16 o[2];o[0]=f32x16{};o[1]=f32x16{};f32x16 cb0,cb1;
  const int qrel=wid*QBLK+r32;
  #define CBIAS(t) do{ const float*cp_=cL+(t)*KVBLK+4*hi; \
    _Pragma("unroll") for(int i_=0;i_<4;++i_){ const float4 u0_=*(const float4*)(cp_+8*i_), u1_=*(const float4*)(cp_+32+8*i_); \
      cb0[4*i_]=qm-u0_.x;cb0[4*i_+1]=qm-u0_.y;cb0[4*i_+2]=qm-u0_.z;cb0[4*i_+3]=qm-u0_.w; \
      cb1[4*i_]=qm-u1_.x;cb1[4*i_+1]=qm-u1_.y;cb1[4*i_+2]=qm-u1_.z;cb1[4*i_+3]=qm-u1_.w; } }while(0)
  #define CMASK(P0,P1,t) do{int jb_=(t)-(NT-4); if(jb_>=0)cmask(P0,P1,jb_,qrel,hi);}while(0)
  bool resc=false;
  #define START(P0,P1) do{ const float rm=rowmax(P0,P1); resc=false; \
    { const float dl=rm; mhat=fadd_s(mhat,dl); \
      _Pragma("unroll") for(int r=0;r<16;++r){P0[r]=fsub_s(P0[r],dl);P1[r]=fsub_s(P1[r],dl);} \
      qm=cq-mhat; } \
    _Pragma("unroll") for(int r=0;r<16;++r)P0[r]=__builtin_amdgcn_exp2f(P0[r]); }while(0)
  #define RESC() do{ if(resc){ asm volatile("s_waitcnt lgkmcnt(0)":::"memory"); \
      _Pragma("unroll") for(int d_=0;d_<2;++d_) _Pragma("unroll") for(int r=0;r<16;++r)o[d_][r]*=wsf[crow(r,hi)]; } }while(0)
  f32x16 pA0,pA1,pB0,pB1;
  int sl_prev=0,sl_cur=0,sl_next=SLOTB;
  #define ROT() do{sl_prev=sl_cur;sl_cur=sl_next;sl_next=(sl_next==(NSLOT-1)*SLOTB)?0:sl_next+SLOTB;}while(0)
  DMA_K(2,2*SLOTB);
  WAIT_BAR(3);
  CBIAS(0); qkt(pA0,pA1,Kbase,qr,cb0,cb1,r32,hi);asm volatile("s_nop 15\n\ts_nop 7":"+v"(pA0),"+v"(pA1));CMASK(pA0,pA1,0);
  START(pA0,pA1);
  _Pragma("unroll") for(int r=0;r<16;++r)pA1[r]=__builtin_amdgcn_exp2f(pA1[r]);
  WAIT_BAR(0);
  DMA_K(3,0);DMA_V(1,SLOTB);
  ROT();
  kload8(kf,kp0+sl_cur);
  WAIT_BAR(2);
  s16x4 vlo[8],vhi[8]; u32x4 pw0,pw1,pw2,pw3;
  #define PKW(P,B) cvtpk_s(P[B],P[B+1])
  #define PAF(k) __builtin_bit_cast(bf16x8,pw##k)
  #define VFR(i) (bf16x8){vlo[i][0],vlo[i][1],vlo[i][2],vlo[i][3],vhi[i][0],vhi[i][1],vhi[i][2],vhi[i][3]}
  #define PIN(x) asm volatile("":"+v"(x))
  #define MX3(a,b,c) __builtin_fmaxf(__builtin_fmaxf((a),(b)),(c))
  #define GAPA(MF,A0,A1,A2,A3,W0,W1,PW) do{ MF; sacc+=A0; sacc+=A1; sacc+=A2; sacc+=A3; PIN(sacc); W0; W1; PIN(PW); SBAR(); }while(0)
  #define EX(v) __builtin_amdgcn_exp2f(v)
  #define GAPB(MF,X,B) do{ MF; X[B]=EX(X[B]); X[B+1]=EX(X[B+1]); X[B+2]=EX(X[B+2]); X[B+3]=EX(X[B+3]); PIN(X); SBAR(); }while(0)
  #define VRD(i) do{ vlo[i]=vtr(vp_+(((i)>>2)*4096+((i)&3)*1024)); vhi[i]=vtr(vp_+(((i)>>2)*4096+((i)&3)*1024+512)); }while(0)
  #define KRD(G,j) do{ if(G){ kload2(kf,kp0+sl_next,j); SBAR(); } }while(0)
  #define STEP(C0,C1,P0,P1,t,GK,GV,GL) do{ SBAR(); CBIAS(t); SBAR(); \
    const lds_cptr vp_=vp0+sl_prev; \
    VRD(0); SBAR(); float sacc=(P0[0]+P0[1]); \
    GAPA(C0=__builtin_amdgcn_mfma_f32_32x32x16_bf16(kf[0],qr[0],cb0,0,0,0), P0[2],P0[3],P0[4],P0[5],     pw0[0]=PKW(P0,0), pw0[1]=PKW(P0,2), pw0); \
    VRD(4); SBAR(); GAPA(C1=__builtin_amdgcn_mfma_f32_32x32x16_bf16(kf[1],qr[0],cb1,0,0,0), P0[6],P0[7],P0[8],P0[9],     pw0[2]=PKW(P0,4), pw0[3]=PKW(P0,6), pw0); \
    VRD(1); SBAR(); GAPA(C0=__builtin_amdgcn_mfma_f32_32x32x16_bf16(kf[2],qr[1],C0,0,0,0),   P0[10],P0[11],P0[12],P0[13], pw1[0]=PKW(P0,8), pw1[1]=PKW(P0,10), pw1); \
    VRD(5); SBAR(); GAPA(C1=__builtin_amdgcn_mfma_f32_32x32x16_bf16(kf[3],qr[1],C1,0,0,0),   P0[14],P0[15],P1[0],P1[1],   pw1[2]=PKW(P0,12),pw1[3]=PKW(P0,14), pw1); \
    VRD(2); SBAR(); GAPA(C0=__builtin_amdgcn_mfma_f32_32x32x16_bf16(kf[4],qr[2],C0,0,0,0),   P1[2],P1[3],P1[4],P1[5],     pw2[0]=PKW(P1,0), pw2[1]=PKW(P1,2), pw2); \
    VRD(6); SBAR(); GAPA(C1=__builtin_amdgcn_mfma_f32_32x32x16_bf16(kf[5],qr[2],C1,0,0,0),   P1[6],P1[7],P1[8],P1[9],     pw2[2]=PKW(P1,4), pw2[3]=PKW(P1,6), pw2); \
    VRD(3); SBAR(); GAPA(C0=__builtin_amdgcn_mfma_f32_32x32x16_bf16(kf[6],qr[3],C0,0,0,0),   P1[10],P1[11],P1[12],P1[13], pw3[0]=PKW(P1,8), pw3[1]=PKW(P1,10), pw3); \
    VRD(7); SBAR(); GAPA(C1=__builtin_amdgcn_mfma_f32_32x32x16_bf16(kf[7],qr[3],C1,0,0,0),   P1[14],P1[15],0.f,0.f,       pw3[2]=PKW(P1,12),pw3[3]=PKW(P1,14), pw3); \
    l_reg+=sacc; \
    if(GK){DMA_K((t)+3,sl_cur);} if(GV){DMA_V((t)+1,sl_next);} \
    CMASK(C0,C1,t); \
    { float a=MX3(C0[0],C0[1],C1[0]),b=MX3(C0[2],C0[3],C1[1]); a=MX3(a,C1[2],C1[3]); \
      _Pragma("unroll") for(int r=4;r<16;r+=4){a=MX3(a,C0[r],C0[r+1]);b=MX3(b,C0[r+2],C0[r+3]);a=MX3(a,C1[r],C1[r+1]);b=MX3(b,C1[r+2],C1[r+3]);} \
      float rm=__builtin_fmaxf(a,b); { auto rr=__builtin_amdgcn_permlane32_swap(__float_as_uint(rm),__float_as_uint(rm),false,false); rm=__builtin_fmaxf(__uint_as_float(rr[0]),__uint_as_float(rr[1])); } \
      resc=false; \
      if(__builtin_expect(__any(rm>(float)THRL),0)){ const float dl=__builtin_fmaxf(rm,0.f); mhat+=dl; \
        _Pragma("unroll") for(int r=0;r<16;++r){C0[r]-=dl;C1[r]-=dl;} \
        qm=cq-mhat; \
        const float f=__builtin_amdgcn_exp2f(-dl); l_reg*=f; if(hi==0)wsf[r32]=f; resc=true; } } \
    SBAR(); \
    GAPB(o[0]=__builtin_amdgcn_mfma_f32_32x32x16_bf16(PAF(0),VFR(0),o[0],0,0,0), C0,0); \
    GAPB(o[1]=__builtin_amdgcn_mfma_f32_32x32x16_bf16(PAF(0),VFR(4),o[1],0,0,0), C0,4); \
    KRD(GL,0); GAPB(o[0]=__builtin_amdgcn_mfma_f32_32x32x16_bf16(PAF(1),VFR(1),o[0],0,0,0), C0,8); \
    KRD(GL,1); GAPB(o[1]=__builtin_amdgcn_mfma_f32_32x32x16_bf16(PAF(1),VFR(5),o[1],0,0,0), C0,12); \
    KRD(GL,2); GAPB(o[0]=__builtin_amdgcn_mfma_f32_32x32x16_bf16(PAF(2),VFR(2),o[0],0,0,0), C1,0); \
    KRD(GL,3); GAPB(o[1]=__builtin_amdgcn_mfma_f32_32x32x16_bf16(PAF(2),VFR(6),o[1],0,0,0), C1,4); \
    GAPB(o[0]=__builtin_amdgcn_mfma_f32_32x32x16_bf16(PAF(3),VFR(3),o[0],0,0,0), C1,8); \
    GAPB(o[1]=__builtin_amdgcn_mfma_f32_32x32x16_bf16(PAF(3),VFR(7),o[1],0,0,0), C1,12); \
    }while(0)
  int t=1;
  #undef CMASK
  #define CMASK(P0,P1,t) do{}while(0)
  for(;t+5<NT;t+=2){
    STEP(pB0,pB1,pA0,pA1,t,true,true,true);     WAIT_BAR(2); RESC(); ROT();
    STEP(pA0,pA1,pB0,pB1,t+1,true,true,true);   WAIT_BAR(2); RESC(); ROT();
  }
  #undef CMASK
  #define CMASK(P0,P1,t) do{int jb_=(t)-(NT-4); if(jb_>=0)cmask(P0,P1,jb_,qrel,hi);}while(0)
  #define ENDW(tt) do{ if((tt)+3<NT){WAIT_BAR(2);} else if((tt)+2<NT){WAIT_BAR(1);} else {WAIT_BAR(0);} }while(0)
  for(;t+1<NT;t+=2){
    STEP(pB0,pB1,pA0,pA1,t,(t+3<NT),(t+1<NT),(t+1<NT));       ENDW(t);   RESC(); ROT();
    STEP(pA0,pA1,pB0,pB1,t+1,(t+4<NT),(t+2<NT),(t+2<NT));     ENDW(t+1); RESC(); ROT();
  }
  STEP(pB0,pB1,pA0,pA1,NT-1,false,false,false); RESC();
  { float sacc=pB0[0]+pB0[1]; _Pragma("unroll") for(int r=2;r<16;++r)sacc+=pB0[r]; _Pragma("unroll") for(int r=0;r<16;++r)sacc+=pB1[r]; l_reg+=sacc;
    pw0=(u32x4){PKW(pB0,0),PKW(pB0,2),PKW(pB0,4),PKW(pB0,6)};pw1=(u32x4){PKW(pB0,8),PKW(pB0,10),PKW(pB0,12),PKW(pB0,14)};pw2=(u32x4){PKW(pB1,0),PKW(pB1,2),PKW(pB1,4),PKW(pB1,6)};pw3=(u32x4){PKW(pB1,8),PKW(pB1,10),PKW(pB1,12),PKW(pB1,14)};
    SBAR(); pv(o,vb0+sl_cur,PAF(0),PAF(1),PAF(2),PAF(3)); }
  #undef PKW
  #undef PAF
  #undef VFR
  #undef PIN
  #undef MX3
  #undef GAPA
  #undef GAPB
  #undef EX
  #undef VRD
  #undef KRD
  #undef STEP
  #undef ENDW
  {auto rr=__builtin_amdgcn_permlane32_swap(__float_as_uint(l_reg),__float_as_uint(l_reg),false,false);l_reg=__uint_as_float(rr[0])+__uint_as_float(rr[1]);}
  if(hi==0)wsf[32+r32]=l_reg;asm volatile("s_waitcnt lgkmcnt(0)":::"memory");
  float rli[16];
  #pragma unroll
  for(int r=0;r<16;++r)rli[r]=__builtin_amdgcn_rcpf(wsf[32+crow(r,hi)]);
  bf16*Ow=O+(rowbase+q0+wid*QBLK)*OP+h*D;
  { bf16*stg=(bf16*)(shm+LDS_OST)+wid*2048;
    #pragma unroll
    for(int r=0;r<16;++r){const int orow=crow(r,hi);
      #pragma unroll
      for(int d0=0;d0<2;++d0)stg[orow*64+d0*32+r32]=__float2bfloat16(o[d0][r]*rli[r]);}
    asm volatile("s_waitcnt lgkmcnt(0)":::"memory");
    #pragma unroll
    for(int i=0;i<4;++i){const int row=i*8+(lane>>3),ch=lane&7; const u32x4 v=*(const u32x4*)(stg+row*64+ch*8); ATTN_STORE16(Ow+(long)row*OP+ch*8,v);} }
  asm volatile("s_waitcnt lgkmcnt(0)\n\ts_barrier":::"memory");
  #undef DMA_K
  #undef DMA_V
  #undef CMASK
  #undef START
  #undef RESC
  #undef ROT
  #undef CBIAS
}
constexpr int ATTN_LDS_BYTES=LDS_BYTES;
#undef SBAR
#undef WAIT_BAR
}

namespace ssd {
constexpr int BP = 136, TP = 72, CBP = 68, SP = 136;
constexpr int L_BC = 0, L_CC = 17408, L_BT = 34816, L_CB = 53248, L_ACS = 70656, L_DT = 71680, L_ST = 72704, ST_BYTES = 8704, L_RS = L_ST + 8 * ST_BYTES, L_END = L_RS + 2048;
struct Ptrs { const bf16_t* XBC; const bf16_t* Zs; const float* DT; const float* conv_w; const float* conv_b; const float* A_log; const float* D_skip;
              const float* state_conv; const float* state_ssm; float* SL; float* dAtot; float* GSS; bf16_t* Mix; float* out; };
#define MFMA32(a, b, c) __builtin_amdgcn_mfma_f32_32x32x16_bf16((a), (b), (c), 0, 0, 0)
#define LDSFENCE() asm volatile("s_waitcnt lgkmcnt(0)" ::: "memory")

template <int MODE> __device__ __forceinline__ void unit(const Ptrs& P, unsigned char* lds, int b, int blk, int hq) {
    int tid_ = threadIdx.x; asm volatile("" : "+v"(tid_));
    const int tid = tid_, lane = tid & 63, wid = __builtin_amdgcn_readfirstlane(tid >> 6), r32 = lane & 31, hi = lane >> 5;
    const int g = hq >> 1, hl = wid >> 1, ph = wid & 1, h = hq * 4 + hl;
    constexpr int NSUB = (MODE == 2) ? 1 : 4;
    constexpr int nvalid = (MODE == 2) ? 16 : 256;
    const int row0 = (MODE == 2) ? MP + b * 16 : b * PSEQ + blk * 256;
    bf16_t* Bc = (bf16_t*)(lds + L_BC); bf16_t* Cc = (bf16_t*)(lds + L_CC); bf16_t* BT = (bf16_t*)(lds + L_BT); float* CB = (float*)(lds + L_CB);
    float* rsL = (float*)(lds + L_RS); float* acsL = (float*)(lds + L_ACS); float* dtL = (float*)(lds + L_DT); bf16_t* St = (bf16_t*)(lds + L_ST + wid * ST_BYTES);
    const int xcol = h * 64 + ph * 32 + r32;
    const int cp = tid & 127, seg = tid >> 7, ch = 2 * cp; const int scol = (ch < 128) ? 1024 + 128 * g + ch : 1280 + 128 * g + (ch - 128);
    const float Asc = -__expf(P.A_log[hq * 4 + (wid & 3)]);
    const float Dh = P.D_skip[h];
    f32x16 st[4];
    if (MODE == 0) {
#pragma unroll
        for (int nb = 0; nb < 4; ++nb) st[nb] = f32x16{};
    } else if (MODE == 1) {
        const float* sp = P.SL + ((size_t)((b * 32 + blk) * 16 + h)) * 8192 + (size_t)(ph * 4) * 1024 + lane;
#pragma unroll
        for (int nb = 0; nb < 4; ++nb)
#pragma unroll
            for (int r = 0; r < 16; ++r) st[nb][r] = sp[(nb * 16 + r) * 64];
    } else {
        const float* sp = P.state_ssm + ((size_t)(b * 16 + h) * 64 + ph * 32 + r32) * 128 + 4 * hi;
#pragma unroll
        for (int nb = 0; nb < 4; ++nb)
#pragma unroll
            for (int q4 = 0; q4 < 4; ++q4) { const f32x4 v = *(const f32x4*)(sp + 32 * nb + 8 * q4); st[nb][4 * q4] = v[0]; st[nb][4 * q4 + 1] = v[1]; st[nb][4 * q4 + 2] = v[2]; st[nb][4 * q4 + 3] = v[3]; }
    }
    float dasum = 0.f;
    unsigned uu[16]; float dtn = 0.f;
    auto load_stage = [&](int tbn) {
        if (MODE != 0 || ch < 128) { const int t0 = tbn + 16 * seg; const bf16_t* sp = P.XBC + (unsigned)((row0 + t0) * DCONV + scol);
#pragma unroll
            for (int i = 0; i < 16; ++i) { uu[i] = *(const unsigned*)(sp + i * DCONV); if (MODE == 2) { asm volatile("" : "+v"(uu[i])); if (t0 + i >= nvalid) uu[i] = 0u; } } }
        if (wid < 4) { const int t = tbn + lane; dtn = (t < nvalid) ? P.DT[(unsigned)((row0 + t) * 16 + hq * 4 + wid)] : 0.f; }
    };
    if (MODE == 0) load_stage(0);
#pragma unroll 1
    for (int sc = 0; sc < NSUB; ++sc) {
        const int tb = 64 * sc;
        unsigned xvp[4][4];
        {
            const bf16_t* xp = P.XBC + (unsigned)((row0 + tb + 8 * hi) * DCONV + xcol);
#pragma unroll
            for (int ks = 0; ks < 4; ++ks)
#pragma unroll
                for (int i = 0; i < 4; ++i) { unsigned lo = xp[(16 * ks + 2 * i) * DCONV], hi16 = xp[(16 * ks + 2 * i + 1) * DCONV];
                    if (MODE == 2) { asm volatile("" : "+v"(lo), "+v"(hi16));     if (tb + 16 * ks + 8 * hi + 2 * i >= nvalid) lo = 0u; if (tb + 16 * ks + 8 * hi + 2 * i + 1 >= nvalid) hi16 = 0u; }
                    xvp[ks][i] = lo | (hi16 << 16); }
        }
        if (MODE != 0) load_stage(tb);
        if (MODE != 0 || ch < 128) {
            bf16_t* nat = ((ch < 128) ? Bc : Cc) + (ch & 127);
#pragma unroll
            for (int i = 0; i < 16; ++i) *(unsigned*)(nat + (16 * seg + i) * BP) = uu[i];
            if (ch < 128) {
                unsigned bt0[8], bt1[8];
#pragma unroll
                for (int i = 0; i < 8; ++i) { bt0[i] = (uu[2 * i] & 0xffffu) | (uu[2 * i + 1] << 16); bt1[i] = (uu[2 * i] >> 16) | (uu[2 * i + 1] & 0xffff0000u); }
                *(u32x4*)(BT + ch * TP + 16 * seg) = (u32x4){bt0[0], bt0[1], bt0[2], bt0[3]}; *(u32x4*)(BT + ch * TP + 16 * seg + 8) = (u32x4){bt0[4], bt0[5], bt0[6], bt0[7]};
                *(u32x4*)(BT + (ch + 1) * TP + 16 * seg) = (u32x4){bt1[0], bt1[1], bt1[2], bt1[3]}; *(u32x4*)(BT + (ch + 1) * TP + 16 * seg + 8) = (u32x4){bt1[4], bt1[5], bt1[6], bt1[7]};
            }
        }
        if (wid < 4) {
            const float dt = dtn;
            float a = dt * Asc;
#pragma unroll
            for (int o = 1; o < 64; o <<= 1) { const float v = __shfl_up(a, o); if (lane >= o) a += v; }
            acsL[wid * 64 + lane] = a; dtL[wid * 64 + lane] = dt; dasum += __shfl(a, 63);
        }
#define XV(ks, j) (((j) & 1) ? __uint_as_float(xvp[ks][(j) >> 1] & 0xffff0000u) : __uint_as_float(xvp[ks][(j) >> 1] << 16))
        __syncthreads();
        if (MODE != 0) {
            if (wid < 3) { const int lb = wid > 0 ? 1 : 0, sb = wid > 1 ? 1 : 0; f32x16 cacc = f32x16{};
#pragma unroll
                for (int ks = 0; ks < 8; ++ks) { const bf16x8 av = *(const bf16x8*)(Cc + (32 * lb + r32) * BP + 16 * ks + 8 * hi), bv = *(const bf16x8*)(Bc + (32 * sb + r32) * BP + 16 * ks + 8 * hi); cacc = MFMA32(av, bv, cacc); }
#pragma unroll
                for (int r = 0; r < 16; ++r) CB[(32 * lb + crow_(r, hi)) * CBP + 32 * sb + r32] = cacc[r]; }
            __syncthreads();
        }
        const float* acsH = acsL + hl * 64; const float* dtH = dtL + hl * 64;
        const float acs_last = acsH[63];
        if (MODE != 0) {
#pragma unroll
            for (int nb = 0; nb < 4; ++nb)
#pragma unroll
                for (int q4 = 0; q4 < 4; ++q4) *(u32x2*)(St + r32 * SP + 32 * nb + 8 * q4 + 4 * hi) = (u32x2){cvtpk(st[nb][4 * q4], st[nb][4 * q4 + 1]), cvtpk(st[nb][4 * q4 + 2], st[nb][4 * q4 + 3])};
            LDSFENCE();
#pragma unroll 1
            for (int lb = 0; lb < 2; ++lb) { if (MODE == 2 && lb == 1) continue;
                f32x16 y = f32x16{};
                unsigned short zr[16];
#pragma unroll
                for (int q4 = 0; q4 < 4; ++q4)
#pragma unroll
                    for (int e = 0; e < 4; ++e) { const int lr = 32 * lb + 8 * q4 + 4 * hi + e; const int row = row0 + tb + lr; zr[4 * q4 + e] = P.Zs[(unsigned)(row * 1024 + xcol)]; }
#pragma unroll
                for (int ks = 0; ks < 8; ++ks) { const bf16x8 av = *(const bf16x8*)(Cc + (32 * lb + r32) * BP + 16 * ks + 8 * hi), bv = *(const bf16x8*)(St + r32 * SP + 16 * ks + 8 * hi); y = MFMA32(av, bv, y); }
#pragma unroll
                for (int q4 = 0; q4 < 4; ++q4) { const f32x4 a4 = *(const f32x4*)(acsH + 32 * lb + 8 * q4 + 4 * hi);
#pragma unroll
                    for (int e = 0; e < 4; ++e) y[4 * q4 + e] *= __expf(a4[e]); }
                const int l = 32 * lb + r32; const float al = acsH[l];
#pragma unroll
                for (int ks = 0; ks < 4; ++ks) { if (ks > 2 * lb + 1) continue;
                    const int s0 = 16 * ks + 8 * hi;
                    const f32x4 c0 = *(const f32x4*)(CB + l * CBP + s0), c1 = *(const f32x4*)(CB + l * CBP + s0 + 4);
                    const f32x4 s4a = *(const f32x4*)(acsH + s0), s4b = *(const f32x4*)(acsH + s0 + 4), d4a = *(const f32x4*)(dtH + s0), d4b = *(const f32x4*)(dtH + s0 + 4);
                    float gg[8], xa[8];
#pragma unroll
                    for (int j = 0; j < 8; ++j) { const float cbv = j < 4 ? c0[j] : c1[j - 4], as = j < 4 ? s4a[j] : s4b[j - 4], dv = j < 4 ? d4a[j] : d4b[j - 4];
                        gg[j] = (s0 + j <= l) ? cbv * __expf(al - as) : 0.f; xa[j] = XV(ks, j) * dv; }
                    const u32x4 gp = {cvtpk(gg[0], gg[1]), cvtpk(gg[2], gg[3]), cvtpk(gg[4], gg[5]), cvtpk(gg[6], gg[7])};
                    const u32x4 xp = {cvtpk(xa[0], xa[1]), cvtpk(xa[2], xa[3]), cvtpk(xa[4], xa[5]), cvtpk(xa[6], xa[7])};
                    y = MFMA32(__builtin_bit_cast(bf16x8, gp), __builtin_bit_cast(bf16x8, xp), y);
                    if (ks >= 2 * lb) { float di[8];
#pragma unroll
                        for (int j = 0; j < 8; ++j) di[j] = (s0 + j == l) ? Dh : 0.f;
                        const u32x4 dp = {cvtpk(di[0], di[1]), cvtpk(di[2], di[3]), cvtpk(di[4], di[5]), cvtpk(di[6], di[7])};
                        const u32x4 xr = {xvp[ks][0], xvp[ks][1], xvp[ks][2], xvp[ks][3]};
                        y = MFMA32(__builtin_bit_cast(bf16x8, dp), __builtin_bit_cast(bf16x8, xr), y); } }
                float s2v[16];
#pragma unroll
                for (int q4 = 0; q4 < 4; ++q4)
#pragma unroll
                    for (int e = 0; e < 4; ++e) { const int r = 4 * q4 + e; const int lr = 32 * lb + 8 * q4 + 4 * hi + e; const int row = row0 + tb + lr;
                        const float yv = y[r] * bf2f(zr[r]);
                        if (MODE != 2 || q4 < 2) P.Mix[(unsigned)(row * DMIX + xcol)] = (bf16_t)(cvtpk(yv, 0.f) & 0xffffu);
                        float s2 = yv * yv;
                        s2 += __shfl_xor(s2, 1); s2 += __shfl_xor(s2, 2); s2 += __shfl_xor(s2, 4); s2 += __shfl_xor(s2, 8); s2 += __shfl_xor(s2, 16);
                        s2v[r] = s2; }
                asm volatile("" ::: "memory");
                if (r32 == 0) {
#pragma unroll
                    for (int q4 = 0; q4 < 4; ++q4)
#pragma unroll
                        for (int e = 0; e < 4; ++e) rsL[wid * 64 + 32 * lb + 8 * q4 + 4 * hi + e] = s2v[4 * q4 + e];
                }
            }
        }
        if (MODE == 0 && sc + 1 < NSUB) load_stage(tb + 64);
        {
            const float dec = __expf(acs_last);
#pragma unroll
            for (int nb = 0; nb < 4; ++nb) st[nb] *= dec;
#pragma unroll
            for (int ks = 0; ks < 4; ++ks) { const int s0 = 16 * ks + 8 * hi;
                const f32x4 s4a = *(const f32x4*)(acsH + s0), s4b = *(const f32x4*)(acsH + s0 + 4), d4a = *(const f32x4*)(dtH + s0), d4b = *(const f32x4*)(dtH + s0 + 4);
                float xb[8];
#pragma unroll
                for (int j = 0; j < 8; ++j) { const float as = j < 4 ? s4a[j] : s4b[j - 4], dv = j < 4 ? d4a[j] : d4b[j - 4]; xb[j] = XV(ks, j) * dv * __expf(acs_last - as); }
                const u32x4 xp = {cvtpk(xb[0], xb[1]), cvtpk(xb[2], xb[3]), cvtpk(xb[4], xb[5]), cvtpk(xb[6], xb[7])};
#pragma unroll
                for (int nb = 0; nb < 4; ++nb) { const bf16x8 av = *(const bf16x8*)(BT + (32 * nb + r32) * TP + 16 * ks + 8 * hi); st[nb] = MFMA32(av, __builtin_bit_cast(bf16x8, xp), st[nb]); } }
        }
        __syncthreads();
        if (MODE != 0) { if (tid < ((MODE == 2) ? 16 : 64)) { float s = 0.f;
#pragma unroll
                for (int w = 0; w < 8; ++w) s += rsL[w * 64 + tid];
                P.GSS[(unsigned)((row0 + tb + tid) * 4 + hq)] = s; } }
    }
    if (MODE == 0) {
        float* sp = P.SL + ((size_t)((b * 32 + blk) * 16 + h)) * 8192 + (size_t)(ph * 4) * 1024 + lane;
#pragma unroll
        for (int nb = 0; nb < 4; ++nb)
#pragma unroll
            for (int r = 0; r < 16; ++r) sp[(nb * 16 + r) * 64] = st[nb][r];
        if (wid < 4 && lane == 0) P.dAtot[(b * 32 + blk) * 16 + hq * 4 + wid] = dasum;
    } else if (MODE == 2 || blk == 31) {
        float* sp = P.out + (MODE == 2 ? O_SSSM : O_PSSM) + ((size_t)(b * 16 + h) * 64 + ph * 32 + r32) * 128 + 4 * hi;
#pragma unroll
        for (int nb = 0; nb < 4; ++nb)
#pragma unroll
            for (int q4 = 0; q4 < 4; ++q4) *(f32x4*)(sp + 32 * nb + 8 * q4) = (f32x4){st[nb][4 * q4], st[nb][4 * q4 + 1], st[nb][4 * q4 + 2], st[nb][4 * q4 + 3]};
    }
}
#undef XV
}

namespace sattn {
constexpr int L_C = 0, L_M = 16640, L_L = L_M + 512, L_O = L_L + 512, OPITCH = 17, L_SCAN = L_O + 8 * 64 * OPITCH * 4, L_END = L_SCAN + 64;
struct Ptrs { const float* cache_k; const float* cache_v; const float* cache_logf; const bf16_t* Qb; const bf16_t* Kb; const bf16_t* Vb; const float* out; bf16_t* Mix; };
__device__ __forceinline__ void unit(const Ptrs& P, unsigned char* lds, int b, int h) {
    int tid_ = threadIdx.x; asm volatile("" : "+v"(tid_));
    const int tid = tid_, lane = tid & 63, wid = __builtin_amdgcn_readfirstlane(tid >> 6), r32 = lane & 31, hi = lane >> 5;
    float* cL = (float*)(lds + L_C); float* mW = (float*)(lds + L_M); float* lW = (float*)(lds + L_L); float* OW = (float*)(lds + L_O); float* wtot = (float*)(lds + L_SCAN);
    constexpr int NK = PAST + SSEQ;
    {
        float v[16]; float run = 0.f; const int s0 = 16 * tid;
#pragma unroll
        for (int i = 0; i < 16; ++i) v[i] = 0.f;
        if (tid < PAST / 16) { const float* lp = P.cache_logf + ((size_t)b * PAST + s0) * 8 + h;
#pragma unroll
            for (int i = 0; i < 16; ++i) v[i] = lp[i * 8];
        } else if (tid == PAST / 16) { const float* lp = P.out + O_SLF + ((size_t)b * 16) * 8 + h;
#pragma unroll
            for (int i = 0; i < 16; ++i) v[i] = lp[i * 8];
        }
#pragma unroll
        for (int i = 0; i < 16; ++i) run += v[i];
        float inc = run;
#pragma unroll
        for (int o = 1; o < 64; o <<= 1) { const float t = __shfl_up(inc, o); if (lane >= o) inc += t; }
        if (lane == 63) wtot[wid] = inc;
        __syncthreads();
        float off = inc - run;
        for (int w = 0; w < wid; ++w) off += wtot[w];
#pragma unroll
        for (int i = 0; i < 16; ++i) { off += v[i]; const int s = s0 + i; if (s < NK + 16) cL[s] = off * L2E; }
        __syncthreads();
    }
    const int q = r32 & 15; const long qrow = (long)MP + b * 16 + q;
    bf16x8 qf[4];
#pragma unroll
    for (int ks = 0; ks < 4; ++ks) qf[ks] = *(const bf16x8*)(P.Qb + qrow * 512 + h * 64 + 16 * ks + 8 * hi);
    const float cq = cL[PAST + q];
    float m = -1e30f, l = 0.f; f32x16 o[2]; o[0] = f32x16{}; o[1] = f32x16{};
    int tile0;
    { const float c0 = cL[PAST]; const int t1 = lane, t2 = lane + 64;
      const bool s1 = (c0 - cL[32 * t1 + 31]) < -(64.0f * L2E), s2 = (c0 - cL[32 * t2 + 31]) < -(64.0f * L2E);
      tile0 = __builtin_amdgcn_readfirstlane(__builtin_popcountll(__ballot(s1)) + __builtin_popcountll(__ballot(s2))); }
    for (int tile = tile0 + wid; tile < 129; tile += 8) {
        const int key0 = 32 * tile; const bool isnew = tile == 128;
        bf16x8 kf[4];
        if (!isnew) { const float* kp = P.cache_k + (((size_t)b * PAST + key0 + r32) * 8 + h) * 64 + 8 * hi;
#pragma unroll
            for (int ks = 0; ks < 4; ++ks) { const f32x4 a = *(const f32x4*)(kp + 16 * ks), c = *(const f32x4*)(kp + 16 * ks + 4);
                const u32x4 w = {cvtpk(a[0], a[1]), cvtpk(a[2], a[3]), cvtpk(c[0], c[1]), cvtpk(c[2], c[3])}; kf[ks] = __builtin_bit_cast(bf16x8, w); }
        } else {
#pragma unroll
            for (int ks = 0; ks < 4; ++ks) kf[ks] = *(const bf16x8*)(P.Kb + ((long)MP + b * 16 + (r32 & 15)) * 512 + h * 64 + 16 * ks + 8 * hi);
        }
        float vall[2][2][8];
        if (!isnew) {
#pragma unroll
            for (int db = 0; db < 2; ++db)
#pragma unroll
                for (int s2 = 0; s2 < 2; ++s2)
#pragma unroll
                    for (int j = 0; j < 8; ++j) { const int kv = crow_(8 * s2 + j, hi); vall[db][s2][j] = P.cache_v[(((size_t)b * PAST + key0 + kv) * 8 + h) * 64 + 32 * db + r32]; }
        } else {
#pragma unroll
            for (int db = 0; db < 2; ++db)
#pragma unroll
                for (int s2 = 0; s2 < 2; ++s2)
#pragma unroll
                    for (int j = 0; j < 8; ++j) { const int kv = crow_(8 * s2 + j, hi); vall[db][s2][j] = bf2f(P.Vb[((long)MP + b * 16 + (kv & 15)) * 512 + h * 64 + 32 * db + r32]) * (kv < 16 ? 1.f : 0.f); }
        }
        f32x16 s = f32x16{};
#pragma unroll
        for (int ks = 0; ks < 4; ++ks) s = MFMA32(kf[ks], qf[ks], s);
        float mt = -1e30f;
#pragma unroll
        for (int q4 = 0; q4 < 4; ++q4) { const f32x4 c4 = *(const f32x4*)(cL + key0 + 8 * q4 + 4 * hi);
#pragma unroll
            for (int e = 0; e < 4; ++e) { const int r = 4 * q4 + e; const int kv = 8 * q4 + 4 * hi + e; float x = s[r] + (cq - c4[e]);
                if (isnew && (kv >= 16 || kv > q)) x = -1e30f;
                s[r] = x; mt = fmaxf(mt, x); } }
        mt = fmaxf(mt, __shfl_xor(mt, 32));
        const float mn = fmaxf(m, mt), alpha = __builtin_amdgcn_exp2f(m - mn); m = mn;
        float ls = 0.f;
#pragma unroll
        for (int r = 0; r < 16; ++r) { const float p = __builtin_amdgcn_exp2f(s[r] - mn); s[r] = p; ls += p; }
        l = l * alpha + ls;
#pragma unroll
        for (int db = 0; db < 2; ++db) o[db] *= alpha;
        bf16x8 pf[2];
#pragma unroll
        for (int s2 = 0; s2 < 2; ++s2) { const u32x4 w = {cvtpk(s[8 * s2], s[8 * s2 + 1]), cvtpk(s[8 * s2 + 2], s[8 * s2 + 3]), cvtpk(s[8 * s2 + 4], s[8 * s2 + 5]), cvtpk(s[8 * s2 + 6], s[8 * s2 + 7])}; pf[s2] = __builtin_bit_cast(bf16x8, w); }
#pragma unroll
        for (int db = 0; db < 2; ++db)
#pragma unroll
            for (int s2 = 0; s2 < 2; ++s2) { const float* vv = vall[db][s2];
                const u32x4 w = {cvtpk(vv[0], vv[1]), cvtpk(vv[2], vv[3]), cvtpk(vv[4], vv[5]), cvtpk(vv[6], vv[7])};
                o[db] = MFMA32(__builtin_bit_cast(bf16x8, w), pf[s2], o[db]); }
    }
    l += __shfl_xor(l, 32);
    if (r32 < 16) { if (hi == 0) { mW[wid * 16 + r32] = m; lW[wid * 16 + r32] = l; }
#pragma unroll
        for (int db = 0; db < 2; ++db)
#pragma unroll
            for (int r = 0; r < 16; ++r) OW[(wid * 64 + 32 * db + crow_(r, hi)) * OPITCH + r32] = o[db][r]; }
    __syncthreads();
#pragma unroll
    for (int it = 0; it < 2; ++it) { const int idx = tid + 512 * it, d = idx & 63, qq = idx >> 6;
        float M = -1e30f;
#pragma unroll
        for (int w = 0; w < 8; ++w) M = fmaxf(M, mW[w * 16 + qq]);
        float L = 0.f, acc = 0.f;
#pragma unroll
        for (int w = 0; w < 8; ++w) { const float f = __builtin_amdgcn_exp2f(mW[w * 16 + qq] - M); L += lW[w * 16 + qq] * f; acc += OW[(w * 64 + d) * OPITCH + qq] * f; }
        P.Mix[((long)MP + b * 16 + qq) * DMIX + 1024 + h * 64 + d] = (bf16_t)(cvtpk(acc / L, 0.f) & 0xffffu); }
    __syncthreads();
}
}

constexpr int NWAVES = 8, LDS_BYTES = 147456;
#define LAS __attribute__((address_space(3)))
struct Args {
    const float *x_prompt, *x_sample, *cache_k, *cache_v, *cache_logf, *state_ssm, *state_conv, *norm1_w, *w_in, *conv_w, *conv_b, *dt_bias, *A_log, *D_skip, *ssd_norm_w, *f_bias,
                *q_norm_w, *k_norm_w, *w_out, *norm2_w, *w_up, *w_down;
    float* out; unsigned char* ws;
};
__device__ __forceinline__ unsigned pk2(float lo, float hi) { return cvtpk(lo, hi); }
template <int MAP> __device__ __forceinline__ void transpose_item(const float* W, int K, int Nsrc, int Nphys, bf16_t* WT, const float* ksc, int ksc_n, float* scr, int item, int lane) {
    const int nblk = Nphys / 32, kb = item / nblk, nb = item % nblk, k0 = 64 * kb, n0 = 32 * nb;
    const int n = n0 + (lane & 31); int src = n;
    if (MAP == 1) { const int L = (n & ~255) + ((n >> 5) & 3) * 64 + ((n >> 7) & 1) * 32 + (n & 31);
        if (L < 2560) src = L; else if (L < 4096) src = L + 16; else if (L < 4112) src = 2560 + (L - 4096); else if (L < 4120) src = L; else src = -1; }
#pragma unroll
    for (int i = 0; i < 32; ++i) { const int kk = 2 * i + (lane >> 5); float v = (src >= 0) ? W[(size_t)(k0 + kk) * Nsrc + src] : 0.f; if (ksc && (k0 + kk) < ksc_n) v *= ksc[k0 + kk]; scr[kk * 33 + (lane & 31)] = v; }
    asm volatile("s_waitcnt lgkmcnt(0)" ::: "memory");
    const int c = lane & 7;
#pragma unroll
    for (int j = 0; j < 4; ++j) { const int nn = (lane >> 3) + 8 * j; const float* s = scr + (8 * c) * 33 + nn;
        u32x4 o; o.x = pk2(s[0 * 33], s[1 * 33]); o.y = pk2(s[2 * 33], s[3 * 33]); o.z = pk2(s[4 * 33], s[5 * 33]); o.w = pk2(s[6 * 33], s[7 * 33]);
        *(u32x4*)(WT + (size_t)(n0 + nn) * K + k0 + 8 * c) = o; }
    asm volatile("s_waitcnt lgkmcnt(0)" ::: "memory");
}
__device__ __forceinline__ float wave_sum(float v) {
#pragma unroll
    for (int o = 1; o < 64; o <<= 1) v += __shfl_xor(v, o);
    return v;
}
__device__ __forceinline__ void rms_row_to_bf16(const float* xrow, bf16_t* orow, int lane) {
    const f32x4* xr = (const f32x4*)xrow + lane; f32x4 v[4]; float s = 0.f;
#pragma unroll
    for (int j = 0; j < 4; ++j) { v[j] = xr[64 * j]; s += (v[j][0] * v[j][0] + v[j][1] * v[j][1]) + (v[j][2] * v[j][2] + v[j][3] * v[j][3]); }
    const float rs = rsqrtf(wave_sum(s) * (1.0f / 1024.0f) + EPSN);
    u32x2* o8 = (u32x2*)orow + lane;
#pragma unroll
    for (int j = 0; j < 4; ++j) o8[64 * j] = (u32x2){pk2(v[j][0] * rs, v[j][1] * rs), pk2(v[j][2] * rs, v[j][3] * rs)};
}

template <int PH> __device__ __forceinline__ void run_phase(const Args& a, unsigned char* lds) {
    int tid_ = threadIdx.x; asm volatile("" : "+v"(tid_));
    const int tid = tid_, lane = tid & 63, wave = __builtin_amdgcn_readfirstlane(tid >> 6);
    int G_ = gridDim.x, bx_ = blockIdx.x; asm volatile("" : "+s"(G_), "+s"(bx_));
    const int G = G_, bx = bx_;
    unsigned char* ws = a.ws; float* out = a.out;
    float* SS1 = (float*)(ws + WS_SS1P); float* GSS = (float*)(ws + WS_GSSP); float* DAT = (float*)(ws + WS_DAT); float* CP = (float*)(ws + WS_CP);
    bf16_t* WinT = (bf16_t*)(ws + WS_WIN); bf16_t* WoutT = (bf16_t*)(ws + WS_WOUT); bf16_t* WupT = (bf16_t*)(ws + WS_WUP); bf16_t* WdnT = (bf16_t*)(ws + WS_WDN);
    bf16_t* XN = (bf16_t*)(ws + WS_XN); float* DT = (float*)(ws + WS_DT); float* SL = (float*)(ws + WS_SL); bf16_t* Zs = (bf16_t*)(ws + WS_ZS); bf16_t* XBC = (bf16_t*)(ws + WS_XBC);
    bf16_t* Qb = (bf16_t*)(ws + WS_QB); bf16_t* Kb = (bf16_t*)(ws + WS_KB); bf16_t* Vb = (bf16_t*)(ws + WS_VB); bf16_t* Mix = (bf16_t*)(ws + WS_MIX); bf16_t* Hb = (bf16_t*)(ws + WS_H);
    (void)tid; (void)lane; (void)wave; (void)SS1; (void)GSS; (void)DAT; (void)CP; (void)WinT; (void)WoutT; (void)WupT; (void)WdnT; (void)XN; (void)DT; (void)SL; (void)Zs; (void)XBC; (void)Qb; (void)Kb; (void)Vb; (void)Mix; (void)Hb; (void)out;
    if constexpr (PH == 0) {
    {
        float* scr = (float*)(lds + wave * 16384);
        const int gw = bx * NWAVES + wave, NGW = G * NWAVES;
        constexpr int I_IN = (1024 / 64) * (NIN / 32), I_OUT = (1536 / 64) * (1024 / 32), I_UP = (1024 / 64) * (4096 / 32), I_DN = (4096 / 64) * (1024 / 32);
        for (int it = gw; it < I_IN + I_OUT + I_UP + I_DN; it += NGW) {
            int r = it;
            if (r < I_IN) { transpose_item<1>(a.w_in, 1024, 4120, NIN, WinT, a.norm1_w, 1024, scr, r, lane); continue; } r -= I_IN;
            if (r < I_OUT) { transpose_item<0>(a.w_out, 1536, 1024, 1024, WoutT, a.ssd_norm_w, 1024, scr, r, lane); continue; } r -= I_OUT;
            if (r < I_UP) { transpose_item<0>(a.w_up, 1024, 4096, 4096, WupT, a.norm2_w, 1024, scr, r, lane); continue; } r -= I_UP;
            transpose_item<0>(a.w_down, 4096, 1024, 1024, WdnT, nullptr, 0, scr, r, lane);
        }
        for (int m0 = gw; m0 < MT; m0 += 4 * NGW) {
            f32x4 v[4][4]; float s[4];
#pragma unroll
            for (int r = 0; r < 4; ++r) { const int m = m0 + r * NGW; const int mc = m < MT ? m : MT - 1;
                const f32x4* xr = (const f32x4*)(mc < MP ? a.x_prompt + (size_t)mc * 1024 : a.x_sample + (size_t)(mc - MP) * 1024) + lane; s[r] = 0.f;
#pragma unroll
                for (int j = 0; j < 4; ++j) { v[r][j] = xr[64 * j]; } }
#pragma unroll
            for (int r = 0; r < 4; ++r) {
#pragma unroll
                for (int j = 0; j < 4; ++j) s[r] += (v[r][j][0] * v[r][j][0] + v[r][j][1] * v[r][j][1]) + (v[r][j][2] * v[r][j][2] + v[r][j][3] * v[r][j][3]);
                const float rs = rsqrtf(wave_sum(s[r]) * (1.0f / 1024.0f) + EPSN); const int m = m0 + r * NGW;
                if (m < MT) { u32x2* o8 = (u32x2*)(XN + (size_t)m * 1024) + lane;
#pragma unroll
                    for (int j = 0; j < 4; ++j) o8[64 * j] = (u32x2){pk2(v[r][j][0] * rs, v[r][j][1] * rs), pk2(v[r][j][2] * rs, v[r][j][3] * rs)}; } }
        }
        if (bx == 0 && tid < 64) ((unsigned*)(ws + WS_CTR))[tid] = 0u;
    }
    }
    if constexpr (PH == 1) {
    {
        pg8::Gemm g{XN, WinT, MT, NIN, 1024, 0}; pg8::StaticOrder S; S.init(MT, NIN, G, bx);
        pg8::EpiIn E{Zs, XBC, Qb, Kb, Vb, DT, out, a.dt_bias, a.f_bias, a.q_norm_w, a.k_norm_w, (bf16_t*)(ws + WS_HIST)};
        pg8::gemm_phase<pg8::EpiIn, pg8::StaticOrder, true, true>((PG8_LAS unsigned char*)lds, g, S, E);
    }
    }
    if constexpr (PH == 9) {
    {
        const bf16_t* HIST = (const bf16_t*)(ws + WS_HIST);
        constexpr int NSEG = MP / 128, NPAIR = DCONV / 2, NTASK = (NSEG + SBATCH) * NPAIR;
        for (int task = bx * 512 + tid; task < NTASK; task += G * 512) {
            const int seg = task / NPAIR, col = 2 * (task - seg * NPAIR);
            float w0[4], w1[4];
#pragma unroll
            for (int k = 0; k < 4; ++k) { w0[k] = a.conv_w[k * DCONV + col]; w1[k] = a.conv_w[k * DCONV + col + 1]; }
            const float b0 = a.conv_b[col], b1 = a.conv_b[col + 1];
            float a3 = 0.f, c3 = 0.f, a2 = 0.f, c2 = 0.f, a1 = 0.f, c1 = 0.f; int row0, n;
            if (seg < NSEG) { row0 = seg * 128; n = 128;
                if (seg & 63) { const bf16_t* hp = HIST + (unsigned)((seg - 1) * 3 * DCONV + col);
                    const unsigned u3 = *(const unsigned*)hp, u2 = *(const unsigned*)(hp + DCONV), u1 = *(const unsigned*)(hp + 2 * DCONV);
                    a3 = bf2f(u3 & 0xffffu); c3 = bf2f(u3 >> 16); a2 = bf2f(u2 & 0xffffu); c2 = bf2f(u2 >> 16); a1 = bf2f(u1 & 0xffffu); c1 = bf2f(u1 >> 16); }
            } else { const int s = seg - NSEG; row0 = MP + s * 16; n = 16; const float* hp = a.state_conv + (unsigned)(s * 3 * DCONV + col);
                a3 = hp[0]; c3 = hp[1]; a2 = hp[DCONV]; c2 = hp[DCONV + 1]; a1 = hp[2 * DCONV]; c1 = hp[2 * DCONV + 1]; }
            bf16_t* xp = XBC + (unsigned)(row0 * DCONV + col);
            for (int i0 = 0; i0 < n; i0 += 16) {
                unsigned uu[16];
#pragma unroll
                for (int i = 0; i < 16; ++i) uu[i] = *(const unsigned*)(xp + (i0 + i) * DCONV);
#pragma unroll
                for (int i = 0; i < 16; ++i) { const float a0 = bf2f(uu[i] & 0xffffu), c0 = bf2f(uu[i] >> 16);
                    const float o0 = silu_f(b0 + w0[0] * a3 + w0[1] * a2 + w0[2] * a1 + w0[3] * a0), o1 = silu_f(b1 + w1[0] * c3 + w1[1] * c2 + w1[2] * c1 + w1[3] * c0);
                    *(unsigned*)(xp + (i0 + i) * DCONV) = cvtpk(o0, o1);
                    a3 = a2; c3 = c2; a2 = a1; c2 = c1; a1 = a0; c1 = c0; }
            }
        }
        sattn::Ptrs Q{a.cache_k, a.cache_v, a.cache_logf, Qb, Kb, Vb, out, Mix};
        for (int u = G - 1 - bx; u < SBATCH * 8; u += G) sattn::unit(Q, lds, u >> 3, u & 7);
    }
    }
    if constexpr (PH == 12) {
    {
        if (G >= 128) { const f32x4* part = (const f32x4*)(ws + WS_MIX); f32x4* y = (f32x4*)(out + O_Y + (size_t)MP * 1024);
            for (int i = bx * 512 + tid; i < MS * 1024 / 4; i += G * 512) { f32x4 s = y[i];
#pragma unroll
                for (int k = 0; k < 16; ++k) s += part[(size_t)k * (MS * 1024 / 4) + i];
                y[i] = s; } }
    }
    }
    if constexpr (PH == 10) {
    {
        const int ks = bx >> 3;
        pg8::Gemm g2{Hb + ks * 256, WdnT + ks * 256, MT, 1024, DFF, 4}; pg8::ListOrder S2{G, bx, G >= 128 ? 128 : 0, 8, MP / 256, 4, 0};
        pg8::EpiDownPartial E2{(float*)(ws + WS_MIX) + (size_t)ks * (MS * 1024)};
        pg8::gemm_phase<pg8::EpiDownPartial, pg8::ListOrder, true, true>((PG8_LAS unsigned char*)lds, g2, S2, E2);
    }
    }
    if constexpr (PH == 11) {
    {
        {
            pg8::Gemm g{Mix, WoutT, MT, 1024, DMIX, 0}; pg8::ListOrder S{G, bx, 8, 8, MP / 256, 4, 0};
            pg8::EpiOut E{a.x_prompt, a.x_sample, out + O_Y, XN, SS1, GSS};
            pg8::gemm_phase<pg8::EpiOut, pg8::ListOrder, true, true>((PG8_LAS unsigned char*)lds, g, S, E);
        }
    }
    }
    if constexpr (PH == 2) {
    {
        ssd::Ptrs P{XBC, Zs, DT, a.conv_w, a.conv_b, a.A_log, a.D_skip, a.state_conv, a.state_ssm, SL, DAT, GSS, Mix, out};
        for (int u = bx; u < PB * 32 * 4; u += G) ssd::unit<0>(P, lds, u >> 7, (u >> 2) & 31, u & 3);
        for (int u = bx; u < SBATCH * 4; u += G) ssd::unit<2>(P, lds, u >> 2, 0, u & 3);
    }
    }
    if constexpr (PH == 3) {
    {
        for (int item = bx * 512 + tid; item < PB * 16 * 8192; item += G * 512) {
            const int bh = item >> 13, b = bh >> 4, h = bh & 15, e = item & 8191; float s = 0.f;
            float* sp = SL + ((size_t)(b * 32 * 16 + h)) * 8192 + e; const float* dp = DAT + b * 32 * 16 + h; float loc[32], dec[32];
#pragma unroll
            for (int blk = 0; blk < 32; ++blk) { loc[blk] = sp[(size_t)blk * 16 * 8192]; dec[blk] = dp[blk * 16]; }
#pragma unroll
            for (int blk = 0; blk < 32; ++blk) { sp[(size_t)blk * 16 * 8192] = s; s = s * __expf(dec[blk]) + loc[blk]; } }
        float* wtot = (float*)lds;
        for (int bh = bx; bh < PB * 8; bh += G) { const int b = bh >> 3, h = bh & 7;
            float v[16]; float run = 0.f; const int s0 = 16 * tid;
#pragma unroll
            for (int i = 0; i < 16; ++i) { v[i] = out[O_PLF + ((size_t)b * PSEQ + s0 + i) * 8 + h]; run += v[i]; }
            float inc = run;
#pragma unroll
            for (int o = 1; o < 64; o <<= 1) { const float t = __shfl_up(inc, o); if (lane >= o) inc += t; }
            __syncthreads();
            if (lane == 63) wtot[wave] = inc;
            __syncthreads();
            float off = inc - run;
            for (int w = 0; w < wave; ++w) off += wtot[w];
#pragma unroll
            for (int i = 0; i < 16; ++i) { off += v[i]; CP[(size_t)bh * PSEQ + s0 + i] = off * L2E; } }
    }
    }
    if constexpr (PH == 4) {
    {
        ssd::Ptrs P{XBC, Zs, DT, a.conv_w, a.conv_b, a.A_log, a.D_skip, a.state_conv, a.state_ssm, SL, DAT, GSS, Mix, out};
        for (int u = bx; u < PB * 32 * 4; u += G) ssd::unit<1>(P, lds, u >> 7, (u >> 2) & 31, u & 3);
    }
    }
    if constexpr (PH == 8) {
    {
        const attn_body::bf16* Qa = (const attn_body::bf16*)Qb; const attn_body::bf16* Ka = (const attn_body::bf16*)Kb; const attn_body::bf16* Va = (const attn_body::bf16*)Vb;
        attn_body::bf16* Oa = (attn_body::bf16*)(Mix + 1024);
        unsigned* ctr = (unsigned*)(ws + WS_CTR); int* slot = (int*)(lds + 147000);
        for (;;) {
            if (tid == 0) *slot = (int)atomicAdd(ctr, 1u);
            __syncthreads();
            const int u = *slot;
            __syncthreads();
            if (u >= PB * 8 * 32) break;
            const int qb = 31 - (u >> 6), bh = u & 63;
            attn_body::attn_unit<8>(bh >> 3, bh & 7, qb, Qa, Ka, Va, Oa, CP, (char*)lds);
        }
    }
    }
    if constexpr (PH == 5) {
    {
        pg8::Gemm g{Mix, WoutT, MP, 1024, DMIX, 0}; pg8::StaticOrder S; S.init(MP, 1024, G, bx);
        pg8::EpiOut E{a.x_prompt, a.x_sample, out + O_Y, XN, SS1, GSS};
        pg8::gemm_phase<pg8::EpiOut, pg8::StaticOrder, true, true>((PG8_LAS unsigned char*)lds, g, S, E);
    }
    }
    if constexpr (PH == 6) {
    {
        pg8::Gemm g{XN, WupT, MT, DFF, 1024, 0}; pg8::StaticOrder S; S.init(MT, DFF, G, bx);
        pg8::EpiUp E{SS1, Hb};
        pg8::gemm_phase<pg8::EpiUp, pg8::StaticOrder, true, true>((PG8_LAS unsigned char*)lds, g, S, E);
    }
    }
    if constexpr (PH == 7) {
    {
        const int Mrows = G >= 128 ? MP : MT;
        pg8::Gemm g{Hb, WdnT, Mrows, 1024, DFF, 0}; pg8::StaticOrder S; S.init(Mrows, 1024, G, bx);
        pg8::EpiDown E{out + O_Y};
        pg8::gemm_phase<pg8::EpiDown, pg8::StaticOrder, true, true>((PG8_LAS unsigned char*)lds, g, S, E);
    }
    }
}
template <int PH> __global__ void __launch_bounds__(NWAVES * 64, 2) phase_kernel(Args a) {
    extern __shared__ __attribute__((aligned(16))) unsigned char lds[];
    run_phase<PH>(a, lds);
}
#ifndef ONE_LAUNCH
#define ONE_LAUNCH 1
#endif
#if ONE_LAUNCH
#define RUN_PHASE(k) do { const __attribute__((address_space(4))) Args* p_ = (const __attribute__((address_space(4))) Args*)__builtin_amdgcn_kernarg_segment_ptr(); asm volatile("" : "+s"(p_)); Args la_; { const __attribute__((address_space(4))) unsigned long long* q_ = (const __attribute__((address_space(4))) unsigned long long*)p_; unsigned long long* d_ = (unsigned long long*)&la_; _Pragma("unroll") for (int i_ = 0; i_ < (int)(sizeof(Args) / 8); ++i_) d_[i_] = q_[i_]; } run_phase<k>(la_, lds); } while (0)
__global__ void __launch_bounds__(NWAVES * 64, 2) fwd_megakernel(Args a) {
    extern __shared__ __attribute__((aligned(16))) unsigned char lds[];
    cg::grid_group grid = cg::this_grid();
    RUN_PHASE(0); grid.sync();
    RUN_PHASE(1); grid.sync();
    RUN_PHASE(9); grid.sync();
    RUN_PHASE(2); grid.sync();
    RUN_PHASE(3); grid.sync();
    RUN_PHASE(4); __syncthreads(); RUN_PHASE(11); __syncthreads(); RUN_PHASE(8); grid.sync();
    RUN_PHASE(5); grid.sync();
    RUN_PHASE(6); grid.sync();
    RUN_PHASE(7); __syncthreads(); RUN_PHASE(10); grid.sync();
    RUN_PHASE(12);
}
#endif
extern "C" void kernel_launch(void* const* d_in, const int* in_sizes, int n_in, void* d_out, int out_size, void* d_ws, size_t ws_size, hipStream_t stream) {
    static int grid = 0;
    if (grid == 0) {
        if (n_in != 22 || (size_t)out_size != O_END || ws_size < WS_END) { fprintf(stderr, "kernel_launch: unexpected shapes: n_in %d out %d ws %zu (need %zu)\n", n_in, out_size, ws_size, (size_t)WS_END); grid = -1; return; }
        int dev = 0, cus = 0, per_cu = 0;
        (void)hipGetDevice(&dev); (void)hipDeviceGetAttribute(&cus, hipDeviceAttributeMultiprocessorCount, dev);
        bool okattr = true;
#if ONE_LAUNCH
        okattr = hipFuncSetAttribute((const void*)fwd_megakernel, hipFuncAttributeMaxDynamicSharedMemorySize, LDS_BYTES) == hipSuccess;
#endif
#if !ONE_LAUNCH
        okattr = okattr && hipFuncSetAttribute((const void*)phase_kernel<0>, hipFuncAttributeMaxDynamicSharedMemorySize, LDS_BYTES) == hipSuccess && hipFuncSetAttribute((const void*)phase_kernel<1>, hipFuncAttributeMaxDynamicSharedMemorySize, LDS_BYTES) == hipSuccess
              && hipFuncSetAttribute((const void*)phase_kernel<2>, hipFuncAttributeMaxDynamicSharedMemorySize, LDS_BYTES) == hipSuccess && hipFuncSetAttribute((const void*)phase_kernel<3>, hipFuncAttributeMaxDynamicSharedMemorySize, LDS_BYTES) == hipSuccess
              && hipFuncSetAttribute((const void*)phase_kernel<4>, hipFuncAttributeMaxDynamicSharedMemorySize, LDS_BYTES) == hipSuccess && hipFuncSetAttribute((const void*)phase_kernel<5>, hipFuncAttributeMaxDynamicSharedMemorySize, LDS_BYTES) == hipSuccess
              && hipFuncSetAttribute((const void*)phase_kernel<6>, hipFuncAttributeMaxDynamicSharedMemorySize, LDS_BYTES) == hipSuccess && hipFuncSetAttribute((const void*)phase_kernel<7>, hipFuncAttributeMaxDynamicSharedMemorySize, LDS_BYTES) == hipSuccess && hipFuncSetAttribute((const void*)phase_kernel<8>, hipFuncAttributeMaxDynamicSharedMemorySize, LDS_BYTES) == hipSuccess && hipFuncSetAttribute((const void*)phase_kernel<9>, hipFuncAttributeMaxDynamicSharedMemorySize, LDS_BYTES) == hipSuccess && hipFuncSetAttribute((const void*)phase_kernel<10>, hipFuncAttributeMaxDynamicSharedMemorySize, LDS_BYTES) == hipSuccess && hipFuncSetAttribute((const void*)phase_kernel<11>, hipFuncAttributeMaxDynamicSharedMemorySize, LDS_BYTES) == hipSuccess && hipFuncSetAttribute((const void*)phase_kernel<12>, hipFuncAttributeMaxDynamicSharedMemorySize, LDS_BYTES) == hipSuccess;
#endif
        if (!okattr) { fprintf(stderr, "kernel_launch: hipFuncSetAttribute failed\n"); grid = -1; return; }
        (void)hipGetLastError();
        grid = cus;
    }
    if (grid < 0) return;
    Args a{};
    a.x_prompt = (const float*)d_in[0]; a.x_sample = (const float*)d_in[1]; a.cache_k = (const float*)d_in[2]; a.cache_v = (const float*)d_in[3]; a.cache_logf = (const float*)d_in[4];
    a.state_ssm = (const float*)d_in[5]; a.state_conv = (const float*)d_in[6]; a.norm1_w = (const float*)d_in[7]; a.w_in = (const float*)d_in[8]; a.conv_w = (const float*)d_in[9];
    a.conv_b = (const float*)d_in[10]; a.dt_bias = (const float*)d_in[11]; a.A_log = (const float*)d_in[12]; a.D_skip = (const float*)d_in[13]; a.ssd_norm_w = (const float*)d_in[14];
    a.f_bias = (const float*)d_in[15]; a.q_norm_w = (const float*)d_in[16]; a.k_norm_w = (const float*)d_in[17]; a.w_out = (const float*)d_in[18]; a.norm2_w = (const float*)d_in[19];
    a.w_up = (const float*)d_in[20]; a.w_down = (const float*)d_in[21]; a.out = (float*)d_out; a.ws = (unsigned char*)d_ws;
#if ONE_LAUNCH
    void* args[] = {&a};
    hipError_t e = hipLaunchCooperativeKernel((const void*)fwd_megakernel, dim3(grid), dim3(NWAVES * 64), args, LDS_BYTES, stream);
    if (e != hipSuccess) fprintf(stderr, "kernel_launch: cooperative launch failed: %s (grid %d)\n", hipGetErrorString(e), grid);
#else
    hipLaunchKernelGGL(phase_kernel<0>, dim3(grid), dim3(NWAVES * 64), LDS_BYTES, stream, a);
    hipLaunchKernelGGL(phase_kernel<1>, dim3(grid), dim3(NWAVES * 64), LDS_BYTES, stream, a);
    hipLaunchKernelGGL(phase_kernel<9>, dim3(grid), dim3(NWAVES * 64), LDS_BYTES, stream, a);
    hipLaunchKernelGGL(phase_kernel<2>, dim3(grid), dim3(NWAVES * 64), LDS_BYTES, stream, a);
    hipLaunchKernelGGL(phase_kernel<3>, dim3(grid), dim3(NWAVES * 64), LDS_BYTES, stream, a);
    hipLaunchKernelGGL(phase_kernel<4>, dim3(grid), dim3(NWAVES * 64), LDS_BYTES, stream, a);
    hipLaunchKernelGGL(phase_kernel<11>, dim3(grid), dim3(NWAVES * 64), LDS_BYTES, stream, a);
    hipLaunchKernelGGL(phase_kernel<8>, dim3(grid), dim3(NWAVES * 64), LDS_BYTES, stream, a);
    hipLaunchKernelGGL(phase_kernel<5>, dim3(grid), dim3(NWAVES * 64), LDS_BYTES, stream, a);
    hipLaunchKernelGGL(phase_kernel<6>, dim3(grid), dim3(NWAVES * 64), LDS_BYTES, stream, a);
    hipLaunchKernelGGL(phase_kernel<7>, dim3(grid), dim3(NWAVES * 64), LDS_BYTES, stream, a);
    hipLaunchKernelGGL(phase_kernel<10>, dim3(grid), dim3(NWAVES * 64), LDS_BYTES, stream, a);
    hipLaunchKernelGGL(phase_kernel<12>, dim3(grid), dim3(NWAVES * 64), LDS_BYTES, stream, a);
#endif
}
```

```cpp
#include <hip/hip_runtime.h>
#include <hip/hip_cooperative_groups.h>
#include <hip/hip_bf16.h>
#include <cstdio>
#include <cstdint>
#include <cmath>
namespace cg = cooperative_groups;

constexpr int DMODEL = 1024, PSEQ = 8192, PB = 8, MP = PB * PSEQ  , SBATCH = 32, SSEQ = 16, MS = SBATCH * SSEQ  , MT = MP + MS  ;
constexpr int PAST = 4096, NIN = 4352  , DFF = 4096, DMIX = 1536, DCONV = 1536;
constexpr float EPSN = 1e-6f, L2E = 1.4426950408889634f;
constexpr size_t O_Y = 0, O_PK = 67633152, O_PV = 101187584, O_PLF = 134742016, O_PSSM = 135266304, O_PCONV = 136314880, O_SK = 136351744, O_SV = 136613888,
                 O_SLF = 136876032, O_SSSM = 136880128, O_SCONV = 141074432, O_END = 141221888;
constexpr size_t MiB = 1u << 20;
constexpr size_t WS_BARW = 1152 * 1024, WS_CTR = 1120 * 1024, WS_SS1 = 0, WS_GSS = 512 * 1024, WS_DAT = 1088 * 1024, WS_CP = 2 * MiB, WS_WIN = 4 * MiB, WS_WOUT = WS_WIN + 8704 * 1024, WS_WUP = WS_WOUT + 3 * MiB, WS_WDN = WS_WUP + 8 * MiB;
constexpr size_t WS_XN = 32 * MiB, WS_DT = 161 * MiB, WS_SL = 166 * MiB, WS_ZS = 294 * MiB, WS_XBC = 423 * MiB, WS_QB = 617 * MiB, WS_KB = 682 * MiB, WS_VB = 747 * MiB, WS_MIX = 812 * MiB,
                 WS_H = 294 * MiB, WS_HIST = 1006 * MiB, WS_GSSP = 1012 * MiB, WS_SS1P = 1014 * MiB, WS_END = 1019 * MiB;
static_assert(WS_WDN + 8 * MiB <= WS_XN && WS_XN + (size_t)MT * 1024 * 2 <= WS_DT && WS_DT + (size_t)MT * 64 <= WS_SL && WS_SL + 128 * MiB <= WS_ZS, "ws map 1");
static_assert(WS_ZS + (size_t)MT * 2048 <= WS_XBC && WS_XBC + (size_t)(MT + 64) * 3072 <= WS_QB && WS_QB + (size_t)MT * 1024 <= WS_KB && WS_KB + (size_t)MT * 1024 <= WS_VB && WS_VB + (size_t)MT * 1024 <= WS_MIX, "ws map 2");
static_assert(WS_MIX + (size_t)MT * 3072 <= WS_END && WS_H + (size_t)MT * 8192 <= WS_MIX, "ws map 3");

typedef unsigned short bf16_t;
typedef short bf16x8 __attribute__((ext_vector_type(8)));
typedef float f32x4 __attribute__((ext_vector_type(4)));
typedef float f32x16 __attribute__((ext_vector_type(16)));
typedef unsigned u32x4 __attribute__((ext_vector_type(4)));
typedef unsigned u32x2 __attribute__((ext_vector_type(2)));
typedef float f32x2_t_ __attribute__((ext_vector_type(2)));
typedef __bf16 bf16x2_t_ __attribute__((ext_vector_type(2)));
__device__ __forceinline__ unsigned cvtpk(float lo, float hi) { f32x2_t_ v = {lo, hi}; bf16x2_t_ b = __builtin_convertvector(v, bf16x2_t_); return __builtin_bit_cast(unsigned, b); }
__device__ __forceinline__ float bf2f(unsigned u16) { return __uint_as_float(u16 << 16); }
__device__ __forceinline__ float silu_f(float v) { return v * __builtin_amdgcn_rcpf(1.0f + __expf(-v)); }
__device__ __forceinline__ float softplus_f(float v) { return v > 20.f ? v : log1pf(__expf(v)); }
__device__ __forceinline__ float logsigmoid_f(float v) { return fminf(v, 0.f) - log1pf(__expf(-fabsf(v))); }
__device__ __forceinline__ int crow_(int r, int hi) { return (r & 3) + 8 * (r >> 2) + 4 * hi; }
__device__ __forceinline__ void gatomic_add(float* p, float v) { (void)__builtin_amdgcn_global_atomic_fadd_f32((__attribute__((address_space(1))) float*)p, v); }
namespace pg8 {
#define PG8_LAS __attribute__((address_space(3)))
typedef unsigned short bf16_t;
typedef short bf16x8 __attribute__((ext_vector_type(8)));
typedef float f32x4 __attribute__((ext_vector_type(4)));
typedef unsigned u32x4 __attribute__((ext_vector_type(4)));
constexpr int BM = 256, BK = 64, HALF = 128, HTB = HALF * BK * 2  , STAGE_BYTES = 8 * HTB, NXCD = 8, WGM = 8;

__host__ __device__ __forceinline__ int lds_byte(int r, int c) { const int st = (r >> 4) * 2 + (c >> 5), rr = r & 15, cc = c & 31, ob = rr * 64 + cc * 2; return st * 1024 + (ob ^ (((ob >> 9) & 1) << 5)); }
__host__ __device__ __forceinline__ void stage_rc(int b, int& R, int& C) { const int st = b / 1024, sb = b % 1024, swz = sb ^ (((sb >> 9) & 1) << 5); R = (st >> 1) * 16 + swz / 64; C = (st & 1) * 32 + (swz % 64) / 2; }
__host__ __device__ __forceinline__ int perm32(int rho) { const int n = rho >> 4, i = rho & 15; return 8 * (i >> 2) + 4 * n + (i & 3); }

struct Unit { int pm, pn, k0; };
struct Gemm { const bf16_t* A; const bf16_t* Bt; int M, N, K, nt; };

struct StaticOrder {
    int nM, nN, nwg, G, c;
    __host__ __device__ void init(int M, int N, int G_, int c_) { nM = M / BM; nN = N / BM; nwg = nM * nN; G = G_; c = c_; }
    __host__ __device__ bool next(int i, Unit& u) const {
        const long L = (long)i * G + c; if (L >= nwg) return false;
        int wgid = (int)L; { const int q = nwg / NXCD, r = nwg % NXCD, xcd = wgid % NXCD, off = wgid / NXCD; wgid = (xcd < r ? xcd * (q + 1) : r * (q + 1) + (xcd - r) * q) + off; }
        const int nig = WGM * nN, gid = wgid / nig, fm = gid * WGM, gsz = (nM - fm) < WGM ? (nM - fm) : WGM;
        u.pm = fm + ((wgid % nig) % gsz); u.pn = (wgid % nig) / gsz; u.k0 = 0; return true;
    }
    __device__ __forceinline__ void a_ready(const Unit&) const {}
    __device__ __forceinline__ void done(const Unit&) const {}
};

struct ListOrder {
    int G, c, count, ntiles, pm0, npn, ksplit;
    __device__ __forceinline__ bool next(int i, Unit& u) const { const int L = i * G + c; if (L >= count) return false; const int tile = L % ntiles, ks = L / ntiles; u.pm = pm0 + tile / npn; u.pn = tile % npn; u.k0 = ks * ksplit; return true; }
    __device__ __forceinline__ void a_ready(const Unit&) const {}
    __device__ __forceinline__ void done(const Unit&) const {}
};

__device__ __forceinline__ void st_bf16x8(bf16_t* p, f32x4 a, f32x4 b) { u32x4 w; w.x = cvtpk(a[0], a[1]); w.y = cvtpk(a[2], a[3]); w.z = cvtpk(b[0], b[1]); w.w = cvtpk(b[2], b[3]); *(u32x4*)p = w; }
struct EpiIn {
    static constexpr bool PERM = true, AFTER_DRAIN = false, KHOOK = false;
    bf16_t *Zs, *XBC, *Qb, *Kb, *Vb; float* DT; float* out; const float *dt_bias, *f_bias, *qw, *kw; bf16_t* HIST;
    __device__ __forceinline__ void operator()(const f32x4 (&acc)[2][2][4][2], const Unit& u, int wr, int wc, int fr, int fq) const {
        const int pn = u.pn; const int lc = pn * 256 + wc * 64 + fq * 8;
        if (pn < 10) {
#pragma unroll
            for (int ai = 0; ai < 2; ++ai)
#pragma unroll
                for (int m = 0; m < 4; ++m) { const int row = u.pm * BM + ai * HALF + wr * 64 + m * 16 + fr;
#pragma unroll
                    for (int bj = 0; bj < 2; ++bj) { f32x4 v0 = acc[ai][bj][m][0], v1 = acc[ai][bj][m][1];
                        if (pn < 4) {
#pragma unroll
                            for (int e = 0; e < 4; ++e) { v0[e] = silu_f(v0[e]); v1[e] = silu_f(v1[e]); }
                            st_bf16x8(Zs + row * 1024 + lc + 32 * bj, v0, v1);
                        } else { const int c = lc - 1024 + 32 * bj;
                            st_bf16x8(XBC + row * 1536 + c, v0, v1);
                            if (row < MP && (row & 127) >= 125) st_bf16x8(HIST + ((row >> 7) * 3 + ((row & 127) - 125)) * DCONV + c, v0, v1);
                            float* cs = nullptr;
                            if (row < MP) { const int t = (int)(row & (PSEQ - 1)); if (t >= PSEQ - 3) cs = out + O_PCONV + ((row >> 13) * 3 + (t - (PSEQ - 3))) * DCONV + c; }
                            else { const int sr = (int)(row - MP), t = sr & 15; if (t >= 13) cs = out + O_SCONV + ((sr >> 4) * 3 + (t - 13)) * DCONV + c; }
                            if (cs) { *(f32x4*)cs = v0; *(f32x4*)(cs + 4) = v1; } } } }
        } else if (pn < 14) {
            const bool isq = pn < 12; const float* w = isq ? qw : kw; const int hcol = lc - (isq ? 2560 : 3072);
#pragma unroll
            for (int ai = 0; ai < 2; ++ai)
#pragma unroll
                for (int m = 0; m < 4; ++m) { const int row = u.pm * BM + ai * HALF + wr * 64 + m * 16 + fr; float ss = 0.f;
#pragma unroll
                    for (int bj = 0; bj < 2; ++bj)
#pragma unroll
                        for (int n = 0; n < 2; ++n) { const f32x4 x = acc[ai][bj][m][n]; ss += (x[0] * x[0] + x[1] * x[1]) + (x[2] * x[2] + x[3] * x[3]); }
                    ss += __shfl_xor(ss, 16); ss += __shfl_xor(ss, 32);
                    const float rs = rsqrtf(ss * (1.0f / 64.0f) + EPSN); const float rq = isq ? rs * (0.125f * L2E) : rs;
#pragma unroll
                    for (int bj = 0; bj < 2; ++bj) { const f32x4 o0 = acc[ai][bj][m][0] * *(const f32x4*)(w + 32 * bj + 8 * fq), o1 = acc[ai][bj][m][1] * *(const f32x4*)(w + 32 * bj + 8 * fq + 4);
                        st_bf16x8((isq ? Qb : Kb) + row * 512 + hcol + 32 * bj, o0 * rq, o1 * rq);
                        if (!isq) { float* kp = (row < MP ? out + O_PK + row * 512 : out + O_SK + (row - MP) * 512) + hcol + 32 * bj; *(f32x4*)kp = o0 * rs; *(f32x4*)(kp + 4) = o1 * rs; } } }
        } else if (pn < 16) {
            const int hcol = lc - 3584;
#pragma unroll
            for (int ai = 0; ai < 2; ++ai)
#pragma unroll
                for (int m = 0; m < 4; ++m) { const int row = u.pm * BM + ai * HALF + wr * 64 + m * 16 + fr;
#pragma unroll
                    for (int bj = 0; bj < 2; ++bj) { const f32x4 v0 = acc[ai][bj][m][0], v1 = acc[ai][bj][m][1];
                        st_bf16x8(Vb + row * 512 + hcol + 32 * bj, v0, v1);
                        float* vp = (row < MP ? out + O_PV + row * 512 : out + O_SV + (row - MP) * 512) + hcol + 32 * bj; *(f32x4*)vp = v0; *(f32x4*)(vp + 4) = v1; } }
        } else {
            if (wc == 0 && fq < 3) {
                const f32x4 b0 = fq < 2 ? *(const f32x4*)(dt_bias + 8 * fq) : *(const f32x4*)(f_bias), b1 = fq < 2 ? *(const f32x4*)(dt_bias + 8 * fq + 4) : *(const f32x4*)(f_bias + 4);
#pragma unroll
                for (int ai = 0; ai < 2; ++ai)
#pragma unroll
                    for (int m = 0; m < 4; ++m) { const int row = u.pm * BM + ai * HALF + wr * 64 + m * 16 + fr;
                        f32x4 v0 = acc[ai][0][m][0] + b0, v1 = acc[ai][0][m][1] + b1;
                        if (fq < 2) {
#pragma unroll
                            for (int e = 0; e < 4; ++e) { v0[e] = softplus_f(v0[e]); v1[e] = softplus_f(v1[e]); }
                            float* dp = DT + row * 16 + 8 * fq; *(f32x4*)dp = v0; *(f32x4*)(dp + 4) = v1;
                        } else {
#pragma unroll
                            for (int e = 0; e < 4; ++e) { v0[e] = logsigmoid_f(v0[e]); v1[e] = logsigmoid_f(v1[e]); }
                            float* lp = (row < MP ? out + O_PLF + row * 8 : out + O_SLF + (row - MP) * 8); *(f32x4*)lp = v0; *(f32x4*)(lp + 4) = v1; } }
            }
        }
    }
};
struct EpiOut {
    static constexpr bool PERM = true, AFTER_DRAIN = false, KHOOK = true;
    const float *xp, *xs; float* Y; bf16_t* X1b; float* SS1; const float* GSS;
    __device__ __forceinline__ void khook(f32x4 (&acc)[2][2][4][2], const Unit& u, int t, int wr, int fr) const {
#pragma unroll
        for (int ai = 0; ai < 2; ++ai)
#pragma unroll
            for (int m = 0; m < 4; ++m) { const int row = u.pm * BM + ai * HALF + wr * 64 + m * 16 + fr;
                const f32x4 gp = *(const f32x4*)(GSS + (unsigned)(row * 4)); const float g0 = gp[0] + gp[1], g1 = gp[2] + gp[3];
                const float r0 = rsqrtf(g0 * (1.0f / 512.0f) + EPSN), r1 = rsqrtf(g1 * (1.0f / 512.0f) + EPSN);
                const float f = (t == 8) ? r0 / r1 : r1;
#pragma unroll
                for (int bj = 0; bj < 2; ++bj)
#pragma unroll
                    for (int n = 0; n < 2; ++n) acc[ai][bj][m][n] *= f; }
    }
    __device__ __forceinline__ void operator()(const f32x4 (&acc)[2][2][4][2], const Unit& u, int wr, int wc, int fr, int fq) const {
        const int col0 = u.pn * BM + wc * 32 + 8 * fq; float ssv[8];
#pragma unroll
        for (int ai = 0; ai < 2; ++ai)
#pragma unroll
            for (int m = 0; m < 4; ++m) { const int row = u.pm * BM + ai * HALF + wr * 64 + m * 16 + fr;
                const float* xr = row < MP ? xp + row * 1024 : xs + (row - MP) * 1024; float ss = 0.f;
#pragma unroll
                for (int bj = 0; bj < 2; ++bj) { const int c = col0 + bj * HALF;
                    const f32x4 o0 = *(const f32x4*)(xr + c) + acc[ai][bj][m][0], o1 = *(const f32x4*)(xr + c + 4) + acc[ai][bj][m][1];
                    *(f32x4*)(Y + row * 1024 + c) = o0; *(f32x4*)(Y + row * 1024 + c + 4) = o1; st_bf16x8(X1b + row * 1024 + c, o0, o1);
                    ss += (o0[0] * o0[0] + o0[1] * o0[1]) + (o0[2] * o0[2] + o0[3] * o0[3]) + (o1[0] * o1[0] + o1[1] * o1[1]) + (o1[2] * o1[2] + o1[3] * o1[3]); }
                ss += __shfl_xor(ss, 16); ss += __shfl_xor(ss, 32);
                ssv[ai * 4 + m] = ss; }
        if (fq == 0) {
#pragma unroll
            for (int ai = 0; ai < 2; ++ai)
#pragma unroll
                for (int m = 0; m < 4; ++m) SS1[(unsigned)((u.pm * BM + ai * HALF + wr * 64 + m * 16 + fr) * 16 + u.pn * 4 + wc)] = ssv[ai * 4 + m]; }
    }
};
struct EpiUp {
    static constexpr bool PERM = true, AFTER_DRAIN = false, KHOOK = false;
    const float* SS1; bf16_t* H;
    __device__ __forceinline__ void operator()(const f32x4 (&acc)[2][2][4][2], const Unit& u, int wr, int wc, int fr, int fq) const {
        const int col0 = u.pn * BM + wc * 32 + 8 * fq;
#pragma unroll
        for (int ai = 0; ai < 2; ++ai)
#pragma unroll
            for (int m = 0; m < 4; ++m) { const int row = u.pm * BM + ai * HALF + wr * 64 + m * 16 + fr;
                const f32x4 s0 = *(const f32x4*)(SS1 + (unsigned)(row * 16)), s1 = *(const f32x4*)(SS1 + (unsigned)(row * 16 + 4)), s2 = *(const f32x4*)(SS1 + (unsigned)(row * 16 + 8)), s3 = *(const f32x4*)(SS1 + (unsigned)(row * 16 + 12));
                const f32x4 st = (s0 + s1) + (s2 + s3); const float r2 = 1.0f / (((st[0] + st[1]) + (st[2] + st[3])) * (1.0f / 1024.0f) + EPSN);
#pragma unroll
                for (int bj = 0; bj < 2; ++bj) { f32x4 v0 = acc[ai][bj][m][0], v1 = acc[ai][bj][m][1];
#pragma unroll
                    for (int e = 0; e < 4; ++e) { const float a = fmaxf(v0[e], 0.f), b = fmaxf(v1[e], 0.f); v0[e] = a * a * r2; v1[e] = b * b * r2; }
                    st_bf16x8(H + row * DFF + col0 + bj * HALF, v0, v1); } }
    }
};
struct EpiDown {
    static constexpr bool PERM = true, AFTER_DRAIN = false, KHOOK = false;
    float* Y;
    __device__ __forceinline__ void operator()(const f32x4 (&acc)[2][2][4][2], const Unit& u, int wr, int wc, int fr, int fq) const {
        const int col0 = u.pn * BM + wc * 32 + 8 * fq;
#pragma unroll
        for (int ai = 0; ai < 2; ++ai)
#pragma unroll
            for (int m = 0; m < 4; ++m) { const int row = u.pm * BM + ai * HALF + wr * 64 + m * 16 + fr;
#pragma unroll
                for (int bj = 0; bj < 2; ++bj) { float* p = Y + row * 1024 + col0 + bj * HALF;
                    const f32x4 o0 = *(const f32x4*)p + acc[ai][bj][m][0], o1 = *(const f32x4*)(p + 4) + acc[ai][bj][m][1]; *(f32x4*)p = o0; *(f32x4*)(p + 4) = o1; } }
    }
};
struct EpiDownPartial {
    static constexpr bool PERM = true, AFTER_DRAIN = false, KHOOK = false;
    float* PART;
    __device__ __forceinline__ void operator()(const f32x4 (&acc)[2][2][4][2], const Unit& u, int wr, int wc, int fr, int fq) const {
        const int col0 = u.pn * BM + wc * 32 + 8 * fq;
#pragma unroll
        for (int ai = 0; ai < 2; ++ai)
#pragma unroll
            for (int m = 0; m < 4; ++m) { const int row = (u.pm - MP / 256) * BM + ai * HALF + wr * 64 + m * 16 + fr;
#pragma unroll
                for (int bj = 0; bj < 2; ++bj) { float* p = PART + (unsigned)(row * 1024 + col0 + bj * HALF); *(f32x4*)p = acc[ai][bj][m][0]; *(f32x4*)(p + 4) = acc[ai][bj][m][1]; } }
    }
};
template <class Epi, class Sched, bool ALIGN_EPI = false, bool SP2 = false>
__device__ __forceinline__ void gemm_phase(PG8_LAS unsigned char* lds, const Gemm g, const Sched& S, const Epi& E) {
    int tid_ = threadIdx.x; asm volatile("" : "+v"(tid_));
    const int tid = tid_, wid = __builtin_amdgcn_readfirstlane(tid >> 6), lane = tid & 63, wr = wid >> 2, wc = wid & 3, fr = lane & 15, fq = lane >> 4;
    const int K = g.K; int nt_ = g.nt ? g.nt : K / BK; asm volatile("" : "+s"(nt_)); const int nt = nt_;
    unsigned voffA[2], voffB[2];
#pragma unroll
    for (int i = 0; i < 2; ++i) { int R, C; stage_rc(tid * 16 + i * 8192, R, C); const int Rb = Epi::PERM ? ((R & ~31) + perm32(R & 31)) : R;
        voffA[i] = (unsigned)(R * K + C) * 2u; voffB[i] = (unsigned)(Rb * K + C) * 2u; }
    const size_t kstep = (size_t)(BK * 2);
    const size_t hstep = (size_t)HALF * K * 2;
    const size_t tstep = 2 * hstep;
    const unsigned ldsw = (unsigned)wid * 1024u;
    const int aoff = lds_byte(wr * 64 + fr, fq * 8), boff = lds_byte(wc * 32 + fr, fq * 8);
#define PG8_SA(b, h) (((b) * 2 + (h)) * HTB)
#define PG8_SB(b, h) ((4 + (b) * 2 + (h)) * HTB)
#define PG8_STAGE(bufoff, gbase, voff) do { _Pragma("unroll") for (int _i = 0; _i < 2; ++_i) \
        __builtin_amdgcn_global_load_lds((const unsigned*)((const char*)(gbase) + (voff)[_i]), (PG8_LAS unsigned*)(lds + (bufoff) + ldsw + _i * 8192), 16, 0, 0); } while (0)
#define PG8_LDA(dst, b, h) do { _Pragma("unroll") for (int m = 0; m < 4; ++m) _Pragma("unroll") for (int k = 0; k < 2; ++k) dst[m][k] = *(const PG8_LAS bf16x8*)(lds + PG8_SA(b, h) + aoff + m * 2048 + k * 1024); } while (0)
#define PG8_LDB(dst, b, h) do { _Pragma("unroll") for (int n = 0; n < 2; ++n) _Pragma("unroll") for (int k = 0; k < 2; ++k) dst[n][k] = *(const PG8_LAS bf16x8*)(lds + PG8_SB(b, h) + boff + n * 2048 + k * 1024); } while (0)
#define PG8_MMA(ai, bj, At, Bt) do { __builtin_amdgcn_s_setprio(1); _Pragma("unroll") for (int m = 0; m < 4; ++m) _Pragma("unroll") for (int n = 0; n < 2; ++n) _Pragma("unroll") for (int k = 0; k < 2; ++k) \
        acc[ai][bj][m][n] = __builtin_amdgcn_mfma_f32_16x16x32_bf16(Bt[n][k], At[m][k], acc[ai][bj][m][n], 0, 0, 0); __builtin_amdgcn_s_setprio(0); } while (0)
#define PG8_WAIT_V(n) asm volatile("s_waitcnt vmcnt(" #n ")" ::: "memory")
#define PG8_WAIT_L(n) asm volatile("s_waitcnt lgkmcnt(" #n ")" ::: "memory")
#define PG8_BAR __builtin_amdgcn_s_barrier()
#define PG8_SCHED __builtin_amdgcn_sched_barrier(0)
    Unit cur, nxt; int ui = 0;
    if (!S.next(0, cur)) return;
    f32x4 acc[2][2][4][2];
#pragma unroll
    for (int a = 0; a < 2; ++a)
#pragma unroll
        for (int b = 0; b < 2; ++b)
#pragma unroll
            for (int m = 0; m < 4; ++m)
#pragma unroll
                for (int n = 0; n < 2; ++n) acc[a][b][m][n] = (f32x4){0.f, 0.f, 0.f, 0.f};
    bf16x8 At[4][2], B0[2][2], B1[2][2];
    const char* cA = (const char*)g.A + (size_t)cur.pm * tstep + (size_t)cur.k0 * 2; const char* cB = (const char*)g.Bt + (size_t)cur.pn * tstep + (size_t)cur.k0 * 2;
    S.a_ready(cur);
    if constexpr (SP2) {
        PG8_STAGE(PG8_SB(0, 0), cB, voffB); PG8_STAGE(PG8_SB(0, 1), cB + hstep, voffB); PG8_STAGE(PG8_SA(0, 0), cA, voffA); PG8_STAGE(PG8_SA(0, 1), cA + hstep, voffA);
        if (wr == 1) PG8_BAR;
        PG8_WAIT_V(2); PG8_BAR;
        PG8_STAGE(PG8_SB(1, 0), cB + kstep, voffB); PG8_STAGE(PG8_SA(1, 0), cA + kstep, voffA); PG8_STAGE(PG8_SB(1, 1), cB + hstep + kstep, voffB);
        PG8_WAIT_V(6); PG8_BAR;
    } else {
        PG8_STAGE(PG8_SB(0, 0), cB, voffB); PG8_STAGE(PG8_SA(0, 0), cA, voffA); PG8_STAGE(PG8_SB(0, 1), cB + hstep, voffB); PG8_STAGE(PG8_SA(0, 1), cA + hstep, voffA);
        if (wr == 1) PG8_BAR;
        PG8_WAIT_V(4); PG8_BAR;
        PG8_STAGE(PG8_SB(1, 0), cB + kstep, voffB); PG8_STAGE(PG8_SA(1, 0), cA + kstep, voffA); PG8_STAGE(PG8_SB(1, 1), cB + hstep + kstep, voffB);
        PG8_WAIT_V(6); PG8_BAR;
    }
    for (;;) {
        const bool has_next = S.next(ui + 1, nxt);
        const char* nA = has_next ? (const char*)g.A + (size_t)nxt.pm * tstep + (size_t)nxt.k0 * 2 : cA; const char* nB = has_next ? (const char*)g.Bt + (size_t)nxt.pn * tstep + (size_t)nxt.k0 * 2 : cB;
        for (int t = 0; t < nt; t += 2) {
            if constexpr (Epi::KHOOK) { if (t == 8 || t == 16) E.khook(acc, cur, t, wr, fr); }
            const bool last = (t == nt - 2);
            const char* a1 = cA + (size_t)(t + 1) * kstep;
            const char* a2 = last ? nA : cA + (size_t)(t + 2) * kstep; const char* b2 = last ? nB : cB + (size_t)(t + 2) * kstep;
            const char* a3 = a2 + kstep; const char* b3 = b2 + kstep;
            if (last && has_next) S.a_ready(nxt);
            if constexpr (SP2) {
            PG8_LDB(B0, 0, 0); PG8_LDB(B1, 0, 1); PG8_SCHED; PG8_LDA(At, 0, 0); PG8_STAGE(PG8_SA(1, 1), a1 + hstep, voffA);
            PG8_WAIT_V(8); PG8_WAIT_L(0); PG8_BAR; PG8_MMA(0, 0, At, B0); PG8_MMA(0, 1, At, B1); PG8_BAR; PG8_SCHED;
            PG8_LDA(At, 0, 1); PG8_STAGE(PG8_SB(0, 0), b2, voffB); PG8_STAGE(PG8_SB(0, 1), b2 + hstep, voffB); PG8_STAGE(PG8_SA(0, 0), a2, voffA);
            PG8_WAIT_V(8); PG8_WAIT_L(0); PG8_BAR; PG8_MMA(1, 0, At, B0); PG8_MMA(1, 1, At, B1); PG8_BAR; PG8_SCHED;
            PG8_LDB(B0, 1, 0); PG8_LDB(B1, 1, 1); PG8_SCHED; PG8_LDA(At, 1, 0); PG8_STAGE(PG8_SA(0, 1), a2 + hstep, voffA);
            PG8_WAIT_V(8); PG8_WAIT_L(0); PG8_BAR; PG8_MMA(0, 0, At, B0); PG8_MMA(0, 1, At, B1); PG8_BAR; PG8_SCHED;
            PG8_LDA(At, 1, 1); PG8_STAGE(PG8_SB(1, 0), b3, voffB); PG8_STAGE(PG8_SB(1, 1), b3 + hstep, voffB); PG8_STAGE(PG8_SA(1, 0), a3, voffA);
            PG8_WAIT_V(8); PG8_WAIT_L(0); PG8_BAR; PG8_MMA(1, 0, At, B0); PG8_MMA(1, 1, At, B1); PG8_BAR; PG8_SCHED;
            } else {
            PG8_LDB(B0, 0, 0); PG8_SCHED; PG8_LDA(At, 0, 0); PG8_STAGE(PG8_SA(1, 1), a1 + hstep, voffA);
            PG8_WAIT_L(8); PG8_BAR; PG8_WAIT_L(0); PG8_MMA(0, 0, At, B0); PG8_BAR; PG8_SCHED;
            PG8_LDB(B1, 0, 1); PG8_STAGE(PG8_SB(0, 0), b2, voffB);
            PG8_BAR; PG8_WAIT_L(0); PG8_MMA(0, 1, At, B1); PG8_BAR;
            PG8_LDA(At, 0, 1); PG8_STAGE(PG8_SA(0, 0), a2, voffA);
            PG8_BAR; PG8_WAIT_L(0); PG8_MMA(1, 0, At, B0); PG8_BAR; PG8_SCHED;
            PG8_STAGE(PG8_SB(0, 1), b2 + hstep, voffB);
            PG8_WAIT_V(6); PG8_BAR; PG8_MMA(1, 1, At, B1); PG8_BAR;
            PG8_LDB(B0, 1, 0); PG8_SCHED; PG8_LDA(At, 1, 0); PG8_STAGE(PG8_SA(0, 1), a2 + hstep, voffA);
            PG8_WAIT_L(8); PG8_BAR; PG8_WAIT_L(0); PG8_MMA(0, 0, At, B0); PG8_BAR; PG8_SCHED;
            PG8_LDB(B1, 1, 1); PG8_STAGE(PG8_SB(1, 0), b3, voffB);
            PG8_BAR; PG8_WAIT_L(0); PG8_MMA(0, 1, At, B1); PG8_BAR;
            PG8_LDA(At, 1, 1); PG8_STAGE(PG8_SA(1, 0), a3, voffA);
            PG8_BAR; PG8_WAIT_L(0); PG8_MMA(1, 0, At, B0); PG8_BAR; PG8_SCHED;
            PG8_STAGE(PG8_SB(1, 1), b3 + hstep, voffB);
            PG8_WAIT_V(6); PG8_BAR; PG8_MMA(1, 1, At, B1); PG8_BAR;
            }
        }
        if constexpr (ALIGN_EPI) { if (wr == 0) PG8_BAR; }
        if constexpr (!Epi::AFTER_DRAIN) { E(acc, cur, wr, wc, fr, fq); S.done(cur); }
        if (!has_next) break;
#pragma unroll
        for (int a = 0; a < 2; ++a)
#pragma unroll
            for (int b = 0; b < 2; ++b)
#pragma unroll
                for (int m = 0; m < 4; ++m)
#pragma unroll
                    for (int n = 0; n < 2; ++n) acc[a][b][m][n] = (f32x4){0.f, 0.f, 0.f, 0.f};
        cur = nxt; cA = nA; cB = nB; ++ui;
        if constexpr (ALIGN_EPI) { if (wr == 1) PG8_BAR; }
    }
    PG8_WAIT_V(0);
    if constexpr (!ALIGN_EPI) { if (wr == 0) PG8_BAR; }
    PG8_BAR;
    if constexpr (Epi::AFTER_DRAIN) { E.fused(acc, cur, wr, wc, fr, fq, lds, wid, lane); S.done(cur); }
#undef PG8_SA
#undef PG8_SB
#undef PG8_STAGE
#undef PG8_LDA
#undef PG8_LDB
#undef PG8_MMA
#undef PG8_WAIT_V
#undef PG8_WAIT_L
#undef PG8_BAR
#undef PG8_SCHED
}
}
#include <hip/hip_bf16.h>
#include <cmath>
namespace attn_body {
using bf16=__hip_bfloat16;
using bf16x8=__attribute__((ext_vector_type(8)))short;
using s16x4=__attribute__((ext_vector_type(4)))short;
using f32x16=__attribute__((ext_vector_type(16)))float;
using u32x4=__attribute__((ext_vector_type(4)))unsigned;
constexpr int BATCH=8,NHEAD=8,SEQ=8192,D=64,DM=NHEAD*D,OP=1536;
constexpr int NW=8,QBLK=32,QB=QBLK*NW,KVBLK=64,NQB=SEQ/QB;
constexpr int ATTN_PITCH=DM, ATTN_UNIT_ROWS=QB;
__device__ __forceinline__ int crow(int r,int hi){return (r&3)+8*(r>>2)+4*hi;}
#define SBAR() __builtin_amdgcn_sched_barrier(0)
__device__ __forceinline__ void cmask(f32x16&p0,f32x16&p1,int jb,int qrel,int hi){
  const float NEG=-INFINITY; int kb=64*jb+4*hi;
  #pragma unroll
  for(int r=0;r<16;++r){int kv=kb+(r&3)+8*(r>>2); if(kv>qrel)p0[r]=NEG; if(kv+32>qrel)p1[r]=NEG;}
}

constexpr int NSLOT=3, SLOTB=8192;
constexpr int LDS_K=0, LDS_V=NSLOT*SLOTB, LDS_WS=2*NSLOT*SLOTB, LDS_OST=LDS_WS+NW*64*4, LDS_C=LDS_OST+NW*4096, LDS_BYTES=LDS_C+SEQ*4;
constexpr float SKIP_L2=64.0f*1.4426950408889634f;
constexpr float C2=0.125f*1.4426950408889634f;
__device__ __forceinline__ void glds16(const void*gsrc,unsigned lds_dst){unsigned keep;
  asm volatile("s_mov_b32 %0, m0\n\ts_mov_b32 m0, %2\n\ts_nop 0\n\tglobal_load_lds_dwordx4 %1, off\n\ts_mov_b32 m0, %0":"=&s"(keep):"v"(gsrc),"s"(lds_dst):"memory");}
__device__ __forceinline__ float max3f(float a,float b,float c){float r;asm("v_max3_f32 %0, %1, %2, %3":"=v"(r):"v"(a),"v"(b),"v"(c));return r;}
__device__ __forceinline__ float max2f(float a,float b){float r;asm("v_max_f32_e32 %0, %1, %2":"=v"(r):"v"(a),"v"(b));return r;}
__device__ __forceinline__ float fadd_s(float a,float b){float r;asm("v_add_f32_e32 %0, %1, %2":"=v"(r):"v"(a),"v"(b));return r;}
__device__ __forceinline__ float fsub_s(float a,float b){float r;asm("v_sub_f32_e32 %0, %1, %2":"=v"(r):"v"(a),"v"(b));return r;}
typedef float f32x2_t __attribute__((ext_vector_type(2))); typedef __bf16 bf16x2_t __attribute__((ext_vector_type(2)));
__device__ __forceinline__ unsigned cvtpk_s(float lo,float hi){f32x2_t v={lo,hi};bf16x2_t b=__builtin_convertvector(v,bf16x2_t);return __builtin_bit_cast(unsigned,b);}
#define WAIT_BAR(N) asm volatile("s_waitcnt vmcnt(" #N ") lgkmcnt(0)\n\ts_barrier":::"memory")

__device__ __forceinline__ void qkt(f32x16&p0,f32x16&p1,const char*Kslot,const bf16x8*qr,const f32x16&cin0,const f32x16&cin1,int r32,int hi){
  const char*kb=Kslot+hi*1024+r32*16;
  #pragma unroll
  for(int d0=0;d0<4;++d0){
    const bf16x8 b0=*reinterpret_cast<const bf16x8*>(kb+d0*2048);
    const bf16x8 b1=*reinterpret_cast<const bf16x8*>(kb+d0*2048+512);
    if(d0==0){p0=__builtin_amdgcn_mfma_f32_32x32x16_bf16(b0,qr[0],cin0,0,0,0);p1=__builtin_amdgcn_mfma_f32_32x32x16_bf16(b1,qr[0],cin1,0,0,0);}
    else{p0=__builtin_amdgcn_mfma_f32_32x32x16_bf16(b0,qr[d0],p0,0,0,0);p1=__builtin_amdgcn_mfma_f32_32x32x16_bf16(b1,qr[d0],p1,0,0,0);}}
}
typedef __attribute__((address_space(3))) const char* lds_cptr;
typedef short v4i16_t __attribute__((ext_vector_type(4)));
__device__ __forceinline__ void kload8(bf16x8*kf,lds_cptr kp){
  kf[0]=*(const __attribute__((address_space(3))) bf16x8*)(kp);      kf[1]=*(const __attribute__((address_space(3))) bf16x8*)(kp+512);
  kf[2]=*(const __attribute__((address_space(3))) bf16x8*)(kp+2048); kf[3]=*(const __attribute__((address_space(3))) bf16x8*)(kp+2560);
  kf[4]=*(const __attribute__((address_space(3))) bf16x8*)(kp+4096); kf[5]=*(const __attribute__((address_space(3))) bf16x8*)(kp+4608);
  kf[6]=*(const __attribute__((address_space(3))) bf16x8*)(kp+6144); kf[7]=*(const __attribute__((address_space(3))) bf16x8*)(kp+6656);
}
__device__ __forceinline__ void kload2(bf16x8*kf,lds_cptr kp,int j){ kf[2*j]=*(const __attribute__((address_space(3))) bf16x8*)(kp+j*2048); kf[2*j+1]=*(const __attribute__((address_space(3))) bf16x8*)(kp+j*2048+512); }
__device__ __forceinline__ s16x4 vtr(lds_cptr p){ return __builtin_bit_cast(s16x4,__builtin_amdgcn_ds_read_tr16_b64_v4i16((__attribute__((address_space(3))) v4i16_t*)p)); }
__device__ __forceinline__ float rowmax(const f32x16&p0,const f32x16&p1){
  float a=max3f(p0[0],p0[1],p1[0]),b=max3f(p0[2],p0[3],p1[1]);a=max3f(a,p1[2],p1[3]);
  #pragma unroll
  for(int r=4;r<16;r+=4){a=max3f(a,p0[r],p0[r+1]);b=max3f(b,p0[r+2],p0[r+3]);a=max3f(a,p1[r],p1[r+1]);b=max3f(b,p1[r+2],p1[r+3]);}
  const float m=max2f(a,b);
  auto rr=__builtin_amdgcn_permlane32_swap(__float_as_uint(m),__float_as_uint(m),false,false);
  return max2f(__uint_as_float(rr[0]),__uint_as_float(rr[1]));
}
__device__ __forceinline__ void pv(f32x16*o,int vb,bf16x8 pa0,bf16x8 pa1,bf16x8 pa2,bf16x8 pa3){
  #pragma unroll
  for(int d0=0;d0<2;++d0){s16x4 lo[4],hi[4];
    #pragma unroll
    for(int ks=0;ks<4;++ks){
      asm volatile("ds_read_b64_tr_b16 %0,%1 offset:%c2":"=&v"(lo[ks]):"v"(vb),"i"(d0*4096+ks*1024):"memory");
      asm volatile("ds_read_b64_tr_b16 %0,%1 offset:%c2":"=&v"(hi[ks]):"v"(vb),"i"(d0*4096+ks*1024+512):"memory");}
    asm volatile("s_waitcnt lgkmcnt(0)":::"memory");SBAR();
    #define PK(k) (bf16x8){lo[k][0],lo[k][1],lo[k][2],lo[k][3],hi[k][0],hi[k][1],hi[k][2],hi[k][3]}
    o[d0]=__builtin_amdgcn_mfma_f32_32x32x16_bf16(pa0,PK(0),o[d0],0,0,0);
    o[d0]=__builtin_amdgcn_mfma_f32_32x32x16_bf16(pa1,PK(1),o[d0],0,0,0);
    o[d0]=__builtin_amdgcn_mfma_f32_32x32x16_bf16(pa2,PK(2),o[d0],0,0,0);
    o[d0]=__builtin_amdgcn_mfma_f32_32x32x16_bf16(pa3,PK(3),o[d0],0,0,0);
    #undef PK
  }
}

#ifndef ATTN_STORE16
#define ATTN_STORE16(p,v) (*(u32x4*)(p)=(v))
#endif
template<int THRL> __device__ __forceinline__ void attn_unit(int b,int h,int qb,const bf16*Q,const bf16*__restrict__ K,const bf16*__restrict__ V,bf16*O,const float*__restrict__ CPL,char*shm){
  int tid_=threadIdx.x; asm volatile("":"+v"(tid_)); const int tid=tid_,lane=tid&63,r32=lane&31,hi=lane>>5; const int wid=__builtin_amdgcn_readfirstlane(tid>>6);
  const long rowbase=(long)b*SEQ; const int q0=qb*QB;
  const bf16*Qw=Q+(rowbase+q0+wid*QBLK)*DM+h*D;
  const float*cg=CPL+((long)(b*NHEAD+h))*SEQ; const int NTF=(q0+QB)/KVBLK; int tst;
  { const float c0=cg[q0]; const int t1=lane,t2=lane+64;
    const bool s1=(t1<NTF-4)&&((c0-cg[64*t1+63])<-SKIP_L2), s2=(t2<NTF-4)&&((c0-cg[64*t2+63])<-SKIP_L2);
    tst=(__builtin_popcountll(__ballot(s1))+__builtin_popcountll(__ballot(s2)))&~1; tst=__builtin_amdgcn_readfirstlane(tst); }
  const bf16*Kh=K+(rowbase+(long)tst*KVBLK)*DM+h*D,*Vh=V+(rowbase+(long)tst*KVBLK)*DM+h*D;
  const unsigned lds0=(unsigned)(uintptr_t)shm;
  float*wsf=(float*)(shm+LDS_WS)+wid*64;
  const bf16*ksrc=Kh+(long)lane*DM+wid*8;
  const bf16*vsrc=Vh+(long)(16*(wid&3)+(lane>>2))*DM+(wid>>2)*32+(lane&3)*8;
  const unsigned kdst=lds0+LDS_K+wid*1024, vdst=lds0+LDS_V+wid*1024;
  #define DMA_K(t,slot) glds16(ksrc+(long)(t)*KVBLK*DM,(unsigned)__builtin_amdgcn_readfirstlane(kdst+(slot)))
  #define DMA_V(t,slot) glds16(vsrc+(long)(t)*KVBLK*DM,(unsigned)__builtin_amdgcn_readfirstlane(vdst+(slot)))
  const int vb0=(int)(lds0+LDS_V)+((lane>>4)&1)*32+(lane&3)*8+(4*hi+((lane&15)>>2))*64;
  const char*Kbase=shm+LDS_K; bf16x8 kf[8];
  const lds_cptr shm3=(lds_cptr)shm; const lds_cptr kp0=shm3+LDS_K+hi*1024+r32*16; const lds_cptr vp0=shm3+LDS_V+((lane>>4)&1)*32+(lane&3)*8+(4*hi+((lane&15)>>2))*64;
  const int NT=NTF-tst;
  float*cL=(float*)(shm+LDS_C);
  for(int i=tid;i<NT*KVBLK/4;i+=NW*64){ *(float4*)(cL+4*i)=*(const float4*)(cg+tst*KVBLK+4*i); }
  const float cq=cg[q0+wid*QBLK+r32]; float qm=cq;
  asm volatile("s_waitcnt vmcnt(0) lgkmcnt(0)":::"memory");
  DMA_K(0,0);DMA_V(0,0);DMA_K(1,SLOTB);
  bf16x8 qr[4];
  #pragma unroll
  for(int d0=0;d0<4;++d0)qr[d0]=*reinterpret_cast<const bf16x8*>(&Qw[(long)r32*DM+d0*16+hi*8]);
  float mhat=0.f,l_reg=0.f;f32x16 o[2];o[0]=f32x16{};o[1]=f32x16{};f32x16 cb0,cb1;
  const int qrel=wid*QBLK+r32;
  #define CBIAS(t) do{ const float*cp_=cL+(t)*KVBLK+4*hi; \
    _Pragma("unroll") for(int i_=0;i_<4;++i_){ const float4 u0_=*(const float4*)(cp_+8*i_), u1_=*(const float4*)(cp_+32+8*i_); \
      cb0[4*i_]=qm-u0_.x;cb0[4*i_+1]=qm-u0_.y;cb0[4*i_+2]=qm-u0_.z;cb0[4*i_+3]=qm-u0_.w; \
      cb1[4*i_]=qm-u1_.x;cb1[4*i_+1]=qm-u1_.y;cb1[4*i_+2]=qm-u1_.z;cb1[4*i_+3]=qm-u1_.w; } }while(0)
  #define CMASK(P0,P1,t) do{int jb_=(t)-(NT-4); if(jb_>=0)cmask(P0,P1,jb_,qrel,hi);}while(0)
  bool resc=false;
  #define START(P0,P1) do{ const float rm=rowmax(P0,P1); resc=false; \
    { const float dl=rm; mhat=fadd_s(mhat,dl); \
      _Pragma("unroll") for(int r=0;r<16;++r){P0[r]=fsub_s(P0[r],dl);P1[r]=fsub_s(P1[r],dl);} \
      qm=cq-mhat; } \
    _Pragma("unroll") for(int r=0;r<16;++r)P0[r]=__builtin_amdgcn_exp2f(P0[r]); }while(0)
  #define RESC() do{ if(resc){ asm volatile("s_waitcnt lgkmcnt(0)":::"memory"); \
      _Pragma("unroll") for(int d_=0;d_<2;++d_) _Pragma("unroll") for(int r=0;r<16;++r)o[d_][r]*=wsf[crow(r,hi)]; } }while(0)
  f32x16 pA0,pA1,pB0,pB1;
  int sl_prev=0,sl_cur=0,sl_next=SLOTB;
  #define ROT() do{sl_prev=sl_cur;sl_cur=sl_next;sl_next=(sl_next==(NSLOT-1)*SLOTB)?0:sl_next+SLOTB;}while(0)
  DMA_K(2,2*SLOTB);
  WAIT_BAR(3);
  CBIAS(0); qkt(pA0,pA1,Kbase,qr,cb0,cb1,r32,hi);asm volatile("s_nop 15\n\ts_nop 7":"+v"(pA0),"+v"(pA1));CMASK(pA0,pA1,0);
  START(pA0,pA1);
  _Pragma("unroll") for(int r=0;r<16;++r)pA1[r]=__builtin_amdgcn_exp2f(pA1[r]);
  WAIT_BAR(0);
  DMA_K(3,0);DMA_V(1,SLOTB);
  ROT();
  kload8(kf,kp0+sl_cur);
  WAIT_BAR(2);
  s16x4 vlo[8],vhi[8]; u32x4 pw0,pw1,pw2,pw3;
  #define PKW(P,B) cvtpk_s(P[B],P[B+1])
  #define PAF(k) __builtin_bit_cast(bf16x8,pw##k)
  #define VFR(i) (bf16x8){vlo[i][0],vlo[i][1],vlo[i][2],vlo[i][3],vhi[i][0],vhi[i][1],vhi[i][2],vhi[i][3]}
  #define PIN(x) asm volatile("":"+v"(x))
  #define MX3(a,b,c) __builtin_fmaxf(__builtin_fmaxf((a),(b)),(c))
  #define GAPA(MF,A0,A1,A2,A3,W0,W1,PW) do{ MF; sacc+=A0; sacc+=A1; sacc+=A2; sacc+=A3; PIN(sacc); W0; W1; PIN(PW); SBAR(); }while(0)
  #define EX(v) __builtin_amdgcn_exp2f(v)
  #define GAPB(MF,X,B) do{ MF; X[B]=EX(X[B]); X[B+1]=EX(X[B+1]); X[B+2]=EX(X[B+2]); X[B+3]=EX(X[B+3]); PIN(X); SBAR(); }while(0)
  #define VRD(i) do{ vlo[i]=vtr(vp_+(((i)>>2)*4096+((i)&3)*1024)); vhi[i]=vtr(vp_+(((i)>>2)*4096+((i)&3)*1024+512)); }while(0)
  #define KRD(G,j) do{ if(G){ kload2(kf,kp0+sl_next,j); SBAR(); } }while(0)
  #define STEP(C0,C1,P0,P1,t,GK,GV,GL) do{ SBAR(); CBIAS(t); SBAR(); \
    const lds_cptr vp_=vp0+sl_prev; \
    VRD(0); SBAR(); float sacc=(P0[0]+P0[1]); \
    GAPA(C0=__builtin_amdgcn_mfma_f32_32x32x16_bf16(kf[0],qr[0],cb0,0,0,0), P0[2],P0[3],P0[4],P0[5],     pw0[0]=PKW(P0,0), pw0[1]=PKW(P0,2), pw0); \
    VRD(4); SBAR(); GAPA(C1=__builtin_amdgcn_mfma_f32_32x32x16_bf16(kf[1],qr[0],cb1,0,0,0), P0[6],P0[7],P0[8],P0[9],     pw0[2]=PKW(P0,4), pw0[3]=PKW(P0,6), pw0); \
    VRD(1); SBAR(); GAPA(C0=__builtin_amdgcn_mfma_f32_32x32x16_bf16(kf[2],qr[1],C0,0,0,0),   P0[10],P0[11],P0[12],P0[13], pw1[0]=PKW(P0,8), pw1[1]=PKW(P0,10), pw1); \
    VRD(5); SBAR(); GAPA(C1=__builtin_amdgcn_mfma_f32_32x32x16_bf16(kf[3],qr[1],C1,0,0,0),   P0[14],P0[15],P1[0],P1[1],   pw1[2]=PKW(P0,12),pw1[3]=PKW(P0,14), pw1); \
    VRD(2); SBAR(); GAPA(C0=__builtin_amdgcn_mfma_f32_32x32x16_bf16(kf[4],qr[2],C0,0,0,0),   P1[2],P1[3],P1[4],P1[5],     pw2[0]=PKW(P1,0), pw2[1]=PKW(P1,2), pw2); \
    VRD(6); SBAR(); GAPA(C1=__builtin_amdgcn_mfma_f32_32x32x16_bf16(kf[5],qr[2],C1,0,0,0),   P1[6],P1[7],P1[8],P1[9],     pw2[2]=PKW(P1,4), pw2[3]=PKW(P1,6), pw2); \
    VRD(3); SBAR(); GAPA(C0=__builtin_amdgcn_mfma_f32_32x32x16_bf16(kf[6],qr[3],C0,0,0,0),   P1[10],P1[11],P1[12],P1[13], pw3[0]=PKW(P1,8), pw3[1]=PKW(P1,10), pw3); \
    VRD(7); SBAR(); GAPA(C1=__builtin_amdgcn_mfma_f32_32x32x16_bf16(kf[7],qr[3],C1,0,0,0),   P1[14],P1[15],0.f,0.f,       pw3[2]=PKW(P1,12),pw3[3]=PKW(P1,14), pw3); \
    l_reg+=sacc; \
    if(GK){DMA_K((t)+3,sl_cur);} if(GV){DMA_V((t)+1,sl_next);} \
    CMASK(C0,C1,t); \
    { float a=MX3(C0[0],C0[1],C1[0]),b=MX3(C0[2],C0[3],C1[1]); a=MX3(a,C1[2],C1[3]); \
      _Pragma("unroll") for(int r=4;r<16;r+=4){a=MX3(a,C0[r],C0[r+1]);b=MX3(b,C0[r+2],C0[r+3]);a=MX3(a,C1[r],C1[r+1]);b=MX3(b,C1[r+2],C1[r+3]);} \
      float rm=__builtin_fmaxf(a,b); { auto rr=__builtin_amdgcn_permlane32_swap(__float_as_uint(rm),__float_as_uint(rm),false,false); rm=__builtin_fmaxf(__uint_as_float(rr[0]),__uint_as_float(rr[1])); } \
      resc=false; \
      if(__builtin_expect(__any(rm>(float)THRL),0)){ const float dl=__builtin_fmaxf(rm,0.f); mhat+=dl; \
        _Pragma("unroll") for(int r=0;r<16;++r){C0[r]-=dl;C1[r]-=dl;} \
        qm=cq-mhat; \
        const float f=__builtin_amdgcn_exp2f(-dl); l_reg*=f; if(hi==0)wsf[r32]=f; resc=true; } } \
    SBAR(); \
    GAPB(o[0]=__builtin_amdgcn_mfma_f32_32x32x16_bf16(PAF(0),VFR(0),o[0],0,0,0), C0,0); \
    GAPB(o[1]=__builtin_amdgcn_mfma_f32_32x32x16_bf16(PAF(0),VFR(4),o[1],0,0,0), C0,4); \
    KRD(GL,0); GAPB(o[0]=__builtin_amdgcn_mfma_f32_32x32x16_bf16(PAF(1),VFR(1),o[0],0,0,0), C0,8); \
    KRD(GL,1); GAPB(o[1]=__builtin_amdgcn_mfma_f32_32x32x16_bf16(PAF(1),VFR(5),o[1],0,0,0), C0,12); \
    KRD(GL,2); GAPB(o[0]=__builtin_amdgcn_mfma_f32_32x32x16_bf16(PAF(2),VFR(2),o[0],0,0,0), C1,0); \
    KRD(GL,3); GAPB(o[1]=__builtin_amdgcn_mfma_f32_32x32x16_bf16(PAF(2),VFR(6),o[1],0,0,0), C1,4); \
    GAPB(o[0]=__builtin_amdgcn_mfma_f32_32x32x16_bf16(PAF(3),VFR(3),o[0],0,0,0), C1,8); \
    GAPB(o[1]=__builtin_amdgcn_mfma_f32_32x32x16_bf16(PAF(3),VFR(7),o[1],0,0,0), C1,12); \
    }while(0)
  int t=1;
  #undef CMASK
  #define CMASK(P0,P1,t) do{}while(0)
  for(;t+5<NT;t+=2){
    STEP(pB0,pB1,pA0,pA1,t,true,true,true);     WAIT_BAR(2); RESC(); ROT();
    STEP(pA0,pA1,pB0,pB1,t+1,true,true,true);   WAIT_BAR(2); RESC(); ROT();
  }
  #undef CMASK
  #define CMASK(P0,P1,t) do{int jb_=(t)-(NT-4); if(jb_>=0)cmask(P0,P1,jb_,qrel,hi);}while(0)
  #define ENDW(tt) do{ if((tt)+3<NT){WAIT_BAR(2);} else if((tt)+2<NT){WAIT_BAR(1);} else {WAIT_BAR(0);} }while(0)
  for(;t+1<NT;t+=2){
    STEP(pB0,pB1,pA0,pA1,t,(t+3<NT),(t+1<NT),(t+1<NT));       ENDW(t);   RESC(); ROT();
    STEP(pA0,pA1,pB0,pB1,t+1,(t+4<NT),(t+2<NT),(t+2<NT));     ENDW(t+1); RESC(); ROT();
  }
  STEP(pB0,pB1,pA0,pA1,NT-1,false,false,false); RESC();
  { float sacc=pB0[0]+pB0[1]; _Pragma("unroll") for(int r=2;r<16;++r)sacc+=pB0[r]; _Pragma("unroll") for(int r=0;r<16;++r)sacc+=pB1[r]; l_reg+=sacc;
    pw0=(u32x4){PKW(pB0,0),PKW(pB0,2),PKW(pB0,4),PKW(pB0,6)};pw1=(u32x4){PKW(pB0,8),PKW(pB0,10),PKW(pB0,12),PKW(pB0,14)};pw2=(u32x4){PKW(pB1,0),PKW(pB1,2),PKW(pB1,4),PKW(pB1,6)};pw3=(u32x4){PKW(pB1,8),PKW(pB1,10),PKW(pB1,12),PKW(pB1,14)};
    SBAR(); pv(o,vb0+sl_cur,PAF(0),PAF(1),PAF(2),PAF(3)); }
  #undef PKW
  #undef PAF
  #undef VFR
  #undef PIN
  #undef MX3
  #undef GAPA
  #undef GAPB
  #undef EX
  #undef VRD
  #undef KRD
  #undef STEP
  #undef ENDW
  {auto rr=__builtin_amdgcn_permlane32_swap(__float_as_uint(l_reg),__float_as_uint(l_reg),false,false);l_reg=__uint_as_float(rr[0])+__uint_as_float(rr[1]);}
  if(hi==0)wsf[32+r32]=l_reg;asm volatile("s_waitcnt lgkmcnt(0)":::"memory");
  float rli[16];
  #pragma unroll
  for(int r=0;r<16;++r)rli[r]=__builtin_amdgcn_rcpf(wsf[32+crow(r,hi)]);
  bf16*Ow=O+(rowbase+q0+wid*QBLK)*OP+h*D;
  { bf16*stg=(bf16*)(shm+LDS_OST)+wid*2048;
    #pragma unroll
    for(int r=0;r<16;++r){const int orow=crow(r,hi);
      #pragma unroll
      for(int d0=0;d0<2;++d0)stg[orow*64+d0*32+r32]=__float2bfloat16(o[d0][r]*rli[r]);}
    asm volatile("s_waitcnt lgkmcnt(0)":::"memory");
    #pragma unroll
    for(int i=0;i<4;++i){const int row=i*8+(lane>>3),ch=lane&7; const u32x4 v=*(const u32x4*)(stg+row*64+ch*8); ATTN_STORE16(Ow+(long)row*OP+ch*8,v);} }
  asm volatile("s_waitcnt lgkmcnt(0)\n\ts_barrier":::"memory");
  #undef DMA_K
  #undef DMA_V
  #undef CMASK
  #undef START
  #undef RESC
  #undef ROT
  #undef CBIAS
}
constexpr int ATTN_LDS_BYTES=LDS_BYTES;
#undef SBAR
#undef WAIT_BAR
}

namespace ssd {
constexpr int BP = 136, TP = 72, CBP = 68, SP = 136;
constexpr int L_BC = 0, L_CC = 17408, L_BT = 34816, L_CB = 53248, L_ACS = 70656, L_DT = 71680, L_ST = 72704, ST_BYTES = 8704, L_RS = L_ST + 8 * ST_BYTES, L_END = L_RS + 2048;
struct Ptrs { const bf16_t* XBC; const bf16_t* Zs; const float* DT; const float* conv_w; const float* conv_b; const float* A_log; const float* D_skip;
              const float* state_conv; const float* state_ssm; float* SL; float* dAtot; float* GSS; bf16_t* Mix; float* out; };
#define MFMA32(a, b, c) __builtin_amdgcn_mfma_f32_32x32x16_bf16((a), (b), (c), 0, 0, 0)
#define LDSFENCE() asm volatile("s_waitcnt lgkmcnt(0)" ::: "memory")

template <int MODE> __device__ __forceinline__ void unit(const Ptrs& P, unsigned char* lds, int b, int blk, int hq) {
    int tid_ = threadIdx.x; asm volatile("" : "+v"(tid_));
    const int tid = tid_, lane = tid & 63, wid = __builtin_amdgcn_readfirstlane(tid >> 6), r32 = lane & 31, hi = lane >> 5;
    const int g = hq >> 1, hl = wid >> 1, ph = wid & 1, h = hq * 4 + hl;
    constexpr int NSUB = (MODE == 2) ? 1 : 4;
    constexpr int nvalid = (MODE == 2) ? 16 : 256;
    const int row0 = (MODE == 2) ? MP + b * 16 : b * PSEQ + blk * 256;
    bf16_t* Bc = (bf16_t*)(lds + L_BC); bf16_t* Cc = (bf16_t*)(lds + L_CC); bf16_t* BT = (bf16_t*)(lds + L_BT); float* CB = (float*)(lds + L_CB);
    float* rsL = (float*)(lds + L_RS); float* acsL = (float*)(lds + L_ACS); float* dtL = (float*)(lds + L_DT); bf16_t* St = (bf16_t*)(lds + L_ST + wid * ST_BYTES);
    const int xcol = h * 64 + ph * 32 + r32;
    const int cp = tid & 127, seg = tid >> 7, ch = 2 * cp; const int scol = (ch < 128) ? 1024 + 128 * g + ch : 1280 + 128 * g + (ch - 128);
    const float Asc = -__expf(P.A_log[hq * 4 + (wid & 3)]);
    const float Dh = P.D_skip[h];
    f32x16 st[4];
    if (MODE == 0) {
#pragma unroll
        for (int nb = 0; nb < 4; ++nb) st[nb] = f32x16{};
    } else if (MODE == 1) {
        const float* sp = P.SL + ((size_t)((b * 32 + blk) * 16 + h)) * 8192 + (size_t)(ph * 4) * 1024 + lane;
#pragma unroll
        for (int nb = 0; nb < 4; ++nb)
#pragma unroll
            for (int r = 0; r < 16; ++r) st[nb][r] = sp[(nb * 16 + r) * 64];
    } else {
        const float* sp = P.state_ssm + ((size_t)(b * 16 + h) * 64 + ph * 32 + r32) * 128 + 4 * hi;
#pragma unroll
        for (int nb = 0; nb < 4; ++nb)
#pragma unroll
            for (int q4 = 0; q4 < 4; ++q4) { const f32x4 v = *(const f32x4*)(sp + 32 * nb + 8 * q4); st[nb][4 * q4] = v[0]; st[nb][4 * q4 + 1] = v[1]; st[nb][4 * q4 + 2] = v[2]; st[nb][4 * q4 + 3] = v[3]; }
    }
    float dasum = 0.f;
    unsigned uu[16]; float dtn = 0.f;
    auto load_stage = [&](int tbn) {
        if (MODE != 0 || ch < 128) { const int t0 = tbn + 16 * seg; const bf16_t* sp = P.XBC + (unsigned)((row0 + t0) * DCONV + scol);
#pragma unroll
            for (int i = 0; i < 16; ++i) { uu[i] = *(const unsigned*)(sp + i * DCONV); if (MODE == 2) { asm volatile("" : "+v"(uu[i])); if (t0 + i >= nvalid) uu[i] = 0u; } } }
        if (wid < 4) { const int t = tbn + lane; dtn = (t < nvalid) ? P.DT[(unsigned)((row0 + t) * 16 + hq * 4 + wid)] : 0.f; }
    };
    if (MODE == 0) load_stage(0);
#pragma unroll 1
    for (int sc = 0; sc < NSUB; ++sc) {
        const int tb = 64 * sc;
        unsigned xvp[4][4];
        {
            const bf16_t* xp = P.XBC + (unsigned)((row0 + tb + 8 * hi) * DCONV + xcol);
#pragma unroll
            for (int ks = 0; ks < 4; ++ks)
#pragma unroll
                for (int i = 0; i < 4; ++i) { unsigned lo = xp[(16 * ks + 2 * i) * DCONV], hi16 = xp[(16 * ks + 2 * i + 1) * DCONV];
                    if (MODE == 2) { asm volatile("" : "+v"(lo), "+v"(hi16));     if (tb + 16 * ks + 8 * hi + 2 * i >= nvalid) lo = 0u; if (tb + 16 * ks + 8 * hi + 2 * i + 1 >= nvalid) hi16 = 0u; }
                    xvp[ks][i] = lo | (hi16 << 16); }
        }
        if (MODE != 0) load_stage(tb);
        if (MODE != 0 || ch < 128) {
            bf16_t* nat = ((ch < 128) ? Bc : Cc) + (ch & 127);
#pragma unroll
            for (int i = 0; i < 16; ++i) *(unsigned*)(nat + (16 * seg + i) * BP) = uu[i];
            if (ch < 128) {
                unsigned bt0[8], bt1[8];
#pragma unroll
                for (int i = 0; i < 8; ++i) { bt0[i] = (uu[2 * i] & 0xffffu) | (uu[2 * i + 1] << 16); bt1[i] = (uu[2 * i] >> 16) | (uu[2 * i + 1] & 0xffff0000u); }
                *(u32x4*)(BT + ch * TP + 16 * seg) = (u32x4){bt0[0], bt0[1], bt0[2], bt0[3]}; *(u32x4*)(BT + ch * TP + 16 * seg + 8) = (u32x4){bt0[4], bt0[5], bt0[6], bt0[7]};
                *(u32x4*)(BT + (ch + 1) * TP + 16 * seg) = (u32x4){bt1[0], bt1[1], bt1[2], bt1[3]}; *(u32x4*)(BT + (ch + 1) * TP + 16 * seg + 8) = (u32x4){bt1[4], bt1[5], bt1[6], bt1[7]};
            }
        }
        if (wid < 4) {
            const float dt = dtn;
            float a = dt * Asc;
#pragma unroll
            for (int o = 1; o < 64; o <<= 1) { const float v = __shfl_up(a, o); if (lane >= o) a += v; }
            acsL[wid * 64 + lane] = a; dtL[wid * 64 + lane] = dt; dasum += __shfl(a, 63);
        }
#define XV(ks, j) (((j) & 1) ? __uint_as_float(xvp[ks][(j) >> 1] & 0xffff0000u) : __uint_as_float(xvp[ks][(j) >> 1] << 16))
        __syncthreads();
        if (MODE != 0) {
            if (wid < 3) { const int lb = wid > 0 ? 1 : 0, sb = wid > 1 ? 1 : 0; f32x16 cacc = f32x16{};
#pragma unroll
                for (int ks = 0; ks < 8; ++ks) { const bf16x8 av = *(const bf16x8*)(Cc + (32 * lb + r32) * BP + 16 * ks + 8 * hi), bv = *(const bf16x8*)(Bc + (32 * sb + r32) * BP + 16 * ks + 8 * hi); cacc = MFMA32(av, bv, cacc); }
#pragma unroll
                for (int r = 0; r < 16; ++r) CB[(32 * lb + crow_(r, hi)) * CBP + 32 * sb + r32] = cacc[r]; }
            __syncthreads();
        }
        const float* acsH = acsL + hl * 64; const float* dtH = dtL + hl * 64;
        const float acs_last = acsH[63];
        if (MODE != 0) {
#pragma unroll
            for (int nb = 0; nb < 4; ++nb)
#pragma unroll
                for (int q4 = 0; q4 < 4; ++q4) *(u32x2*)(St + r32 * SP + 32 * nb + 8 * q4 + 4 * hi) = (u32x2){cvtpk(st[nb][4 * q4], st[nb][4 * q4 + 1]), cvtpk(st[nb][4 * q4 + 2], st[nb][4 * q4 + 3])};
            LDSFENCE();
#pragma unroll 1
            for (int lb = 0; lb < 2; ++lb) { if (MODE == 2 && lb == 1) continue;
                f32x16 y = f32x16{};
                unsigned short zr[16];
#pragma unroll
                for (int q4 = 0; q4 < 4; ++q4)
#pragma unroll
                    for (int e = 0; e < 4; ++e) { const int lr = 32 * lb + 8 * q4 + 4 * hi + e; const int row = row0 + tb + lr; zr[4 * q4 + e] = P.Zs[(unsigned)(row * 1024 + xcol)]; }
#pragma unroll
                for (int ks = 0; ks < 8; ++ks) { const bf16x8 av = *(const bf16x8*)(Cc + (32 * lb + r32) * BP + 16 * ks + 8 * hi), bv = *(const bf16x8*)(St + r32 * SP + 16 * ks + 8 * hi); y = MFMA32(av, bv, y); }
#pragma unroll
                for (int q4 = 0; q4 < 4; ++q4) { const f32x4 a4 = *(const f32x4*)(acsH + 32 * lb + 8 * q4 + 4 * hi);
#pragma unroll
                    for (int e = 0; e < 4; ++e) y[4 * q4 + e] *= __expf(a4[e]); }
                const int l = 32 * lb + r32; const float al = acsH[l];
#pragma unroll
                for (int ks = 0; ks < 4; ++ks) { if (ks > 2 * lb + 1) continue;
                    const int s0 = 16 * ks + 8 * hi;
                    const f32x4 c0 = *(const f32x4*)(CB + l * CBP + s0), c1 = *(const f32x4*)(CB + l * CBP + s0 + 4);
                    const f32x4 s4a = *(const f32x4*)(acsH + s0), s4b = *(const f32x4*)(acsH + s0 + 4), d4a = *(const f32x4*)(dtH + s0), d4b = *(const f32x4*)(dtH + s0 + 4);
                    float gg[8], xa[8];
#pragma unroll
                    for (int j = 0; j < 8; ++j) { const float cbv = j < 4 ? c0[j] : c1[j - 4], as = j < 4 ? s4a[j] : s4b[j - 4], dv = j < 4 ? d4a[j] : d4b[j - 4];
                        gg[j] = (s0 + j <= l) ? cbv * __expf(al - as) : 0.f; xa[j] = XV(ks, j) * dv; }
                    const u32x4 gp = {cvtpk(gg[0], gg[1]), cvtpk(gg[2], gg[3]), cvtpk(gg[4], gg[5]), cvtpk(gg[6], gg[7])};
                    const u32x4 xp = {cvtpk(xa[0], xa[1]), cvtpk(xa[2], xa[3]), cvtpk(xa[4], xa[5]), cvtpk(xa[6], xa[7])};
                    y = MFMA32(__builtin_bit_cast(bf16x8, gp), __builtin_bit_cast(bf16x8, xp), y);
                    if (ks >= 2 * lb) { float di[8];
#pragma unroll
                        for (int j = 0; j < 8; ++j) di[j] = (s0 + j == l) ? Dh : 0.f;
                        const u32x4 dp = {cvtpk(di[0], di[1]), cvtpk(di[2], di[3]), cvtpk(di[4], di[5]), cvtpk(di[6], di[7])};
                        const u32x4 xr = {xvp[ks][0], xvp[ks][1], xvp[ks][2], xvp[ks][3]};
                        y = MFMA32(__builtin_bit_cast(bf16x8, dp), __builtin_bit_cast(bf16x8, xr), y); } }
                float s2v[16];
#pragma unroll
                for (int q4 = 0; q4 < 4; ++q4)
#pragma unroll
                    for (int e = 0; e < 4; ++e) { const int r = 4 * q4 + e; const int lr = 32 * lb + 8 * q4 + 4 * hi + e; const int row = row0 + tb + lr;
                        const float yv = y[r] * bf2f(zr[r]);
                        if (MODE != 2 || q4 < 2) P.Mix[(unsigned)(row * DMIX + xcol)] = (bf16_t)(cvtpk(yv, 0.f) & 0xffffu);
                        float s2 = yv * yv;
                        s2 += __shfl_xor(s2, 1); s2 += __shfl_xor(s2, 2); s2 += __shfl_xor(s2, 4); s2 += __shfl_xor(s2, 8); s2 += __shfl_xor(s2, 16);
                        s2v[r] = s2; }
                asm volatile("" ::: "memory");
                if (r32 == 0) {
#pragma unroll
                    for (int q4 = 0; q4 < 4; ++q4)
#pragma unroll
                        for (int e = 0; e < 4; ++e) rsL[wid * 64 + 32 * lb + 8 * q4 + 4 * hi + e] = s2v[4 * q4 + e];
                }
            }
        }
        if (MODE == 0 && sc + 1 < NSUB) load_stage(tb + 64);
        {
            const float dec = __expf(acs_last);
#pragma unroll
            for (int nb = 0; nb < 4; ++nb) st[nb] *= dec;
#pragma unroll
            for (int ks = 0; ks < 4; ++ks) { const int s0 = 16 * ks + 8 * hi;
                const f32x4 s4a = *(const f32x4*)(acsH + s0), s4b = *(const f32x4*)(acsH + s0 + 4), d4a = *(const f32x4*)(dtH + s0), d4b = *(const f32x4*)(dtH + s0 + 4);
                float xb[8];
#pragma unroll
                for (int j = 0; j < 8; ++j) { const float as = j < 4 ? s4a[j] : s4b[j - 4], dv = j < 4 ? d4a[j] : d4b[j - 4]; xb[j] = XV(ks, j) * dv * __expf(acs_last - as); }
                const u32x4 xp = {cvtpk(xb[0], xb[1]), cvtpk(xb[2], xb[3]), cvtpk(xb[4], xb[5]), cvtpk(xb[6], xb[7])};
#pragma unroll
                for (int nb = 0; nb < 4; ++nb) { const bf16x8 av = *(const bf16x8*)(BT + (32 * nb + r32) * TP + 16 * ks + 8 * hi); st[nb] = MFMA32(av, __builtin_bit_cast(bf16x8, xp), st[nb]); } }
        }
        __syncthreads();
        if (MODE != 0) { if (tid < ((MODE == 2) ? 16 : 64)) { float s = 0.f;
#pragma unroll
                for (int w = 0; w < 8; ++w) s += rsL[w * 64 + tid];
                P.GSS[(unsigned)((row0 + tb + tid) * 4 + hq)] = s; } }
    }
    if (MODE == 0) {
        float* sp = P.SL + ((size_t)((b * 32 + blk) * 16 + h)) * 8192 + (size_t)(ph * 4) * 1024 + lane;
#pragma unroll
        for (int nb = 0; nb < 4; ++nb)
#pragma unroll
            for (int r = 0; r < 16; ++r) sp[(nb * 16 + r) * 64] = st[nb][r];
        if (wid < 4 && lane == 0) P.dAtot[(b * 32 + blk) * 16 + hq * 4 + wid] = dasum;
    } else if (MODE == 2 || blk == 31) {
        float* sp = P.out + (MODE == 2 ? O_SSSM : O_PSSM) + ((size_t)(b * 16 + h) * 64 + ph * 32 + r32) * 128 + 4 * hi;
#pragma unroll
        for (int nb = 0; nb < 4; ++nb)
#pragma unroll
            for (int q4 = 0; q4 < 4; ++q4) *(f32x4*)(sp + 32 * nb + 8 * q4) = (f32x4){st[nb][4 * q4], st[nb][4 * q4 + 1], st[nb][4 * q4 + 2], st[nb][4 * q4 + 3]};
    }
}
#undef XV
}

namespace sattn {
constexpr int L_C = 0, L_M = 16640, L_L = L_M + 512, L_O = L_L + 512, OPITCH = 17, L_SCAN = L_O + 8 * 64 * OPITCH * 4, L_END = L_SCAN + 64;
struct Ptrs { const float* cache_k; const float* cache_v; const float* cache_logf; const bf16_t* Qb; const bf16_t* Kb; const bf16_t* Vb; const float* out; bf16_t* Mix; };
__device__ __forceinline__ void unit(const Ptrs& P, unsigned char* lds, int b, int h) {
    int tid_ = threadIdx.x; asm volatile("" : "+v"(tid_));
    const int tid = tid_, lane = tid & 63, wid = __builtin_amdgcn_readfirstlane(tid >> 6), r32 = lane & 31, hi = lane >> 5;
    float* cL = (float*)(lds + L_C); float* mW = (float*)(lds + L_M); float* lW = (float*)(lds + L_L); float* OW = (float*)(lds + L_O); float* wtot = (float*)(lds + L_SCAN);
    constexpr int NK = PAST + SSEQ;
    {
        float v[16]; float run = 0.f; const int s0 = 16 * tid;
#pragma unroll
        for (int i = 0; i < 16; ++i) v[i] = 0.f;
        if (tid < PAST / 16) { const float* lp = P.cache_logf + ((size_t)b * PAST + s0) * 8 + h;
#pragma unroll
            for (int i = 0; i < 16; ++i) v[i] = lp[i * 8];
        } else if (tid == PAST / 16) { const float* lp = P.out + O_SLF + ((size_t)b * 16) * 8 + h;
#pragma unroll
            for (int i = 0; i < 16; ++i) v[i] = lp[i * 8];
        }
#pragma unroll
        for (int i = 0; i < 16; ++i) run += v[i];
        float inc = run;
#pragma unroll
        for (int o = 1; o < 64; o <<= 1) { const float t = __shfl_up(inc, o); if (lane >= o) inc += t; }
        if (lane == 63) wtot[wid] = inc;
        __syncthreads();
        float off = inc - run;
        for (int w = 0; w < wid; ++w) off += wtot[w];
#pragma unroll
        for (int i = 0; i < 16; ++i) { off += v[i]; const int s = s0 + i; if (s < NK + 16) cL[s] = off * L2E; }
        __syncthreads();
    }
    const int q = r32 & 15; const long qrow = (long)MP + b * 16 + q;
    bf16x8 qf[4];
#pragma unroll
    for (int ks = 0; ks < 4; ++ks) qf[ks] = *(const bf16x8*)(P.Qb + qrow * 512 + h * 64 + 16 * ks + 8 * hi);
    const float cq = cL[PAST + q];
    float m = -1e30f, l = 0.f; f32x16 o[2]; o[0] = f32x16{}; o[1] = f32x16{};
    int tile0;
    { const float c0 = cL[PAST]; const int t1 = lane, t2 = lane + 64;
      const bool s1 = (c0 - cL[32 * t1 + 31]) < -(64.0f * L2E), s2 = (c0 - cL[32 * t2 + 31]) < -(64.0f * L2E);
      tile0 = __builtin_amdgcn_readfirstlane(__builtin_popcountll(__ballot(s1)) + __builtin_popcountll(__ballot(s2))); }
    for (int tile = tile0 + wid; tile < 129; tile += 8) {
        const int key0 = 32 * tile; const bool isnew = tile == 128;
        bf16x8 kf[4];
        if (!isnew) { const float* kp = P.cache_k + (((size_t)b * PAST + key0 + r32) * 8 + h) * 64 + 8 * hi;
#pragma unroll
            for (int ks = 0; ks < 4; ++ks) { const f32x4 a = *(const f32x4*)(kp + 16 * ks), c = *(const f32x4*)(kp + 16 * ks + 4);
                const u32x4 w = {cvtpk(a[0], a[1]), cvtpk(a[2], a[3]), cvtpk(c[0], c[1]), cvtpk(c[2], c[3])}; kf[ks] = __builtin_bit_cast(bf16x8, w); }
        } else {
#pragma unroll
            for (int ks = 0; ks < 4; ++ks) kf[ks] = *(const bf16x8*)(P.Kb + ((long)MP + b * 16 + (r32 & 15)) * 512 + h * 64 + 16 * ks + 8 * hi);
        }
        float vall[2][2][8];
        if (!isnew) {
#pragma unroll
            for (int db = 0; db < 2; ++db)
#pragma unroll
                for (int s2 = 0; s2 < 2; ++s2)
#pragma unroll
                    for (int j = 0; j < 8; ++j) { const int kv = crow_(8 * s2 + j, hi); vall[db][s2][j] = P.cache_v[(((size_t)b * PAST + key0 + kv) * 8 + h) * 64 + 32 * db + r32]; }
        } else {
#pragma unroll
            for (int db = 0; db < 2; ++db)
#pragma unroll
                for (int s2 = 0; s2 < 2; ++s2)
#pragma unroll
                    for (int j = 0; j < 8; ++j) { const int kv = crow_(8 * s2 + j, hi); vall[db][s2][j] = bf2f(P.Vb[((long)MP + b * 16 + (kv & 15)) * 512 + h * 64 + 32 * db + r32]) * (kv < 16 ? 1.f : 0.f); }
        }
        f32x16 s = f32x16{};
#pragma unroll
        for (int ks = 0; ks < 4; ++ks) s = MFMA32(kf[ks], qf[ks], s);
        float mt = -1e30f;
#pragma unroll
        for (int q4 = 0; q4 < 4; ++q4) { const f32x4 c4 = *(const f32x4*)(cL + key0 + 8 * q4 + 4 * hi);
#pragma unroll
            for (int e = 0; e < 4; ++e) { const int r = 4 * q4 + e; const int kv = 8 * q4 + 4 * hi + e; float x = s[r] + (cq - c4[e]);
                if (isnew && (kv >= 16 || kv > q)) x = -1e30f;
                s[r] = x; mt = fmaxf(mt, x); } }
        mt = fmaxf(mt, __shfl_xor(mt, 32));
        const float mn = fmaxf(m, mt), alpha = __builtin_amdgcn_exp2f(m - mn); m = mn;
        float ls = 0.f;
#pragma unroll
        for (int r = 0; r < 16; ++r) { const float p = __builtin_amdgcn_exp2f(s[r] - mn); s[r] = p; ls += p; }
        l = l * alpha + ls;
#pragma unroll
        for (int db = 0; db < 2; ++db) o[db] *= alpha;
        bf16x8 pf[2];
#pragma unroll
        for (int s2 = 0; s2 < 2; ++s2) { const u32x4 w = {cvtpk(s[8 * s2], s[8 * s2 + 1]), cvtpk(s[8 * s2 + 2], s[8 * s2 + 3]), cvtpk(s[8 * s2 + 4], s[8 * s2 + 5]), cvtpk(s[8 * s2 + 6], s[8 * s2 + 7])}; pf[s2] = __builtin_bit_cast(bf16x8, w); }
#pragma unroll
        for (int db = 0; db < 2; ++db)
#pragma unroll
            for (int s2 = 0; s2 < 2; ++s2) { const float* vv = vall[db][s2];
                const u32x4 w = {cvtpk(vv[0], vv[1]), cvtpk(vv[2], vv[3]), cvtpk(vv[4], vv[5]), cvtpk(vv[6], vv[7])};
                o[db] = MFMA32(__builtin_bit_cast(bf16x8, w), pf[s2], o[db]); }
    }
    l += __shfl_xor(l, 32);
    if (r32 < 16) { if (hi == 0) { mW[wid * 16 + r32] = m; lW[wid * 16 + r32] = l; }
#pragma unroll
        for (int db = 0; db < 2; ++db)
#pragma unroll
            for (int r = 0; r < 16; ++r) OW[(wid * 64 + 32 * db + crow_(r, hi)) * OPITCH + r32] = o[db][r]; }
    __syncthreads();
#pragma unroll
    for (int it = 0; it < 2; ++it) { const int idx = tid + 512 * it, d = idx & 63, qq = idx >> 6;
        float M = -1e30f;
#pragma unroll
        for (int w = 0; w < 8; ++w) M = fmaxf(M, mW[w * 16 + qq]);
        float L = 0.f, acc = 0.f;
#pragma unroll
        for (int w = 0; w < 8; ++w) { const float f = __builtin_amdgcn_exp2f(mW[w * 16 + qq] - M); L += lW[w * 16 + qq] * f; acc += OW[(w * 64 + d) * OPITCH + qq] * f; }
        P.Mix[((long)MP + b * 16 + qq) * DMIX + 1024 + h * 64 + d] = (bf16_t)(cvtpk(acc / L, 0.f) & 0xffffu); }
    __syncthreads();
}
}

constexpr int NWAVES = 8, LDS_BYTES = 147456;
#define LAS __attribute__((address_space(3)))
struct Args {
    const float *x_prompt, *x_sample, *cache_k, *cache_v, *cache_logf, *state_ssm, *state_conv, *norm1_w, *w_in, *conv_w, *conv_b, *dt_bias, *A_log, *D_skip, *ssd_norm_w, *f_bias,
                *q_norm_w, *k_norm_w, *w_out, *norm2_w, *w_up, *w_down;
    float* out; unsigned char* ws;
};
__device__ __forceinline__ unsigned pk2(float lo, float hi) { return cvtpk(lo, hi); }
template <int MAP> __device__ __forceinline__ void transpose_item(const float* W, int K, int Nsrc, int Nphys, bf16_t* WT, const float* ksc, int ksc_n, float* scr, int item, int lane) {
    const int nblk = Nphys / 32, kb = item / nblk, nb = item % nblk, k0 = 64 * kb, n0 = 32 * nb;
    const int n = n0 + (lane & 31); int src = n;
    if (MAP == 1) { const int L = (n & ~255) + ((n >> 5) & 3) * 64 + ((n >> 7) & 1) * 32 + (n & 31);
        if (L < 2560) src = L; else if (L < 4096) src = L + 16; else if (L < 4112) src = 2560 + (L - 4096); else if (L < 4120) src = L; else src = -1; }
#pragma unroll
    for (int i = 0; i < 32; ++i) { const int kk = 2 * i + (lane >> 5); float v = (src >= 0) ? W[(size_t)(k0 + kk) * Nsrc + src] : 0.f; if (ksc && (k0 + kk) < ksc_n) v *= ksc[k0 + kk]; scr[kk * 33 + (lane & 31)] = v; }
    asm volatile("s_waitcnt lgkmcnt(0)" ::: "memory");
    const int c = lane & 7;
#pragma unroll
    for (int j = 0; j < 4; ++j) { const int nn = (lane >> 3) + 8 * j; const float* s = scr + (8 * c) * 33 + nn;
        u32x4 o; o.x = pk2(s[0 * 33], s[1 * 33]); o.y = pk2(s[2 * 33], s[3 * 33]); o.z = pk2(s[4 * 33], s[5 * 33]); o.w = pk2(s[6 * 33], s[7 * 33]);
        *(u32x4*)(WT + (size_t)(n0 + nn) * K + k0 + 8 * c) = o; }
    asm volatile("s_waitcnt lgkmcnt(0)" ::: "memory");
}
__device__ __forceinline__ float wave_sum(float v) {
#pragma unroll
    for (int o = 1; o < 64; o <<= 1) v += __shfl_xor(v, o);
    return v;
}
__device__ __forceinline__ void rms_row_to_bf16(const float* xrow, bf16_t* orow, int lane) {
    const f32x4* xr = (const f32x4*)xrow + lane; f32x4 v[4]; float s = 0.f;
#pragma unroll
    for (int j = 0; j < 4; ++j) { v[j] = xr[64 * j]; s += (v[j][0] * v[j][0] + v[j][1] * v[j][1]) + (v[j][2] * v[j][2] + v[j][3] * v[j][3]); }
    const float rs = rsqrtf(wave_sum(s) * (1.0f / 1024.0f) + EPSN);
    u32x2* o8 = (u32x2*)orow + lane;
#pragma unroll
    for (int j = 0; j < 4; ++j) o8[64 * j] = (u32x2){pk2(v[j][0] * rs, v[j][1] * rs), pk2(v[j][2] * rs, v[j][3] * rs)};
}

#define XB_TMO      128
#define XB_XCNT(j)  (256  + 64 * (j))
#define XB_XSUB(j)  (1280 + 64 * (j))
#define XB_XGEN(j)  (2304 + 64 * (j))
#define XB_TOP      3328
#define XB_TOPGEN   3392
#define XCD_BAR_WORDS 3456
#define XB_SPIN_CAP (1u << 18)

__device__ __forceinline__ unsigned xb_ld(unsigned* p)              { return __hip_atomic_load(p, __ATOMIC_RELAXED, __HIP_MEMORY_SCOPE_AGENT); }
__device__ __forceinline__ unsigned xb_add(unsigned* p, unsigned v) { return __hip_atomic_fetch_add(p, v, __ATOMIC_RELAXED, __HIP_MEMORY_SCOPE_AGENT); }
__device__ __forceinline__ unsigned xb_xcc_id() { return (unsigned)__builtin_amdgcn_s_getreg((3 << 11) | 20) & 0xFu; }
#define XB_SPIN(cond, bar) do { unsigned _sp = 0; while (cond) { __builtin_amdgcn_s_sleep(1); \
    if ((++_sp & 255u) == 0u) { if (xb_ld(&(bar)[XB_TMO])) break; if (_sp > XB_SPIN_CAP) { atomicAdd(&(bar)[XB_TMO], 1u); break; } } } } while (0)

struct XcdBarrier {
    unsigned* bar; unsigned x;
    volatile LAS unsigned* st;
};

__device__ __forceinline__ XcdBarrier xcd_barrier_post(unsigned* bar, volatile LAS unsigned* st) {
    XcdBarrier b; b.bar = bar; b.x = xb_xcc_id(); b.st = st;
    if (threadIdx.x == 0) (void)xb_add(&bar[XB_XCNT(b.x)], 1u);
    return b;
}
__device__ __forceinline__ void xcd_barrier_complete(unsigned* bar, unsigned x, unsigned& nloc, unsigned& nx) {
    const unsigned G = gridDim.x * gridDim.y * gridDim.z;
    unsigned sum, cnt, mine, sp = 0u;
    for (;;) {
        sum = 0u; cnt = 0u; mine = 0u;
#pragma unroll
        for (unsigned j = 0; j < 16; ++j) { const unsigned c = xb_ld(&bar[XB_XCNT(j)]); sum += c; cnt += (c > 0u) ? 1u : 0u; mine = (j == x) ? c : mine; }
        if (sum == G) break;
        __builtin_amdgcn_s_sleep(1);
        if ((++sp & 255u) == 0u) { if (xb_ld(&bar[XB_TMO])) break; if (sp > XB_SPIN_CAP) { atomicAdd(&bar[XB_TMO], 1u); break; } }
    }
    nloc = mine > 0u ? mine : 1u; nx = cnt > 0u ? cnt : 1u;
}

__device__ __forceinline__ void xcd_barrier(const XcdBarrier& b) {
    asm volatile("s_waitcnt vmcnt(0)" ::: "memory");
    __syncthreads();
    if (threadIdx.x == 0) {
        unsigned* bar = b.bar;
        __builtin_amdgcn_s_waitcnt(0);
        unsigned nloc = b.st[0], nx = b.st[1];
        if (nloc == 0u) { xcd_barrier_complete(bar, b.x, nloc, nx); b.st[0] = nloc; b.st[1] = nx; }
        const unsigned old = xb_add(&bar[XB_XSUB(b.x)], 1u);
        const unsigned gen = old / nloc;
        if (old + 1u == (gen + 1u) * nloc) {
            __builtin_amdgcn_fence(__ATOMIC_RELEASE, "agent");
            asm volatile("s_waitcnt vmcnt(0)" ::: "memory");
            const unsigned og = xb_add(&bar[XB_TOP], 1u);
            const unsigned tg = og / nx;
            if (og + 1u == (tg + 1u) * nx) xb_add(&bar[XB_TOPGEN], 1u);
            else XB_SPIN(xb_ld(&bar[XB_TOPGEN]) == tg, bar);
            __builtin_amdgcn_fence(__ATOMIC_ACQUIRE, "agent");
            xb_add(&bar[XB_XGEN(b.x)], 1u);
            asm volatile("s_waitcnt vmcnt(0)" ::: "memory");
        } else {
            XB_SPIN(xb_ld(&bar[XB_XGEN(b.x)]) == gen, bar);
            __builtin_amdgcn_fence(__ATOMIC_ACQUIRE, "agent");
            asm volatile("s_waitcnt vmcnt(0)" ::: "memory");
        }
    }
    __syncthreads();
}

template <int PH> __device__ __forceinline__ void run_phase(const Args& a, unsigned char* lds) {
    int tid_ = threadIdx.x; asm volatile("" : "+v"(tid_));
    const int tid = tid_, lane = tid & 63, wave = __builtin_amdgcn_readfirstlane(tid >> 6);
    int G_ = gridDim.x, bx_ = blockIdx.x; asm volatile("" : "+s"(G_), "+s"(bx_));
    const int G = G_, bx = bx_;
    unsigned char* ws = a.ws; float* out = a.out;
    float* SS1 = (float*)(ws + WS_SS1P); float* GSS = (float*)(ws + WS_GSSP); float* DAT = (float*)(ws + WS_DAT); float* CP = (float*)(ws + WS_CP);
    bf16_t* WinT = (bf16_t*)(ws + WS_WIN); bf16_t* WoutT = (bf16_t*)(ws + WS_WOUT); bf16_t* WupT = (bf16_t*)(ws + WS_WUP); bf16_t* WdnT = (bf16_t*)(ws + WS_WDN);
    bf16_t* XN = (bf16_t*)(ws + WS_XN); float* DT = (float*)(ws + WS_DT); float* SL = (float*)(ws + WS_SL); bf16_t* Zs = (bf16_t*)(ws + WS_ZS); bf16_t* XBC = (bf16_t*)(ws + WS_XBC);
    bf16_t* Qb = (bf16_t*)(ws + WS_QB); bf16_t* Kb = (bf16_t*)(ws + WS_KB); bf16_t* Vb = (bf16_t*)(ws + WS_VB); bf16_t* Mix = (bf16_t*)(ws + WS_MIX); bf16_t* Hb = (bf16_t*)(ws + WS_H);
    (void)tid; (void)lane; (void)wave; (void)SS1; (void)GSS; (void)DAT; (void)CP; (void)WinT; (void)WoutT; (void)WupT; (void)WdnT; (void)XN; (void)DT; (void)SL; (void)Zs; (void)XBC; (void)Qb; (void)Kb; (void)Vb; (void)Mix; (void)Hb; (void)out;
    if constexpr (PH == 0) {
    {
        float* scr = (float*)(lds + wave * 16384);
        const int gw = bx * NWAVES + wave, NGW = G * NWAVES;
        constexpr int I_IN = (1024 / 64) * (NIN / 32), I_OUT = (1536 / 64) * (1024 / 32), I_UP = (1024 / 64) * (4096 / 32), I_DN = (4096 / 64) * (1024 / 32);
        for (int it = gw; it < I_IN + I_OUT + I_UP + I_DN; it += NGW) {
            int r = it;
            if (r < I_IN) { transpose_item<1>(a.w_in, 1024, 4120, NIN, WinT, a.norm1_w, 1024, scr, r, lane); continue; } r -= I_IN;
            if (r < I_OUT) { transpose_item<0>(a.w_out, 1536, 1024, 1024, WoutT, a.ssd_norm_w, 1024, scr, r, lane); continue; } r -= I_OUT;
            if (r < I_UP) { transpose_item<0>(a.w_up, 1024, 4096, 4096, WupT, a.norm2_w, 1024, scr, r, lane); continue; } r -= I_UP;
            transpose_item<0>(a.w_down, 4096, 1024, 1024, WdnT, nullptr, 0, scr, r, lane);
        }
        for (int m0 = gw; m0 < MT; m0 += 4 * NGW) {
            f32x4 v[4][4]; float s[4];
#pragma unroll
            for (int r = 0; r < 4; ++r) { const int m = m0 + r * NGW; const int mc = m < MT ? m : MT - 1;
                const f32x4* xr = (const f32x4*)(mc < MP ? a.x_prompt + (size_t)mc * 1024 : a.x_sample + (size_t)(mc - MP) * 1024) + lane; s[r] = 0.f;
#pragma unroll
                for (int j = 0; j < 4; ++j) { v[r][j] = xr[64 * j]; } }
#pragma unroll
            for (int r = 0; r < 4; ++r) {
#pragma unroll
                for (int j = 0; j < 4; ++j) s[r] += (v[r][j][0] * v[r][j][0] + v[r][j][1] * v[r][j][1]) + (v[r][j][2] * v[r][j][2] + v[r][j][3] * v[r][j][3]);
                const float rs = rsqrtf(wave_sum(s[r]) * (1.0f / 1024.0f) + EPSN); const int m = m0 + r * NGW;
                if (m < MT) { u32x2* o8 = (u32x2*)(XN + (size_t)m * 1024) + lane;
#pragma unroll
                    for (int j = 0; j < 4; ++j) o8[64 * j] = (u32x2){pk2(v[r][j][0] * rs, v[r][j][1] * rs), pk2(v[r][j][2] * rs, v[r][j][3] * rs)}; } }
        }
        if (bx == 0 && tid < 64) ((unsigned*)(ws + WS_CTR))[tid] = 0u;
    }
    }
    if constexpr (PH == 1) {
    {
        pg8::Gemm g{XN, WinT, MT, NIN, 1024, 0}; pg8::StaticOrder S; S.init(MT, NIN, G, bx);
        pg8::EpiIn E{Zs, XBC, Qb, Kb, Vb, DT, out, a.dt_bias, a.f_bias, a.q_norm_w, a.k_norm_w, (bf16_t*)(ws + WS_HIST)};
        pg8::gemm_phase<pg8::EpiIn, pg8::StaticOrder, true, true>((PG8_LAS unsigned char*)lds, g, S, E);
    }
    }
    if constexpr (PH == 9) {
    {
        const bf16_t* HIST = (const bf16_t*)(ws + WS_HIST);
        constexpr int NSEG = MP / 128, NPAIR = DCONV / 2, NTASK = (NSEG + SBATCH) * NPAIR;
        for (int task = bx * 512 + tid; task < NTASK; task += G * 512) {
            const int seg = task / NPAIR, col = 2 * (task - seg * NPAIR);
            float w0[4], w1[4];
#pragma unroll
            for (int k = 0; k < 4; ++k) { w0[k] = a.conv_w[k * DCONV + col]; w1[k] = a.conv_w[k * DCONV + col + 1]; }
            const float b0 = a.conv_b[col], b1 = a.conv_b[col + 1];
            float a3 = 0.f, c3 = 0.f, a2 = 0.f, c2 = 0.f, a1 = 0.f, c1 = 0.f; int row0, n;
            if (seg < NSEG) { row0 = seg * 128; n = 128;
                if (seg & 63) { const bf16_t* hp = HIST + (unsigned)((seg - 1) * 3 * DCONV + col);
                    const unsigned u3 = *(const unsigned*)hp, u2 = *(const unsigned*)(hp + DCONV), u1 = *(const unsigned*)(hp + 2 * DCONV);
                    a3 = bf2f(u3 & 0xffffu); c3 = bf2f(u3 >> 16); a2 = bf2f(u2 & 0xffffu); c2 = bf2f(u2 >> 16); a1 = bf2f(u1 & 0xffffu); c1 = bf2f(u1 >> 16); }
            } else { const int s = seg - NSEG; row0 = MP + s * 16; n = 16; const float* hp = a.state_conv + (unsigned)(s * 3 * DCONV + col);
                a3 = hp[0]; c3 = hp[1]; a2 = hp[DCONV]; c2 = hp[DCONV + 1]; a1 = hp[2 * DCONV]; c1 = hp[2 * DCONV + 1]; }
            bf16_t* xp = XBC + (unsigned)(row0 * DCONV + col);
            for (int i0 = 0; i0 < n; i0 += 16) {
                unsigned uu[16];
#pragma unroll
                for (int i = 0; i < 16; ++i) uu[i] = *(const unsigned*)(xp + (i0 + i) * DCONV);
#pragma unroll
                for (int i = 0; i < 16; ++i) { const float a0 = bf2f(uu[i] & 0xffffu), c0 = bf2f(uu[i] >> 16);
                    const float o0 = silu_f(b0 + w0[0] * a3 + w0[1] * a2 + w0[2] * a1 + w0[3] * a0), o1 = silu_f(b1 + w1[0] * c3 + w1[1] * c2 + w1[2] * c1 + w1[3] * c0);
                    *(unsigned*)(xp + (i0 + i) * DCONV) = cvtpk(o0, o1);
                    a3 = a2; c3 = c2; a2 = a1; c2 = c1; a1 = a0; c1 = c0; }
            }
        }
        sattn::Ptrs Q{a.cache_k, a.cache_v, a.cache_logf, Qb, Kb, Vb, out, Mix};
        for (int u = G - 1 - bx; u < SBATCH * 8; u += G) sattn::unit(Q, lds, u >> 3, u & 7);
    }
    }
    if constexpr (PH == 12) {
    {
        if (G >= 128) { const f32x4* part = (const f32x4*)(ws + WS_MIX); f32x4* y = (f32x4*)(out + O_Y + (size_t)MP * 1024);
            for (int i = bx * 512 + tid; i < MS * 1024 / 4; i += G * 512) { f32x4 s = y[i];
#pragma unroll
                for (int k = 0; k < 16; ++k) s += part[(size_t)k * (MS * 1024 / 4) + i];
                y[i] = s; } }
    }
    }
    if constexpr (PH == 10) {
    {
        const int ks = bx >> 3;
        pg8::Gemm g2{Hb + ks * 256, WdnT + ks * 256, MT, 1024, DFF, 4}; pg8::ListOrder S2{G, bx, G >= 128 ? 128 : 0, 8, MP / 256, 4, 0};
        pg8::EpiDownPartial E2{(float*)(ws + WS_MIX) + (size_t)ks * (MS * 1024)};
        pg8::gemm_phase<pg8::EpiDownPartial, pg8::ListOrder, true, true>((PG8_LAS unsigned char*)lds, g2, S2, E2);
    }
    }
    if constexpr (PH == 11) {
    {
        {
            pg8::Gemm g{Mix, WoutT, MT, 1024, DMIX, 0}; pg8::ListOrder S{G, bx, 8, 8, MP / 256, 4, 0};
            pg8::EpiOut E{a.x_prompt, a.x_sample, out + O_Y, XN, SS1, GSS};
            pg8::gemm_phase<pg8::EpiOut, pg8::ListOrder, true, true>((PG8_LAS unsigned char*)lds, g, S, E);
        }
    }
    }
    if constexpr (PH == 2) {
    {
        ssd::Ptrs P{XBC, Zs, DT, a.conv_w, a.conv_b, a.A_log, a.D_skip, a.state_conv, a.state_ssm, SL, DAT, GSS, Mix, out};
        for (int u = bx; u < PB * 32 * 4; u += G) ssd::unit<0>(P, lds, u >> 7, (u >> 2) & 31, u & 3);
        for (int u = bx; u < SBATCH * 4; u += G) ssd::unit<2>(P, lds, u >> 2, 0, u & 3);
    }
    }
    if constexpr (PH == 3) {
    {
        for (int item = bx * 512 + tid; item < PB * 16 * 8192; item += G * 512) {
            const int bh = item >> 13, b = bh >> 4, h = bh & 15, e = item & 8191; float s = 0.f;
            float* sp = SL + ((size_t)(b * 32 * 16 + h)) * 8192 + e; const float* dp = DAT + b * 32 * 16 + h; float loc[32], dec[32];
#pragma unroll
            for (int blk = 0; blk < 32; ++blk) { loc[blk] = sp[(size_t)blk * 16 * 8192]; dec[blk] = dp[blk * 16]; }
#pragma unroll
            for (int blk = 0; blk < 32; ++blk) { sp[(size_t)blk * 16 * 8192] = s; s = s * __expf(dec[blk]) + loc[blk]; } }
        float* wtot = (float*)lds;
        for (int bh = bx; bh < PB * 8; bh += G) { const int b = bh >> 3, h = bh & 7;
            float v[16]; float run = 0.f; const int s0 = 16 * tid;
#pragma unroll
            for (int i = 0; i < 16; ++i) { v[i] = out[O_PLF + ((size_t)b * PSEQ + s0 + i) * 8 + h]; run += v[i]; }
            float inc = run;
#pragma unroll
            for (int o = 1; o < 64; o <<= 1) { const float t = __shfl_up(inc, o); if (lane >= o) inc += t; }
            __syncthreads();
            if (lane == 63) wtot[wave] = inc;
            __syncthreads();
            float off = inc - run;
            for (int w = 0; w < wave; ++w) off += wtot[w];
#pragma unroll
            for (int i = 0; i < 16; ++i) { off += v[i]; CP[(size_t)bh * PSEQ + s0 + i] = off * L2E; } }
    }
    }
    if constexpr (PH == 4) {
    {
        ssd::Ptrs P{XBC, Zs, DT, a.conv_w, a.conv_b, a.A_log, a.D_skip, a.state_conv, a.state_ssm, SL, DAT, GSS, Mix, out};
        for (int u = bx; u < PB * 32 * 4; u += G) ssd::unit<1>(P, lds, u >> 7, (u >> 2) & 31, u & 3);
    }
    }
    if constexpr (PH == 8) {
    {
        const attn_body::bf16* Qa = (const attn_body::bf16*)Qb; const attn_body::bf16* Ka = (const attn_body::bf16*)Kb; const attn_body::bf16* Va = (const attn_body::bf16*)Vb;
        attn_body::bf16* Oa = (attn_body::bf16*)(Mix + 1024);
        unsigned* ctr = (unsigned*)(ws + WS_CTR); int* slot = (int*)(lds + 147000);
        for (;;) {
            if (tid == 0) *slot = (int)atomicAdd(ctr, 1u);
            __syncthreads();
            const int u = *slot;
            __syncthreads();
            if (u >= PB * 8 * 32) break;
            const int qb = 31 - (u >> 6), bh = u & 63;
            attn_body::attn_unit<8>(bh >> 3, bh & 7, qb, Qa, Ka, Va, Oa, CP, (char*)lds);
        }
    }
    }
    if constexpr (PH == 5) {
    {
        pg8::Gemm g{Mix, WoutT, MP, 1024, DMIX, 0}; pg8::StaticOrder S; S.init(MP, 1024, G, bx);
        pg8::EpiOut E{a.x_prompt, a.x_sample, out + O_Y, XN, SS1, GSS};
        pg8::gemm_phase<pg8::EpiOut, pg8::StaticOrder, true, true>((PG8_LAS unsigned char*)lds, g, S, E);
    }
    }
    if constexpr (PH == 6) {
    {
        pg8::Gemm g{XN, WupT, MT, DFF, 1024, 0}; pg8::StaticOrder S; S.init(MT, DFF, G, bx);
        pg8::EpiUp E{SS1, Hb};
        pg8::gemm_phase<pg8::EpiUp, pg8::StaticOrder, true, true>((PG8_LAS unsigned char*)lds, g, S, E);
    }
    }
    if constexpr (PH == 7) {
    {
        const int Mrows = G >= 128 ? MP : MT;
        pg8::Gemm g{Hb, WdnT, Mrows, 1024, DFF, 0}; pg8::StaticOrder S; S.init(Mrows, 1024, G, bx);
        pg8::EpiDown E{out + O_Y};
        pg8::gemm_phase<pg8::EpiDown, pg8::StaticOrder, true, true>((PG8_LAS unsigned char*)lds, g, S, E);
    }
    }
}
template <int PH> __global__ void __launch_bounds__(NWAVES * 64, 2) phase_kernel(Args a) {
    extern __shared__ __attribute__((aligned(16))) unsigned char lds[];
    run_phase<PH>(a, lds);
}
#ifndef ONE_LAUNCH
#define ONE_LAUNCH 1
#endif
#if ONE_LAUNCH
#define RUN_PHASE(k) do { const __attribute__((address_space(4))) Args* p_ = (const __attribute__((address_space(4))) Args*)__builtin_amdgcn_kernarg_segment_ptr(); asm volatile("" : "+s"(p_)); Args la_; { const __attribute__((address_space(4))) unsigned long long* q_ = (const __attribute__((address_space(4))) unsigned long long*)p_; unsigned long long* d_ = (unsigned long long*)&la_; _Pragma("unroll") for (int i_ = 0; i_ < (int)(sizeof(Args) / 8); ++i_) d_[i_] = q_[i_]; } run_phase<k>(la_, lds); } while (0)
__global__ void __launch_bounds__(NWAVES * 64, 2) fwd_megakernel(Args a) {
    extern __shared__ __attribute__((aligned(16))) unsigned char lds[];
    cg::grid_group grid = cg::this_grid();
    if (threadIdx.x < 2) ((volatile LAS unsigned*)(lds + 147016))[threadIdx.x] = 0u;
    __syncthreads();
    XcdBarrier xbar;
    { const __attribute__((address_space(4))) Args* p_ = (const __attribute__((address_space(4))) Args*)__builtin_amdgcn_kernarg_segment_ptr();
      xbar = xcd_barrier_post((unsigned*)(p_->ws + WS_BARW), (volatile LAS unsigned*)(lds + 147016)); }
    RUN_PHASE(0); grid.sync();
    RUN_PHASE(1); xcd_barrier(xbar);
    RUN_PHASE(9); xcd_barrier(xbar);
    RUN_PHASE(2); xcd_barrier(xbar);
    RUN_PHASE(3); xcd_barrier(xbar);
    RUN_PHASE(4); __syncthreads(); RUN_PHASE(11); __syncthreads(); RUN_PHASE(8); xcd_barrier(xbar);
    RUN_PHASE(5); xcd_barrier(xbar);
    RUN_PHASE(6); xcd_barrier(xbar);
    RUN_PHASE(7); __syncthreads(); RUN_PHASE(10); xcd_barrier(xbar);
    RUN_PHASE(12);
}
#endif
extern "C" void kernel_launch(void* const* d_in, const int* in_sizes, int n_in, void* d_out, int out_size, void* d_ws, size_t ws_size, hipStream_t stream) {
    static int grid = 0;
    if (grid == 0) {
        if (n_in != 22 || (size_t)out_size != O_END || ws_size < WS_END) { fprintf(stderr, "kernel_launch: unexpected shapes: n_in %d out %d ws %zu (need %zu)\n", n_in, out_size, ws_size, (size_t)WS_END); grid = -1; return; }
        int dev = 0, cus = 0, per_cu = 0;
        (void)hipGetDevice(&dev); (void)hipDeviceGetAttribute(&cus, hipDeviceAttributeMultiprocessorCount, dev);
        bool okattr = true;
#if ONE_LAUNCH
        okattr = hipFuncSetAttribute((const void*)fwd_megakernel, hipFuncAttributeMaxDynamicSharedMemorySize, LDS_BYTES) == hipSuccess;
#endif
#if !ONE_LAUNCH
        okattr = okattr && hipFuncSetAttribute((const void*)phase_kernel<0>, hipFuncAttributeMaxDynamicSharedMemorySize, LDS_BYTES) == hipSuccess && hipFuncSetAttribute((const void*)phase_kernel<1>, hipFuncAttributeMaxDynamicSharedMemorySize, LDS_BYTES) == hipSuccess
              && hipFuncSetAttribute((const void*)phase_kernel<2>, hipFuncAttributeMaxDynamicSharedMemorySize, LDS_BYTES) == hipSuccess && hipFuncSetAttribute((const void*)phase_kernel<3>, hipFuncAttributeMaxDynamicSharedMemorySize, LDS_BYTES) == hipSuccess
              && hipFuncSetAttribute((const void*)phase_kernel<4>, hipFuncAttributeMaxDynamicSharedMemorySize, LDS_BYTES) == hipSuccess && hipFuncSetAttribute((const void*)phase_kernel<5>, hipFuncAttributeMaxDynamicSharedMemorySize, LDS_BYTES) == hipSuccess
              && hipFuncSetAttribute((const void*)phase_kernel<6>, hipFuncAttributeMaxDynamicSharedMemorySize, LDS_BYTES) == hipSuccess && hipFuncSetAttribute((const void*)phase_kernel<7>, hipFuncAttributeMaxDynamicSharedMemorySize, LDS_BYTES) == hipSuccess && hipFuncSetAttribute((const void*)phase_kernel<8>, hipFuncAttributeMaxDynamicSharedMemorySize, LDS_BYTES) == hipSuccess && hipFuncSetAttribute((const void*)phase_kernel<9>, hipFuncAttributeMaxDynamicSharedMemorySize, LDS_BYTES) == hipSuccess && hipFuncSetAttribute((const void*)phase_kernel<10>, hipFuncAttributeMaxDynamicSharedMemorySize, LDS_BYTES) == hipSuccess && hipFuncSetAttribute((const void*)phase_kernel<11>, hipFuncAttributeMaxDynamicSharedMemorySize, LDS_BYTES) == hipSuccess && hipFuncSetAttribute((const void*)phase_kernel<12>, hipFuncAttributeMaxDynamicSharedMemorySize, LDS_BYTES) == hipSuccess;
#endif
        if (!okattr) { fprintf(stderr, "kernel_launch: hipFuncSetAttribute failed\n"); grid = -1; return; }
        (void)hipGetLastError();
        grid = cus;
    }
    if (grid < 0) return;
    Args a{};
    a.x_prompt = (const float*)d_in[0]; a.x_sample = (const float*)d_in[1]; a.cache_k = (const float*)d_in[2]; a.cache_v = (const float*)d_in[3]; a.cache_logf = (const float*)d_in[4];
    a.state_ssm = (const float*)d_in[5]; a.state_conv = (const float*)d_in[6]; a.norm1_w = (const float*)d_in[7]; a.w_in = (const float*)d_in[8]; a.conv_w = (const float*)d_in[9];
    a.conv_b = (const float*)d_in[10]; a.dt_bias = (const float*)d_in[11]; a.A_log = (const float*)d_in[12]; a.D_skip = (const float*)d_in[13]; a.ssd_norm_w = (const float*)d_in[14];
    a.f_bias = (const float*)d_in[15]; a.q_norm_w = (const float*)d_in[16]; a.k_norm_w = (const float*)d_in[17]; a.w_out = (const float*)d_in[18]; a.norm2_w = (const float*)d_in[19];
    a.w_up = (const float*)d_in[20]; a.w_down = (const float*)d_in[21]; a.out = (float*)d_out; a.ws = (unsigned char*)d_ws;
#if ONE_LAUNCH
    if (hipMemsetAsync((char*)d_ws + WS_BARW, 0, 16384, stream) != hipSuccess) { fprintf(stderr, "kernel_launch: hipMemsetAsync failed\n"); return; }
    void* args[] = {&a};
    hipError_t e = hipLaunchCooperativeKernel((const void*)fwd_megakernel, dim3(grid), dim3(NWAVES * 64), args, LDS_BYTES, stream);
    if (e != hipSuccess) fprintf(stderr, "kernel_launch: cooperative launch failed: %s (grid %d)\n", hipGetErrorString(e), grid);
#else
    hipLaunchKernelGGL(phase_kernel<0>, dim3(grid), dim3(NWAVES * 64), LDS_BYTES, stream, a);
    hipLaunchKernelGGL(phase_kernel<1>, dim3(grid), dim3(NWAVES * 64), LDS_BYTES, stream, a);
    hipLaunchKernelGGL(phase_kernel<9>, dim3(grid), dim3(NWAVES * 64), LDS_BYTES, stream, a);
    hipLaunchKernelGGL(phase_kernel<2>, dim3(grid), dim3(NWAVES * 64), LDS_BYTES, stream, a);
    hipLaunchKernelGGL(phase_kernel<3>, dim3(grid), dim3(NWAVES * 64), LDS_BYTES, stream, a);
    hipLaunchKernelGGL(phase_kernel<4>, dim3(grid), dim3(NWAVES * 64), LDS_BYTES, stream, a);
    hipLaunchKernelGGL(phase_kernel<11>, dim3(grid), dim3(NWAVES * 64), LDS_BYTES, stream, a);
    hipLaunchKernelGGL(phase_kernel<8>, dim3(grid), dim3(NWAVES * 64), LDS_BYTES, stream, a);
    hipLaunchKernelGGL(phase_kernel<5>, dim3(grid), dim3(NWAVES * 64), LDS_BYTES, stream, a);
    hipLaunchKernelGGL(phase_kernel<6>, dim3(grid), dim3(NWAVES * 64), LDS_BYTES, stream, a);
    hipLaunchKernelGGL(phase_kernel<7>, dim3(grid), dim3(NWAVES * 64), LDS_BYTES, stream, a);
    hipLaunchKernelGGL(phase_kernel<10>, dim3(grid), dim3(NWAVES * 64), LDS_BYTES, stream, a);
    hipLaunchKernelGGL(phase_kernel<12>, dim3(grid), dim3(NWAVES * 64), LDS_BYTES, stream, a);
#endif
}
```

```cpp
#include <hip/hip_runtime.h>
#include <hip/hip_cooperative_groups.h>
#include <hip/hip_bf16.h>
#include <cstdio>
#include <cstdint>
#include <cmath>
namespace cg = cooperative_groups;

constexpr int DMODEL = 1024, PSEQ = 8192, PB = 8, MP = PB * PSEQ  , SBATCH = 32, SSEQ = 16, MS = SBATCH * SSEQ  , MT = MP + MS  ;
constexpr int PAST = 4096, NIN = 4352  , DFF = 4096, DMIX = 1536, DCONV = 1536;
constexpr float EPSN = 1e-6f, L2E = 1.4426950408889634f;
constexpr size_t O_Y = 0, O_PK = 67633152, O_PV = 101187584, O_PLF = 134742016, O_PSSM = 135266304, O_PCONV = 136314880, O_SK = 136351744, O_SV = 136613888,
                 O_SLF = 136876032, O_SSSM = 136880128, O_SCONV = 141074432, O_END = 141221888;
constexpr size_t MiB = 1u << 20;
constexpr size_t WS_BARW = 1152 * 1024, WS_CTR = 1120 * 1024, WS_SS1 = 0, WS_GSS = 512 * 1024, WS_DAT = 1088 * 1024, WS_CP = 2 * MiB, WS_WIN = 4 * MiB, WS_WOUT = WS_WIN + 8704 * 1024, WS_WUP = WS_WOUT + 3 * MiB, WS_WDN = WS_WUP + 8 * MiB;
constexpr size_t WS_XN = 32 * MiB, WS_DT = 161 * MiB, WS_SL = 166 * MiB, WS_ZS = 294 * MiB, WS_XBC = 423 * MiB, WS_QB = 617 * MiB, WS_KB = 682 * MiB, WS_VB = 747 * MiB, WS_MIX = 812 * MiB,
                 WS_H = 294 * MiB, WS_HIST = 1006 * MiB, WS_GSSP = 1012 * MiB, WS_SS1P = 1014 * MiB, WS_END = 1019 * MiB;
static_assert(WS_WDN + 8 * MiB <= WS_XN && WS_XN + (size_t)MT * 1024 * 2 <= WS_DT && WS_DT + (size_t)MT * 64 <= WS_SL && WS_SL + 128 * MiB <= WS_ZS, "ws map 1");
static_assert(WS_ZS + (size_t)MT * 2048 <= WS_XBC && WS_XBC + (size_t)(MT + 64) * 3072 <= WS_QB && WS_QB + (size_t)MT * 1024 <= WS_KB && WS_KB + (size_t)MT * 1024 <= WS_VB && WS_VB + (size_t)MT * 1024 <= WS_MIX, "ws map 2");
static_assert(WS_MIX + (size_t)MT * 3072 <= WS_END && WS_H + (size_t)MT * 8192 <= WS_MIX, "ws map 3");

typedef unsigned short bf16_t;
typedef short bf16x8 __attribute__((ext_vector_type(8)));
typedef float f32x4 __attribute__((ext_vector_type(4)));
typedef float f32x16 __attribute__((ext_vector_type(16)));
typedef unsigned u32x4 __attribute__((ext_vector_type(4)));
typedef unsigned u32x2 __attribute__((ext_vector_type(2)));
typedef float f32x2_t_ __attribute__((ext_vector_type(2)));
typedef __bf16 bf16x2_t_ __attribute__((ext_vector_type(2)));
__device__ __forceinline__ unsigned cvtpk(float lo, float hi) { f32x2_t_ v = {lo, hi}; bf16x2_t_ b = __builtin_convertvector(v, bf16x2_t_); return __builtin_bit_cast(unsigned, b); }
__device__ __forceinline__ float bf2f(unsigned u16) { return __uint_as_float(u16 << 16); }
__device__ __forceinline__ float silu_f(float v) { return v * __builtin_amdgcn_rcpf(1.0f + __expf(-v)); }
__device__ __forceinline__ float softplus_f(float v) { return v > 20.f ? v : log1pf(__expf(v)); }
__device__ __forceinline__ float logsigmoid_f(float v) { return fminf(v, 0.f) - log1pf(__expf(-fabsf(v))); }
__device__ __forceinline__ int crow_(int r, int hi) { return (r & 3) + 8 * (r >> 2) + 4 * hi; }
__device__ __forceinline__ void gatomic_add(float* p, float v) { (void)__builtin_amdgcn_global_atomic_fadd_f32((__attribute__((address_space(1))) float*)p, v); }
namespace pg8 {
#define PG8_LAS __attribute__((address_space(3)))
typedef unsigned short bf16_t;
typedef short bf16x8 __attribute__((ext_vector_type(8)));
typedef float f32x4 __attribute__((ext_vector_type(4)));
typedef unsigned u32x4 __attribute__((ext_vector_type(4)));
constexpr int BM = 256, BK = 64, HALF = 128, HTB = HALF * BK * 2  , STAGE_BYTES = 8 * HTB, NXCD = 8, WGM = 8;

__host__ __device__ __forceinline__ int lds_byte(int r, int c) { const int st = (r >> 4) * 2 + (c >> 5), rr = r & 15, cc = c & 31, ob = rr * 64 + cc * 2; return st * 1024 + (ob ^ (((ob >> 9) & 1) << 5)); }
__host__ __device__ __forceinline__ void stage_rc(int b, int& R, int& C) { const int st = b / 1024, sb = b % 1024, swz = sb ^ (((sb >> 9) & 1) << 5); R = (st >> 1) * 16 + swz / 64; C = (st & 1) * 32 + (swz % 64) / 2; }
__host__ __device__ __forceinline__ int perm32(int rho) { const int n = rho >> 4, i = rho & 15; return 8 * (i >> 2) + 4 * n + (i & 3); }

struct Unit { int pm, pn, k0; };
struct Gemm { const bf16_t* A; const bf16_t* Bt; int M, N, K, nt; };

struct StaticOrder {
    int nM, nN, nwg, G, c;
    __host__ __device__ void init(int M, int N, int G_, int c_) { nM = M / BM; nN = N / BM; nwg = nM * nN; G = G_; c = c_; }
    __host__ __device__ bool next(int i, Unit& u) const {
        const long L = (long)i * G + c; if (L >= nwg) return false;
        int wgid = (int)L; { const int q = nwg / NXCD, r = nwg % NXCD, xcd = wgid % NXCD, off = wgid / NXCD; wgid = (xcd < r ? xcd * (q + 1) : r * (q + 1) + (xcd - r) * q) + off; }
        const int nig = WGM * nN, gid = wgid / nig, fm = gid * WGM, gsz = (nM - fm) < WGM ? (nM - fm) : WGM;
        u.pm = fm + ((wgid % nig) % gsz); u.pn = (wgid % nig) / gsz; u.k0 = 0; return true;
    }
    __device__ __forceinline__ void a_ready(const Unit&) const {}
    __device__ __forceinline__ void done(const Unit&) const {}
};

struct ListOrder {
    int G, c, count, ntiles, pm0, npn, ksplit;
    __device__ __forceinline__ bool next(int i, Unit& u) const { const int L = i * G + c; if (L >= count) return false; const int tile = L % ntiles, ks = L / ntiles; u.pm = pm0 + tile / npn; u.pn = tile % npn; u.k0 = ks * ksplit; return true; }
    __device__ __forceinline__ void a_ready(const Unit&) const {}
    __device__ __forceinline__ void done(const Unit&) const {}
};

__device__ __forceinline__ void st_bf16x8(bf16_t* p, f32x4 a, f32x4 b) { u32x4 w; w.x = cvtpk(a[0], a[1]); w.y = cvtpk(a[2], a[3]); w.z = cvtpk(b[0], b[1]); w.w = cvtpk(b[2], b[3]); *(u32x4*)p = w; }
struct EpiIn {
    static constexpr bool PERM = true, AFTER_DRAIN = false, KHOOK = false;
    bf16_t *Zs, *XBC, *Qb, *Kb, *Vb; float* DT; float* out; const float *dt_bias, *f_bias, *qw, *kw; bf16_t* HIST;
    __device__ __forceinline__ void operator()(const f32x4 (&acc)[2][2][4][2], const Unit& u, int wr, int wc, int fr, int fq) const {
        const int pn = u.pn; const int lc = pn * 256 + wc * 64 + fq * 8;
        if (pn < 10) {
#pragma unroll
            for (int ai = 0; ai < 2; ++ai)
#pragma unroll
                for (int m = 0; m < 4; ++m) { const int row = u.pm * BM + ai * HALF + wr * 64 + m * 16 + fr;
#pragma unroll
                    for (int bj = 0; bj < 2; ++bj) { f32x4 v0 = acc[ai][bj][m][0], v1 = acc[ai][bj][m][1];
                        if (pn < 4) {
#pragma unroll
                            for (int e = 0; e < 4; ++e) { v0[e] = silu_f(v0[e]); v1[e] = silu_f(v1[e]); }
                            st_bf16x8(Zs + row * 1024 + lc + 32 * bj, v0, v1);
                        } else { const int c = lc - 1024 + 32 * bj;
                            st_bf16x8(XBC + row * 1536 + c, v0, v1);
                            if (row < MP && (row & 127) >= 125) st_bf16x8(HIST + ((row >> 7) * 3 + ((row & 127) - 125)) * DCONV + c, v0, v1);
                            float* cs = nullptr;
                            if (row < MP) { const int t = (int)(row & (PSEQ - 1)); if (t >= PSEQ - 3) cs = out + O_PCONV + ((row >> 13) * 3 + (t - (PSEQ - 3))) * DCONV + c; }
                            else { const int sr = (int)(row - MP), t = sr & 15; if (t >= 13) cs = out + O_SCONV + ((sr >> 4) * 3 + (t - 13)) * DCONV + c; }
                            if (cs) { *(f32x4*)cs = v0; *(f32x4*)(cs + 4) = v1; } } } }
        } else if (pn < 14) {
            const bool isq = pn < 12; const float* w = isq ? qw : kw; const int hcol = lc - (isq ? 2560 : 3072);
#pragma unroll
            for (int ai = 0; ai < 2; ++ai)
#pragma unroll
                for (int m = 0; m < 4; ++m) { const int row = u.pm * BM + ai * HALF + wr * 64 + m * 16 + fr; float ss = 0.f;
#pragma unroll
                    for (int bj = 0; bj < 2; ++bj)
#pragma unroll
                        for (int n = 0; n < 2; ++n) { const f32x4 x = acc[ai][bj][m][n]; ss += (x[0] * x[0] + x[1] * x[1]) + (x[2] * x[2] + x[3] * x[3]); }
                    ss += __shfl_xor(ss, 16); ss += __shfl_xor(ss, 32);
                    const float rs = rsqrtf(ss * (1.0f / 64.0f) + EPSN); const float rq = isq ? rs * (0.125f * L2E) : rs;
#pragma unroll
                    for (int bj = 0; bj < 2; ++bj) { const f32x4 o0 = acc[ai][bj][m][0] * *(const f32x4*)(w + 32 * bj + 8 * fq), o1 = acc[ai][bj][m][1] * *(const f32x4*)(w + 32 * bj + 8 * fq + 4);
                        st_bf16x8((isq ? Qb : Kb) + row * 512 + hcol + 32 * bj, o0 * rq, o1 * rq);
                        if (!isq) { float* kp = (row < MP ? out + O_PK + row * 512 : out + O_SK + (row - MP) * 512) + hcol + 32 * bj; __builtin_nontemporal_store(o0 * rs, (f32x4*)kp); __builtin_nontemporal_store(o1 * rs, (f32x4*)(kp + 4)); }     } }
        } else if (pn < 16) {
            const int hcol = lc - 3584;
#pragma unroll
            for (int ai = 0; ai < 2; ++ai)
#pragma unroll
                for (int m = 0; m < 4; ++m) { const int row = u.pm * BM + ai * HALF + wr * 64 + m * 16 + fr;
#pragma unroll
                    for (int bj = 0; bj < 2; ++bj) { const f32x4 v0 = acc[ai][bj][m][0], v1 = acc[ai][bj][m][1];
                        st_bf16x8(Vb + row * 512 + hcol + 32 * bj, v0, v1);
                        float* vp = (row < MP ? out + O_PV + row * 512 : out + O_SV + (row - MP) * 512) + hcol + 32 * bj; __builtin_nontemporal_store(v0, (f32x4*)vp); __builtin_nontemporal_store(v1, (f32x4*)(vp + 4)); } }
        } else {
            if (wc == 0 && fq < 3) {
                const f32x4 b0 = fq < 2 ? *(const f32x4*)(dt_bias + 8 * fq) : *(const f32x4*)(f_bias), b1 = fq < 2 ? *(const f32x4*)(dt_bias + 8 * fq + 4) : *(const f32x4*)(f_bias + 4);
#pragma unroll
                for (int ai = 0; ai < 2; ++ai)
#pragma unroll
                    for (int m = 0; m < 4; ++m) { const int row = u.pm * BM + ai * HALF + wr * 64 + m * 16 + fr;
                        f32x4 v0 = acc[ai][0][m][0] + b0, v1 = acc[ai][0][m][1] + b1;
                        if (fq < 2) {
#pragma unroll
                            for (int e = 0; e < 4; ++e) { v0[e] = softplus_f(v0[e]); v1[e] = softplus_f(v1[e]); }
                            float* dp = DT + row * 16 + 8 * fq; *(f32x4*)dp = v0; *(f32x4*)(dp + 4) = v1;
                        } else {
#pragma unroll
                            for (int e = 0; e < 4; ++e) { v0[e] = logsigmoid_f(v0[e]); v1[e] = logsigmoid_f(v1[e]); }
                            float* lp = (row < MP ? out + O_PLF + row * 8 : out + O_SLF + (row - MP) * 8); *(f32x4*)lp = v0; *(f32x4*)(lp + 4) = v1; } }
            }
        }
    }
};
struct EpiOut {
    static constexpr bool PERM = true, AFTER_DRAIN = false, KHOOK = true;
    const float *xp, *xs; float* Y; bf16_t* X1b; float* SS1; const float* GSS;
    __device__ __forceinline__ void khook(f32x4 (&acc)[2][2][4][2], const Unit& u, int t, int wr, int fr) const {
#pragma unroll
        for (int ai = 0; ai < 2; ++ai)
#pragma unroll
            for (int m = 0; m < 4; ++m) { const int row = u.pm * BM + ai * HALF + wr * 64 + m * 16 + fr;
                const f32x4 gp = *(const f32x4*)(GSS + (unsigned)(row * 4)); const float g0 = gp[0] + gp[1], g1 = gp[2] + gp[3];
                const float r0 = rsqrtf(g0 * (1.0f / 512.0f) + EPSN), r1 = rsqrtf(g1 * (1.0f / 512.0f) + EPSN);
                const float f = (t == 8) ? r0 / r1 : r1;
#pragma unroll
                for (int bj = 0; bj < 2; ++bj)
#pragma unroll
                    for (int n = 0; n < 2; ++n) acc[ai][bj][m][n] *= f; }
    }
    __device__ __forceinline__ void operator()(const f32x4 (&acc)[2][2][4][2], const Unit& u, int wr, int wc, int fr, int fq) const {
        const int col0 = u.pn * BM + wc * 32 + 8 * fq; float ssv[8];
#pragma unroll
        for (int ai = 0; ai < 2; ++ai)
#pragma unroll
            for (int m = 0; m < 4; ++m) { const int row = u.pm * BM + ai * HALF + wr * 64 + m * 16 + fr;
                const float* xr = row < MP ? xp + row * 1024 : xs + (row - MP) * 1024; float ss = 0.f;
#pragma unroll
                for (int bj = 0; bj < 2; ++bj) { const int c = col0 + bj * HALF;
                    const f32x4 o0 = __builtin_nontemporal_load((const f32x4*)(xr + c)) + acc[ai][bj][m][0], o1 = __builtin_nontemporal_load((const f32x4*)(xr + c + 4)) + acc[ai][bj][m][1];
                    *(f32x4*)(Y + row * 1024 + c) = o0; *(f32x4*)(Y + row * 1024 + c + 4) = o1; st_bf16x8(X1b + row * 1024 + c, o0, o1);
                    ss += (o0[0] * o0[0] + o0[1] * o0[1]) + (o0[2] * o0[2] + o0[3] * o0[3]) + (o1[0] * o1[0] + o1[1] * o1[1]) + (o1[2] * o1[2] + o1[3] * o1[3]); }
                ss += __shfl_xor(ss, 16); ss += __shfl_xor(ss, 32);
                ssv[ai * 4 + m] = ss; }
        if (fq == 0) {
#pragma unroll
            for (int ai = 0; ai < 2; ++ai)
#pragma unroll
                for (int m = 0; m < 4; ++m) SS1[(unsigned)((u.pm * BM + ai * HALF + wr * 64 + m * 16 + fr) * 16 + u.pn * 4 + wc)] = ssv[ai * 4 + m]; }
    }
};
struct EpiUp {
    static constexpr bool PERM = true, AFTER_DRAIN = false, KHOOK = false;
    const float* SS1; bf16_t* H;
    __device__ __forceinline__ void operator()(const f32x4 (&acc)[2][2][4][2], const Unit& u, int wr, int wc, int fr, int fq) const {
        const int col0 = u.pn * BM + wc * 32 + 8 * fq;
#pragma unroll
        for (int ai = 0; ai < 2; ++ai)
#pragma unroll
            for (int m = 0; m < 4; ++m) { const int row = u.pm * BM + ai * HALF + wr * 64 + m * 16 + fr;
                const f32x4 s0 = *(const f32x4*)(SS1 + (unsigned)(row * 16)), s1 = *(const f32x4*)(SS1 + (unsigned)(row * 16 + 4)), s2 = *(const f32x4*)(SS1 + (unsigned)(row * 16 + 8)), s3 = *(const f32x4*)(SS1 + (unsigned)(row * 16 + 12));
                const f32x4 st = (s0 + s1) + (s2 + s3); const float r2 = 1.0f / (((st[0] + st[1]) + (st[2] + st[3])) * (1.0f / 1024.0f) + EPSN);
#pragma unroll
                for (int bj = 0; bj < 2; ++bj) { f32x4 v0 = acc[ai][bj][m][0], v1 = acc[ai][bj][m][1];
#pragma unroll
                    for (int e = 0; e < 4; ++e) { const float a = fmaxf(v0[e], 0.f), b = fmaxf(v1[e], 0.f); v0[e] = a * a * r2; v1[e] = b * b * r2; }
                    st_bf16x8(H + row * DFF + col0 + bj * HALF, v0, v1); } }
    }
};
struct EpiDown {
    static constexpr bool PERM = true, AFTER_DRAIN = false, KHOOK = false;
    float* Y;
    __device__ __forceinline__ void operator()(const f32x4 (&acc)[2][2][4][2], const Unit& u, int wr, int wc, int fr, int fq) const {
        const int col0 = u.pn * BM + wc * 32 + 8 * fq;
#pragma unroll
        for (int ai = 0; ai < 2; ++ai)
#pragma unroll
            for (int m = 0; m < 4; ++m) { const int row = u.pm * BM + ai * HALF + wr * 64 + m * 16 + fr;
#pragma unroll
                for (int bj = 0; bj < 2; ++bj) { float* p = Y + row * 1024 + col0 + bj * HALF;
                    const f32x4 o0 = *(const f32x4*)p + acc[ai][bj][m][0], o1 = *(const f32x4*)(p + 4) + acc[ai][bj][m][1]; __builtin_nontemporal_store(o0, (f32x4*)p); __builtin_nontemporal_store(o1, (f32x4*)(p + 4)); } }
    }
};
struct EpiDownPartial {
    static constexpr bool PERM = true, AFTER_DRAIN = false, KHOOK = false;
    float* PART;
    __device__ __forceinline__ void operator()(const f32x4 (&acc)[2][2][4][2], const Unit& u, int wr, int wc, int fr, int fq) const {
        const int col0 = u.pn * BM + wc * 32 + 8 * fq;
#pragma unroll
        for (int ai = 0; ai < 2; ++ai)
#pragma unroll
            for (int m = 0; m < 4; ++m) { const int row = (u.pm - MP / 256) * BM + ai * HALF + wr * 64 + m * 16 + fr;
#pragma unroll
                for (int bj = 0; bj < 2; ++bj) { float* p = PART + (unsigned)(row * 1024 + col0 + bj * HALF); *(f32x4*)p = acc[ai][bj][m][0]; *(f32x4*)(p + 4) = acc[ai][bj][m][1]; } }
    }
};
template <class Epi, class Sched, bool ALIGN_EPI = false, bool SP2 = false>
__device__ __forceinline__ void gemm_phase(PG8_LAS unsigned char* lds, const Gemm g, const Sched& S, const Epi& E) {
    int tid_ = threadIdx.x; asm volatile("" : "+v"(tid_));
    const int tid = tid_, wid = __builtin_amdgcn_readfirstlane(tid >> 6), lane = tid & 63, wr = wid >> 2, wc = wid & 3, fr = lane & 15, fq = lane >> 4;
    const int K = g.K; int nt_ = g.nt ? g.nt : K / BK; asm volatile("" : "+s"(nt_)); const int nt = nt_;
    unsigned voffA[2], voffB[2];
#pragma unroll
    for (int i = 0; i < 2; ++i) { int R, C; stage_rc(tid * 16 + i * 8192, R, C); const int Rb = Epi::PERM ? ((R & ~31) + perm32(R & 31)) : R;
        voffA[i] = (unsigned)(R * K + C) * 2u; voffB[i] = (unsigned)(Rb * K + C) * 2u; }
    const size_t kstep = (size_t)(BK * 2);
    const size_t hstep = (size_t)HALF * K * 2;
    const size_t tstep = 2 * hstep;
    const unsigned ldsw = (unsigned)wid * 1024u;
    const int aoff = lds_byte(wr * 64 + fr, fq * 8), boff = lds_byte(wc * 32 + fr, fq * 8);
#define PG8_SA(b, h) (((b) * 2 + (h)) * HTB)
#define PG8_SB(b, h) ((4 + (b) * 2 + (h)) * HTB)
#define PG8_STAGE(bufoff, gbase, voff) do { _Pragma("unroll") for (int _i = 0; _i < 2; ++_i) \
        __builtin_amdgcn_global_load_lds((const unsigned*)((const char*)(gbase) + (voff)[_i]), (PG8_LAS unsigned*)(lds + (bufoff) + ldsw + _i * 8192), 16, 0, 0); } while (0)
#define PG8_LDA(dst, b, h) do { _Pragma("unroll") for (int m = 0; m < 4; ++m) _Pragma("unroll") for (int k = 0; k < 2; ++k) dst[m][k] = *(const PG8_LAS bf16x8*)(lds + PG8_SA(b, h) + aoff + m * 2048 + k * 1024); } while (0)
#define PG8_LDB(dst, b, h) do { _Pragma("unroll") for (int n = 0; n < 2; ++n) _Pragma("unroll") for (int k = 0; k < 2; ++k) dst[n][k] = *(const PG8_LAS bf16x8*)(lds + PG8_SB(b, h) + boff + n * 2048 + k * 1024); } while (0)
#define PG8_MMA(ai, bj, At, Bt) do { __builtin_amdgcn_s_setprio(1); _Pragma("unroll") for (int m = 0; m < 4; ++m) _Pragma("unroll") for (int n = 0; n < 2; ++n) _Pragma("unroll") for (int k = 0; k < 2; ++k) \
        acc[ai][bj][m][n] = __builtin_amdgcn_mfma_f32_16x16x32_bf16(Bt[n][k], At[m][k], acc[ai][bj][m][n], 0, 0, 0); __builtin_amdgcn_s_setprio(0); } while (0)
#define PG8_WAIT_V(n) asm volatile("s_waitcnt vmcnt(" #n ")" ::: "memory")
#define PG8_WAIT_L(n) asm volatile("s_waitcnt lgkmcnt(" #n ")" ::: "memory")
#define PG8_BAR __builtin_amdgcn_s_barrier()
#define PG8_SCHED __builtin_amdgcn_sched_barrier(0)
    Unit cur, nxt; int ui = 0;
    if (!S.next(0, cur)) return;
    f32x4 acc[2][2][4][2];
#pragma unroll
    for (int a = 0; a < 2; ++a)
#pragma unroll
        for (int b = 0; b < 2; ++b)
#pragma unroll
            for (int m = 0; m < 4; ++m)
#pragma unroll
                for (int n = 0; n < 2; ++n) acc[a][b][m][n] = (f32x4){0.f, 0.f, 0.f, 0.f};
    bf16x8 At[4][2], B0[2][2], B1[2][2];
    const char* cA = (const char*)g.A + (size_t)cur.pm * tstep + (size_t)cur.k0 * 2; const char* cB = (const char*)g.Bt + (size_t)cur.pn * tstep + (size_t)cur.k0 * 2;
    S.a_ready(cur);
    if constexpr (SP2) {
        PG8_STAGE(PG8_SB(0, 0), cB, voffB); PG8_STAGE(PG8_SB(0, 1), cB + hstep, voffB); PG8_STAGE(PG8_SA(0, 0), cA, voffA); PG8_STAGE(PG8_SA(0, 1), cA + hstep, voffA);
        if (wr == 1) PG8_BAR;
        PG8_WAIT_V(2); PG8_BAR;
        PG8_STAGE(PG8_SB(1, 0), cB + kstep, voffB); PG8_STAGE(PG8_SA(1, 0), cA + kstep, voffA); PG8_STAGE(PG8_SB(1, 1), cB + hstep + kstep, voffB);
        PG8_WAIT_V(6); PG8_BAR;
    } else {
        PG8_STAGE(PG8_SB(0, 0), cB, voffB); PG8_STAGE(PG8_SA(0, 0), cA, voffA); PG8_STAGE(PG8_SB(0, 1), cB + hstep, voffB); PG8_STAGE(PG8_SA(0, 1), cA + hstep, voffA);
        if (wr == 1) PG8_BAR;
        PG8_WAIT_V(4); PG8_BAR;
        PG8_STAGE(PG8_SB(1, 0), cB + kstep, voffB); PG8_STAGE(PG8_SA(1, 0), cA + kstep, voffA); PG8_STAGE(PG8_SB(1, 1), cB + hstep + kstep, voffB);
        PG8_WAIT_V(6); PG8_BAR;
    }
    for (;;) {
        const bool has_next = S.next(ui + 1, nxt);
        const char* nA = has_next ? (const char*)g.A + (size_t)nxt.pm * tstep + (size_t)nxt.k0 * 2 : cA; const char* nB = has_next ? (const char*)g.Bt + (size_t)nxt.pn * tstep + (size_t)nxt.k0 * 2 : cB;
        for (int t = 0; t < nt; t += 2) {
            if constexpr (Epi::KHOOK) { if (t == 8 || t == 16) E.khook(acc, cur, t, wr, fr); }
            const bool last = (t == nt - 2);
            const char* a1 = cA + (size_t)(t + 1) * kstep;
            const char* a2 = last ? nA : cA + (size_t)(t + 2) * kstep; const char* b2 = last ? nB : cB + (size_t)(t + 2) * kstep;
            const char* a3 = a2 + kstep; const char* b3 = b2 + kstep;
            if (last && has_next) S.a_ready(nxt);
            if constexpr (SP2) {
            PG8_LDB(B0, 0, 0); PG8_LDB(B1, 0, 1); PG8_SCHED; PG8_LDA(At, 0, 0); PG8_STAGE(PG8_SA(1, 1), a1 + hstep, voffA);
            PG8_WAIT_V(8); PG8_WAIT_L(0); PG8_BAR; PG8_MMA(0, 0, At, B0); PG8_MMA(0, 1, At, B1); PG8_BAR; PG8_SCHED;
            PG8_LDA(At, 0, 1); PG8_STAGE(PG8_SB(0, 0), b2, voffB); PG8_STAGE(PG8_SB(0, 1), b2 + hstep, voffB); PG8_STAGE(PG8_SA(0, 0), a2, voffA);
            PG8_WAIT_V(8); PG8_WAIT_L(0); PG8_BAR; PG8_MMA(1, 0, At, B0); PG8_MMA(1, 1, At, B1); PG8_BAR; PG8_SCHED;
            PG8_LDB(B0, 1, 0); PG8_LDB(B1, 1, 1); PG8_SCHED; PG8_LDA(At, 1, 0); PG8_STAGE(PG8_SA(0, 1), a2 + hstep, voffA);
            PG8_WAIT_V(8); PG8_WAIT_L(0); PG8_BAR; PG8_MMA(0, 0, At, B0); PG8_MMA(0, 1, At, B1); PG8_BAR; PG8_SCHED;
            PG8_LDA(At, 1, 1); PG8_STAGE(PG8_SB(1, 0), b3, voffB); PG8_STAGE(PG8_SB(1, 1), b3 + hstep, voffB); PG8_STAGE(PG8_SA(1, 0), a3, voffA);
            PG8_WAIT_V(8); PG8_WAIT_L(0); PG8_BAR; PG8_MMA(1, 0, At, B0); PG8_MMA(1, 1, At, B1); PG8_BAR; PG8_SCHED;
            } else {
            PG8_LDB(B0, 0, 0); PG8_SCHED; PG8_LDA(At, 0, 0); PG8_STAGE(PG8_SA(1, 1), a1 + hstep, voffA);
            PG8_WAIT_L(8); PG8_BAR; PG8_WAIT_L(0); PG8_MMA(0, 0, At, B0); PG8_BAR; PG8_SCHED;
            PG8_LDB(B1, 0, 1); PG8_STAGE(PG8_SB(0, 0), b2, voffB);
            PG8_BAR; PG8_WAIT_L(0); PG8_MMA(0, 1, At, B1); PG8_BAR;
            PG8_LDA(At, 0, 1); PG8_STAGE(PG8_SA(0, 0), a2, voffA);
            PG8_BAR; PG8_WAIT_L(0); PG8_MMA(1, 0, At, B0); PG8_BAR; PG8_SCHED;
            PG8_STAGE(PG8_SB(0, 1), b2 + hstep, voffB);
            PG8_WAIT_V(6); PG8_BAR; PG8_MMA(1, 1, At, B1); PG8_BAR;
            PG8_LDB(B0, 1, 0); PG8_SCHED; PG8_LDA(At, 1, 0); PG8_STAGE(PG8_SA(0, 1), a2 + hstep, voffA);
            PG8_WAIT_L(8); PG8_BAR; PG8_WAIT_L(0); PG8_MMA(0, 0, At, B0); PG8_BAR; PG8_SCHED;
            PG8_LDB(B1, 1, 1); PG8_STAGE(PG8_SB(1, 0), b3, voffB);
            PG8_BAR; PG8_WAIT_L(0); PG8_MMA(0, 1, At, B1); PG8_BAR;
            PG8_LDA(At, 1, 1); PG8_STAGE(PG8_SA(1, 0), a3, voffA);
            PG8_BAR; PG8_WAIT_L(0); PG8_MMA(1, 0, At, B0); PG8_BAR; PG8_SCHED;
            PG8_STAGE(PG8_SB(1, 1), b3 + hstep, voffB);
            PG8_WAIT_V(6); PG8_BAR; PG8_MMA(1, 1, At, B1); PG8_BAR;
            }
        }
        if constexpr (ALIGN_EPI) { if (wr == 0) PG8_BAR; }
        if constexpr (!Epi::AFTER_DRAIN) { E(acc, cur, wr, wc, fr, fq); S.done(cur); }
        if (!has_next) break;
#pragma unroll
        for (int a = 0; a < 2; ++a)
#pragma unroll
            for (int b = 0; b < 2; ++b)
#pragma unroll
                for (int m = 0; m < 4; ++m)
#pragma unroll
                    for (int n = 0; n < 2; ++n) acc[a][b][m][n] = (f32x4){0.f, 0.f, 0.f, 0.f};
        cur = nxt; cA = nA; cB = nB; ++ui;
        if constexpr (ALIGN_EPI) { if (wr == 1) PG8_BAR; }
    }
    PG8_WAIT_V(0);
    if constexpr (!ALIGN_EPI) { if (wr == 0) PG8_BAR; }
    PG8_BAR;
    if constexpr (Epi::AFTER_DRAIN) { E.fused(acc, cur, wr, wc, fr, fq, lds, wid, lane); S.done(cur); }
#undef PG8_SA
#undef PG8_SB
#undef PG8_STAGE
#undef PG8_LDA
#undef PG8_LDB
#undef PG8_MMA
#undef PG8_WAIT_V
#undef PG8_WAIT_L
#undef PG8_BAR
#undef PG8_SCHED
}
}
#include <hip/hip_bf16.h>
#include <cmath>
namespace attn_body {
using bf16=__hip_bfloat16;
using bf16x8=__attribute__((ext_vector_type(8)))short;
using s16x4=__attribute__((ext_vector_type(4)))short;
using f32x16=__attribute__((ext_vector_type(16)))float;
using u32x4=__attribute__((ext_vector_type(4)))unsigned;
constexpr int BATCH=8,NHEAD=8,SEQ=8192,D=64,DM=NHEAD*D,OP=1536;
constexpr int NW=8,QBLK=32,QB=QBLK*NW,KVBLK=64,NQB=SEQ/QB;
constexpr int ATTN_PITCH=DM, ATTN_UNIT_ROWS=QB;
__device__ __forceinline__ int crow(int r,int hi){return (r&3)+8*(r>>2)+4*hi;}
#define SBAR() __builtin_amdgcn_sched_barrier(0)
__device__ __forceinline__ void cmask(f32x16&p0,f32x16&p1,int jb,int qrel,int hi){
  const float NEG=-INFINITY; int kb=64*jb+4*hi;
  #pragma unroll
  for(int r=0;r<16;++r){int kv=kb+(r&3)+8*(r>>2); if(kv>qrel)p0[r]=NEG; if(kv+32>qrel)p1[r]=NEG;}
}

constexpr int NSLOT=3, SLOTB=8192;
constexpr int LDS_K=0, LDS_V=NSLOT*SLOTB, LDS_WS=2*NSLOT*SLOTB, LDS_OST=LDS_WS+NW*64*4, LDS_C=LDS_OST+NW*4096, LDS_BYTES=LDS_C+SEQ*4;
constexpr float SKIP_L2=64.0f*1.4426950408889634f;
constexpr float C2=0.125f*1.4426950408889634f;
__device__ __forceinline__ void glds16(const void*gsrc,unsigned lds_dst){unsigned keep;
  asm volatile("s_mov_b32 %0, m0\n\ts_mov_b32 m0, %2\n\ts_nop 0\n\tglobal_load_lds_dwordx4 %1, off\n\ts_mov_b32 m0, %0":"=&s"(keep):"v"(gsrc),"s"(lds_dst):"memory");}
__device__ __forceinline__ float max3f(float a,float b,float c){float r;asm("v_max3_f32 %0, %1, %2, %3":"=v"(r):"v"(a),"v"(b),"v"(c));return r;}
__device__ __forceinline__ float max2f(float a,float b){float r;asm("v_max_f32_e32 %0, %1, %2":"=v"(r):"v"(a),"v"(b));return r;}
__device__ __forceinline__ float fadd_s(float a,float b){float r;asm("v_add_f32_e32 %0, %1, %2":"=v"(r):"v"(a),"v"(b));return r;}
__device__ __forceinline__ float fsub_s(float a,float b){float r;asm("v_sub_f32_e32 %0, %1, %2":"=v"(r):"v"(a),"v"(b));return r;}
typedef float f32x2_t __attribute__((ext_vector_type(2))); typedef __bf16 bf16x2_t __attribute__((ext_vector_type(2)));
__device__ __forceinline__ unsigned cvtpk_s(float lo,float hi){f32x2_t v={lo,hi};bf16x2_t b=__builtin_convertvector(v,bf16x2_t);return __builtin_bit_cast(unsigned,b);}
#define WAIT_BAR(N) asm volatile("s_waitcnt vmcnt(" #N ") lgkmcnt(0)\n\ts_barrier":::"memory")

__device__ __forceinline__ void qkt(f32x16&p0,f32x16&p1,const char*Kslot,const bf16x8*qr,const f32x16&cin0,const f32x16&cin1,int r32,int hi){
  const char*kb=Kslot+hi*1024+r32*16;
  #pragma unroll
  for(int d0=0;d0<4;++d0){
    const bf16x8 b0=*reinterpret_cast<const bf16x8*>(kb+d0*2048);
    const bf16x8 b1=*reinterpret_cast<const bf16x8*>(kb+d0*2048+512);
    if(d0==0){p0=__builtin_amdgcn_mfma_f32_32x32x16_bf16(b0,qr[0],cin0,0,0,0);p1=__builtin_amdgcn_mfma_f32_32x32x16_bf16(b1,qr[0],cin1,0,0,0);}
    else{p0=__builtin_amdgcn_mfma_f32_32x32x16_bf16(b0,qr[d0],p0,0,0,0);p1=__builtin_amdgcn_mfma_f32_32x32x16_bf16(b1,qr[d0],p1,0,0,0);}}
}
typedef __attribute__((address_space(3))) const char* lds_cptr;
typedef short v4i16_t __attribute__((ext_vector_type(4)));
__device__ __forceinline__ void kload8(bf16x8*kf,lds_cptr kp){
  kf[0]=*(const __attribute__((address_space(3))) bf16x8*)(kp);      kf[1]=*(const __attribute__((address_space(3))) bf16x8*)(kp+512);
  kf[2]=*(const __attribute__((address_space(3))) bf16x8*)(kp+2048); kf[3]=*(const __attribute__((address_space(3))) bf16x8*)(kp+2560);
  kf[4]=*(const __attribute__((address_space(3))) bf16x8*)(kp+4096); kf[5]=*(const __attribute__((address_space(3))) bf16x8*)(kp+4608);
  kf[6]=*(const __attribute__((address_space(3))) bf16x8*)(kp+6144); kf[7]=*(const __attribute__((address_space(3))) bf16x8*)(kp+6656);
}
__device__ __forceinline__ void kload2(bf16x8*kf,lds_cptr kp,int j){ kf[2*j]=*(const __attribute__((address_space(3))) bf16x8*)(kp+j*2048); kf[2*j+1]=*(const __attribute__((address_space(3))) bf16x8*)(kp+j*2048+512); }
__device__ __forceinline__ s16x4 vtr(lds_cptr p){ return __builtin_bit_cast(s16x4,__builtin_amdgcn_ds_read_tr16_b64_v4i16((__attribute__((address_space(3))) v4i16_t*)p)); }
__device__ __forceinline__ float rowmax(const f32x16&p0,const f32x16&p1){
  float a=max3f(p0[0],p0[1],p1[0]),b=max3f(p0[2],p0[3],p1[1]);a=max3f(a,p1[2],p1[3]);
  #pragma unroll
  for(int r=4;r<16;r+=4){a=max3f(a,p0[r],p0[r+1]);b=max3f(b,p0[r+2],p0[r+3]);a=max3f(a,p1[r],p1[r+1]);b=max3f(b,p1[r+2],p1[r+3]);}
  const float m=max2f(a,b);
  auto rr=__builtin_amdgcn_permlane32_swap(__float_as_uint(m),__float_as_uint(m),false,false);
  return max2f(__uint_as_float(rr[0]),__uint_as_float(rr[1]));
}
__device__ __forceinline__ void pv(f32x16*o,int vb,bf16x8 pa0,bf16x8 pa1,bf16x8 pa2,bf16x8 pa3){
  #pragma unroll
  for(int d0=0;d0<2;++d0){s16x4 lo[4],hi[4];
    #pragma unroll
    for(int ks=0;ks<4;++ks){
      asm volatile("ds_read_b64_tr_b16 %0,%1 offset:%c2":"=&v"(lo[ks]):"v"(vb),"i"(d0*4096+ks*1024):"memory");
      asm volatile("ds_read_b64_tr_b16 %0,%1 offset:%c2":"=&v"(hi[ks]):"v"(vb),"i"(d0*4096+ks*1024+512):"memory");}
    asm volatile("s_waitcnt lgkmcnt(0)":::"memory");SBAR();
    #define PK(k) (bf16x8){lo[k][0],lo[k][1],lo[k][2],lo[k][3],hi[k][0],hi[k][1],hi[k][2],hi[k][3]}
    o[d0]=__builtin_amdgcn_mfma_f32_32x32x16_bf16(pa0,PK(0),o[d0],0,0,0);
    o[d0]=__builtin_amdgcn_mfma_f32_32x32x16_bf16(pa1,PK(1),o[d0],0,0,0);
    o[d0]=__builtin_amdgcn_mfma_f32_32x32x16_bf16(pa2,PK(2),o[d0],0,0,0);
    o[d0]=__builtin_amdgcn_mfma_f32_32x32x16_bf16(pa3,PK(3),o[d0],0,0,0);
    #undef PK
  }
}

#ifndef ATTN_STORE16
#define ATTN_STORE16(p,v) (*(u32x4*)(p)=(v))
#endif
template<int THRL> __device__ __forceinline__ void attn_unit(int b,int h,int qb,const bf16*Q,const bf16*__restrict__ K,const bf16*__restrict__ V,bf16*O,const float*__restrict__ CPL,char*shm){
  int tid_=threadIdx.x; asm volatile("":"+v"(tid_)); const int tid=tid_,lane=tid&63,r32=lane&31,hi=lane>>5; const int wid=__builtin_amdgcn_readfirstlane(tid>>6);
  const long rowbase=(long)b*SEQ; const int q0=qb*QB;
  const bf16*Qw=Q+(rowbase+q0+wid*QBLK)*DM+h*D;
  const float*cg=CPL+((long)(b*NHEAD+h))*SEQ; const int NTF=(q0+QB)/KVBLK; int tst;
  { const float c0=cg[q0]; const int t1=lane,t2=lane+64;
    const bool s1=(t1<NTF-4)&&((c0-cg[64*t1+63])<-SKIP_L2), s2=(t2<NTF-4)&&((c0-cg[64*t2+63])<-SKIP_L2);
    tst=(__builtin_popcountll(__ballot(s1))+__builtin_popcountll(__ballot(s2)))&~1; tst=__builtin_amdgcn_readfirstlane(tst); }
  const bf16*Kh=K+(rowbase+(long)tst*KVBLK)*DM+h*D,*Vh=V+(rowbase+(long)tst*KVBLK)*DM+h*D;
  const unsigned lds0=(unsigned)(uintptr_t)shm;
  float*wsf=(float*)(shm+LDS_WS)+wid*64;
  const bf16*ksrc=Kh+(long)lane*DM+wid*8;
  const bf16*vsrc=Vh+(long)(16*(wid&3)+(lane>>2))*DM+(wid>>2)*32+(lane&3)*8;
  const unsigned kdst=lds0+LDS_K+wid*1024, vdst=lds0+LDS_V+wid*1024;
  #define DMA_K(t,slot) glds16(ksrc+(long)(t)*KVBLK*DM,(unsigned)__builtin_amdgcn_readfirstlane(kdst+(slot)))
  #define DMA_V(t,slot) glds16(vsrc+(long)(t)*KVBLK*DM,(unsigned)__builtin_amdgcn_readfirstlane(vdst+(slot)))
  const int vb0=(int)(lds0+LDS_V)+((lane>>4)&1)*32+(lane&3)*8+(4*hi+((lane&15)>>2))*64;
  const char*Kbase=shm+LDS_K; bf16x8 kf[8];
  const lds_cptr shm3=(lds_cptr)shm; const lds_cptr kp0=shm3+LDS_K+hi*1024+r32*16; const lds_cptr vp0=shm3+LDS_V+((lane>>4)&1)*32+(lane&3)*8+(4*hi+((lane&15)>>2))*64;
  const int NT=NTF-tst;
  float*cL=(float*)(shm+LDS_C);
  for(int i=tid;i<NT*KVBLK/4;i+=NW*64){ *(float4*)(cL+4*i)=*(const float4*)(cg+tst*KVBLK+4*i); }
  const float cq=cg[q0+wid*QBLK+r32]; float qm=cq;
  asm volatile("s_waitcnt vmcnt(0) lgkmcnt(0)":::"memory");
  DMA_K(0,0);DMA_V(0,0);DMA_K(1,SLOTB);
  bf16x8 qr[4];
  #pragma unroll
  for(int d0=0;d0<4;++d0)qr[d0]=*reinterpret_cast<const bf16x8*>(&Qw[(long)r32*DM+d0*16+hi*8]);
  float mhat=0.f,l_reg=0.f;f32x16 o[2];o[0]=f32x16{};o[1]=f32x16{};f32x16 cb0,cb1;
  const int qrel=wid*QBLK+r32;
  #define CBIAS(t) do{ const float*cp_=cL+(t)*KVBLK+4*hi; \
    _Pragma("unroll") for(int i_=0;i_<4;++i_){ const float4 u0_=*(const float4*)(cp_+8*i_), u1_=*(const float4*)(cp_+32+8*i_); \
      cb0[4*i_]=qm-u0_.x;cb0[4*i_+1]=qm-u0_.y;cb0[4*i_+2]=qm-u0_.z;cb0[4*i_+3]=qm-u0_.w; \
      cb1[4*i_]=qm-u1_.x;cb1[4*i_+1]=qm-u1_.y;cb1[4*i_+2]=qm-u1_.z;cb1[4*i_+3]=qm-u1_.w; } }while(0)
  #define CMASK(P0,P1,t) do{int jb_=(t)-(NT-4); if(jb_>=0)cmask(P0,P1,jb_,qrel,hi);}while(0)
  bool resc=false;
  #define START(P0,P1) do{ const float rm=rowmax(P0,P1); resc=false; \
    { const float dl=rm; mhat=fadd_s(mhat,dl); \
      _Pragma("unroll") for(int r=0;r<16;++r){P0[r]=fsub_s(P0[r],dl);P1[r]=fsub_s(P1[r],dl);} \
      qm=cq-mhat; } \
    _Pragma("unroll") for(int r=0;r<16;++r)P0[r]=__builtin_amdgcn_exp2f(P0[r]); }while(0)
  #define RESC() do{ if(resc){ asm volatile("s_waitcnt lgkmcnt(0)":::"memory"); \
      _Pragma("unroll") for(int d_=0;d_<2;++d_) _Pragma("unroll") for(int r=0;r<16;++r)o[d_][r]*=wsf[crow(r,hi)]; } }while(0)
  f32x16 pA0,pA1,pB0,pB1;
  int sl_prev=0,sl_cur=0,sl_next=SLOTB;
  #define ROT() do{sl_prev=sl_cur;sl_cur=sl_next;sl_next=(sl_next==(NSLOT-1)*SLOTB)?0:sl_next+SLOTB;}while(0)
  DMA_K(2,2*SLOTB);
  WAIT_BAR(3);
  CBIAS(0); qkt(pA0,pA1,Kbase,qr,cb0,cb1,r32,hi);asm volatile("s_nop 15\n\ts_nop 7":"+v"(pA0),"+v"(pA1));CMASK(pA0,pA1,0);
  START(pA0,pA1);
  _Pragma("unroll") for(int r=0;r<16;++r)pA1[r]=__builtin_amdgcn_exp2f(pA1[r]);
  WAIT_BAR(0);
  DMA_K(3,0);DMA_V(1,SLOTB);
  ROT();
  kload8(kf,kp0+sl_cur);
  WAIT_BAR(2);
  s16x4 vlo[8],vhi[8]; u32x4 pw0,pw1,pw2,pw3;
  #define PKW(P,B) cvtpk_s(P[B],P[B+1])
  #define PAF(k) __builtin_bit_cast(bf16x8,pw##k)
  #define VFR(i) (bf16x8){vlo[i][0],vlo[i][1],vlo[i][2],vlo[i][3],vhi[i][0],vhi[i][1],vhi[i][2],vhi[i][3]}
  #define PIN(x) asm volatile("":"+v"(x))
  #define MX3(a,b,c) __builtin_fmaxf(__builtin_fmaxf((a),(b)),(c))
  #define GAPA(MF,A0,A1,A2,A3,W0,W1,PW) do{ MF; sacc+=A0; sacc+=A1; sacc+=A2; sacc+=A3; PIN(sacc); W0; W1; PIN(PW); SBAR(); }while(0)
  #define EX(v) __builtin_amdgcn_exp2f(v)
  #define GAPB(MF,X,B) do{ MF; X[B]=EX(X[B]); X[B+1]=EX(X[B+1]); X[B+2]=EX(X[B+2]); X[B+3]=EX(X[B+3]); PIN(X); SBAR(); }while(0)
  #define VRD(i) do{ vlo[i]=vtr(vp_+(((i)>>2)*4096+((i)&3)*1024)); vhi[i]=vtr(vp_+(((i)>>2)*4096+((i)&3)*1024+512)); }while(0)
  #define KRD(G,j) do{ if(G){ kload2(kf,kp0+sl_next,j); SBAR(); } }while(0)
  #define STEP(C0,C1,P0,P1,t,GK,GV,GL) do{ SBAR(); CBIAS(t); SBAR(); \
    const lds_cptr vp_=vp0+sl_prev; \
    VRD(0); SBAR(); float sacc=(P0[0]+P0[1]); \
    GAPA(C0=__builtin_amdgcn_mfma_f32_32x32x16_bf16(kf[0],qr[0],cb0,0,0,0), P0[2],P0[3],P0[4],P0[5],     pw0[0]=PKW(P0,0), pw0[1]=PKW(P0,2), pw0); \
    VRD(4); SBAR(); GAPA(C1=__builtin_amdgcn_mfma_f32_32x32x16_bf16(kf[1],qr[0],cb1,0,0,0), P0[6],P0[7],P0[8],P0[9],     pw0[2]=PKW(P0,4), pw0[3]=PKW(P0,6), pw0); \
    VRD(1); SBAR(); GAPA(C0=__builtin_amdgcn_mfma_f32_32x32x16_bf16(kf[2],qr[1],C0,0,0,0),   P0[10],P0[11],P0[12],P0[13], pw1[0]=PKW(P0,8), pw1[1]=PKW(P0,10), pw1); \
    VRD(5); SBAR(); GAPA(C1=__builtin_amdgcn_mfma_f32_32x32x16_bf16(kf[3],qr[1],C1,0,0,0),   P0[14],P0[15],P1[0],P1[1],   pw1[2]=PKW(P0,12),pw1[3]=PKW(P0,14), pw1); \
    VRD(2); SBAR(); GAPA(C0=__builtin_amdgcn_mfma_f32_32x32x16_bf16(kf[4],qr[2],C0,0,0,0),   P1[2],P1[3],P1[4],P1[5],     pw2[0]=PKW(P1,0), pw2[1]=PKW(P1,2), pw2); \
    VRD(6); SBAR(); GAPA(C1=__builtin_amdgcn_mfma_f32_32x32x16_bf16(kf[5],qr[2],C1,0,0,0),   P1[6],P1[7],P1[8],P1[9],     pw2[2]=PKW(P1,4), pw2[3]=PKW(P1,6), pw2); \
    VRD(3); SBAR(); GAPA(C0=__builtin_amdgcn_mfma_f32_32x32x16_bf16(kf[6],qr[3],C0,0,0,0),   P1[10],P1[11],P1[12],P1[13], pw3[0]=PKW(P1,8), pw3[1]=PKW(P1,10), pw3); \
    VRD(7); SBAR(); GAPA(C1=__builtin_amdgcn_mfma_f32_32x32x16_bf16(kf[7],qr[3],C1,0,0,0),   P1[14],P1[15],0.f,0.f,       pw3[2]=PKW(P1,12),pw3[3]=PKW(P1,14), pw3); \
    l_reg+=sacc; \
    if(GK){DMA_K((t)+3,sl_cur);} if(GV){DMA_V((t)+1,sl_next);} \
    CMASK(C0,C1,t); \
    { float a=MX3(C0[0],C0[1],C1[0]),b=MX3(C0[2],C0[3],C1[1]); a=MX3(a,C1[2],C1[3]); \
      _Pragma("unroll") for(int r=4;r<16;r+=4){a=MX3(a,C0[r],C0[r+1]);b=MX3(b,C0[r+2],C0[r+3]);a=MX3(a,C1[r],C1[r+1]);b=MX3(b,C1[r+2],C1[r+3]);} \
      float rm=__builtin_fmaxf(a,b); { auto rr=__builtin_amdgcn_permlane32_swap(__float_as_uint(rm),__float_as_uint(rm),false,false); rm=__builtin_fmaxf(__uint_as_float(rr[0]),__uint_as_float(rr[1])); } \
      resc=false; \
      if(__builtin_expect(__any(rm>(float)THRL),0)){ const float dl=__builtin_fmaxf(rm,0.f); mhat+=dl; \
        _Pragma("unroll") for(int r=0;r<16;++r){C0[r]-=dl;C1[r]-=dl;} \
        qm=cq-mhat; \
        const float f=__builtin_amdgcn_exp2f(-dl); l_reg*=f; if(hi==0)wsf[r32]=f; resc=true; } } \
    SBAR(); \
    GAPB(o[0]=__builtin_amdgcn_mfma_f32_32x32x16_bf16(PAF(0),VFR(0),o[0],0,0,0), C0,0); \
    GAPB(o[1]=__builtin_amdgcn_mfma_f32_32x32x16_bf16(PAF(0),VFR(4),o[1],0,0,0), C0,4); \
    KRD(GL,0); GAPB(o[0]=__builtin_amdgcn_mfma_f32_32x32x16_bf16(PAF(1),VFR(1),o[0],0,0,0), C0,8); \
    KRD(GL,1); GAPB(o[1]=__builtin_amdgcn_mfma_f32_32x32x16_bf16(PAF(1),VFR(5),o[1],0,0,0), C0,12); \
    KRD(GL,2); GAPB(o[0]=__builtin_amdgcn_mfma_f32_32x32x16_bf16(PAF(2),VFR(2),o[0],0,0,0), C1,0); \
    KRD(GL,3); GAPB(o[1]=__builtin_amdgcn_mfma_f32_32x32x16_bf16(PAF(2),VFR(6),o[1],0,0,0), C1,4); \
    GAPB(o[0]=__builtin_amdgcn_mfma_f32_32x32x16_bf16(PAF(3),VFR(3),o[0],0,0,0), C1,8); \
    GAPB(o[1]=__builtin_amdgcn_mfma_f32_32x32x16_bf16(PAF(3),VFR(7),o[1],0,0,0), C1,12); \
    }while(0)
  int t=1;
  #undef CMASK
  #define CMASK(P0,P1,t) do{}while(0)
  for(;t+5<NT;t+=2){
    STEP(pB0,pB1,pA0,pA1,t,true,true,true);     WAIT_BAR(2); RESC(); ROT();
    STEP(pA0,pA1,pB0,pB1,t+1,true,true,true);   WAIT_BAR(2); RESC(); ROT();
  }
  #undef CMASK
  #define CMASK(P0,P1,t) do{int jb_=(t)-(NT-4); if(jb_>=0)cmask(P0,P1,jb_,qrel,hi);}while(0)
  #define ENDW(tt) do{ if((tt)+3<NT){WAIT_BAR(2);} else if((tt)+2<NT){WAIT_BAR(1);} else {WAIT_BAR(0);} }while(0)
  for(;t+1<NT;t+=2){
    STEP(pB0,pB1,pA0,pA1,t,(t+3<NT),(t+1<NT),(t+1<NT));       ENDW(t);   RESC(); ROT();
    STEP(pA0,pA1,pB0,pB1,t+1,(t+4<NT),(t+2<NT),(t+2<NT));     ENDW(t+1); RESC(); ROT();
  }
  STEP(pB0,pB1,pA0,pA1,NT-1,false,false,false); RESC();
  { float sacc=pB0[0]+pB0[1]; _Pragma("unroll") for(int r=2;r<16;++r)sacc+=pB0[r]; _Pragma("unroll") for(int r=0;r<16;++r)sacc+=pB1[r]; l_reg+=sacc;
    pw0=(u32x4){PKW(pB0,0),PKW(pB0,2),PKW(pB0,4),PKW(pB0,6)};pw1=(u32x4){PKW(pB0,8),PKW(pB0,10),PKW(pB0,12),PKW(pB0,14)};pw2=(u32x4){PKW(pB1,0),PKW(pB1,2),PKW(pB1,4),PKW(pB1,6)};pw3=(u32x4){PKW(pB1,8),PKW(pB1,10),PKW(pB1,12),PKW(pB1,14)};
    SBAR(); pv(o,vb0+sl_cur,PAF(0),PAF(1),PAF(2),PAF(3)); }
  #undef PKW
  #undef PAF
  #undef VFR
  #undef PIN
  #undef MX3
  #undef GAPA
  #undef GAPB
  #undef EX
  #undef VRD
  #undef KRD
  #undef STEP
  #undef ENDW
  {auto rr=__builtin_amdgcn_permlane32_swap(__float_as_uint(l_reg),__float_as_uint(l_reg),false,false);l_reg=__uint_as_float(rr[0])+__uint_as_float(rr[1]);}
  if(hi==0)wsf[32+r32]=l_reg;asm volatile("s_waitcnt lgkmcnt(0)":::"memory");
  float rli[16];
  #pragma unroll
  for(int r=0;r<16;++r)rli[r]=__builtin_amdgcn_rcpf(wsf[32+crow(r,hi)]);
  bf16*Ow=O+(rowbase+q0+wid*QBLK)*OP+h*D;
  { bf16*stg=(bf16*)(shm+LDS_OST)+wid*2048;
    #pragma unroll
    for(int r=0;r<16;++r){const int orow=crow(r,hi);
      #pragma unroll
      for(int d0=0;d0<2;++d0)stg[orow*64+d0*32+r32]=__float2bfloat16(o[d0][r]*rli[r]);}
    asm volatile("s_waitcnt lgkmcnt(0)":::"memory");
    #pragma unroll
    for(int i=0;i<4;++i){const int row=i*8+(lane>>3),ch=lane&7; const u32x4 v=*(const u32x4*)(stg+row*64+ch*8); ATTN_STORE16(Ow+(long)row*OP+ch*8,v);} }
  asm volatile("s_waitcnt lgkmcnt(0)\n\ts_barrier":::"memory");
  #undef DMA_K
  #undef DMA_V
  #undef CMASK
  #undef START
  #undef RESC
  #undef ROT
  #undef CBIAS
}
constexpr int ATTN_LDS_BYTES=LDS_BYTES;
#undef SBAR
#undef WAIT_BAR
}

namespace ssd {
constexpr int BP = 136, TP = 72, CBP = 68, SP = 136;
constexpr int L_BC = 0, L_CC = 17408, L_BT = 34816, L_CB = 53248, L_ACS = 70656, L_DT = 71680, L_ST = 72704, ST_BYTES = 8704, L_RS = L_ST + 8 * ST_BYTES, L_END = L_RS + 2048;
struct Ptrs { const bf16_t* XBC; const bf16_t* Zs; const float* DT; const float* conv_w; const float* conv_b; const float* A_log; const float* D_skip;
              const float* state_conv; const float* state_ssm; float* SL; float* dAtot; float* GSS; bf16_t* Mix; float* out; };
#define MFMA32(a, b, c) __builtin_amdgcn_mfma_f32_32x32x16_bf16((a), (b), (c), 0, 0, 0)
#define LDSFENCE() asm volatile("s_waitcnt lgkmcnt(0)" ::: "memory")

template <int MODE> __device__ __forceinline__ void unit(const Ptrs& P, unsigned char* lds, int b, int blk, int hq) {
    int tid_ = threadIdx.x; asm volatile("" : "+v"(tid_));
    const int tid = tid_, lane = tid & 63, wid = __builtin_amdgcn_readfirstlane(tid >> 6), r32 = lane & 31, hi = lane >> 5;
    const int g = hq >> 1, hl = wid >> 1, ph = wid & 1, h = hq * 4 + hl;
    constexpr int NSUB = (MODE == 2) ? 1 : 4;
    constexpr int nvalid = (MODE == 2) ? 16 : 256;
    const int row0 = (MODE == 2) ? MP + b * 16 : b * PSEQ + blk * 256;
    bf16_t* Bc = (bf16_t*)(lds + L_BC); bf16_t* Cc = (bf16_t*)(lds + L_CC); bf16_t* BT = (bf16_t*)(lds + L_BT); float* CB = (float*)(lds + L_CB);
    float* rsL = (float*)(lds + L_RS); float* acsL = (float*)(lds + L_ACS); float* dtL = (float*)(lds + L_DT); bf16_t* St = (bf16_t*)(lds + L_ST + wid * ST_BYTES);
    const int xcol = h * 64 + ph * 32 + r32;
    const int cp = tid & 127, seg = tid >> 7, ch = 2 * cp; const int scol = (ch < 128) ? 1024 + 128 * g + ch : 1280 + 128 * g + (ch - 128);
    const float Asc = -__expf(P.A_log[hq * 4 + (wid & 3)]);
    const float Dh = P.D_skip[h];
    f32x16 st[4];
    if (MODE == 0) {
#pragma unroll
        for (int nb = 0; nb < 4; ++nb) st[nb] = f32x16{};
    } else if (MODE == 1) {
        const float* sp = P.SL + ((size_t)((b * 32 + blk) * 16 + h)) * 8192 + (size_t)(ph * 4) * 1024 + lane;
#pragma unroll
        for (int nb = 0; nb < 4; ++nb)
#pragma unroll
            for (int r = 0; r < 16; ++r) st[nb][r] = sp[(nb * 16 + r) * 64];
    } else {
        const float* sp = P.state_ssm + ((size_t)(b * 16 + h) * 64 + ph * 32 + r32) * 128 + 4 * hi;
#pragma unroll
        for (int nb = 0; nb < 4; ++nb)
#pragma unroll
            for (int q4 = 0; q4 < 4; ++q4) { const f32x4 v = *(const f32x4*)(sp + 32 * nb + 8 * q4); st[nb][4 * q4] = v[0]; st[nb][4 * q4 + 1] = v[1]; st[nb][4 * q4 + 2] = v[2]; st[nb][4 * q4 + 3] = v[3]; }
    }
    float dasum = 0.f;
    unsigned uu[16]; float dtn = 0.f;
    auto load_stage = [&](int tbn) {
        if (MODE != 0 || ch < 128) { const int t0 = tbn + 16 * seg; const bf16_t* sp = P.XBC + (unsigned)((row0 + t0) * DCONV + scol);
#pragma unroll
            for (int i = 0; i < 16; ++i) { uu[i] = *(const unsigned*)(sp + i * DCONV); if (MODE == 2) { asm volatile("" : "+v"(uu[i])); if (t0 + i >= nvalid) uu[i] = 0u; } } }
        if (wid < 4) { const int t = tbn + lane; dtn = (t < nvalid) ? P.DT[(unsigned)((row0 + t) * 16 + hq * 4 + wid)] : 0.f; }
    };
    if (MODE == 0) load_stage(0);
#pragma unroll 1
    for (int sc = 0; sc < NSUB; ++sc) {
        const int tb = 64 * sc;
        unsigned xvp[4][4];
        {
            const bf16_t* xp = P.XBC + (unsigned)((row0 + tb + 8 * hi) * DCONV + xcol);
#pragma unroll
            for (int ks = 0; ks < 4; ++ks)
#pragma unroll
                for (int i = 0; i < 4; ++i) { unsigned lo = xp[(16 * ks + 2 * i) * DCONV], hi16 = xp[(16 * ks + 2 * i + 1) * DCONV];
                    if (MODE == 2) { asm volatile("" : "+v"(lo), "+v"(hi16));     if (tb + 16 * ks + 8 * hi + 2 * i >= nvalid) lo = 0u; if (tb + 16 * ks + 8 * hi + 2 * i + 1 >= nvalid) hi16 = 0u; }
                    xvp[ks][i] = lo | (hi16 << 16); }
        }
        if (MODE != 0) load_stage(tb);
        if (MODE != 0 || ch < 128) {
            bf16_t* nat = ((ch < 128) ? Bc : Cc) + (ch & 127);
#pragma unroll
            for (int i = 0; i < 16; ++i) *(unsigned*)(nat + (16 * seg + i) * BP) = uu[i];
            if (ch < 128) {
                unsigned bt0[8], bt1[8];
#pragma unroll
                for (int i = 0; i < 8; ++i) { bt0[i] = (uu[2 * i] & 0xffffu) | (uu[2 * i + 1] << 16); bt1[i] = (uu[2 * i] >> 16) | (uu[2 * i + 1] & 0xffff0000u); }
                *(u32x4*)(BT + ch * TP + 16 * seg) = (u32x4){bt0[0], bt0[1], bt0[2], bt0[3]}; *(u32x4*)(BT + ch * TP + 16 * seg + 8) = (u32x4){bt0[4], bt0[5], bt0[6], bt0[7]};
                *(u32x4*)(BT + (ch + 1) * TP + 16 * seg) = (u32x4){bt1[0], bt1[1], bt1[2], bt1[3]}; *(u32x4*)(BT + (ch + 1) * TP + 16 * seg + 8) = (u32x4){bt1[4], bt1[5], bt1[6], bt1[7]};
            }
        }
        if (wid < 4) {
            const float dt = dtn;
            float a = dt * Asc;
#pragma unroll
            for (int o = 1; o < 64; o <<= 1) { const float v = __shfl_up(a, o); if (lane >= o) a += v; }
            acsL[wid * 64 + lane] = a; dtL[wid * 64 + lane] = dt; dasum += __shfl(a, 63);
        }
#define XV(ks, j) (((j) & 1) ? __uint_as_float(xvp[ks][(j) >> 1] & 0xffff0000u) : __uint_as_float(xvp[ks][(j) >> 1] << 16))
        __syncthreads();
        if (MODE != 0) {
            if (wid < 3) { const int lb = wid > 0 ? 1 : 0, sb = wid > 1 ? 1 : 0; f32x16 cacc = f32x16{};
#pragma unroll
                for (int ks = 0; ks < 8; ++ks) { const bf16x8 av = *(const bf16x8*)(Cc + (32 * lb + r32) * BP + 16 * ks + 8 * hi), bv = *(const bf16x8*)(Bc + (32 * sb + r32) * BP + 16 * ks + 8 * hi); cacc = MFMA32(av, bv, cacc); }
#pragma unroll
                for (int r = 0; r < 16; ++r) CB[(32 * lb + crow_(r, hi)) * CBP + 32 * sb + r32] = cacc[r]; }
            __syncthreads();
        }
        const float* acsH = acsL + hl * 64; const float* dtH = dtL + hl * 64;
        const float acs_last = acsH[63];
        if (MODE != 0) {
#pragma unroll
            for (int nb = 0; nb < 4; ++nb)
#pragma unroll
                for (int q4 = 0; q4 < 4; ++q4) *(u32x2*)(St + r32 * SP + 32 * nb + 8 * q4 + 4 * hi) = (u32x2){cvtpk(st[nb][4 * q4], st[nb][4 * q4 + 1]), cvtpk(st[nb][4 * q4 + 2], st[nb][4 * q4 + 3])};
            LDSFENCE();
#pragma unroll 1
            for (int lb = 0; lb < 2; ++lb) { if (MODE == 2 && lb == 1) continue;
                f32x16 y = f32x16{};
                unsigned short zr[16];
#pragma unroll
                for (int q4 = 0; q4 < 4; ++q4)
#pragma unroll
                    for (int e = 0; e < 4; ++e) { const int lr = 32 * lb + 8 * q4 + 4 * hi + e; const int row = row0 + tb + lr; zr[4 * q4 + e] = P.Zs[(unsigned)(row * 1024 + xcol)]; }
#pragma unroll
                for (int ks = 0; ks < 8; ++ks) { const bf16x8 av = *(const bf16x8*)(Cc + (32 * lb + r32) * BP + 16 * ks + 8 * hi), bv = *(const bf16x8*)(St + r32 * SP + 16 * ks + 8 * hi); y = MFMA32(av, bv, y); }
#pragma unroll
                for (int q4 = 0; q4 < 4; ++q4) { const f32x4 a4 = *(const f32x4*)(acsH + 32 * lb + 8 * q4 + 4 * hi);
#pragma unroll
                    for (int e = 0; e < 4; ++e) y[4 * q4 + e] *= __expf(a4[e]); }
                const int l = 32 * lb + r32; const float al = acsH[l];
#pragma unroll
                for (int ks = 0; ks < 4; ++ks) { if (ks > 2 * lb + 1) continue;
                    const int s0 = 16 * ks + 8 * hi;
                    const f32x4 c0 = *(const f32x4*)(CB + l * CBP + s0), c1 = *(const f32x4*)(CB + l * CBP + s0 + 4);
                    const f32x4 s4a = *(const f32x4*)(acsH + s0), s4b = *(const f32x4*)(acsH + s0 + 4), d4a = *(const f32x4*)(dtH + s0), d4b = *(const f32x4*)(dtH + s0 + 4);
                    float gg[8], xa[8];
#pragma unroll
                    for (int j = 0; j < 8; ++j) { const float cbv = j < 4 ? c0[j] : c1[j - 4], as = j < 4 ? s4a[j] : s4b[j - 4], dv = j < 4 ? d4a[j] : d4b[j - 4];
                        gg[j] = (s0 + j <= l) ? cbv * __expf(al - as) : 0.f; xa[j] = XV(ks, j) * dv; }
                    const u32x4 gp = {cvtpk(gg[0], gg[1]), cvtpk(gg[2], gg[3]), cvtpk(gg[4], gg[5]), cvtpk(gg[6], gg[7])};
                    const u32x4 xp = {cvtpk(xa[0], xa[1]), cvtpk(xa[2], xa[3]), cvtpk(xa[4], xa[5]), cvtpk(xa[6], xa[7])};
                    y = MFMA32(__builtin_bit_cast(bf16x8, gp), __builtin_bit_cast(bf16x8, xp), y);
                    if (ks >= 2 * lb) { float di[8];
#pragma unroll
                        for (int j = 0; j < 8; ++j) di[j] = (s0 + j == l) ? Dh : 0.f;
                        const u32x4 dp = {cvtpk(di[0], di[1]), cvtpk(di[2], di[3]), cvtpk(di[4], di[5]), cvtpk(di[6], di[7])};
                        const u32x4 xr = {xvp[ks][0], xvp[ks][1], xvp[ks][2], xvp[ks][3]};
                        y = MFMA32(__builtin_bit_cast(bf16x8, dp), __builtin_bit_cast(bf16x8, xr), y); } }
                float s2v[16];
#pragma unroll
                for (int q4 = 0; q4 < 4; ++q4)
#pragma unroll
                    for (int e = 0; e < 4; ++e) { const int r = 4 * q4 + e; const int lr = 32 * lb + 8 * q4 + 4 * hi + e; const int row = row0 + tb + lr;
                        const float yv = y[r] * bf2f(zr[r]);
                        if (MODE != 2 || q4 < 2) P.Mix[(unsigned)(row * DMIX + xcol)] = (bf16_t)(cvtpk(yv, 0.f) & 0xffffu);
                        float s2 = yv * yv;
                        s2 += __shfl_xor(s2, 1); s2 += __shfl_xor(s2, 2); s2 += __shfl_xor(s2, 4); s2 += __shfl_xor(s2, 8); s2 += __shfl_xor(s2, 16);
                        s2v[r] = s2; }
                asm volatile("" ::: "memory");
                if (r32 == 0) {
#pragma unroll
                    for (int q4 = 0; q4 < 4; ++q4)
#pragma unroll
                        for (int e = 0; e < 4; ++e) rsL[wid * 64 + 32 * lb + 8 * q4 + 4 * hi + e] = s2v[4 * q4 + e];
                }
            }
        }
        if (MODE == 0 && sc + 1 < NSUB) load_stage(tb + 64);
        {
            const float dec = __expf(acs_last);
#pragma unroll
            for (int nb = 0; nb < 4; ++nb) st[nb] *= dec;
#pragma unroll
            for (int ks = 0; ks < 4; ++ks) { const int s0 = 16 * ks + 8 * hi;
                const f32x4 s4a = *(const f32x4*)(acsH + s0), s4b = *(const f32x4*)(acsH + s0 + 4), d4a = *(const f32x4*)(dtH + s0), d4b = *(const f32x4*)(dtH + s0 + 4);
                float xb[8];
#pragma unroll
                for (int j = 0; j < 8; ++j) { const float as = j < 4 ? s4a[j] : s4b[j - 4], dv = j < 4 ? d4a[j] : d4b[j - 4]; xb[j] = XV(ks, j) * dv * __expf(acs_last - as); }
                const u32x4 xp = {cvtpk(xb[0], xb[1]), cvtpk(xb[2], xb[3]), cvtpk(xb[4], xb[5]), cvtpk(xb[6], xb[7])};
#pragma unroll
                for (int nb = 0; nb < 4; ++nb) { const bf16x8 av = *(const bf16x8*)(BT + (32 * nb + r32) * TP + 16 * ks + 8 * hi); st[nb] = MFMA32(av, __builtin_bit_cast(bf16x8, xp), st[nb]); } }
        }
        __syncthreads();
        if (MODE != 0) { if (tid < ((MODE == 2) ? 16 : 64)) { float s = 0.f;
#pragma unroll
                for (int w = 0; w < 8; ++w) s += rsL[w * 64 + tid];
                P.GSS[(unsigned)((row0 + tb + tid) * 4 + hq)] = s; } }
    }
    if (MODE == 0) {
        float* sp = P.SL + ((size_t)((b * 32 + blk) * 16 + h)) * 8192 + (size_t)(ph * 4) * 1024 + lane;
#pragma unroll
        for (int nb = 0; nb < 4; ++nb)
#pragma unroll
            for (int r = 0; r < 16; ++r) sp[(nb * 16 + r) * 64] = st[nb][r];
        if (wid < 4 && lane == 0) P.dAtot[(b * 32 + blk) * 16 + hq * 4 + wid] = dasum;
    } else if (MODE == 2 || blk == 31) {
        float* sp = P.out + (MODE == 2 ? O_SSSM : O_PSSM) + ((size_t)(b * 16 + h) * 64 + ph * 32 + r32) * 128 + 4 * hi;
#pragma unroll
        for (int nb = 0; nb < 4; ++nb)
#pragma unroll
            for (int q4 = 0; q4 < 4; ++q4) *(f32x4*)(sp + 32 * nb + 8 * q4) = (f32x4){st[nb][4 * q4], st[nb][4 * q4 + 1], st[nb][4 * q4 + 2], st[nb][4 * q4 + 3]};
    }
}
#undef XV
}

namespace sattn {
constexpr int L_C = 0, L_M = 16640, L_L = L_M + 512, L_O = L_L + 512, OPITCH = 17, L_SCAN = L_O + 8 * 64 * OPITCH * 4, L_END = L_SCAN + 64;
struct Ptrs { const float* cache_k; const float* cache_v; const float* cache_logf; const bf16_t* Qb; const bf16_t* Kb; const bf16_t* Vb; const float* out; bf16_t* Mix; };
__device__ __forceinline__ void unit(const Ptrs& P, unsigned char* lds, int b, int h) {
    int tid_ = threadIdx.x; asm volatile("" : "+v"(tid_));
    const int tid = tid_, lane = tid & 63, wid = __builtin_amdgcn_readfirstlane(tid >> 6), r32 = lane & 31, hi = lane >> 5;
    float* cL = (float*)(lds + L_C); float* mW = (float*)(lds + L_M); float* lW = (float*)(lds + L_L); float* OW = (float*)(lds + L_O); float* wtot = (float*)(lds + L_SCAN);
    constexpr int NK = PAST + SSEQ;
    {
        float v[16]; float run = 0.f; const int s0 = 16 * tid;
#pragma unroll
        for (int i = 0; i < 16; ++i) v[i] = 0.f;
        if (tid < PAST / 16) { const float* lp = P.cache_logf + ((size_t)b * PAST + s0) * 8 + h;
#pragma unroll
            for (int i = 0; i < 16; ++i) v[i] = lp[i * 8];
        } else if (tid == PAST / 16) { const float* lp = P.out + O_SLF + ((size_t)b * 16) * 8 + h;
#pragma unroll
            for (int i = 0; i < 16; ++i) v[i] = lp[i * 8];
        }
#pragma unroll
        for (int i = 0; i < 16; ++i) run += v[i];
        float inc = run;
#pragma unroll
        for (int o = 1; o < 64; o <<= 1) { const float t = __shfl_up(inc, o); if (lane >= o) inc += t; }
        if (lane == 63) wtot[wid] = inc;
        __syncthreads();
        float off = inc - run;
        for (int w = 0; w < wid; ++w) off += wtot[w];
#pragma unroll
        for (int i = 0; i < 16; ++i) { off += v[i]; const int s = s0 + i; if (s < NK + 16) cL[s] = off * L2E; }
        __syncthreads();
    }
    const int q = r32 & 15; const long qrow = (long)MP + b * 16 + q;
    bf16x8 qf[4];
#pragma unroll
    for (int ks = 0; ks < 4; ++ks) qf[ks] = *(const bf16x8*)(P.Qb + qrow * 512 + h * 64 + 16 * ks + 8 * hi);
    const float cq = cL[PAST + q];
    float m = -1e30f, l = 0.f; f32x16 o[2]; o[0] = f32x16{}; o[1] = f32x16{};
    int tile0;
    { const float c0 = cL[PAST]; const int t1 = lane, t2 = lane + 64;
      const bool s1 = (c0 - cL[32 * t1 + 31]) < -(64.0f * L2E), s2 = (c0 - cL[32 * t2 + 31]) < -(64.0f * L2E);
      tile0 = __builtin_amdgcn_readfirstlane(__builtin_popcountll(__ballot(s1)) + __builtin_popcountll(__ballot(s2))); }
    for (int tile = tile0 + wid; tile < 129; tile += 8) {
        const int key0 = 32 * tile; const bool isnew = tile == 128;
        bf16x8 kf[4];
        if (!isnew) { const float* kp = P.cache_k + (((size_t)b * PAST + key0 + r32) * 8 + h) * 64 + 8 * hi;
#pragma unroll
            for (int ks = 0; ks < 4; ++ks) { const f32x4 a = *(const f32x4*)(kp + 16 * ks), c = *(const f32x4*)(kp + 16 * ks + 4);
                const u32x4 w = {cvtpk(a[0], a[1]), cvtpk(a[2], a[3]), cvtpk(c[0], c[1]), cvtpk(c[2], c[3])}; kf[ks] = __builtin_bit_cast(bf16x8, w); }
        } else {
#pragma unroll
            for (int ks = 0; ks < 4; ++ks) kf[ks] = *(const bf16x8*)(P.Kb + ((long)MP + b * 16 + (r32 & 15)) * 512 + h * 64 + 16 * ks + 8 * hi);
        }
        float vall[2][2][8];
        if (!isnew) {
#pragma unroll
            for (int db = 0; db < 2; ++db)
#pragma unroll
                for (int s2 = 0; s2 < 2; ++s2)
#pragma unroll
                    for (int j = 0; j < 8; ++j) { const int kv = crow_(8 * s2 + j, hi); vall[db][s2][j] = P.cache_v[(((size_t)b * PAST + key0 + kv) * 8 + h) * 64 + 32 * db + r32]; }
        } else {
#pragma unroll
            for (int db = 0; db < 2; ++db)
#pragma unroll
                for (int s2 = 0; s2 < 2; ++s2)
#pragma unroll
                    for (int j = 0; j < 8; ++j) { const int kv = crow_(8 * s2 + j, hi); vall[db][s2][j] = bf2f(P.Vb[((long)MP + b * 16 + (kv & 15)) * 512 + h * 64 + 32 * db + r32]) * (kv < 16 ? 1.f : 0.f); }
        }
        f32x16 s = f32x16{};
#pragma unroll
        for (int ks = 0; ks < 4; ++ks) s = MFMA32(kf[ks], qf[ks], s);
        float mt = -1e30f;
#pragma unroll
        for (int q4 = 0; q4 < 4; ++q4) { const f32x4 c4 = *(const f32x4*)(cL + key0 + 8 * q4 + 4 * hi);
#pragma unroll
            for (int e = 0; e < 4; ++e) { const int r = 4 * q4 + e; const int kv = 8 * q4 + 4 * hi + e; float x = s[r] + (cq - c4[e]);
                if (isnew && (kv >= 16 || kv > q)) x = -1e30f;
                s[r] = x; mt = fmaxf(mt, x); } }
        mt = fmaxf(mt, __shfl_xor(mt, 32));
        const float mn = fmaxf(m, mt), alpha = __builtin_amdgcn_exp2f(m - mn); m = mn;
        float ls = 0.f;
#pragma unroll
        for (int r = 0; r < 16; ++r) { const float p = __builtin_amdgcn_exp2f(s[r] - mn); s[r] = p; ls += p; }
        l = l * alpha + ls;
#pragma unroll
        for (int db = 0; db < 2; ++db) o[db] *= alpha;
        bf16x8 pf[2];
#pragma unroll
        for (int s2 = 0; s2 < 2; ++s2) { const u32x4 w = {cvtpk(s[8 * s2], s[8 * s2 + 1]), cvtpk(s[8 * s2 + 2], s[8 * s2 + 3]), cvtpk(s[8 * s2 + 4], s[8 * s2 + 5]), cvtpk(s[8 * s2 + 6], s[8 * s2 + 7])}; pf[s2] = __builtin_bit_cast(bf16x8, w); }
#pragma unroll
        for (int db = 0; db < 2; ++db)
#pragma unroll
            for (int s2 = 0; s2 < 2; ++s2) { const float* vv = vall[db][s2];
                const u32x4 w = {cvtpk(vv[0], vv[1]), cvtpk(vv[2], vv[3]), cvtpk(vv[4], vv[5]), cvtpk(vv[6], vv[7])};
                o[db] = MFMA32(__builtin_bit_cast(bf16x8, w), pf[s2], o[db]); }
    }
    l += __shfl_xor(l, 32);
    if (r32 < 16) { if (hi == 0) { mW[wid * 16 + r32] = m; lW[wid * 16 + r32] = l; }
#pragma unroll
        for (int db = 0; db < 2; ++db)
#pragma unroll
            for (int r = 0; r < 16; ++r) OW[(wid * 64 + 32 * db + crow_(r, hi)) * OPITCH + r32] = o[db][r]; }
    __syncthreads();
#pragma unroll
    for (int it = 0; it < 2; ++it) { const int idx = tid + 512 * it, d = idx & 63, qq = idx >> 6;
        float M = -1e30f;
#pragma unroll
        for (int w = 0; w < 8; ++w) M = fmaxf(M, mW[w * 16 + qq]);
        float L = 0.f, acc = 0.f;
#pragma unroll
        for (int w = 0; w < 8; ++w) { const float f = __builtin_amdgcn_exp2f(mW[w * 16 + qq] - M); L += lW[w * 16 + qq] * f; acc += OW[(w * 64 + d) * OPITCH + qq] * f; }
        P.Mix[((long)MP + b * 16 + qq) * DMIX + 1024 + h * 64 + d] = (bf16_t)(cvtpk(acc / L, 0.f) & 0xffffu); }
    __syncthreads();
}
}

constexpr int NWAVES = 8, LDS_BYTES = 147456;
#define LAS __attribute__((address_space(3)))
struct Args {
    const float *x_prompt, *x_sample, *cache_k, *cache_v, *cache_logf, *state_ssm, *state_conv, *norm1_w, *w_in, *conv_w, *conv_b, *dt_bias, *A_log, *D_skip, *ssd_norm_w, *f_bias,
                *q_norm_w, *k_norm_w, *w_out, *norm2_w, *w_up, *w_down;
    float* out; unsigned char* ws;
};
__device__ __forceinline__ unsigned pk2(float lo, float hi) { return cvtpk(lo, hi); }
template <int MAP> __device__ __forceinline__ void transpose_item(const float* W, int K, int Nsrc, int Nphys, bf16_t* WT, const float* ksc, int ksc_n, float* scr, int item, int lane) {
    const int nblk = Nphys / 32, kb = item / nblk, nb = item % nblk, k0 = 64 * kb, n0 = 32 * nb;
    const int n = n0 + (lane & 31); int src = n;
    if (MAP == 1) { const int L = (n & ~255) + ((n >> 5) & 3) * 64 + ((n >> 7) & 1) * 32 + (n & 31);
        if (L < 2560) src = L; else if (L < 4096) src = L + 16; else if (L < 4112) src = 2560 + (L - 4096); else if (L < 4120) src = L; else src = -1; }
#pragma unroll
    for (int i = 0; i < 32; ++i) { const int kk = 2 * i + (lane >> 5); float v = (src >= 0) ? W[(size_t)(k0 + kk) * Nsrc + src] : 0.f; if (ksc && (k0 + kk) < ksc_n) v *= ksc[k0 + kk]; scr[kk * 33 + (lane & 31)] = v; }
    asm volatile("s_waitcnt lgkmcnt(0)" ::: "memory");
    const int c = lane & 7;
#pragma unroll
    for (int j = 0; j < 4; ++j) { const int nn = (lane >> 3) + 8 * j; const float* s = scr + (8 * c) * 33 + nn;
        u32x4 o; o.x = pk2(s[0 * 33], s[1 * 33]); o.y = pk2(s[2 * 33], s[3 * 33]); o.z = pk2(s[4 * 33], s[5 * 33]); o.w = pk2(s[6 * 33], s[7 * 33]);
        *(u32x4*)(WT + (size_t)(n0 + nn) * K + k0 + 8 * c) = o; }
    asm volatile("s_waitcnt lgkmcnt(0)" ::: "memory");
}
__device__ __forceinline__ float wave_sum(float v) {
#pragma unroll
    for (int o = 1; o < 64; o <<= 1) v += __shfl_xor(v, o);
    return v;
}
__device__ __forceinline__ void rms_row_to_bf16(const float* xrow, bf16_t* orow, int lane) {
    const f32x4* xr = (const f32x4*)xrow + lane; f32x4 v[4]; float s = 0.f;
#pragma unroll
    for (int j = 0; j < 4; ++j) { v[j] = xr[64 * j]; s += (v[j][0] * v[j][0] + v[j][1] * v[j][1]) + (v[j][2] * v[j][2] + v[j][3] * v[j][3]); }
    const float rs = rsqrtf(wave_sum(s) * (1.0f / 1024.0f) + EPSN);
    u32x2* o8 = (u32x2*)orow + lane;
#pragma unroll
    for (int j = 0; j < 4; ++j) o8[64 * j] = (u32x2){pk2(v[j][0] * rs, v[j][1] * rs), pk2(v[j][2] * rs, v[j][3] * rs)};
}

#define XB_TMO      128
#define XB_XCNT(j)  (256  + 64 * (j))
#define XB_XSUB(j)  (1280 + 64 * (j))
#define XB_XGEN(j)  (2304 + 64 * (j))
#define XB_TOP      3328
#define XB_TOPGEN   3392
#define XCD_BAR_WORDS 3456
#define XB_SPIN_CAP (1u << 18)

__device__ __forceinline__ unsigned xb_ld(unsigned* p)              { return __hip_atomic_load(p, __ATOMIC_RELAXED, __HIP_MEMORY_SCOPE_AGENT); }
__device__ __forceinline__ unsigned xb_add(unsigned* p, unsigned v) { return __hip_atomic_fetch_add(p, v, __ATOMIC_RELAXED, __HIP_MEMORY_SCOPE_AGENT); }
__device__ __forceinline__ unsigned xb_xcc_id() { return (unsigned)__builtin_amdgcn_s_getreg((3 << 11) | 20) & 0xFu; }
#define XB_SPIN(cond, bar) do { unsigned _sp = 0; while (cond) { __builtin_amdgcn_s_sleep(1); \
    if ((++_sp & 255u) == 0u) { if (xb_ld(&(bar)[XB_TMO])) break; if (_sp > XB_SPIN_CAP) { atomicAdd(&(bar)[XB_TMO], 1u); break; } } } } while (0)

struct XcdBarrier {
    unsigned* bar; unsigned x;
    volatile LAS unsigned* st;
};

__device__ __forceinline__ XcdBarrier xcd_barrier_post(unsigned* bar, volatile LAS unsigned* st) {
    XcdBarrier b; b.bar = bar; b.x = xb_xcc_id(); b.st = st;
    if (threadIdx.x == 0) (void)xb_add(&bar[XB_XCNT(b.x)], 1u);
    return b;
}
__device__ __forceinline__ void xcd_barrier_complete(unsigned* bar, unsigned x, unsigned& nloc, unsigned& nx) {
    const unsigned G = gridDim.x * gridDim.y * gridDim.z;
    unsigned sum, cnt, mine, sp = 0u;
    for (;;) {
        sum = 0u; cnt = 0u; mine = 0u;
#pragma unroll
        for (unsigned j = 0; j < 16; ++j) { const unsigned c = xb_ld(&bar[XB_XCNT(j)]); sum += c; cnt += (c > 0u) ? 1u : 0u; mine = (j == x) ? c : mine; }
        if (sum == G) break;
        __builtin_amdgcn_s_sleep(1);
        if ((++sp & 255u) == 0u) { if (xb_ld(&bar[XB_TMO])) break; if (sp > XB_SPIN_CAP) { atomicAdd(&bar[XB_TMO], 1u); break; } }
    }
    nloc = mine > 0u ? mine : 1u; nx = cnt > 0u ? cnt : 1u;
}

__device__ __forceinline__ void xcd_barrier(const XcdBarrier& b) {
    asm volatile("s_waitcnt vmcnt(0)" ::: "memory");
    __syncthreads();
    if (threadIdx.x == 0) {
        unsigned* bar = b.bar;
        __builtin_amdgcn_s_waitcnt(0);
        unsigned nloc = b.st[0], nx = b.st[1];
        if (nloc == 0u) { xcd_barrier_complete(bar, b.x, nloc, nx); b.st[0] = nloc; b.st[1] = nx; }
        const unsigned old = xb_add(&bar[XB_XSUB(b.x)], 1u);
        const unsigned gen = old / nloc;
        if (old + 1u == (gen + 1u) * nloc) {
            __builtin_amdgcn_fence(__ATOMIC_RELEASE, "agent");
            asm volatile("s_waitcnt vmcnt(0)" ::: "memory");
            const unsigned og = xb_add(&bar[XB_TOP], 1u);
            const unsigned tg = og / nx;
            if (og + 1u == (tg + 1u) * nx) xb_add(&bar[XB_TOPGEN], 1u);
            else XB_SPIN(xb_ld(&bar[XB_TOPGEN]) == tg, bar);
            __builtin_amdgcn_fence(__ATOMIC_ACQUIRE, "agent");
            xb_add(&bar[XB_XGEN(b.x)], 1u);
            asm volatile("s_waitcnt vmcnt(0)" ::: "memory");
        } else {
            XB_SPIN(xb_ld(&bar[XB_XGEN(b.x)]) == gen, bar);
            __builtin_amdgcn_fence(__ATOMIC_ACQUIRE, "agent");
            asm volatile("s_waitcnt vmcnt(0)" ::: "memory");
        }
    }
    __syncthreads();
}

template <int PH> __device__ __forceinline__ void run_phase(const Args& a, unsigned char* lds) {
    int tid_ = threadIdx.x; asm volatile("" : "+v"(tid_));
    const int tid = tid_, lane = tid & 63, wave = __builtin_amdgcn_readfirstlane(tid >> 6);
    int G_ = gridDim.x, bx_ = blockIdx.x; asm volatile("" : "+s"(G_), "+s"(bx_));
    const int G = G_, bx = bx_;
    unsigned char* ws = a.ws; float* out = a.out;
    float* SS1 = (float*)(ws + WS_SS1P); float* GSS = (float*)(ws + WS_GSSP); float* DAT = (float*)(ws + WS_DAT); float* CP = (float*)(ws + WS_CP);
    bf16_t* WinT = (bf16_t*)(ws + WS_WIN); bf16_t* WoutT = (bf16_t*)(ws + WS_WOUT); bf16_t* WupT = (bf16_t*)(ws + WS_WUP); bf16_t* WdnT = (bf16_t*)(ws + WS_WDN);
    bf16_t* XN = (bf16_t*)(ws + WS_XN); float* DT = (float*)(ws + WS_DT); float* SL = (float*)(ws + WS_SL); bf16_t* Zs = (bf16_t*)(ws + WS_ZS); bf16_t* XBC = (bf16_t*)(ws + WS_XBC);
    bf16_t* Qb = (bf16_t*)(ws + WS_QB); bf16_t* Kb = (bf16_t*)(ws + WS_KB); bf16_t* Vb = (bf16_t*)(ws + WS_VB); bf16_t* Mix = (bf16_t*)(ws + WS_MIX); bf16_t* Hb = (bf16_t*)(ws + WS_H);
    (void)tid; (void)lane; (void)wave; (void)SS1; (void)GSS; (void)DAT; (void)CP; (void)WinT; (void)WoutT; (void)WupT; (void)WdnT; (void)XN; (void)DT; (void)SL; (void)Zs; (void)XBC; (void)Qb; (void)Kb; (void)Vb; (void)Mix; (void)Hb; (void)out;
    if constexpr (PH == 0) {
    {
        float* scr = (float*)(lds + wave * 16384);
        const int gw = bx * NWAVES + wave, NGW = G * NWAVES;
        constexpr int I_IN = (1024 / 64) * (NIN / 32), I_OUT = (1536 / 64) * (1024 / 32), I_UP = (1024 / 64) * (4096 / 32), I_DN = (4096 / 64) * (1024 / 32);
        for (int it = gw; it < I_IN + I_OUT + I_UP + I_DN; it += NGW) {
            int r = it;
            if (r < I_IN) { transpose_item<1>(a.w_in, 1024, 4120, NIN, WinT, a.norm1_w, 1024, scr, r, lane); continue; } r -= I_IN;
            if (r < I_OUT) { transpose_item<0>(a.w_out, 1536, 1024, 1024, WoutT, a.ssd_norm_w, 1024, scr, r, lane); continue; } r -= I_OUT;
            if (r < I_UP) { transpose_item<0>(a.w_up, 1024, 4096, 4096, WupT, a.norm2_w, 1024, scr, r, lane); continue; } r -= I_UP;
            transpose_item<0>(a.w_down, 4096, 1024, 1024, WdnT, nullptr, 0, scr, r, lane);
        }
        for (int m0 = gw; m0 < MT; m0 += 4 * NGW) {
            f32x4 v[4][4]; float s[4];
#pragma unroll
            for (int r = 0; r < 4; ++r) { const int m = m0 + r * NGW; const int mc = m < MT ? m : MT - 1;
                const f32x4* xr = (const f32x4*)(mc < MP ? a.x_prompt + (size_t)mc * 1024 : a.x_sample + (size_t)(mc - MP) * 1024) + lane; s[r] = 0.f;
#pragma unroll
                for (int j = 0; j < 4; ++j) { v[r][j] = __builtin_nontemporal_load(xr + 64 * j); } }
#pragma unroll
            for (int r = 0; r < 4; ++r) {
#pragma unroll
                for (int j = 0; j < 4; ++j) s[r] += (v[r][j][0] * v[r][j][0] + v[r][j][1] * v[r][j][1]) + (v[r][j][2] * v[r][j][2] + v[r][j][3] * v[r][j][3]);
                const float rs = rsqrtf(wave_sum(s[r]) * (1.0f / 1024.0f) + EPSN); const int m = m0 + r * NGW;
                if (m < MT) { u32x2* o8 = (u32x2*)(XN + (size_t)m * 1024) + lane;
#pragma unroll
                    for (int j = 0; j < 4; ++j) o8[64 * j] = (u32x2){pk2(v[r][j][0] * rs, v[r][j][1] * rs), pk2(v[r][j][2] * rs, v[r][j][3] * rs)}; } }
        }
        if (bx == 0 && tid < 64) ((unsigned*)(ws + WS_CTR))[tid] = 0u;
    }
    }
    if constexpr (PH == 1) {
    {
        pg8::Gemm g{XN, WinT, MT, NIN, 1024, 0}; pg8::StaticOrder S; S.init(MT, NIN, G, bx);
        pg8::EpiIn E{Zs, XBC, Qb, Kb, Vb, DT, out, a.dt_bias, a.f_bias, a.q_norm_w, a.k_norm_w, (bf16_t*)(ws + WS_HIST)};
        pg8::gemm_phase<pg8::EpiIn, pg8::StaticOrder, true, true>((PG8_LAS unsigned char*)lds, g, S, E);
    }
    }
    if constexpr (PH == 9) {
    {
        const bf16_t* HIST = (const bf16_t*)(ws + WS_HIST);
        constexpr int NSEG = MP / 128, NPAIR = DCONV / 2, NTASK = (NSEG + SBATCH) * NPAIR;
        for (int task = bx * 512 + tid; task < NTASK; task += G * 512) {
            const int seg = task / NPAIR, col = 2 * (task - seg * NPAIR);
            float w0[4], w1[4];
#pragma unroll
            for (int k = 0; k < 4; ++k) { w0[k] = a.conv_w[k * DCONV + col]; w1[k] = a.conv_w[k * DCONV + col + 1]; }
            const float b0 = a.conv_b[col], b1 = a.conv_b[col + 1];
            float a3 = 0.f, c3 = 0.f, a2 = 0.f, c2 = 0.f, a1 = 0.f, c1 = 0.f; int row0, n;
            if (seg < NSEG) { row0 = seg * 128; n = 128;
                if (seg & 63) { const bf16_t* hp = HIST + (unsigned)((seg - 1) * 3 * DCONV + col);
                    const unsigned u3 = *(const unsigned*)hp, u2 = *(const unsigned*)(hp + DCONV), u1 = *(const unsigned*)(hp + 2 * DCONV);
                    a3 = bf2f(u3 & 0xffffu); c3 = bf2f(u3 >> 16); a2 = bf2f(u2 & 0xffffu); c2 = bf2f(u2 >> 16); a1 = bf2f(u1 & 0xffffu); c1 = bf2f(u1 >> 16); }
            } else { const int s = seg - NSEG; row0 = MP + s * 16; n = 16; const float* hp = a.state_conv + (unsigned)(s * 3 * DCONV + col);
                a3 = hp[0]; c3 = hp[1]; a2 = hp[DCONV]; c2 = hp[DCONV + 1]; a1 = hp[2 * DCONV]; c1 = hp[2 * DCONV + 1]; }
            bf16_t* xp = XBC + (unsigned)(row0 * DCONV + col);
            for (int i0 = 0; i0 < n; i0 += 16) {
                unsigned uu[16];
#pragma unroll
                for (int i = 0; i < 16; ++i) uu[i] = *(const unsigned*)(xp + (i0 + i) * DCONV);
#pragma unroll
                for (int i = 0; i < 16; ++i) { const float a0 = bf2f(uu[i] & 0xffffu), c0 = bf2f(uu[i] >> 16);
                    const float o0 = silu_f(b0 + w0[0] * a3 + w0[1] * a2 + w0[2] * a1 + w0[3] * a0), o1 = silu_f(b1 + w1[0] * c3 + w1[1] * c2 + w1[2] * c1 + w1[3] * c0);
                    *(unsigned*)(xp + (i0 + i) * DCONV) = cvtpk(o0, o1);
                    a3 = a2; c3 = c2; a2 = a1; c2 = c1; a1 = a0; c1 = c0; }
            }
        }
        sattn::Ptrs Q{a.cache_k, a.cache_v, a.cache_logf, Qb, Kb, Vb, out, Mix};
        for (int u = G - 1 - bx; u < SBATCH * 8; u += G) sattn::unit(Q, lds, u >> 3, u & 7);
    }
    }
    if constexpr (PH == 12) {
    {
        if (G >= 128) { const f32x4* part = (const f32x4*)(ws + WS_MIX); f32x4* y = (f32x4*)(out + O_Y + (size_t)MP * 1024);
            for (int i = bx * 512 + tid; i < MS * 1024 / 4; i += G * 512) { f32x4 s = y[i];
#pragma unroll
                for (int k = 0; k < 16; ++k) s += part[(size_t)k * (MS * 1024 / 4) + i];
                y[i] = s; } }
    }
    }
    if constexpr (PH == 10) {
    {
        const int ks = bx >> 3;
        pg8::Gemm g2{Hb + ks * 256, WdnT + ks * 256, MT, 1024, DFF, 4}; pg8::ListOrder S2{G, bx, G >= 128 ? 128 : 0, 8, MP / 256, 4, 0};
        pg8::EpiDownPartial E2{(float*)(ws + WS_MIX) + (size_t)ks * (MS * 1024)};
        pg8::gemm_phase<pg8::EpiDownPartial, pg8::ListOrder, true, true>((PG8_LAS unsigned char*)lds, g2, S2, E2);
    }
    }
    if constexpr (PH == 11) {
    {
        {
            pg8::Gemm g{Mix, WoutT, MT, 1024, DMIX, 0}; pg8::ListOrder S{G, bx, 8, 8, MP / 256, 4, 0};
            pg8::EpiOut E{a.x_prompt, a.x_sample, out + O_Y, XN, SS1, GSS};
            pg8::gemm_phase<pg8::EpiOut, pg8::ListOrder, true, true>((PG8_LAS unsigned char*)lds, g, S, E);
        }
    }
    }
    if constexpr (PH == 2) {
    {
        ssd::Ptrs P{XBC, Zs, DT, a.conv_w, a.conv_b, a.A_log, a.D_skip, a.state_conv, a.state_ssm, SL, DAT, GSS, Mix, out};
        for (int u = bx; u < PB * 32 * 4; u += G) ssd::unit<0>(P, lds, u >> 7, (u >> 2) & 31, u & 3);
        for (int u = bx; u < SBATCH * 4; u += G) ssd::unit<2>(P, lds, u >> 2, 0, u & 3);
    }
    }
    if constexpr (PH == 3) {
    {
        for (int item = bx * 512 + tid; item < PB * 16 * 8192; item += G * 512) {
            const int bh = item >> 13, b = bh >> 4, h = bh & 15, e = item & 8191; float s = 0.f;
            float* sp = SL + ((size_t)(b * 32 * 16 + h)) * 8192 + e; const float* dp = DAT + b * 32 * 16 + h; float loc[32], dec[32];
#pragma unroll
            for (int blk = 0; blk < 32; ++blk) { loc[blk] = sp[(size_t)blk * 16 * 8192]; dec[blk] = dp[blk * 16]; }
#pragma unroll
            for (int blk = 0; blk < 32; ++blk) { sp[(size_t)blk * 16 * 8192] = s; s = s * __expf(dec[blk]) + loc[blk]; } }
        float* wtot = (float*)lds;
        for (int bh = bx; bh < PB * 8; bh += G) { const int b = bh >> 3, h = bh & 7;
            float v[16]; float run = 0.f; const int s0 = 16 * tid;
#pragma unroll
            for (int i = 0; i < 16; ++i) { v[i] = out[O_PLF + ((size_t)b * PSEQ + s0 + i) * 8 + h]; run += v[i]; }
            float inc = run;
#pragma unroll
            for (int o = 1; o < 64; o <<= 1) { const float t = __shfl_up(inc, o); if (lane >= o) inc += t; }
            __syncthreads();
            if (lane == 63) wtot[wave] = inc;
            __syncthreads();
            float off = inc - run;
            for (int w = 0; w < wave; ++w) off += wtot[w];
#pragma unroll
            for (int i = 0; i < 16; ++i) { off += v[i]; CP[(size_t)bh * PSEQ + s0 + i] = off * L2E; } }
    }
    }
    if constexpr (PH == 4) {
    {
        ssd::Ptrs P{XBC, Zs, DT, a.conv_w, a.conv_b, a.A_log, a.D_skip, a.state_conv, a.state_ssm, SL, DAT, GSS, Mix, out};
        for (int u = bx; u < PB * 32 * 4; u += G) ssd::unit<1>(P, lds, u >> 7, (u >> 2) & 31, u & 3);
    }
    }
    if constexpr (PH == 8) {
    {
        const attn_body::bf16* Qa = (const attn_body::bf16*)Qb; const attn_body::bf16* Ka = (const attn_body::bf16*)Kb; const attn_body::bf16* Va = (const attn_body::bf16*)Vb;
        attn_body::bf16* Oa = (attn_body::bf16*)(Mix + 1024);
        unsigned* ctr = (unsigned*)(ws + WS_CTR); int* slot = (int*)(lds + 147000);
        for (;;) {
            if (tid == 0) *slot = (int)atomicAdd(ctr, 1u);
            __syncthreads();
            const int u = *slot;
            __syncthreads();
            if (u >= PB * 8 * 32) break;
            const int qb = 31 - (u >> 6), bh = u & 63;
            attn_body::attn_unit<8>(bh >> 3, bh & 7, qb, Qa, Ka, Va, Oa, CP, (char*)lds);
        }
    }
    }
    if constexpr (PH == 5) {
    {
        pg8::Gemm g{Mix, WoutT, MP, 1024, DMIX, 0}; pg8::StaticOrder S; S.init(MP, 1024, G, bx);
        pg8::EpiOut E{a.x_prompt, a.x_sample, out + O_Y, XN, SS1, GSS};
        pg8::gemm_phase<pg8::EpiOut, pg8::StaticOrder, true, true>((PG8_LAS unsigned char*)lds, g, S, E);
    }
    }
    if constexpr (PH == 6) {
    {
        pg8::Gemm g{XN, WupT, MT, DFF, 1024, 0}; pg8::StaticOrder S; S.init(MT, DFF, G, bx);
        pg8::EpiUp E{SS1, Hb};
        pg8::gemm_phase<pg8::EpiUp, pg8::StaticOrder, true, true>((PG8_LAS unsigned char*)lds, g, S, E);
    }
    }
    if constexpr (PH == 7) {
    {
        const int Mrows = G >= 128 ? MP : MT;
        pg8::Gemm g{Hb, WdnT, Mrows, 1024, DFF, 0}; pg8::StaticOrder S; S.init(Mrows, 1024, G, bx);
        pg8::EpiDown E{out + O_Y};
        pg8::gemm_phase<pg8::EpiDown, pg8::StaticOrder, true, true>((PG8_LAS unsigned char*)lds, g, S, E);
    }
    }
}
template <int PH> __global__ void __launch_bounds__(NWAVES * 64, 2) phase_kernel(Args a) {
    extern __shared__ __attribute__((aligned(16))) unsigned char lds[];
    run_phase<PH>(a, lds);
}
#ifndef ONE_LAUNCH
#define ONE_LAUNCH 1
#endif
#if ONE_LAUNCH
#define RUN_PHASE(k) do { const __attribute__((address_space(4))) Args* p_ = (const __attribute__((address_space(4))) Args*)__builtin_amdgcn_kernarg_segment_ptr(); asm volatile("" : "+s"(p_)); Args la_; { const __attribute__((address_space(4))) unsigned long long* q_ = (const __attribute__((address_space(4))) unsigned long long*)p_; unsigned long long* d_ = (unsigned long long*)&la_; _Pragma("unroll") for (int i_ = 0; i_ < (int)(sizeof(Args) / 8); ++i_) d_[i_] = q_[i_]; } run_phase<k>(la_, lds); } while (0)
__global__ void __launch_bounds__(NWAVES * 64, 2) fwd_megakernel(Args a) {
    extern __shared__ __attribute__((aligned(16))) unsigned char lds[];
    cg::grid_group grid = cg::this_grid();
    if (threadIdx.x < 2) ((volatile LAS unsigned*)(lds + 147016))[threadIdx.x] = 0u;
    __syncthreads();
    XcdBarrier xbar;
    { const __attribute__((address_space(4))) Args* p_ = (const __attribute__((address_space(4))) Args*)__builtin_amdgcn_kernarg_segment_ptr();
      xbar = xcd_barrier_post((unsigned*)(p_->ws + WS_BARW), (volatile LAS unsigned*)(lds + 147016)); }
    RUN_PHASE(0); grid.sync();
    RUN_PHASE(1); xcd_barrier(xbar);
    RUN_PHASE(9); xcd_barrier(xbar);
    RUN_PHASE(2); xcd_barrier(xbar);
    RUN_PHASE(3); xcd_barrier(xbar);
    RUN_PHASE(4); __syncthreads(); RUN_PHASE(11); __syncthreads(); RUN_PHASE(8); xcd_barrier(xbar);
    RUN_PHASE(5); xcd_barrier(xbar);
    RUN_PHASE(6); xcd_barrier(xbar);
    RUN_PHASE(7); __syncthreads(); RUN_PHASE(10); xcd_barrier(xbar);
    RUN_PHASE(12);
}
#endif
extern "C" void kernel_launch(void* const* d_in, const int* in_sizes, int n_in, void* d_out, int out_size, void* d_ws, size_t ws_size, hipStream_t stream) {
    static int grid = 0;
    if (grid == 0) {
        if (n_in != 22 || (size_t)out_size != O_END || ws_size < WS_END) { fprintf(stderr, "kernel_launch: unexpected shapes: n_in %d out %d ws %zu (need %zu)\n", n_in, out_size, ws_size, (size_t)WS_END); grid = -1; return; }
        int dev = 0, cus = 0, per_cu = 0;
        (void)hipGetDevice(&dev); (void)hipDeviceGetAttribute(&cus, hipDeviceAttributeMultiprocessorCount, dev);
        bool okattr = true;
#if ONE_LAUNCH
        okattr = hipFuncSetAttribute((const void*)fwd_megakernel, hipFuncAttributeMaxDynamicSharedMemorySize, LDS_BYTES) == hipSuccess;
#endif
#if !ONE_LAUNCH
        okattr = okattr && hipFuncSetAttribute((const void*)phase_kernel<0>, hipFuncAttributeMaxDynamicSharedMemorySize, LDS_BYTES) == hipSuccess && hipFuncSetAttribute((const void*)phase_kernel<1>, hipFuncAttributeMaxDynamicSharedMemorySize, LDS_BYTES) == hipSuccess
              && hipFuncSetAttribute((const void*)phase_kernel<2>, hipFuncAttributeMaxDynamicSharedMemorySize, LDS_BYTES) == hipSuccess && hipFuncSetAttribute((const void*)phase_kernel<3>, hipFuncAttributeMaxDynamicSharedMemorySize, LDS_BYTES) == hipSuccess
              && hipFuncSetAttribute((const void*)phase_kernel<4>, hipFuncAttributeMaxDynamicSharedMemorySize, LDS_BYTES) == hipSuccess && hipFuncSetAttribute((const void*)phase_kernel<5>, hipFuncAttributeMaxDynamicSharedMemorySize, LDS_BYTES) == hipSuccess
              && hipFuncSetAttribute((const void*)phase_kernel<6>, hipFuncAttributeMaxDynamicSharedMemorySize, LDS_BYTES) == hipSuccess && hipFuncSetAttribute((const void*)phase_kernel<7>, hipFuncAttributeMaxDynamicSharedMemorySize, LDS_BYTES) == hipSuccess && hipFuncSetAttribute((const void*)phase_kernel<8>, hipFuncAttributeMaxDynamicSharedMemorySize, LDS_BYTES) == hipSuccess && hipFuncSetAttribute((const void*)phase_kernel<9>, hipFuncAttributeMaxDynamicSharedMemorySize, LDS_BYTES) == hipSuccess && hipFuncSetAttribute((const void*)phase_kernel<10>, hipFuncAttributeMaxDynamicSharedMemorySize, LDS_BYTES) == hipSuccess && hipFuncSetAttribute((const void*)phase_kernel<11>, hipFuncAttributeMaxDynamicSharedMemorySize, LDS_BYTES) == hipSuccess && hipFuncSetAttribute((const void*)phase_kernel<12>, hipFuncAttributeMaxDynamicSharedMemorySize, LDS_BYTES) == hipSuccess;
#endif
        if (!okattr) { fprintf(stderr, "kernel_launch: hipFuncSetAttribute failed\n"); grid = -1; return; }
        (void)hipGetLastError();
        grid = cus;
    }
    if (grid < 0) return;
    Args a{};
    a.x_prompt = (const float*)d_in[0]; a.x_sample = (const float*)d_in[1]; a.cache_k = (const float*)d_in[2]; a.cache_v = (const float*)d_in[3]; a.cache_logf = (const float*)d_in[4];
    a.state_ssm = (const float*)d_in[5]; a.state_conv = (const float*)d_in[6]; a.norm1_w = (const float*)d_in[7]; a.w_in = (const float*)d_in[8]; a.conv_w = (const float*)d_in[9];
    a.conv_b = (const float*)d_in[10]; a.dt_bias = (const float*)d_in[11]; a.A_log = (const float*)d_in[12]; a.D_skip = (const float*)d_in[13]; a.ssd_norm_w = (const float*)d_in[14];
    a.f_bias = (const float*)d_in[15]; a.q_norm_w = (const float*)d_in[16]; a.k_norm_w = (const float*)d_in[17]; a.w_out = (const float*)d_in[18]; a.norm2_w = (const float*)d_in[19];
    a.w_up = (const float*)d_in[20]; a.w_down = (const float*)d_in[21]; a.out = (float*)d_out; a.ws = (unsigned char*)d_ws;
#if ONE_LAUNCH
    if (hipMemsetAsync((char*)d_ws + WS_BARW, 0, 16384, stream) != hipSuccess) { fprintf(stderr, "kernel_launch: hipMemsetAsync failed\n"); return; }
    void* args[] = {&a};
    hipError_t e = hipLaunchCooperativeKernel((const void*)fwd_megakernel, dim3(grid), dim3(NWAVES * 64), args, LDS_BYTES, stream);
    if (e != hipSuccess) fprintf(stderr, "kernel_launch: cooperative launch failed: %s (grid %d)\n", hipGetErrorString(e), grid);
#else
    hipLaunchKernelGGL(phase_kernel<0>, dim3(grid), dim3(NWAVES * 64), LDS_BYTES, stream, a);
    hipLaunchKernelGGL(phase_kernel<1>, dim3(grid), dim3(NWAVES * 64), LDS_BYTES, stream, a);
    hipLaunchKernelGGL(phase_kernel<9>, dim3(grid), dim3(NWAVES * 64), LDS_BYTES, stream, a);
    hipLaunchKernelGGL(phase_kernel<2>, dim3(grid), dim3(NWAVES * 64), LDS_BYTES, stream, a);
    hipLaunchKernelGGL(phase_kernel<3>, dim3(grid), dim3(NWAVES * 64), LDS_BYTES, stream, a);
    hipLaunchKernelGGL(phase_kernel<4>, dim3(grid), dim3(NWAVES * 64), LDS_BYTES, stream, a);
    hipLaunchKernelGGL(phase_kernel<11>, dim3(grid), dim3(NWAVES * 64), LDS_BYTES, stream, a);
    hipLaunchKernelGGL(phase_kernel<8>, dim3(grid), dim3(NWAVES * 64), LDS_BYTES, stream, a);
    hipLaunchKernelGGL(phase_kernel<5>, dim3(grid), dim3(NWAVES * 64), LDS_BYTES, stream, a);
    hipLaunchKernelGGL(phase_kernel<6>, dim3(grid), dim3(NWAVES * 64), LDS_BYTES, stream, a);
    hipLaunchKernelGGL(phase_kernel<7>, dim3(grid), dim3(NWAVES * 64), LDS_BYTES, stream, a);
    hipLaunchKernelGGL(phase_kernel<10>, dim3(grid), dim3(NWAVES * 64), LDS_BYTES, stream, a);
    hipLaunchKernelGGL(phase_kernel<12>, dim3(grid), dim3(NWAVES * 64), LDS_BYTES, stream, a);
#endif
}
```

```cpp
#include <hip/hip_runtime.h>
#include <hip/hip_cooperative_groups.h>
#include <hip/hip_bf16.h>
#include <cstdio>
#include <cstdint>
#include <cmath>
namespace cg = cooperative_groups;

constexpr int DMODEL = 1024, PSEQ = 8192, PB = 8, MP = PB * PSEQ  , SBATCH = 32, SSEQ = 16, MS = SBATCH * SSEQ  , MT = MP + MS  ;
constexpr int PAST = 4096, NIN = 4352  , DFF = 4096, DMIX = 1536, DCONV = 1536;
constexpr float EPSN = 1e-6f, L2E = 1.4426950408889634f;
constexpr size_t O_Y = 0, O_PK = 67633152, O_PV = 101187584, O_PLF = 134742016, O_PSSM = 135266304, O_PCONV = 136314880, O_SK = 136351744, O_SV = 136613888,
                 O_SLF = 136876032, O_SSSM = 136880128, O_SCONV = 141074432, O_END = 141221888;
constexpr size_t MiB = 1u << 20;
constexpr size_t WS_BARW = 1152 * 1024, WS_CTR = 1120 * 1024, WS_SS1 = 0, WS_GSS = 512 * 1024, WS_DAT = 1088 * 1024, WS_CP = 2 * MiB, WS_WIN = 4 * MiB, WS_WOUT = WS_WIN + 8704 * 1024, WS_WUP = WS_WOUT + 3 * MiB, WS_WDN = WS_WUP + 8 * MiB;
constexpr size_t WS_XN = 32 * MiB, WS_DT = 161 * MiB, WS_SL = 166 * MiB, WS_ZS = 294 * MiB, WS_XBC = 423 * MiB, WS_QB = 617 * MiB, WS_KB = 682 * MiB, WS_VB = 747 * MiB, WS_MIX = 812 * MiB,
                 WS_H = 294 * MiB, WS_HIST = 1006 * MiB, WS_GSSP = 1012 * MiB, WS_SS1P = 1014 * MiB, WS_END = 1019 * MiB;
static_assert(WS_WDN + 8 * MiB <= WS_XN && WS_XN + (size_t)MT * 1024 * 2 <= WS_DT && WS_DT + (size_t)MT * 64 <= WS_SL && WS_SL + 128 * MiB <= WS_ZS, "ws map 1");
static_assert(WS_ZS + (size_t)MT * 2048 <= WS_XBC && WS_XBC + (size_t)(MT + 64) * 3072 <= WS_QB && WS_QB + (size_t)MT * 1024 <= WS_KB && WS_KB + (size_t)MT * 1024 <= WS_VB && WS_VB + (size_t)MT * 1024 <= WS_MIX, "ws map 2");
static_assert(WS_MIX + (size_t)MT * 3072 <= WS_END && WS_H + (size_t)MT * 8192 <= WS_MIX, "ws map 3");

typedef unsigned short bf16_t;
typedef short bf16x8 __attribute__((ext_vector_type(8)));
typedef float f32x4 __attribute__((ext_vector_type(4)));
typedef float f32x16 __attribute__((ext_vector_type(16)));
typedef unsigned u32x4 __attribute__((ext_vector_type(4)));
typedef unsigned u32x2 __attribute__((ext_vector_type(2)));
typedef float f32x2_t_ __attribute__((ext_vector_type(2)));
typedef __bf16 bf16x2_t_ __attribute__((ext_vector_type(2)));
__device__ __forceinline__ unsigned cvtpk(float lo, float hi) { f32x2_t_ v = {lo, hi}; bf16x2_t_ b = __builtin_convertvector(v, bf16x2_t_); return __builtin_bit_cast(unsigned, b); }
__device__ __forceinline__ float bf2f(unsigned u16) { return __uint_as_float(u16 << 16); }
__device__ __forceinline__ float silu_f(float v) { return v * __builtin_amdgcn_rcpf(1.0f + __expf(-v)); }
__device__ __forceinline__ float softplus_f(float v) { return v > 20.f ? v : log1pf(__expf(v)); }
__device__ __forceinline__ float logsigmoid_f(float v) { return fminf(v, 0.f) - log1pf(__expf(-fabsf(v))); }
__device__ __forceinline__ int crow_(int r, int hi) { return (r & 3) + 8 * (r >> 2) + 4 * hi; }
__device__ __forceinline__ void gatomic_add(float* p, float v) { (void)__builtin_amdgcn_global_atomic_fadd_f32((__attribute__((address_space(1))) float*)p, v); }
namespace pg8 {
#define PG8_LAS __attribute__((address_space(3)))
typedef unsigned short bf16_t;
typedef short bf16x8 __attribute__((ext_vector_type(8)));
typedef float f32x4 __attribute__((ext_vector_type(4)));
typedef unsigned u32x4 __attribute__((ext_vector_type(4)));
constexpr int BM = 256, BK = 64, HALF = 128, HTB = HALF * BK * 2  , STAGE_BYTES = 8 * HTB, NXCD = 8, WGM = 8;

__host__ __device__ __forceinline__ int lds_byte(int r, int c) { const int st = (r >> 4) * 2 + (c >> 5), rr = r & 15, cc = c & 31, ob = rr * 64 + cc * 2; return st * 1024 + (ob ^ (((ob >> 9) & 1) << 5)); }
__host__ __device__ __forceinline__ void stage_rc(int b, int& R, int& C) { const int st = b / 1024, sb = b % 1024, swz = sb ^ (((sb >> 9) & 1) << 5); R = (st >> 1) * 16 + swz / 64; C = (st & 1) * 32 + (swz % 64) / 2; }
__host__ __device__ __forceinline__ int perm32(int rho) { const int n = rho >> 4, i = rho & 15; return 8 * (i >> 2) + 4 * n + (i & 3); }

struct Unit { int pm, pn, k0; };
struct Gemm { const bf16_t* A; const bf16_t* Bt; int M, N, K, nt; };

struct StaticOrder {
    int nM, nN, nwg, G, c;
    __host__ __device__ void init(int M, int N, int G_, int c_) { nM = M / BM; nN = N / BM; nwg = nM * nN; G = G_; c = c_; }
    __host__ __device__ bool next(int i, Unit& u) const {
        const long L = (long)i * G + c; if (L >= nwg) return false;
        int wgid = (int)L; { const int q = nwg / NXCD, r = nwg % NXCD, xcd = wgid % NXCD, off = wgid / NXCD; wgid = (xcd < r ? xcd * (q + 1) : r * (q + 1) + (xcd - r) * q) + off; }
        const int nig = WGM * nN, gid = wgid / nig, fm = gid * WGM, gsz = (nM - fm) < WGM ? (nM - fm) : WGM;
        u.pm = fm + ((wgid % nig) % gsz); u.pn = (wgid % nig) / gsz; u.k0 = 0; return true;
    }
    __device__ __forceinline__ void a_ready(const Unit&) const {}
    __device__ __forceinline__ void done(const Unit&) const {}
};

struct ListOrder {
    int G, c, count, ntiles, pm0, npn, ksplit;
    __device__ __forceinline__ bool next(int i, Unit& u) const { const int L = i * G + c; if (L >= count) return false; const int tile = L % ntiles, ks = L / ntiles; u.pm = pm0 + tile / npn; u.pn = tile % npn; u.k0 = ks * ksplit; return true; }
    __device__ __forceinline__ void a_ready(const Unit&) const {}
    __device__ __forceinline__ void done(const Unit&) const {}
};

__device__ __forceinline__ void st_bf16x8(bf16_t* p, f32x4 a, f32x4 b) { u32x4 w; w.x = cvtpk(a[0], a[1]); w.y = cvtpk(a[2], a[3]); w.z = cvtpk(b[0], b[1]); w.w = cvtpk(b[2], b[3]); *(u32x4*)p = w; }
struct EpiIn {
    static constexpr bool PERM = true, AFTER_DRAIN = false, KHOOK = false;
    bf16_t *Zs, *XBC, *Qb, *Kb, *Vb; float* DT; float* out; const float *dt_bias, *f_bias, *qw, *kw; bf16_t* HIST;
    __device__ __forceinline__ void operator()(const f32x4 (&acc)[2][2][4][2], const Unit& u, int wr, int wc, int fr, int fq) const {
        const int pn = u.pn; const int lc = pn * 256 + wc * 64 + fq * 8;
        if (pn < 10) {
#pragma unroll
            for (int ai = 0; ai < 2; ++ai)
#pragma unroll
                for (int m = 0; m < 4; ++m) { const int row = u.pm * BM + ai * HALF + wr * 64 + m * 16 + fr;
#pragma unroll
                    for (int bj = 0; bj < 2; ++bj) { f32x4 v0 = acc[ai][bj][m][0], v1 = acc[ai][bj][m][1];
                        if (pn < 4) {
#pragma unroll
                            for (int e = 0; e < 4; ++e) { v0[e] = silu_f(v0[e]); v1[e] = silu_f(v1[e]); }
                            st_bf16x8(Zs + row * 1024 + lc + 32 * bj, v0, v1);
                        } else { const int c = lc - 1024 + 32 * bj;
                            st_bf16x8(XBC + row * 1536 + c, v0, v1);
                            if (row < MP && (row & 127) >= 125) st_bf16x8(HIST + ((row >> 7) * 3 + ((row & 127) - 125)) * DCONV + c, v0, v1);
                            float* cs = nullptr;
                            if (row < MP) { const int t = (int)(row & (PSEQ - 1)); if (t >= PSEQ - 3) cs = out + O_PCONV + ((row >> 13) * 3 + (t - (PSEQ - 3))) * DCONV + c; }
                            else { const int sr = (int)(row - MP), t = sr & 15; if (t >= 13) cs = out + O_SCONV + ((sr >> 4) * 3 + (t - 13)) * DCONV + c; }
                            if (cs) { *(f32x4*)cs = v0; *(f32x4*)(cs + 4) = v1; } } } }
        } else if (pn < 14) {
            const bool isq = pn < 12; const float* w = isq ? qw : kw; const int hcol = lc - (isq ? 2560 : 3072);
#pragma unroll
            for (int ai = 0; ai < 2; ++ai)
#pragma unroll
                for (int m = 0; m < 4; ++m) { const int row = u.pm * BM + ai * HALF + wr * 64 + m * 16 + fr; float ss = 0.f;
#pragma unroll
                    for (int bj = 0; bj < 2; ++bj)
#pragma unroll
                        for (int n = 0; n < 2; ++n) { const f32x4 x = acc[ai][bj][m][n]; ss += (x[0] * x[0] + x[1] * x[1]) + (x[2] * x[2] + x[3] * x[3]); }
                    ss += __shfl_xor(ss, 16); ss += __shfl_xor(ss, 32);
                    const float rs = rsqrtf(ss * (1.0f / 64.0f) + EPSN); const float rq = isq ? rs * (0.125f * L2E) : rs;
#pragma unroll
                    for (int bj = 0; bj < 2; ++bj) { const f32x4 o0 = acc[ai][bj][m][0] * *(const f32x4*)(w + 32 * bj + 8 * fq), o1 = acc[ai][bj][m][1] * *(const f32x4*)(w + 32 * bj + 8 * fq + 4);
                        st_bf16x8((isq ? Qb : Kb) + row * 512 + hcol + 32 * bj, o0 * rq, o1 * rq);
                        if (!isq) { float* kp = (row < MP ? out + O_PK + row * 512 : out + O_SK + (row - MP) * 512) + hcol + 32 * bj; __builtin_nontemporal_store(o0 * rs, (f32x4*)kp); __builtin_nontemporal_store(o1 * rs, (f32x4*)(kp + 4)); }     } }
        } else if (pn < 16) {
            const int hcol = lc - 3584;
#pragma unroll
            for (int ai = 0; ai < 2; ++ai)
#pragma unroll
                for (int m = 0; m < 4; ++m) { const int row = u.pm * BM + ai * HALF + wr * 64 + m * 16 + fr;
#pragma unroll
                    for (int bj = 0; bj < 2; ++bj) { const f32x4 v0 = acc[ai][bj][m][0], v1 = acc[ai][bj][m][1];
                        st_bf16x8(Vb + row * 512 + hcol + 32 * bj, v0, v1);
                        float* vp = (row < MP ? out + O_PV + row * 512 : out + O_SV + (row - MP) * 512) + hcol + 32 * bj; __builtin_nontemporal_store(v0, (f32x4*)vp); __builtin_nontemporal_store(v1, (f32x4*)(vp + 4)); } }
        } else {
            if (wc == 0 && fq < 3) {
                const f32x4 b0 = fq < 2 ? *(const f32x4*)(dt_bias + 8 * fq) : *(const f32x4*)(f_bias), b1 = fq < 2 ? *(const f32x4*)(dt_bias + 8 * fq + 4) : *(const f32x4*)(f_bias + 4);
#pragma unroll
                for (int ai = 0; ai < 2; ++ai)
#pragma unroll
                    for (int m = 0; m < 4; ++m) { const int row = u.pm * BM + ai * HALF + wr * 64 + m * 16 + fr;
                        f32x4 v0 = acc[ai][0][m][0] + b0, v1 = acc[ai][0][m][1] + b1;
                        if (fq < 2) {
#pragma unroll
                            for (int e = 0; e < 4; ++e) { v0[e] = softplus_f(v0[e]); v1[e] = softplus_f(v1[e]); }
                            float* dp = DT + row * 16 + 8 * fq; *(f32x4*)dp = v0; *(f32x4*)(dp + 4) = v1;
                        } else {
#pragma unroll
                            for (int e = 0; e < 4; ++e) { v0[e] = logsigmoid_f(v0[e]); v1[e] = logsigmoid_f(v1[e]); }
                            float* lp = (row < MP ? out + O_PLF + row * 8 : out + O_SLF + (row - MP) * 8); *(f32x4*)lp = v0; *(f32x4*)(lp + 4) = v1; } }
            }
        }
    }
};
struct EpiOut {
    static constexpr bool PERM = true, AFTER_DRAIN = false, KHOOK = true;
    const float *xp, *xs; float* Y; bf16_t* X1b; float* SS1; const float* GSS;
    __device__ __forceinline__ void khook(f32x4 (&acc)[2][2][4][2], const Unit& u, int t, int wr, int fr) const {
#pragma unroll
        for (int ai = 0; ai < 2; ++ai)
#pragma unroll
            for (int m = 0; m < 4; ++m) { const int row = u.pm * BM + ai * HALF + wr * 64 + m * 16 + fr;
                const f32x4 gp = *(const f32x4*)(GSS + (unsigned)(row * 4)); const float g0 = gp[0] + gp[1], g1 = gp[2] + gp[3];
                const float r0 = rsqrtf(g0 * (1.0f / 512.0f) + EPSN), r1 = rsqrtf(g1 * (1.0f / 512.0f) + EPSN);
                const float f = (t == 8) ? r0 / r1 : r1;
#pragma unroll
                for (int bj = 0; bj < 2; ++bj)
#pragma unroll
                    for (int n = 0; n < 2; ++n) acc[ai][bj][m][n] *= f; }
    }
    __device__ __forceinline__ void operator()(const f32x4 (&acc)[2][2][4][2], const Unit& u, int wr, int wc, int fr, int fq) const {
        const int col0 = u.pn * BM + wc * 32 + 8 * fq; float ssv[8];
#pragma unroll
        for (int ai = 0; ai < 2; ++ai)
#pragma unroll
            for (int m = 0; m < 4; ++m) { const int row = u.pm * BM + ai * HALF + wr * 64 + m * 16 + fr;
                const float* xr = row < MP ? xp + row * 1024 : xs + (row - MP) * 1024; float ss = 0.f;
#pragma unroll
                for (int bj = 0; bj < 2; ++bj) { const int c = col0 + bj * HALF;
                    const f32x4 o0 = __builtin_nontemporal_load((const f32x4*)(xr + c)) + acc[ai][bj][m][0], o1 = __builtin_nontemporal_load((const f32x4*)(xr + c + 4)) + acc[ai][bj][m][1];
                    *(f32x4*)(Y + row * 1024 + c) = o0; *(f32x4*)(Y + row * 1024 + c + 4) = o1; st_bf16x8(X1b + row * 1024 + c, o0, o1);
                    ss += (o0[0] * o0[0] + o0[1] * o0[1]) + (o0[2] * o0[2] + o0[3] * o0[3]) + (o1[0] * o1[0] + o1[1] * o1[1]) + (o1[2] * o1[2] + o1[3] * o1[3]); }
                ss += __shfl_xor(ss, 16); ss += __shfl_xor(ss, 32);
                ssv[ai * 4 + m] = ss; }
        if (fq == 0) {
#pragma unroll
            for (int ai = 0; ai < 2; ++ai)
#pragma unroll
                for (int m = 0; m < 4; ++m) SS1[(unsigned)((u.pm * BM + ai * HALF + wr * 64 + m * 16 + fr) * 16 + u.pn * 4 + wc)] = ssv[ai * 4 + m]; }
    }
};
struct EpiUp {
    static constexpr bool PERM = true, AFTER_DRAIN = false, KHOOK = false;
    const float* SS1; bf16_t* H;
    __device__ __forceinline__ void operator()(const f32x4 (&acc)[2][2][4][2], const Unit& u, int wr, int wc, int fr, int fq) const {
        const int col0 = u.pn * BM + wc * 32 + 8 * fq;
#pragma unroll
        for (int ai = 0; ai < 2; ++ai)
#pragma unroll
            for (int m = 0; m < 4; ++m) { const int row = u.pm * BM + ai * HALF + wr * 64 + m * 16 + fr;
                const f32x4 s0 = *(const f32x4*)(SS1 + (unsigned)(row * 16)), s1 = *(const f32x4*)(SS1 + (unsigned)(row * 16 + 4)), s2 = *(const f32x4*)(SS1 + (unsigned)(row * 16 + 8)), s3 = *(const f32x4*)(SS1 + (unsigned)(row * 16 + 12));
                const f32x4 st = (s0 + s1) + (s2 + s3); const float r2 = 1.0f / (((st[0] + st[1]) + (st[2] + st[3])) * (1.0f / 1024.0f) + EPSN);
#pragma unroll
                for (int bj = 0; bj < 2; ++bj) { f32x4 v0 = acc[ai][bj][m][0], v1 = acc[ai][bj][m][1];
#pragma unroll
                    for (int e = 0; e < 4; ++e) { const float a = fmaxf(v0[e], 0.f), b = fmaxf(v1[e], 0.f); v0[e] = a * a * r2; v1[e] = b * b * r2; }
                    st_bf16x8(H + row * DFF + col0 + bj * HALF, v0, v1); } }
    }
};
struct EpiDown {
    static constexpr bool PERM = true, AFTER_DRAIN = false, KHOOK = false;
    float* Y;
    __device__ __forceinline__ void operator()(const f32x4 (&acc)[2][2][4][2], const Unit& u, int wr, int wc, int fr, int fq) const {
        const int col0 = u.pn * BM + wc * 32 + 8 * fq;
#pragma unroll
        for (int ai = 0; ai < 2; ++ai)
#pragma unroll
            for (int m = 0; m < 4; ++m) { const int row = u.pm * BM + ai * HALF + wr * 64 + m * 16 + fr;
#pragma unroll
                for (int bj = 0; bj < 2; ++bj) { float* p = Y + row * 1024 + col0 + bj * HALF;
                    const f32x4 o0 = *(const f32x4*)p + acc[ai][bj][m][0], o1 = *(const f32x4*)(p + 4) + acc[ai][bj][m][1]; __builtin_nontemporal_store(o0, (f32x4*)p); __builtin_nontemporal_store(o1, (f32x4*)(p + 4)); } }
    }
};
struct EpiDownPartial {
    static constexpr bool PERM = true, AFTER_DRAIN = false, KHOOK = false;
    float* PART;
    __device__ __forceinline__ void operator()(const f32x4 (&acc)[2][2][4][2], const Unit& u, int wr, int wc, int fr, int fq) const {
        const int col0 = u.pn * BM + wc * 32 + 8 * fq;
#pragma unroll
        for (int ai = 0; ai < 2; ++ai)
#pragma unroll
            for (int m = 0; m < 4; ++m) { const int row = (u.pm - MP / 256) * BM + ai * HALF + wr * 64 + m * 16 + fr;
#pragma unroll
                for (int bj = 0; bj < 2; ++bj) { float* p = PART + (unsigned)(row * 1024 + col0 + bj * HALF); *(f32x4*)p = acc[ai][bj][m][0]; *(f32x4*)(p + 4) = acc[ai][bj][m][1]; } }
    }
};
template <class Epi, class Sched, bool ALIGN_EPI = false, bool SP2 = false>
__device__ __forceinline__ void gemm_phase(PG8_LAS unsigned char* lds, const Gemm g, const Sched& S, const Epi& E) {
    int tid_ = threadIdx.x; asm volatile("" : "+v"(tid_));
    const int tid = tid_, wid = __builtin_amdgcn_readfirstlane(tid >> 6), lane = tid & 63, wr = wid >> 2, wc = wid & 3, fr = lane & 15, fq = lane >> 4;
    const int K = g.K; int nt_ = g.nt ? g.nt : K / BK; asm volatile("" : "+s"(nt_)); const int nt = nt_;
    unsigned voffA[2], voffB[2];
#pragma unroll
    for (int i = 0; i < 2; ++i) { int R, C; stage_rc(tid * 16 + i * 8192, R, C); const int Rb = Epi::PERM ? ((R & ~31) + perm32(R & 31)) : R;
        voffA[i] = (unsigned)(R * K + C) * 2u; voffB[i] = (unsigned)(Rb * K + C) * 2u; }
    const size_t kstep = (size_t)(BK * 2);
    const size_t hstep = (size_t)HALF * K * 2;
    const size_t tstep = 2 * hstep;
    const unsigned ldsw = (unsigned)wid * 1024u;
    const int aoff = lds_byte(wr * 64 + fr, fq * 8), boff = lds_byte(wc * 32 + fr, fq * 8);
#define PG8_SA(b, h) (((b) * 2 + (h)) * HTB)
#define PG8_SB(b, h) ((4 + (b) * 2 + (h)) * HTB)
#define PG8_STAGE(bufoff, gbase, voff) do { _Pragma("unroll") for (int _i = 0; _i < 2; ++_i) \
        __builtin_amdgcn_global_load_lds((const unsigned*)((const char*)(gbase) + (voff)[_i]), (PG8_LAS unsigned*)(lds + (bufoff) + ldsw + _i * 8192), 16, 0, 0); } while (0)
#define PG8_LDA(dst, b, h) do { _Pragma("unroll") for (int m = 0; m < 4; ++m) _Pragma("unroll") for (int k = 0; k < 2; ++k) dst[m][k] = *(const PG8_LAS bf16x8*)(lds + PG8_SA(b, h) + aoff + m * 2048 + k * 1024); } while (0)
#define PG8_LDB(dst, b, h) do { _Pragma("unroll") for (int n = 0; n < 2; ++n) _Pragma("unroll") for (int k = 0; k < 2; ++k) dst[n][k] = *(const PG8_LAS bf16x8*)(lds + PG8_SB(b, h) + boff + n * 2048 + k * 1024); } while (0)
#define PG8_MMA(ai, bj, At, Bt) do { __builtin_amdgcn_s_setprio(1); _Pragma("unroll") for (int m = 0; m < 4; ++m) _Pragma("unroll") for (int n = 0; n < 2; ++n) _Pragma("unroll") for (int k = 0; k < 2; ++k) \
        acc[ai][bj][m][n] = __builtin_amdgcn_mfma_f32_16x16x32_bf16(Bt[n][k], At[m][k], acc[ai][bj][m][n], 0, 0, 0); __builtin_amdgcn_s_setprio(0); } while (0)
#define PG8_WAIT_V(n) asm volatile("s_waitcnt vmcnt(" #n ")" ::: "memory")
#define PG8_WAIT_L(n) asm volatile("s_waitcnt lgkmcnt(" #n ")" ::: "memory")
#define PG8_BAR __builtin_amdgcn_s_barrier()
#define PG8_SCHED __builtin_amdgcn_sched_barrier(0)
    Unit cur, nxt; int ui = 0;
    if (!S.next(0, cur)) return;
    f32x4 acc[2][2][4][2];
#pragma unroll
    for (int a = 0; a < 2; ++a)
#pragma unroll
        for (int b = 0; b < 2; ++b)
#pragma unroll
            for (int m = 0; m < 4; ++m)
#pragma unroll
                for (int n = 0; n < 2; ++n) acc[a][b][m][n] = (f32x4){0.f, 0.f, 0.f, 0.f};
    bf16x8 At[4][2], B0[2][2], B1[2][2];
    const char* cA = (const char*)g.A + (size_t)cur.pm * tstep + (size_t)cur.k0 * 2; const char* cB = (const char*)g.Bt + (size_t)cur.pn * tstep + (size_t)cur.k0 * 2;
    S.a_ready(cur);
    if constexpr (SP2) {
        PG8_STAGE(PG8_SB(0, 0), cB, voffB); PG8_STAGE(PG8_SB(0, 1), cB + hstep, voffB); PG8_STAGE(PG8_SA(0, 0), cA, voffA); PG8_STAGE(PG8_SA(0, 1), cA + hstep, voffA);
        if (wr == 1) PG8_BAR;
        PG8_WAIT_V(2); PG8_BAR;
        PG8_STAGE(PG8_SB(1, 0), cB + kstep, voffB); PG8_STAGE(PG8_SA(1, 0), cA + kstep, voffA); PG8_STAGE(PG8_SB(1, 1), cB + hstep + kstep, voffB);
        PG8_WAIT_V(6); PG8_BAR;
    } else {
        PG8_STAGE(PG8_SB(0, 0), cB, voffB); PG8_STAGE(PG8_SA(0, 0), cA, voffA); PG8_STAGE(PG8_SB(0, 1), cB + hstep, voffB); PG8_STAGE(PG8_SA(0, 1), cA + hstep, voffA);
        if (wr == 1) PG8_BAR;
        PG8_WAIT_V(4); PG8_BAR;
        PG8_STAGE(PG8_SB(1, 0), cB + kstep, voffB); PG8_STAGE(PG8_SA(1, 0), cA + kstep, voffA); PG8_STAGE(PG8_SB(1, 1), cB + hstep + kstep, voffB);
        PG8_WAIT_V(6); PG8_BAR;
    }
    for (;;) {
        const bool has_next = S.next(ui + 1, nxt);
        const char* nA = has_next ? (const char*)g.A + (size_t)nxt.pm * tstep + (size_t)nxt.k0 * 2 : cA; const char* nB = has_next ? (const char*)g.Bt + (size_t)nxt.pn * tstep + (size_t)nxt.k0 * 2 : cB;
        for (int t = 0; t < nt; t += 2) {
            if constexpr (Epi::KHOOK) { if (t == 8 || t == 16) E.khook(acc, cur, t, wr, fr); }
            const bool last = (t == nt - 2);
            const char* a1 = cA + (size_t)(t + 1) * kstep;
            const char* a2 = last ? nA : cA + (size_t)(t + 2) * kstep; const char* b2 = last ? nB : cB + (size_t)(t + 2) * kstep;
            const char* a3 = a2 + kstep; const char* b3 = b2 + kstep;
            if (last && has_next) S.a_ready(nxt);
            if constexpr (SP2) {
            PG8_LDB(B0, 0, 0); PG8_LDB(B1, 0, 1); PG8_SCHED; PG8_LDA(At, 0, 0); PG8_STAGE(PG8_SA(1, 1), a1 + hstep, voffA);
            PG8_WAIT_V(8); PG8_WAIT_L(0); PG8_BAR; PG8_MMA(0, 0, At, B0); PG8_MMA(0, 1, At, B1); PG8_BAR; PG8_SCHED;
            PG8_LDA(At, 0, 1); PG8_STAGE(PG8_SB(0, 0), b2, voffB); PG8_STAGE(PG8_SB(0, 1), b2 + hstep, voffB); PG8_STAGE(PG8_SA(0, 0), a2, voffA);
            PG8_WAIT_V(8); PG8_WAIT_L(0); PG8_BAR; PG8_MMA(1, 0, At, B0); PG8_MMA(1, 1, At, B1); PG8_BAR; PG8_SCHED;
            PG8_LDB(B0, 1, 0); PG8_LDB(B1, 1, 1); PG8_SCHED; PG8_LDA(At, 1, 0); PG8_STAGE(PG8_SA(0, 1), a2 + hstep, voffA);
            PG8_WAIT_V(8); PG8_WAIT_L(0); PG8_BAR; PG8_MMA(0, 0, At, B0); PG8_MMA(0, 1, At, B1); PG8_BAR; PG8_SCHED;
            PG8_LDA(At, 1, 1); PG8_STAGE(PG8_SB(1, 0), b3, voffB); PG8_STAGE(PG8_SB(1, 1), b3 + hstep, voffB); PG8_STAGE(PG8_SA(1, 0), a3, voffA);
            PG8_WAIT_V(8); PG8_WAIT_L(0); PG8_BAR; PG8_MMA(1, 0, At, B0); PG8_MMA(1, 1, At, B1); PG8_BAR; PG8_SCHED;
            } else {
            PG8_LDB(B0, 0, 0); PG8_SCHED; PG8_LDA(At, 0, 0); PG8_STAGE(PG8_SA(1, 1), a1 + hstep, voffA);
            PG8_WAIT_L(8); PG8_BAR; PG8_WAIT_L(0); PG8_MMA(0, 0, At, B0); PG8_BAR; PG8_SCHED;
            PG8_LDB(B1, 0, 1); PG8_STAGE(PG8_SB(0, 0), b2, voffB);
            PG8_BAR; PG8_WAIT_L(0); PG8_MMA(0, 1, At, B1); PG8_BAR;
            PG8_LDA(At, 0, 1); PG8_STAGE(PG8_SA(0, 0), a2, voffA);
            PG8_BAR; PG8_WAIT_L(0); PG8_MMA(1, 0, At, B0); PG8_BAR; PG8_SCHED;
            PG8_STAGE(PG8_SB(0, 1), b2 + hstep, voffB);
            PG8_WAIT_V(6); PG8_BAR; PG8_MMA(1, 1, At, B1); PG8_BAR;
            PG8_LDB(B0, 1, 0); PG8_SCHED; PG8_LDA(At, 1, 0); PG8_STAGE(PG8_SA(0, 1), a2 + hstep, voffA);
            PG8_WAIT_L(8); PG8_BAR; PG8_WAIT_L(0); PG8_MMA(0, 0, At, B0); PG8_BAR; PG8_SCHED;
            PG8_LDB(B1, 1, 1); PG8_STAGE(PG8_SB(1, 0), b3, voffB);
            PG8_BAR; PG8_WAIT_L(0); PG8_MMA(0, 1, At, B1); PG8_BAR;
            PG8_LDA(At, 1, 1); PG8_STAGE(PG8_SA(1, 0), a3, voffA);
            PG8_BAR; PG8_WAIT_L(0); PG8_MMA(1, 0, At, B0); PG8_BAR; PG8_SCHED;
            PG8_STAGE(PG8_SB(1, 1), b3 + hstep, voffB);
            PG8_WAIT_V(6); PG8_BAR; PG8_MMA(1, 1, At, B1); PG8_BAR;
            }
        }
        if constexpr (ALIGN_EPI) { if (wr == 0) PG8_BAR; }
        if constexpr (!Epi::AFTER_DRAIN) { E(acc, cur, wr, wc, fr, fq); S.done(cur); }
        if (!has_next) break;
#pragma unroll
        for (int a = 0; a < 2; ++a)
#pragma unroll
            for (int b = 0; b < 2; ++b)
#pragma unroll
                for (int m = 0; m < 4; ++m)
#pragma unroll
                    for (int n = 0; n < 2; ++n) acc[a][b][m][n] = (f32x4){0.f, 0.f, 0.f, 0.f};
        cur = nxt; cA = nA; cB = nB; ++ui;
        if constexpr (ALIGN_EPI) { if (wr == 1) PG8_BAR; }
    }
    PG8_WAIT_V(0);
    if constexpr (!ALIGN_EPI) { if (wr == 0) PG8_BAR; }
    PG8_BAR;
    if constexpr (Epi::AFTER_DRAIN) { E.fused(acc, cur, wr, wc, fr, fq, lds, wid, lane); S.done(cur); }
#undef PG8_SA
#undef PG8_SB
#undef PG8_STAGE
#undef PG8_LDA
#undef PG8_LDB
#undef PG8_MMA
#undef PG8_WAIT_V
#undef PG8_WAIT_L
#undef PG8_BAR
#undef PG8_SCHED
}
}
#include <hip/hip_bf16.h>
#include <cmath>
namespace attn_body {
using bf16=__hip_bfloat16;
using bf16x8=__attribute__((ext_vector_type(8)))short;
using s16x4=__attribute__((ext_vector_type(4)))short;
using f32x16=__attribute__((ext_vector_type(16)))float;
using u32x4=__attribute__((ext_vector_type(4)))unsigned;
constexpr int BATCH=8,NHEAD=8,SEQ=8192,D=64,DM=NHEAD*D,OP=1536;
constexpr int NW=8,QBLK=32,QB=QBLK*NW,KVBLK=64,NQB=SEQ/QB;
constexpr int ATTN_PITCH=DM, ATTN_UNIT_ROWS=QB;
__device__ __forceinline__ int crow(int r,int hi){return (r&3)+8*(r>>2)+4*hi;}
#define SBAR() __builtin_amdgcn_sched_barrier(0)
__device__ __forceinline__ void cmask(f32x16&p0,f32x16&p1,int jb,int qrel,int hi){
  const float NEG=-INFINITY; int kb=64*jb+4*hi;
  #pragma unroll
  for(int r=0;r<16;++r){int kv=kb+(r&3)+8*(r>>2); if(kv>qrel)p0[r]=NEG; if(kv+32>qrel)p1[r]=NEG;}
}

constexpr int NSLOT=3, SLOTB=8192;
constexpr int LDS_K=0, LDS_V=NSLOT*SLOTB, LDS_WS=2*NSLOT*SLOTB, LDS_OST=LDS_WS+NW*64*4, LDS_C=LDS_OST+NW*4096, LDS_BYTES=LDS_C+SEQ*4;
constexpr float SKIP_L2=64.0f*1.4426950408889634f;
constexpr float C2=0.125f*1.4426950408889634f;
__device__ __forceinline__ void glds16(const void*gsrc,unsigned lds_dst){unsigned keep;
  asm volatile("s_mov_b32 %0, m0\n\ts_mov_b32 m0, %2\n\ts_nop 0\n\tglobal_load_lds_dwordx4 %1, off\n\ts_mov_b32 m0, %0":"=&s"(keep):"v"(gsrc),"s"(lds_dst):"memory");}
__device__ __forceinline__ float max3f(float a,float b,float c){float r;asm("v_max3_f32 %0, %1, %2, %3":"=v"(r):"v"(a),"v"(b),"v"(c));return r;}
__device__ __forceinline__ float max2f(float a,float b){float r;asm("v_max_f32_e32 %0, %1, %2":"=v"(r):"v"(a),"v"(b));return r;}
__device__ __forceinline__ float fadd_s(float a,float b){float r;asm("v_add_f32_e32 %0, %1, %2":"=v"(r):"v"(a),"v"(b));return r;}
__device__ __forceinline__ float fsub_s(float a,float b){float r;asm("v_sub_f32_e32 %0, %1, %2":"=v"(r):"v"(a),"v"(b));return r;}
typedef float f32x2_t __attribute__((ext_vector_type(2))); typedef __bf16 bf16x2_t __attribute__((ext_vector_type(2)));
__device__ __forceinline__ unsigned cvtpk_s(float lo,float hi){f32x2_t v={lo,hi};bf16x2_t b=__builtin_convertvector(v,bf16x2_t);return __builtin_bit_cast(unsigned,b);}
#define WAIT_BAR(N) asm volatile("s_waitcnt vmcnt(" #N ") lgkmcnt(0)\n\ts_barrier":::"memory")

__device__ __forceinline__ void qkt(f32x16&p0,f32x16&p1,const char*Kslot,const bf16x8*qr,const f32x16&cin0,const f32x16&cin1,int r32,int hi){
  const char*kb=Kslot+hi*1024+r32*16;
  #pragma unroll
  for(int d0=0;d0<4;++d0){
    const bf16x8 b0=*reinterpret_cast<const bf16x8*>(kb+d0*2048);
    const bf16x8 b1=*reinterpret_cast<const bf16x8*>(kb+d0*2048+512);
    if(d0==0){p0=__builtin_amdgcn_mfma_f32_32x32x16_bf16(b0,qr[0],cin0,0,0,0);p1=__builtin_amdgcn_mfma_f32_32x32x16_bf16(b1,qr[0],cin1,0,0,0);}
    else{p0=__builtin_amdgcn_mfma_f32_32x32x16_bf16(b0,qr[d0],p0,0,0,0);p1=__builtin_amdgcn_mfma_f32_32x32x16_bf16(b1,qr[d0],p1,0,0,0);}}
}
typedef __attribute__((address_space(3))) const char* lds_cptr;
typedef short v4i16_t __attribute__((ext_vector_type(4)));
__device__ __forceinline__ void kload8(bf16x8*kf,lds_cptr kp){
  kf[0]=*(const __attribute__((address_space(3))) bf16x8*)(kp);      kf[1]=*(const __attribute__((address_space(3))) bf16x8*)(kp+512);
  kf[2]=*(const __attribute__((address_space(3))) bf16x8*)(kp+2048); kf[3]=*(const __attribute__((address_space(3))) bf16x8*)(kp+2560);
  kf[4]=*(const __attribute__((address_space(3))) bf16x8*)(kp+4096); kf[5]=*(const __attribute__((address_space(3))) bf16x8*)(kp+4608);
  kf[6]=*(const __attribute__((address_space(3))) bf16x8*)(kp+6144); kf[7]=*(const __attribute__((address_space(3))) bf16x8*)(kp+6656);
}
__device__ __forceinline__ void kload2(bf16x8*kf,lds_cptr kp,int j){ kf[2*j]=*(const __attribute__((address_space(3))) bf16x8*)(kp+j*2048); kf[2*j+1]=*(const __attribute__((address_space(3))) bf16x8*)(kp+j*2048+512); }
__device__ __forceinline__ s16x4 vtr(lds_cptr p){ return __builtin_bit_cast(s16x4,__builtin_amdgcn_ds_read_tr16_b64_v4i16((__attribute__((address_space(3))) v4i16_t*)p)); }
__device__ __forceinline__ float rowmax(const f32x16&p0,const f32x16&p1){
  float a=max3f(p0[0],p0[1],p1[0]),b=max3f(p0[2],p0[3],p1[1]);a=max3f(a,p1[2],p1[3]);
  #pragma unroll
  for(int r=4;r<16;r+=4){a=max3f(a,p0[r],p0[r+1]);b=max3f(b,p0[r+2],p0[r+3]);a=max3f(a,p1[r],p1[r+1]);b=max3f(b,p1[r+2],p1[r+3]);}
  const float m=max2f(a,b);
  auto rr=__builtin_amdgcn_permlane32_swap(__float_as_uint(m),__float_as_uint(m),false,false);
  return max2f(__uint_as_float(rr[0]),__uint_as_float(rr[1]));
}
__device__ __forceinline__ void pv(f32x16*o,int vb,bf16x8 pa0,bf16x8 pa1,bf16x8 pa2,bf16x8 pa3){
  #pragma unroll
  for(int d0=0;d0<2;++d0){s16x4 lo[4],hi[4];
    #pragma unroll
    for(int ks=0;ks<4;++ks){
      asm volatile("ds_read_b64_tr_b16 %0,%1 offset:%c2":"=&v"(lo[ks]):"v"(vb),"i"(d0*4096+ks*1024):"memory");
      asm volatile("ds_read_b64_tr_b16 %0,%1 offset:%c2":"=&v"(hi[ks]):"v"(vb),"i"(d0*4096+ks*1024+512):"memory");}
    asm volatile("s_waitcnt lgkmcnt(0)":::"memory");SBAR();
    #define PK(k) (bf16x8){lo[k][0],lo[k][1],lo[k][2],lo[k][3],hi[k][0],hi[k][1],hi[k][2],hi[k][3]}
    o[d0]=__builtin_amdgcn_mfma_f32_32x32x16_bf16(pa0,PK(0),o[d0],0,0,0);
    o[d0]=__builtin_amdgcn_mfma_f32_32x32x16_bf16(pa1,PK(1),o[d0],0,0,0);
    o[d0]=__builtin_amdgcn_mfma_f32_32x32x16_bf16(pa2,PK(2),o[d0],0,0,0);
    o[d0]=__builtin_amdgcn_mfma_f32_32x32x16_bf16(pa3,PK(3),o[d0],0,0,0);
    #undef PK
  }
}

#ifndef ATTN_STORE16
#define ATTN_STORE16(p,v) (*(u32x4*)(p)=(v))
#endif
template<int THRL> __device__ __forceinline__ void attn_unit(int b,int h,int qb,const bf16*Q,const bf16*__restrict__ K,const bf16*__restrict__ V,bf16*O,const float*__restrict__ CPL,float skipl2,char*shm){
  int tid_=threadIdx.x; asm volatile("":"+v"(tid_)); const int tid=tid_,lane=tid&63,r32=lane&31,hi=lane>>5; const int wid=__builtin_amdgcn_readfirstlane(tid>>6);
  const long rowbase=(long)b*SEQ; const int q0=qb*QB;
  const bf16*Qw=Q+(rowbase+q0+wid*QBLK)*DM+h*D;
  const float*cg=CPL+((long)(b*NHEAD+h))*SEQ; const int NTF=(q0+QB)/KVBLK; int tst;
  { const float c0=cg[q0]; const int t1=lane,t2=lane+64;
    const bool s1=(t1<NTF-4)&&((c0-cg[64*t1+63])<-skipl2), s2=(t2<NTF-4)&&((c0-cg[64*t2+63])<-skipl2);
    tst=(__builtin_popcountll(__ballot(s1))+__builtin_popcountll(__ballot(s2)))&~1; tst=__builtin_amdgcn_readfirstlane(tst); }
  const bf16*Kh=K+(rowbase+(long)tst*KVBLK)*DM+h*D,*Vh=V+(rowbase+(long)tst*KVBLK)*DM+h*D;
  const unsigned lds0=(unsigned)(uintptr_t)shm;
  float*wsf=(float*)(shm+LDS_WS)+wid*64;
  const bf16*ksrc=Kh+(long)lane*DM+wid*8;
  const bf16*vsrc=Vh+(long)(16*(wid&3)+(lane>>2))*DM+(wid>>2)*32+(lane&3)*8;
  const unsigned kdst=lds0+LDS_K+wid*1024, vdst=lds0+LDS_V+wid*1024;
  #define DMA_K(t,slot) glds16(ksrc+(long)(t)*KVBLK*DM,(unsigned)__builtin_amdgcn_readfirstlane(kdst+(slot)))
  #define DMA_V(t,slot) glds16(vsrc+(long)(t)*KVBLK*DM,(unsigned)__builtin_amdgcn_readfirstlane(vdst+(slot)))
  const int vb0=(int)(lds0+LDS_V)+((lane>>4)&1)*32+(lane&3)*8+(4*hi+((lane&15)>>2))*64;
  const char*Kbase=shm+LDS_K; bf16x8 kf[8];
  const lds_cptr shm3=(lds_cptr)shm; const lds_cptr kp0=shm3+LDS_K+hi*1024+r32*16; const lds_cptr vp0=shm3+LDS_V+((lane>>4)&1)*32+(lane&3)*8+(4*hi+((lane&15)>>2))*64;
  const int NT=NTF-tst;
  float*cL=(float*)(shm+LDS_C);
  for(int i=tid;i<NT*KVBLK/4;i+=NW*64){ *(float4*)(cL+4*i)=*(const float4*)(cg+tst*KVBLK+4*i); }
  const float cq=cg[q0+wid*QBLK+r32]; float qm=cq;
  asm volatile("s_waitcnt vmcnt(0) lgkmcnt(0)":::"memory");
  DMA_K(0,0);DMA_V(0,0);DMA_K(1,SLOTB);
  bf16x8 qr[4];
  #pragma unroll
  for(int d0=0;d0<4;++d0)qr[d0]=*reinterpret_cast<const bf16x8*>(&Qw[(long)r32*DM+d0*16+hi*8]);
  float mhat=0.f,l_reg=0.f;f32x16 o[2];o[0]=f32x16{};o[1]=f32x16{};f32x16 cb0,cb1;
  const int qrel=wid*QBLK+r32;
  #define CBIAS(t) do{ const float*cp_=cL+(t)*KVBLK+4*hi; \
    _Pragma("unroll") for(int i_=0;i_<4;++i_){ const float4 u0_=*(const float4*)(cp_+8*i_), u1_=*(const float4*)(cp_+32+8*i_); \
      cb0[4*i_]=qm-u0_.x;cb0[4*i_+1]=qm-u0_.y;cb0[4*i_+2]=qm-u0_.z;cb0[4*i_+3]=qm-u0_.w; \
      cb1[4*i_]=qm-u1_.x;cb1[4*i_+1]=qm-u1_.y;cb1[4*i_+2]=qm-u1_.z;cb1[4*i_+3]=qm-u1_.w; } }while(0)
  #define CMASK(P0,P1,t) do{int jb_=(t)-(NT-4); if(jb_>=0)cmask(P0,P1,jb_,qrel,hi);}while(0)
  bool resc=false;
  #define START(P0,P1) do{ const float rm=rowmax(P0,P1); resc=false; \
    { const float dl=rm; mhat=fadd_s(mhat,dl); \
      _Pragma("unroll") for(int r=0;r<16;++r){P0[r]=fsub_s(P0[r],dl);P1[r]=fsub_s(P1[r],dl);} \
      qm=cq-mhat; } \
    _Pragma("unroll") for(int r=0;r<16;++r)P0[r]=__builtin_amdgcn_exp2f(P0[r]); }while(0)
  #define RESC() do{ if(resc){ asm volatile("s_waitcnt lgkmcnt(0)":::"memory"); \
      _Pragma("unroll") for(int d_=0;d_<2;++d_) _Pragma("unroll") for(int r=0;r<16;++r)o[d_][r]*=wsf[crow(r,hi)]; } }while(0)
  f32x16 pA0,pA1,pB0,pB1;
  int sl_prev=0,sl_cur=0,sl_next=SLOTB;
  #define ROT() do{sl_prev=sl_cur;sl_cur=sl_next;sl_next=(sl_next==(NSLOT-1)*SLOTB)?0:sl_next+SLOTB;}while(0)
  DMA_K(2,2*SLOTB);
  WAIT_BAR(3);
  CBIAS(0); qkt(pA0,pA1,Kbase,qr,cb0,cb1,r32,hi);asm volatile("s_nop 15\n\ts_nop 7":"+v"(pA0),"+v"(pA1));CMASK(pA0,pA1,0);
  START(pA0,pA1);
  _Pragma("unroll") for(int r=0;r<16;++r)pA1[r]=__builtin_amdgcn_exp2f(pA1[r]);
  WAIT_BAR(0);
  DMA_K(3,0);DMA_V(1,SLOTB);
  ROT();
  kload8(kf,kp0+sl_cur);
  WAIT_BAR(2);
  s16x4 vlo[8],vhi[8]; u32x4 pw0,pw1,pw2,pw3;
  #define PKW(P,B) cvtpk_s(P[B],P[B+1])
  #define PAF(k) __builtin_bit_cast(bf16x8,pw##k)
  #define VFR(i) (bf16x8){vlo[i][0],vlo[i][1],vlo[i][2],vlo[i][3],vhi[i][0],vhi[i][1],vhi[i][2],vhi[i][3]}
  #define PIN(x) asm volatile("":"+v"(x))
  #define MX3(a,b,c) __builtin_fmaxf(__builtin_fmaxf((a),(b)),(c))
  #define GAPA(MF,A0,A1,A2,A3,W0,W1,PW) do{ MF; sacc+=A0; sacc+=A1; sacc+=A2; sacc+=A3; PIN(sacc); W0; W1; PIN(PW); SBAR(); }while(0)
  #define EX(v) __builtin_amdgcn_exp2f(v)
  #define GAPB(MF,X,B) do{ MF; X[B]=EX(X[B]); X[B+1]=EX(X[B+1]); X[B+2]=EX(X[B+2]); X[B+3]=EX(X[B+3]); PIN(X); SBAR(); }while(0)
  #define VRD(i) do{ vlo[i]=vtr(vp_+(((i)>>2)*4096+((i)&3)*1024)); vhi[i]=vtr(vp_+(((i)>>2)*4096+((i)&3)*1024+512)); }while(0)
  #define KRD(G,j) do{ if(G){ kload2(kf,kp0+sl_next,j); SBAR(); } }while(0)
  #define STEP(C0,C1,P0,P1,t,GK,GV,GL) do{ SBAR(); CBIAS(t); SBAR(); \
    const lds_cptr vp_=vp0+sl_prev; \
    VRD(0); SBAR(); float sacc=(P0[0]+P0[1]); \
    GAPA(C0=__builtin_amdgcn_mfma_f32_32x32x16_bf16(kf[0],qr[0],cb0,0,0,0), P0[2],P0[3],P0[4],P0[5],     pw0[0]=PKW(P0,0), pw0[1]=PKW(P0,2), pw0); \
    VRD(4); SBAR(); GAPA(C1=__builtin_amdgcn_mfma_f32_32x32x16_bf16(kf[1],qr[0],cb1,0,0,0), P0[6],P0[7],P0[8],P0[9],     pw0[2]=PKW(P0,4), pw0[3]=PKW(P0,6), pw0); \
    VRD(1); SBAR(); GAPA(C0=__builtin_amdgcn_mfma_f32_32x32x16_bf16(kf[2],qr[1],C0,0,0,0),   P0[10],P0[11],P0[12],P0[13], pw1[0]=PKW(P0,8), pw1[1]=PKW(P0,10), pw1); \
    VRD(5); SBAR(); GAPA(C1=__builtin_amdgcn_mfma_f32_32x32x16_bf16(kf[3],qr[1],C1,0,0,0),   P0[14],P0[15],P1[0],P1[1],   pw1[2]=PKW(P0,12),pw1[3]=PKW(P0,14), pw1); \
    VRD(2); SBAR(); GAPA(C0=__builtin_amdgcn_mfma_f32_32x32x16_bf16(kf[4],qr[2],C0,0,0,0),   P1[2],P1[3],P1[4],P1[5],     pw2[0]=PKW(P1,0), pw2[1]=PKW(P1,2), pw2); \
    VRD(6); SBAR(); GAPA(C1=__builtin_amdgcn_mfma_f32_32x32x16_bf16(kf[5],qr[2],C1,0,0,0),   P1[6],P1[7],P1[8],P1[9],     pw2[2]=PKW(P1,4), pw2[3]=PKW(P1,6), pw2); \
    VRD(3); SBAR(); GAPA(C0=__builtin_amdgcn_mfma_f32_32x32x16_bf16(kf[6],qr[3],C0,0,0,0),   P1[10],P1[11],P1[12],P1[13], pw3[0]=PKW(P1,8), pw3[1]=PKW(P1,10), pw3); \
    VRD(7); SBAR(); GAPA(C1=__builtin_amdgcn_mfma_f32_32x32x16_bf16(kf[7],qr[3],C1,0,0,0),   P1[14],P1[15],0.f,0.f,       pw3[2]=PKW(P1,12),pw3[3]=PKW(P1,14), pw3); \
    l_reg+=sacc; \
    if(GK){DMA_K((t)+3,sl_cur);} if(GV){DMA_V((t)+1,sl_next);} \
    CMASK(C0,C1,t); \
    { float a=MX3(C0[0],C0[1],C1[0]),b=MX3(C0[2],C0[3],C1[1]); a=MX3(a,C1[2],C1[3]); \
      _Pragma("unroll") for(int r=4;r<16;r+=4){a=MX3(a,C0[r],C0[r+1]);b=MX3(b,C0[r+2],C0[r+3]);a=MX3(a,C1[r],C1[r+1]);b=MX3(b,C1[r+2],C1[r+3]);} \
      float rm=__builtin_fmaxf(a,b); { auto rr=__builtin_amdgcn_permlane32_swap(__float_as_uint(rm),__float_as_uint(rm),false,false); rm=__builtin_fmaxf(__uint_as_float(rr[0]),__uint_as_float(rr[1])); } \
      resc=false; \
      if(__builtin_expect(__any(rm>(float)THRL),0)){ const float dl=__builtin_fmaxf(rm,0.f); mhat+=dl; \
        _Pragma("unroll") for(int r=0;r<16;++r){C0[r]-=dl;C1[r]-=dl;} \
        qm=cq-mhat; \
        const float f=__builtin_amdgcn_exp2f(-dl); l_reg*=f; if(hi==0)wsf[r32]=f; resc=true; } } \
    SBAR(); \
    GAPB(o[0]=__builtin_amdgcn_mfma_f32_32x32x16_bf16(PAF(0),VFR(0),o[0],0,0,0), C0,0); \
    GAPB(o[1]=__builtin_amdgcn_mfma_f32_32x32x16_bf16(PAF(0),VFR(4),o[1],0,0,0), C0,4); \
    KRD(GL,0); GAPB(o[0]=__builtin_amdgcn_mfma_f32_32x32x16_bf16(PAF(1),VFR(1),o[0],0,0,0), C0,8); \
    KRD(GL,1); GAPB(o[1]=__builtin_amdgcn_mfma_f32_32x32x16_bf16(PAF(1),VFR(5),o[1],0,0,0), C0,12); \
    KRD(GL,2); GAPB(o[0]=__builtin_amdgcn_mfma_f32_32x32x16_bf16(PAF(2),VFR(2),o[0],0,0,0), C1,0); \
    KRD(GL,3); GAPB(o[1]=__builtin_amdgcn_mfma_f32_32x32x16_bf16(PAF(2),VFR(6),o[1],0,0,0), C1,4); \
    GAPB(o[0]=__builtin_amdgcn_mfma_f32_32x32x16_bf16(PAF(3),VFR(3),o[0],0,0,0), C1,8); \
    GAPB(o[1]=__builtin_amdgcn_mfma_f32_32x32x16_bf16(PAF(3),VFR(7),o[1],0,0,0), C1,12); \
    }while(0)
  int t=1;
  #undef CMASK
  #define CMASK(P0,P1,t) do{}while(0)
  for(;t+5<NT;t+=2){
    STEP(pB0,pB1,pA0,pA1,t,true,true,true);     WAIT_BAR(2); RESC(); ROT();
    STEP(pA0,pA1,pB0,pB1,t+1,true,true,true);   WAIT_BAR(2); RESC(); ROT();
  }
  #undef CMASK
  #define CMASK(P0,P1,t) do{int jb_=(t)-(NT-4); if(jb_>=0)cmask(P0,P1,jb_,qrel,hi);}while(0)
  #define ENDW(tt) do{ if((tt)+3<NT){WAIT_BAR(2);} else if((tt)+2<NT){WAIT_BAR(1);} else {WAIT_BAR(0);} }while(0)
  for(;t+1<NT;t+=2){
    STEP(pB0,pB1,pA0,pA1,t,(t+3<NT),(t+1<NT),(t+1<NT));       ENDW(t);   RESC(); ROT();
    STEP(pA0,pA1,pB0,pB1,t+1,(t+4<NT),(t+2<NT),(t+2<NT));     ENDW(t+1); RESC(); ROT();
  }
  STEP(pB0,pB1,pA0,pA1,NT-1,false,false,false); RESC();
  { float sacc=pB0[0]+pB0[1]; _Pragma("unroll") for(int r=2;r<16;++r)sacc+=pB0[r]; _Pragma("unroll") for(int r=0;r<16;++r)sacc+=pB1[r]; l_reg+=sacc;
    pw0=(u32x4){PKW(pB0,0),PKW(pB0,2),PKW(pB0,4),PKW(pB0,6)};pw1=(u32x4){PKW(pB0,8),PKW(pB0,10),PKW(pB0,12),PKW(pB0,14)};pw2=(u32x4){PKW(pB1,0),PKW(pB1,2),PKW(pB1,4),PKW(pB1,6)};pw3=(u32x4){PKW(pB1,8),PKW(pB1,10),PKW(pB1,12),PKW(pB1,14)};
    SBAR(); pv(o,vb0+sl_cur,PAF(0),PAF(1),PAF(2),PAF(3)); }
  #undef PKW
  #undef PAF
  #undef VFR
  #undef PIN
  #undef MX3
  #undef GAPA
  #undef GAPB
  #undef EX
  #undef VRD
  #undef KRD
  #undef STEP
  #undef ENDW
  {auto rr=__builtin_amdgcn_permlane32_swap(__float_as_uint(l_reg),__float_as_uint(l_reg),false,false);l_reg=__uint_as_float(rr[0])+__uint_as_float(rr[1]);}
  if(hi==0)wsf[32+r32]=l_reg;asm volatile("s_waitcnt lgkmcnt(0)":::"memory");
  float rli[16];
  #pragma unroll
  for(int r=0;r<16;++r)rli[r]=__builtin_amdgcn_rcpf(wsf[32+crow(r,hi)]);
  bf16*Ow=O+(rowbase+q0+wid*QBLK)*OP+h*D;
  { bf16*stg=(bf16*)(shm+LDS_OST)+wid*2048;
    #pragma unroll
    for(int r=0;r<16;++r){const int orow=crow(r,hi);
      #pragma unroll
      for(int d0=0;d0<2;++d0)stg[orow*64+d0*32+r32]=__float2bfloat16(o[d0][r]*rli[r]);}
    asm volatile("s_waitcnt lgkmcnt(0)":::"memory");
    #pragma unroll
    for(int i=0;i<4;++i){const int row=i*8+(lane>>3),ch=lane&7; const u32x4 v=*(const u32x4*)(stg+row*64+ch*8); ATTN_STORE16(Ow+(long)row*OP+ch*8,v);} }
  asm volatile("s_waitcnt lgkmcnt(0)\n\ts_barrier":::"memory");
  #undef DMA_K
  #undef DMA_V
  #undef CMASK
  #undef START
  #undef RESC
  #undef ROT
  #undef CBIAS
}
constexpr int ATTN_LDS_BYTES=LDS_BYTES;
#undef SBAR
#undef WAIT_BAR
}

namespace ssd {
constexpr int BP = 136, TP = 72, CBP = 68, SP = 136;
constexpr int L_BC = 0, L_CC = 17408, L_BT = 34816, L_CB = 53248, L_ACS = 70656, L_DT = 71680, L_ST = 72704, ST_BYTES = 8704, L_RS = L_ST + 8 * ST_BYTES, L_END = L_RS + 2048;
struct Ptrs { const bf16_t* XBC; const bf16_t* Zs; const float* DT; const float* conv_w; const float* conv_b; const float* A_log; const float* D_skip;
              const float* state_conv; const float* state_ssm; float* SL; float* dAtot; float* GSS; bf16_t* Mix; float* out; };
#define MFMA32(a, b, c) __builtin_amdgcn_mfma_f32_32x32x16_bf16((a), (b), (c), 0, 0, 0)
#define LDSFENCE() asm volatile("s_waitcnt lgkmcnt(0)" ::: "memory")

template <int MODE> __device__ __forceinline__ void unit(const Ptrs& P, unsigned char* lds, int b, int blk, int hq) {
    int tid_ = threadIdx.x; asm volatile("" : "+v"(tid_));
    const int tid = tid_, lane = tid & 63, wid = __builtin_amdgcn_readfirstlane(tid >> 6), r32 = lane & 31, hi = lane >> 5;
    const int g = hq >> 1, hl = wid >> 1, ph = wid & 1, h = hq * 4 + hl;
    constexpr int NSUB = (MODE == 2) ? 1 : 4;
    constexpr int nvalid = (MODE == 2) ? 16 : 256;
    const int row0 = (MODE == 2) ? MP + b * 16 : b * PSEQ + blk * 256;
    bf16_t* Bc = (bf16_t*)(lds + L_BC); bf16_t* Cc = (bf16_t*)(lds + L_CC); bf16_t* BT = (bf16_t*)(lds + L_BT); float* CB = (float*)(lds + L_CB);
    float* rsL = (float*)(lds + L_RS); float* acsL = (float*)(lds + L_ACS); float* dtL = (float*)(lds + L_DT); bf16_t* St = (bf16_t*)(lds + L_ST + wid * ST_BYTES);
    const int xcol = h * 64 + ph * 32 + r32;
    const int cp = tid & 127, seg = tid >> 7, ch = 2 * cp; const int scol = (ch < 128) ? 1024 + 128 * g + ch : 1280 + 128 * g + (ch - 128);
    const float Asc = -__expf(P.A_log[hq * 4 + (wid & 3)]);
    const float Dh = P.D_skip[h];
    f32x16 st[4];
    if (MODE == 0) {
#pragma unroll
        for (int nb = 0; nb < 4; ++nb) st[nb] = f32x16{};
    } else if (MODE == 1) {
        const float* sp = P.SL + ((size_t)((b * 32 + blk) * 16 + h)) * 8192 + (size_t)(ph * 4) * 1024 + lane;
#pragma unroll
        for (int nb = 0; nb < 4; ++nb)
#pragma unroll
            for (int r = 0; r < 16; ++r) st[nb][r] = sp[(nb * 16 + r) * 64];
    } else {
        const float* sp = P.state_ssm + ((size_t)(b * 16 + h) * 64 + ph * 32 + r32) * 128 + 4 * hi;
#pragma unroll
        for (int nb = 0; nb < 4; ++nb)
#pragma unroll
            for (int q4 = 0; q4 < 4; ++q4) { const f32x4 v = *(const f32x4*)(sp + 32 * nb + 8 * q4); st[nb][4 * q4] = v[0]; st[nb][4 * q4 + 1] = v[1]; st[nb][4 * q4 + 2] = v[2]; st[nb][4 * q4 + 3] = v[3]; }
    }
    float dasum = 0.f;
    unsigned uu[16]; float dtn = 0.f;
    auto load_stage = [&](int tbn) {
        if (MODE != 0 || ch < 128) { const int t0 = tbn + 16 * seg; const bf16_t* sp = P.XBC + (unsigned)((row0 + t0) * DCONV + scol);
#pragma unroll
            for (int i = 0; i < 16; ++i) { uu[i] = *(const unsigned*)(sp + i * DCONV); if (MODE == 2) { asm volatile("" : "+v"(uu[i])); if (t0 + i >= nvalid) uu[i] = 0u; } } }
        if (wid < 4) { const int t = tbn + lane; dtn = (t < nvalid) ? P.DT[(unsigned)((row0 + t) * 16 + hq * 4 + wid)] : 0.f; }
    };
    if (MODE == 0) load_stage(0);
#pragma unroll 1
    for (int sc = 0; sc < NSUB; ++sc) {
        const int tb = 64 * sc;
        unsigned xvp[4][4];
        {
            const bf16_t* xp = P.XBC + (unsigned)((row0 + tb + 8 * hi) * DCONV + xcol);
#pragma unroll
            for (int ks = 0; ks < 4; ++ks)
#pragma unroll
                for (int i = 0; i < 4; ++i) { unsigned lo = xp[(16 * ks + 2 * i) * DCONV], hi16 = xp[(16 * ks + 2 * i + 1) * DCONV];
                    if (MODE == 2) { asm volatile("" : "+v"(lo), "+v"(hi16));     if (tb + 16 * ks + 8 * hi + 2 * i >= nvalid) lo = 0u; if (tb + 16 * ks + 8 * hi + 2 * i + 1 >= nvalid) hi16 = 0u; }
                    xvp[ks][i] = lo | (hi16 << 16); }
        }
        if (MODE != 0) load_stage(tb);
        if (MODE != 0 || ch < 128) {
            bf16_t* nat = ((ch < 128) ? Bc : Cc) + (ch & 127);
#pragma unroll
            for (int i = 0; i < 16; ++i) *(unsigned*)(nat + (16 * seg + i) * BP) = uu[i];
            if (ch < 128) {
                unsigned bt0[8], bt1[8];
#pragma unroll
                for (int i = 0; i < 8; ++i) { bt0[i] = (uu[2 * i] & 0xffffu) | (uu[2 * i + 1] << 16); bt1[i] = (uu[2 * i] >> 16) | (uu[2 * i + 1] & 0xffff0000u); }
                *(u32x4*)(BT + ch * TP + 16 * seg) = (u32x4){bt0[0], bt0[1], bt0[2], bt0[3]}; *(u32x4*)(BT + ch * TP + 16 * seg + 8) = (u32x4){bt0[4], bt0[5], bt0[6], bt0[7]};
                *(u32x4*)(BT + (ch + 1) * TP + 16 * seg) = (u32x4){bt1[0], bt1[1], bt1[2], bt1[3]}; *(u32x4*)(BT + (ch + 1) * TP + 16 * seg + 8) = (u32x4){bt1[4], bt1[5], bt1[6], bt1[7]};
            }
        }
        if (wid < 4) {
            const float dt = dtn;
            float a = dt * Asc;
#pragma unroll
            for (int o = 1; o < 64; o <<= 1) { const float v = __shfl_up(a, o); if (lane >= o) a += v; }
            acsL[wid * 64 + lane] = a; dtL[wid * 64 + lane] = dt; dasum += __shfl(a, 63);
        }
#define XV(ks, j) (((j) & 1) ? __uint_as_float(xvp[ks][(j) >> 1] & 0xffff0000u) : __uint_as_float(xvp[ks][(j) >> 1] << 16))
        __syncthreads();
        if (MODE != 0) {
            if (wid < 3) { const int lb = wid > 0 ? 1 : 0, sb = wid > 1 ? 1 : 0; f32x16 cacc = f32x16{};
#pragma unroll
                for (int ks = 0; ks < 8; ++ks) { const bf16x8 av = *(const bf16x8*)(Cc + (32 * lb + r32) * BP + 16 * ks + 8 * hi), bv = *(const bf16x8*)(Bc + (32 * sb + r32) * BP + 16 * ks + 8 * hi); cacc = MFMA32(av, bv, cacc); }
#pragma unroll
                for (int r = 0; r < 16; ++r) CB[(32 * lb + crow_(r, hi)) * CBP + 32 * sb + r32] = cacc[r]; }
            __syncthreads();
        }
        const float* acsH = acsL + hl * 64; const float* dtH = dtL + hl * 64;
        const float acs_last = acsH[63];
        if (MODE != 0) {
#pragma unroll
            for (int nb = 0; nb < 4; ++nb)
#pragma unroll
                for (int q4 = 0; q4 < 4; ++q4) *(u32x2*)(St + r32 * SP + 32 * nb + 8 * q4 + 4 * hi) = (u32x2){cvtpk(st[nb][4 * q4], st[nb][4 * q4 + 1]), cvtpk(st[nb][4 * q4 + 2], st[nb][4 * q4 + 3])};
            LDSFENCE();
#pragma unroll 1
            for (int lb = 0; lb < 2; ++lb) { if (MODE == 2 && lb == 1) continue;
                f32x16 y = f32x16{};
                unsigned short zr[16];
#pragma unroll
                for (int q4 = 0; q4 < 4; ++q4)
#pragma unroll
                    for (int e = 0; e < 4; ++e) { const int lr = 32 * lb + 8 * q4 + 4 * hi + e; const int row = row0 + tb + lr; zr[4 * q4 + e] = P.Zs[(unsigned)(row * 1024 + xcol)]; }
#pragma unroll
                for (int ks = 0; ks < 8; ++ks) { const bf16x8 av = *(const bf16x8*)(Cc + (32 * lb + r32) * BP + 16 * ks + 8 * hi), bv = *(const bf16x8*)(St + r32 * SP + 16 * ks + 8 * hi); y = MFMA32(av, bv, y); }
#pragma unroll
                for (int q4 = 0; q4 < 4; ++q4) { const f32x4 a4 = *(const f32x4*)(acsH + 32 * lb + 8 * q4 + 4 * hi);
#pragma unroll
                    for (int e = 0; e < 4; ++e) y[4 * q4 + e] *= __expf(a4[e]); }
                const int l = 32 * lb + r32; const float al = acsH[l];
#pragma unroll
                for (int ks = 0; ks < 4; ++ks) { if (ks > 2 * lb + 1) continue;
                    const int s0 = 16 * ks + 8 * hi;
                    const f32x4 c0 = *(const f32x4*)(CB + l * CBP + s0), c1 = *(const f32x4*)(CB + l * CBP + s0 + 4);
                    const f32x4 s4a = *(const f32x4*)(acsH + s0), s4b = *(const f32x4*)(acsH + s0 + 4), d4a = *(const f32x4*)(dtH + s0), d4b = *(const f32x4*)(dtH + s0 + 4);
                    float gg[8], xa[8];
#pragma unroll
                    for (int j = 0; j < 8; ++j) { const float cbv = j < 4 ? c0[j] : c1[j - 4], as = j < 4 ? s4a[j] : s4b[j - 4], dv = j < 4 ? d4a[j] : d4b[j - 4];
                        gg[j] = (s0 + j <= l) ? cbv * __expf(al - as) : 0.f; xa[j] = XV(ks, j) * dv; }
                    const u32x4 gp = {cvtpk(gg[0], gg[1]), cvtpk(gg[2], gg[3]), cvtpk(gg[4], gg[5]), cvtpk(gg[6], gg[7])};
                    const u32x4 xp = {cvtpk(xa[0], xa[1]), cvtpk(xa[2], xa[3]), cvtpk(xa[4], xa[5]), cvtpk(xa[6], xa[7])};
                    y = MFMA32(__builtin_bit_cast(bf16x8, gp), __builtin_bit_cast(bf16x8, xp), y);
                    if (ks >= 2 * lb) { float di[8];
#pragma unroll
                        for (int j = 0; j < 8; ++j) di[j] = (s0 + j == l) ? Dh : 0.f;
                        const u32x4 dp = {cvtpk(di[0], di[1]), cvtpk(di[2], di[3]), cvtpk(di[4], di[5]), cvtpk(di[6], di[7])};
                        const u32x4 xr = {xvp[ks][0], xvp[ks][1], xvp[ks][2], xvp[ks][3]};
                        y = MFMA32(__builtin_bit_cast(bf16x8, dp), __builtin_bit_cast(bf16x8, xr), y); } }
                float s2v[16];
#pragma unroll
                for (int q4 = 0; q4 < 4; ++q4)
#pragma unroll
                    for (int e = 0; e < 4; ++e) { const int r = 4 * q4 + e; const int lr = 32 * lb + 8 * q4 + 4 * hi + e; const int row = row0 + tb + lr;
                        const float yv = y[r] * bf2f(zr[r]);
                        if (MODE != 2 || q4 < 2) P.Mix[(unsigned)(row * DMIX + xcol)] = (bf16_t)(cvtpk(yv, 0.f) & 0xffffu);
                        float s2 = yv * yv;
                        s2 += __shfl_xor(s2, 1); s2 += __shfl_xor(s2, 2); s2 += __shfl_xor(s2, 4); s2 += __shfl_xor(s2, 8); s2 += __shfl_xor(s2, 16);
                        s2v[r] = s2; }
                asm volatile("" ::: "memory");
                if (r32 == 0) {
#pragma unroll
                    for (int q4 = 0; q4 < 4; ++q4)
#pragma unroll
                        for (int e = 0; e < 4; ++e) rsL[wid * 64 + 32 * lb + 8 * q4 + 4 * hi + e] = s2v[4 * q4 + e];
                }
            }
        }
        if (MODE == 0 && sc + 1 < NSUB) load_stage(tb + 64);
        {
            const float dec = __expf(acs_last);
#pragma unroll
            for (int nb = 0; nb < 4; ++nb) st[nb] *= dec;
#pragma unroll
            for (int ks = 0; ks < 4; ++ks) { const int s0 = 16 * ks + 8 * hi;
                const f32x4 s4a = *(const f32x4*)(acsH + s0), s4b = *(const f32x4*)(acsH + s0 + 4), d4a = *(const f32x4*)(dtH + s0), d4b = *(const f32x4*)(dtH + s0 + 4);
                float xb[8];
#pragma unroll
                for (int j = 0; j < 8; ++j) { const float as = j < 4 ? s4a[j] : s4b[j - 4], dv = j < 4 ? d4a[j] : d4b[j - 4]; xb[j] = XV(ks, j) * dv * __expf(acs_last - as); }
                const u32x4 xp = {cvtpk(xb[0], xb[1]), cvtpk(xb[2], xb[3]), cvtpk(xb[4], xb[5]), cvtpk(xb[6], xb[7])};
#pragma unroll
                for (int nb = 0; nb < 4; ++nb) { const bf16x8 av = *(const bf16x8*)(BT + (32 * nb + r32) * TP + 16 * ks + 8 * hi); st[nb] = MFMA32(av, __builtin_bit_cast(bf16x8, xp), st[nb]); } }
        }
        __syncthreads();
        if (MODE != 0) { if (tid < ((MODE == 2) ? 16 : 64)) { float s = 0.f;
#pragma unroll
                for (int w = 0; w < 8; ++w) s += rsL[w * 64 + tid];
                P.GSS[(unsigned)((row0 + tb + tid) * 4 + hq)] = s; } }
    }
    if (MODE == 0) {
        float* sp = P.SL + ((size_t)((b * 32 + blk) * 16 + h)) * 8192 + (size_t)(ph * 4) * 1024 + lane;
#pragma unroll
        for (int nb = 0; nb < 4; ++nb)
#pragma unroll
            for (int r = 0; r < 16; ++r) sp[(nb * 16 + r) * 64] = st[nb][r];
        if (wid < 4 && lane == 0) P.dAtot[(b * 32 + blk) * 16 + hq * 4 + wid] = dasum;
    } else if (MODE == 2 || blk == 31) {
        float* sp = P.out + (MODE == 2 ? O_SSSM : O_PSSM) + ((size_t)(b * 16 + h) * 64 + ph * 32 + r32) * 128 + 4 * hi;
#pragma unroll
        for (int nb = 0; nb < 4; ++nb)
#pragma unroll
            for (int q4 = 0; q4 < 4; ++q4) *(f32x4*)(sp + 32 * nb + 8 * q4) = (f32x4){st[nb][4 * q4], st[nb][4 * q4 + 1], st[nb][4 * q4 + 2], st[nb][4 * q4 + 3]};
    }
}
#undef XV
}

namespace sattn {
constexpr int L_C = 0, L_M = 16640, L_L = L_M + 512, L_O = L_L + 512, OPITCH = 17, L_SCAN = L_O + 8 * 64 * OPITCH * 4, L_END = L_SCAN + 64;
struct Ptrs { const float* cache_k; const float* cache_v; const float* cache_logf; const bf16_t* Qb; const bf16_t* Kb; const bf16_t* Vb; const float* out; bf16_t* Mix; };
__device__ __forceinline__ void unit(const Ptrs& P, unsigned char* lds, int b, int h) {
    int tid_ = threadIdx.x; asm volatile("" : "+v"(tid_));
    const int tid = tid_, lane = tid & 63, wid = __builtin_amdgcn_readfirstlane(tid >> 6), r32 = lane & 31, hi = lane >> 5;
    float* cL = (float*)(lds + L_C); float* mW = (float*)(lds + L_M); float* lW = (float*)(lds + L_L); float* OW = (float*)(lds + L_O); float* wtot = (float*)(lds + L_SCAN);
    constexpr int NK = PAST + SSEQ;
    {
        float v[16]; float run = 0.f; const int s0 = 16 * tid;
#pragma unroll
        for (int i = 0; i < 16; ++i) v[i] = 0.f;
        if (tid < PAST / 16) { const float* lp = P.cache_logf + ((size_t)b * PAST + s0) * 8 + h;
#pragma unroll
            for (int i = 0; i < 16; ++i) v[i] = lp[i * 8];
        } else if (tid == PAST / 16) { const float* lp = P.out + O_SLF + ((size_t)b * 16) * 8 + h;
#pragma unroll
            for (int i = 0; i < 16; ++i) v[i] = lp[i * 8];
        }
#pragma unroll
        for (int i = 0; i < 16; ++i) run += v[i];
        float inc = run;
#pragma unroll
        for (int o = 1; o < 64; o <<= 1) { const float t = __shfl_up(inc, o); if (lane >= o) inc += t; }
        if (lane == 63) wtot[wid] = inc;
        __syncthreads();
        float off = inc - run;
        for (int w = 0; w < wid; ++w) off += wtot[w];
#pragma unroll
        for (int i = 0; i < 16; ++i) { off += v[i]; const int s = s0 + i; if (s < NK + 16) cL[s] = off * L2E; }
        __syncthreads();
    }
    const int q = r32 & 15; const long qrow = (long)MP + b * 16 + q;
    bf16x8 qf[4];
#pragma unroll
    for (int ks = 0; ks < 4; ++ks) qf[ks] = *(const bf16x8*)(P.Qb + qrow * 512 + h * 64 + 16 * ks + 8 * hi);
    const float cq = cL[PAST + q];
    float m = -1e30f, l = 0.f; f32x16 o[2]; o[0] = f32x16{}; o[1] = f32x16{};
    int tile0;
    { const float c0 = cL[PAST]; const int t1 = lane, t2 = lane + 64;
      const bool s1 = (c0 - cL[32 * t1 + 31]) < -(64.0f * L2E), s2 = (c0 - cL[32 * t2 + 31]) < -(64.0f * L2E);
      tile0 = __builtin_amdgcn_readfirstlane(__builtin_popcountll(__ballot(s1)) + __builtin_popcountll(__ballot(s2))); }
    for (int tile = tile0 + wid; tile < 129; tile += 8) {
        const int key0 = 32 * tile; const bool isnew = tile == 128;
        bf16x8 kf[4];
        if (!isnew) { const float* kp = P.cache_k + (((size_t)b * PAST + key0 + r32) * 8 + h) * 64 + 8 * hi;
#pragma unroll
            for (int ks = 0; ks < 4; ++ks) { const f32x4 a = *(const f32x4*)(kp + 16 * ks), c = *(const f32x4*)(kp + 16 * ks + 4);
                const u32x4 w = {cvtpk(a[0], a[1]), cvtpk(a[2], a[3]), cvtpk(c[0], c[1]), cvtpk(c[2], c[3])}; kf[ks] = __builtin_bit_cast(bf16x8, w); }
        } else {
#pragma unroll
            for (int ks = 0; ks < 4; ++ks) kf[ks] = *(const bf16x8*)(P.Kb + ((long)MP + b * 16 + (r32 & 15)) * 512 + h * 64 + 16 * ks + 8 * hi);
        }
        float vall[2][2][8];
        if (!isnew) {
#pragma unroll
            for (int db = 0; db < 2; ++db)
#pragma unroll
                for (int s2 = 0; s2 < 2; ++s2)
#pragma unroll
                    for (int j = 0; j < 8; ++j) { const int kv = crow_(8 * s2 + j, hi); vall[db][s2][j] = P.cache_v[(((size_t)b * PAST + key0 + kv) * 8 + h) * 64 + 32 * db + r32]; }
        } else {
#pragma unroll
            for (int db = 0; db < 2; ++db)
#pragma unroll
                for (int s2 = 0; s2 < 2; ++s2)
#pragma unroll
                    for (int j = 0; j < 8; ++j) { const int kv = crow_(8 * s2 + j, hi); vall[db][s2][j] = bf2f(P.Vb[((long)MP + b * 16 + (kv & 15)) * 512 + h * 64 + 32 * db + r32]) * (kv < 16 ? 1.f : 0.f); }
        }
        f32x16 s = f32x16{};
#pragma unroll
        for (int ks = 0; ks < 4; ++ks) s = MFMA32(kf[ks], qf[ks], s);
        float mt = -1e30f;
#pragma unroll
        for (int q4 = 0; q4 < 4; ++q4) { const f32x4 c4 = *(const f32x4*)(cL + key0 + 8 * q4 + 4 * hi);
#pragma unroll
            for (int e = 0; e < 4; ++e) { const int r = 4 * q4 + e; const int kv = 8 * q4 + 4 * hi + e; float x = s[r] + (cq - c4[e]);
                if (isnew && (kv >= 16 || kv > q)) x = -1e30f;
                s[r] = x; mt = fmaxf(mt, x); } }
        mt = fmaxf(mt, __shfl_xor(mt, 32));
        const float mn = fmaxf(m, mt), alpha = __builtin_amdgcn_exp2f(m - mn); m = mn;
        float ls = 0.f;
#pragma unroll
        for (int r = 0; r < 16; ++r) { const float p = __builtin_amdgcn_exp2f(s[r] - mn); s[r] = p; ls += p; }
        l = l * alpha + ls;
#pragma unroll
        for (int db = 0; db < 2; ++db) o[db] *= alpha;
        bf16x8 pf[2];
#pragma unroll
        for (int s2 = 0; s2 < 2; ++s2) { const u32x4 w = {cvtpk(s[8 * s2], s[8 * s2 + 1]), cvtpk(s[8 * s2 + 2], s[8 * s2 + 3]), cvtpk(s[8 * s2 + 4], s[8 * s2 + 5]), cvtpk(s[8 * s2 + 6], s[8 * s2 + 7])}; pf[s2] = __builtin_bit_cast(bf16x8, w); }
#pragma unroll
        for (int db = 0; db < 2; ++db)
#pragma unroll
            for (int s2 = 0; s2 < 2; ++s2) { const float* vv = vall[db][s2];
                const u32x4 w = {cvtpk(vv[0], vv[1]), cvtpk(vv[2], vv[3]), cvtpk(vv[4], vv[5]), cvtpk(vv[6], vv[7])};
                o[db] = MFMA32(__builtin_bit_cast(bf16x8, w), pf[s2], o[db]); }
    }
    l += __shfl_xor(l, 32);
    if (r32 < 16) { if (hi == 0) { mW[wid * 16 + r32] = m; lW[wid * 16 + r32] = l; }
#pragma unroll
        for (int db = 0; db < 2; ++db)
#pragma unroll
            for (int r = 0; r < 16; ++r) OW[(wid * 64 + 32 * db + crow_(r, hi)) * OPITCH + r32] = o[db][r]; }
    __syncthreads();
#pragma unroll
    for (int it = 0; it < 2; ++it) { const int idx = tid + 512 * it, d = idx & 63, qq = idx >> 6;
        float M = -1e30f;
#pragma unroll
        for (int w = 0; w < 8; ++w) M = fmaxf(M, mW[w * 16 + qq]);
        float L = 0.f, acc = 0.f;
#pragma unroll
        for (int w = 0; w < 8; ++w) { const float f = __builtin_amdgcn_exp2f(mW[w * 16 + qq] - M); L += lW[w * 16 + qq] * f; acc += OW[(w * 64 + d) * OPITCH + qq] * f; }
        P.Mix[((long)MP + b * 16 + qq) * DMIX + 1024 + h * 64 + d] = (bf16_t)(cvtpk(acc / L, 0.f) & 0xffffu); }
    __syncthreads();
}
}

constexpr int NWAVES = 8, LDS_BYTES = 147456;
#define LAS __attribute__((address_space(3)))
struct Args {
    const float *x_prompt, *x_sample, *cache_k, *cache_v, *cache_logf, *state_ssm, *state_conv, *norm1_w, *w_in, *conv_w, *conv_b, *dt_bias, *A_log, *D_skip, *ssd_norm_w, *f_bias,
                *q_norm_w, *k_norm_w, *w_out, *norm2_w, *w_up, *w_down;
    float* out; unsigned char* ws;
};
__device__ __forceinline__ unsigned pk2(float lo, float hi) { return cvtpk(lo, hi); }
template <int MAP> __device__ __forceinline__ void transpose_item(const float* W, int K, int Nsrc, int Nphys, bf16_t* WT, const float* ksc, int ksc_n, float* scr, int item, int lane) {
    const int nblk = Nphys / 32, kb = item / nblk, nb = item % nblk, k0 = 64 * kb, n0 = 32 * nb;
    const int n = n0 + (lane & 31); int src = n;
    if (MAP == 1) { const int L = (n & ~255) + ((n >> 5) & 3) * 64 + ((n >> 7) & 1) * 32 + (n & 31);
        if (L < 2560) src = L; else if (L < 4096) src = L + 16; else if (L < 4112) src = 2560 + (L - 4096); else if (L < 4120) src = L; else src = -1; }
#pragma unroll
    for (int i = 0; i < 32; ++i) { const int kk = 2 * i + (lane >> 5); float v = (src >= 0) ? W[(size_t)(k0 + kk) * Nsrc + src] : 0.f; if (ksc && (k0 + kk) < ksc_n) v *= ksc[k0 + kk]; scr[kk * 33 + (lane & 31)] = v; }
    asm volatile("s_waitcnt lgkmcnt(0)" ::: "memory");
    const int c = lane & 7;
#pragma unroll
    for (int j = 0; j < 4; ++j) { const int nn = (lane >> 3) + 8 * j; const float* s = scr + (8 * c) * 33 + nn;
        u32x4 o; o.x = pk2(s[0 * 33], s[1 * 33]); o.y = pk2(s[2 * 33], s[3 * 33]); o.z = pk2(s[4 * 33], s[5 * 33]); o.w = pk2(s[6 * 33], s[7 * 33]);
        *(u32x4*)(WT + (size_t)(n0 + nn) * K + k0 + 8 * c) = o; }
    asm volatile("s_waitcnt lgkmcnt(0)" ::: "memory");
}
__device__ __forceinline__ float wave_sum(float v) {
#pragma unroll
    for (int o = 1; o < 64; o <<= 1) v += __shfl_xor(v, o);
    return v;
}
__device__ __forceinline__ void rms_row_to_bf16(const float* xrow, bf16_t* orow, int lane) {
    const f32x4* xr = (const f32x4*)xrow + lane; f32x4 v[4]; float s = 0.f;
#pragma unroll
    for (int j = 0; j < 4; ++j) { v[j] = xr[64 * j]; s += (v[j][0] * v[j][0] + v[j][1] * v[j][1]) + (v[j][2] * v[j][2] + v[j][3] * v[j][3]); }
    const float rs = rsqrtf(wave_sum(s) * (1.0f / 1024.0f) + EPSN);
    u32x2* o8 = (u32x2*)orow + lane;
#pragma unroll
    for (int j = 0; j < 4; ++j) o8[64 * j] = (u32x2){pk2(v[j][0] * rs, v[j][1] * rs), pk2(v[j][2] * rs, v[j][3] * rs)};
}

#define XB_TMO      128
#define XB_XCNT(j)  (256  + 64 * (j))
#define XB_XSUB(j)  (1280 + 64 * (j))
#define XB_XGEN(j)  (2304 + 64 * (j))
#define XB_TOP      3328
#define XB_TOPGEN   3392
#define XCD_BAR_WORDS 3456
#define XB_SPIN_CAP (1u << 18)

__device__ __forceinline__ unsigned xb_ld(unsigned* p)              { return __hip_atomic_load(p, __ATOMIC_RELAXED, __HIP_MEMORY_SCOPE_AGENT); }
__device__ __forceinline__ unsigned xb_add(unsigned* p, unsigned v) { return __hip_atomic_fetch_add(p, v, __ATOMIC_RELAXED, __HIP_MEMORY_SCOPE_AGENT); }
__device__ __forceinline__ unsigned xb_xcc_id() { return (unsigned)__builtin_amdgcn_s_getreg((3 << 11) | 20) & 0xFu; }
#define XB_SPIN(cond, bar) do { unsigned _sp = 0; while (cond) { __builtin_amdgcn_s_sleep(1); \
    if ((++_sp & 255u) == 0u) { if (xb_ld(&(bar)[XB_TMO])) break; if (_sp > XB_SPIN_CAP) { atomicAdd(&(bar)[XB_TMO], 1u); break; } } } } while (0)

struct XcdBarrier {
    unsigned* bar; unsigned x;
    volatile LAS unsigned* st;
};

__device__ __forceinline__ XcdBarrier xcd_barrier_post(unsigned* bar, volatile LAS unsigned* st) {
    XcdBarrier b; b.bar = bar; b.x = xb_xcc_id(); b.st = st;
    if (threadIdx.x == 0) (void)xb_add(&bar[XB_XCNT(b.x)], 1u);
    return b;
}
__device__ __forceinline__ void xcd_barrier_complete(unsigned* bar, unsigned x, unsigned& nloc, unsigned& nx) {
    const unsigned G = gridDim.x * gridDim.y * gridDim.z;
    unsigned sum, cnt, mine, sp = 0u;
    for (;;) {
        sum = 0u; cnt = 0u; mine = 0u;
#pragma unroll
        for (unsigned j = 0; j < 16; ++j) { const unsigned c = xb_ld(&bar[XB_XCNT(j)]); sum += c; cnt += (c > 0u) ? 1u : 0u; mine = (j == x) ? c : mine; }
        if (sum == G) break;
        __builtin_amdgcn_s_sleep(1);
        if ((++sp & 255u) == 0u) { if (xb_ld(&bar[XB_TMO])) break; if (sp > XB_SPIN_CAP) { atomicAdd(&bar[XB_TMO], 1u); break; } }
    }
    nloc = mine > 0u ? mine : 1u; nx = cnt > 0u ? cnt : 1u;
}

__device__ __forceinline__ void xcd_barrier(const XcdBarrier& b) {
    asm volatile("s_waitcnt vmcnt(0)" ::: "memory");
    __syncthreads();
    if (threadIdx.x == 0) {
        unsigned* bar = b.bar;
        __builtin_amdgcn_s_waitcnt(0);
        unsigned nloc = b.st[0], nx = b.st[1];
        if (nloc == 0u) { xcd_barrier_complete(bar, b.x, nloc, nx); b.st[0] = nloc; b.st[1] = nx; }
        const unsigned old = xb_add(&bar[XB_XSUB(b.x)], 1u);
        const unsigned gen = old / nloc;
        if (old + 1u == (gen + 1u) * nloc) {
            __builtin_amdgcn_fence(__ATOMIC_RELEASE, "agent");
            asm volatile("s_waitcnt vmcnt(0)" ::: "memory");
            const unsigned og = xb_add(&bar[XB_TOP], 1u);
            const unsigned tg = og / nx;
            if (og + 1u == (tg + 1u) * nx) xb_add(&bar[XB_TOPGEN], 1u);
            else XB_SPIN(xb_ld(&bar[XB_TOPGEN]) == tg, bar);
            __builtin_amdgcn_fence(__ATOMIC_ACQUIRE, "agent");
            xb_add(&bar[XB_XGEN(b.x)], 1u);
            asm volatile("s_waitcnt vmcnt(0)" ::: "memory");
        } else {
            XB_SPIN(xb_ld(&bar[XB_XGEN(b.x)]) == gen, bar);
            __builtin_amdgcn_fence(__ATOMIC_ACQUIRE, "agent");
            asm volatile("s_waitcnt vmcnt(0)" ::: "memory");
        }
    }
    __syncthreads();
}

template <int PH> __device__ __forceinline__ void run_phase(const Args& a, unsigned char* lds) {
    int tid_ = threadIdx.x; asm volatile("" : "+v"(tid_));
    const int tid = tid_, lane = tid & 63, wave = __builtin_amdgcn_readfirstlane(tid >> 6);
    int G_ = gridDim.x, bx_ = blockIdx.x; asm volatile("" : "+s"(G_), "+s"(bx_));
    const int G = G_, bx = bx_;
    unsigned char* ws = a.ws; float* out = a.out;
    float* SS1 = (float*)(ws + WS_SS1P); float* GSS = (float*)(ws + WS_GSSP); float* DAT = (float*)(ws + WS_DAT); float* CP = (float*)(ws + WS_CP);
    bf16_t* WinT = (bf16_t*)(ws + WS_WIN); bf16_t* WoutT = (bf16_t*)(ws + WS_WOUT); bf16_t* WupT = (bf16_t*)(ws + WS_WUP); bf16_t* WdnT = (bf16_t*)(ws + WS_WDN);
    bf16_t* XN = (bf16_t*)(ws + WS_XN); float* DT = (float*)(ws + WS_DT); float* SL = (float*)(ws + WS_SL); bf16_t* Zs = (bf16_t*)(ws + WS_ZS); bf16_t* XBC = (bf16_t*)(ws + WS_XBC);
    bf16_t* Qb = (bf16_t*)(ws + WS_QB); bf16_t* Kb = (bf16_t*)(ws + WS_KB); bf16_t* Vb = (bf16_t*)(ws + WS_VB); bf16_t* Mix = (bf16_t*)(ws + WS_MIX); bf16_t* Hb = (bf16_t*)(ws + WS_H);
    (void)tid; (void)lane; (void)wave; (void)SS1; (void)GSS; (void)DAT; (void)CP; (void)WinT; (void)WoutT; (void)WupT; (void)WdnT; (void)XN; (void)DT; (void)SL; (void)Zs; (void)XBC; (void)Qb; (void)Kb; (void)Vb; (void)Mix; (void)Hb; (void)out;
    if constexpr (PH == 0) {
    {
        float* scr = (float*)(lds + wave * 16384);
        const int gw = bx * NWAVES + wave, NGW = G * NWAVES;
        constexpr int I_IN = (1024 / 64) * (NIN / 32), I_OUT = (1536 / 64) * (1024 / 32), I_UP = (1024 / 64) * (4096 / 32), I_DN = (4096 / 64) * (1024 / 32);
        for (int it = gw; it < I_IN + I_OUT + I_UP + I_DN; it += NGW) {
            int r = it;
            if (r < I_IN) { transpose_item<1>(a.w_in, 1024, 4120, NIN, WinT, a.norm1_w, 1024, scr, r, lane); continue; } r -= I_IN;
            if (r < I_OUT) { transpose_item<0>(a.w_out, 1536, 1024, 1024, WoutT, a.ssd_norm_w, 1024, scr, r, lane); continue; } r -= I_OUT;
            if (r < I_UP) { transpose_item<0>(a.w_up, 1024, 4096, 4096, WupT, a.norm2_w, 1024, scr, r, lane); continue; } r -= I_UP;
            transpose_item<0>(a.w_down, 4096, 1024, 1024, WdnT, nullptr, 0, scr, r, lane);
        }
        for (int m0 = gw; m0 < MT; m0 += 4 * NGW) {
            f32x4 v[4][4]; float s[4];
#pragma unroll
            for (int r = 0; r < 4; ++r) { const int m = m0 + r * NGW; const int mc = m < MT ? m : MT - 1;
                const f32x4* xr = (const f32x4*)(mc < MP ? a.x_prompt + (size_t)mc * 1024 : a.x_sample + (size_t)(mc - MP) * 1024) + lane; s[r] = 0.f;
#pragma unroll
                for (int j = 0; j < 4; ++j) { v[r][j] = __builtin_nontemporal_load(xr + 64 * j); } }
#pragma unroll
            for (int r = 0; r < 4; ++r) {
#pragma unroll
                for (int j = 0; j < 4; ++j) s[r] += (v[r][j][0] * v[r][j][0] + v[r][j][1] * v[r][j][1]) + (v[r][j][2] * v[r][j][2] + v[r][j][3] * v[r][j][3]);
                const float rs = rsqrtf(wave_sum(s[r]) * (1.0f / 1024.0f) + EPSN); const int m = m0 + r * NGW;
                if (m < MT) { u32x2* o8 = (u32x2*)(XN + (size_t)m * 1024) + lane;
#pragma unroll
                    for (int j = 0; j < 4; ++j) o8[64 * j] = (u32x2){pk2(v[r][j][0] * rs, v[r][j][1] * rs), pk2(v[r][j][2] * rs, v[r][j][3] * rs)}; } }
        }
        if (bx == 0 && tid < 64) ((unsigned*)(ws + WS_CTR))[tid] = 0u;
    }
    }
    if constexpr (PH == 1) {
    {
        pg8::Gemm g{XN, WinT, MT, NIN, 1024, 0}; pg8::StaticOrder S; S.init(MT, NIN, G, bx);
        pg8::EpiIn E{Zs, XBC, Qb, Kb, Vb, DT, out, a.dt_bias, a.f_bias, a.q_norm_w, a.k_norm_w, (bf16_t*)(ws + WS_HIST)};
        pg8::gemm_phase<pg8::EpiIn, pg8::StaticOrder, true, true>((PG8_LAS unsigned char*)lds, g, S, E);
    }
    }
    if constexpr (PH == 9) {
    {
        const bf16_t* HIST = (const bf16_t*)(ws + WS_HIST);
        constexpr int NSEG = MP / 128, NPAIR = DCONV / 2, NTASK = (NSEG + SBATCH) * NPAIR;
        for (int task = bx * 512 + tid; task < NTASK; task += G * 512) {
            const int seg = task / NPAIR, col = 2 * (task - seg * NPAIR);
            float w0[4], w1[4];
#pragma unroll
            for (int k = 0; k < 4; ++k) { w0[k] = a.conv_w[k * DCONV + col]; w1[k] = a.conv_w[k * DCONV + col + 1]; }
            const float b0 = a.conv_b[col], b1 = a.conv_b[col + 1];
            float a3 = 0.f, c3 = 0.f, a2 = 0.f, c2 = 0.f, a1 = 0.f, c1 = 0.f; int row0, n;
            if (seg < NSEG) { row0 = seg * 128; n = 128;
                if (seg & 63) { const bf16_t* hp = HIST + (unsigned)((seg - 1) * 3 * DCONV + col);
                    const unsigned u3 = *(const unsigned*)hp, u2 = *(const unsigned*)(hp + DCONV), u1 = *(const unsigned*)(hp + 2 * DCONV);
                    a3 = bf2f(u3 & 0xffffu); c3 = bf2f(u3 >> 16); a2 = bf2f(u2 & 0xffffu); c2 = bf2f(u2 >> 16); a1 = bf2f(u1 & 0xffffu); c1 = bf2f(u1 >> 16); }
            } else { const int s = seg - NSEG; row0 = MP + s * 16; n = 16; const float* hp = a.state_conv + (unsigned)(s * 3 * DCONV + col);
                a3 = hp[0]; c3 = hp[1]; a2 = hp[DCONV]; c2 = hp[DCONV + 1]; a1 = hp[2 * DCONV]; c1 = hp[2 * DCONV + 1]; }
            bf16_t* xp = XBC + (unsigned)(row0 * DCONV + col);
            for (int i0 = 0; i0 < n; i0 += 16) {
                unsigned uu[16];
#pragma unroll
                for (int i = 0; i < 16; ++i) uu[i] = *(const unsigned*)(xp + (i0 + i) * DCONV);
#pragma unroll
                for (int i = 0; i < 16; ++i) { const float a0 = bf2f(uu[i] & 0xffffu), c0 = bf2f(uu[i] >> 16);
                    const float o0 = silu_f(b0 + w0[0] * a3 + w0[1] * a2 + w0[2] * a1 + w0[3] * a0), o1 = silu_f(b1 + w1[0] * c3 + w1[1] * c2 + w1[2] * c1 + w1[3] * c0);
                    *(unsigned*)(xp + (i0 + i) * DCONV) = cvtpk(o0, o1);
                    a3 = a2; c3 = c2; a2 = a1; c2 = c1; a1 = a0; c1 = c0; }
            }
        }
        sattn::Ptrs Q{a.cache_k, a.cache_v, a.cache_logf, Qb, Kb, Vb, out, Mix};
        for (int u = G - 1 - bx; u < SBATCH * 8; u += G) sattn::unit(Q, lds, u >> 3, u & 7);
    }
    }
    if constexpr (PH == 12) {
    {
        if (G >= 128) { const f32x4* part = (const f32x4*)(ws + WS_MIX); f32x4* y = (f32x4*)(out + O_Y + (size_t)MP * 1024);
            for (int i = bx * 512 + tid; i < MS * 1024 / 4; i += G * 512) { f32x4 s = y[i];
#pragma unroll
                for (int k = 0; k < 16; ++k) s += part[(size_t)k * (MS * 1024 / 4) + i];
                y[i] = s; } }
    }
    }
    if constexpr (PH == 10) {
    {
        const int ks = bx >> 3;
        pg8::Gemm g2{Hb + ks * 256, WdnT + ks * 256, MT, 1024, DFF, 4}; pg8::ListOrder S2{G, bx, G >= 128 ? 128 : 0, 8, MP / 256, 4, 0};
        pg8::EpiDownPartial E2{(float*)(ws + WS_MIX) + (size_t)ks * (MS * 1024)};
        pg8::gemm_phase<pg8::EpiDownPartial, pg8::ListOrder, true, true>((PG8_LAS unsigned char*)lds, g2, S2, E2);
    }
    }
    if constexpr (PH == 11) {
    {
        {
            pg8::Gemm g{Mix, WoutT, MT, 1024, DMIX, 0}; pg8::ListOrder S{G, bx, 8, 8, MP / 256, 4, 0};
            pg8::EpiOut E{a.x_prompt, a.x_sample, out + O_Y, XN, SS1, GSS};
            pg8::gemm_phase<pg8::EpiOut, pg8::ListOrder, true, true>((PG8_LAS unsigned char*)lds, g, S, E);
        }
    }
    }
    if constexpr (PH == 2) {
    {
        ssd::Ptrs P{XBC, Zs, DT, a.conv_w, a.conv_b, a.A_log, a.D_skip, a.state_conv, a.state_ssm, SL, DAT, GSS, Mix, out};
        for (int u = bx; u < PB * 32 * 4; u += G) ssd::unit<0>(P, lds, u >> 7, (u >> 2) & 31, u & 3);
        for (int u = bx; u < SBATCH * 4; u += G) ssd::unit<2>(P, lds, u >> 2, 0, u & 3);
    }
    }
    if constexpr (PH == 3) {
    {
        for (int item = bx * 512 + tid; item < PB * 16 * 8192; item += G * 512) {
            const int bh = item >> 13, b = bh >> 4, h = bh & 15, e = item & 8191; float s = 0.f;
            float* sp = SL + ((size_t)(b * 32 * 16 + h)) * 8192 + e; const float* dp = DAT + b * 32 * 16 + h; float loc[32], dec[32];
#pragma unroll
            for (int blk = 0; blk < 32; ++blk) { loc[blk] = sp[(size_t)blk * 16 * 8192]; dec[blk] = dp[blk * 16]; }
#pragma unroll
            for (int blk = 0; blk < 32; ++blk) { sp[(size_t)blk * 16 * 8192] = s; s = s * __expf(dec[blk]) + loc[blk]; } }
        float* wtot = (float*)lds;
        for (int bh = bx; bh < PB * 8; bh += G) { const int b = bh >> 3, h = bh & 7;
            float v[16]; float run = 0.f; const int s0 = 16 * tid;
#pragma unroll
            for (int i = 0; i < 16; ++i) { v[i] = out[O_PLF + ((size_t)b * PSEQ + s0 + i) * 8 + h]; run += v[i]; }
            float inc = run;
#pragma unroll
            for (int o = 1; o < 64; o <<= 1) { const float t = __shfl_up(inc, o); if (lane >= o) inc += t; }
            __syncthreads();
            if (lane == 63) wtot[wave] = inc;
            __syncthreads();
            float off = inc - run;
            for (int w = 0; w < wave; ++w) off += wtot[w];
#pragma unroll
            for (int i = 0; i < 16; ++i) { off += v[i]; CP[(size_t)bh * PSEQ + s0 + i] = off * L2E; } }
    }
    }
    if constexpr (PH == 4) {
    {
        ssd::Ptrs P{XBC, Zs, DT, a.conv_w, a.conv_b, a.A_log, a.D_skip, a.state_conv, a.state_ssm, SL, DAT, GSS, Mix, out};
        for (int u = bx; u < PB * 32 * 4; u += G) ssd::unit<1>(P, lds, u >> 7, (u >> 2) & 31, u & 3);
    }
    }
    if constexpr (PH == 8) {
    {
        const attn_body::bf16* Qa = (const attn_body::bf16*)Qb; const attn_body::bf16* Ka = (const attn_body::bf16*)Kb; const attn_body::bf16* Va = (const attn_body::bf16*)Vb;
        attn_body::bf16* Oa = (attn_body::bf16*)(Mix + 1024);
        unsigned* ctr = (unsigned*)(ws + WS_CTR); int* slot = (int*)(lds + 147000);
        float skipl2;
        { float mq = fabsf(a.q_norm_w[lane]), mk = fabsf(a.k_norm_w[lane]);
#pragma unroll
          for (int o = 1; o < 64; o <<= 1) { mq = fmaxf(mq, __shfl_xor(mq, o)); mk = fmaxf(mk, __shfl_xor(mk, o)); }
          skipl2 = (16.0f * mq * mk + 33.0f) * L2E; }
        if (tid == 0) *slot = (int)atomicAdd(ctr, 1u);
        __syncthreads();
        int u = *slot;
        __syncthreads();
        while (u < PB * 8 * 32) {
            int nx = 0; if (tid == 0) nx = (int)atomicAdd(ctr, 1u);
            const int qb = 31 - (u >> 6), bh = u & 63;
            attn_body::attn_unit<8>(bh >> 3, bh & 7, qb, Qa, Ka, Va, Oa, CP, skipl2, (char*)lds);
            if (tid == 0) *slot = nx;
            __syncthreads();
            u = *slot;
            __syncthreads();
        }
    }
    }
    if constexpr (PH == 5) {
    {
        pg8::Gemm g{Mix, WoutT, MP, 1024, DMIX, 0}; pg8::StaticOrder S; S.init(MP, 1024, G, bx);
        pg8::EpiOut E{a.x_prompt, a.x_sample, out + O_Y, XN, SS1, GSS};
        pg8::gemm_phase<pg8::EpiOut, pg8::StaticOrder, true, true>((PG8_LAS unsigned char*)lds, g, S, E);
    }
    }
    if constexpr (PH == 6) {
    {
        pg8::Gemm g{XN, WupT, MT, DFF, 1024, 0}; pg8::StaticOrder S; S.init(MT, DFF, G, bx);
        pg8::EpiUp E{SS1, Hb};
        pg8::gemm_phase<pg8::EpiUp, pg8::StaticOrder, true, true>((PG8_LAS unsigned char*)lds, g, S, E);
    }
    }
    if constexpr (PH == 7) {
    {
        const int Mrows = G >= 128 ? MP : MT;
        pg8::Gemm g{Hb, WdnT, Mrows, 1024, DFF, 0}; pg8::StaticOrder S; S.init(Mrows, 1024, G, bx);
        pg8::EpiDown E{out + O_Y};
        pg8::gemm_phase<pg8::EpiDown, pg8::StaticOrder, true, true>((PG8_LAS unsigned char*)lds, g, S, E);
    }
    }
}
template <int PH> __global__ void __launch_bounds__(NWAVES * 64, 2) phase_kernel(Args a) {
    extern __shared__ __attribute__((aligned(16))) unsigned char lds[];
    run_phase<PH>(a, lds);
}
#ifndef ONE_LAUNCH
#define ONE_LAUNCH 1
#endif
#if ONE_LAUNCH
#define RUN_PHASE(k) do { const __attribute__((address_space(4))) Args* p_ = (const __attribute__((address_space(4))) Args*)__builtin_amdgcn_kernarg_segment_ptr(); asm volatile("" : "+s"(p_)); Args la_; { const __attribute__((address_space(4))) unsigned long long* q_ = (const __attribute__((address_space(4))) unsigned long long*)p_; unsigned long long* d_ = (unsigned long long*)&la_; _Pragma("unroll") for (int i_ = 0; i_ < (int)(sizeof(Args) / 8); ++i_) d_[i_] = q_[i_]; } run_phase<k>(la_, lds); } while (0)
__global__ void __launch_bounds__(NWAVES * 64, 2) fwd_megakernel(Args a) {
    extern __shared__ __attribute__((aligned(16))) unsigned char lds[];
    cg::grid_group grid = cg::this_grid();
    if (threadIdx.x < 2) ((volatile LAS unsigned*)(lds + 147016))[threadIdx.x] = 0u;
    __syncthreads();
    XcdBarrier xbar;
    { const __attribute__((address_space(4))) Args* p_ = (const __attribute__((address_space(4))) Args*)__builtin_amdgcn_kernarg_segment_ptr();
      xbar = xcd_barrier_post((unsigned*)(p_->ws + WS_BARW), (volatile LAS unsigned*)(lds + 147016)); }
    RUN_PHASE(0); grid.sync();
    RUN_PHASE(1); xcd_barrier(xbar);
    RUN_PHASE(9); xcd_barrier(xbar);
    RUN_PHASE(2); xcd_barrier(xbar);
    RUN_PHASE(3); xcd_barrier(xbar);
    RUN_PHASE(4); __syncthreads(); RUN_PHASE(11); __syncthreads(); RUN_PHASE(8); xcd_barrier(xbar);
    RUN_PHASE(5); xcd_barrier(xbar);
    RUN_PHASE(6); xcd_barrier(xbar);
    RUN_PHASE(7); __syncthreads(); RUN_PHASE(10); xcd_barrier(xbar);
    RUN_PHASE(12);
}
#endif
extern "C" void kernel_launch(void* const* d_in, const int* in_sizes, int n_in, void* d_out, int out_size, void* d_ws, size_t ws_size, hipStream_t stream) {
    static int grid = 0;
    if (grid == 0) {
        if (n_in != 22 || (size_t)out_size != O_END || ws_size < WS_END) { fprintf(stderr, "kernel_launch: unexpected shapes: n_in %d out %d ws %zu (need %zu)\n", n_in, out_size, ws_size, (size_t)WS_END); grid = -1; return; }
        int dev = 0, cus = 0, per_cu = 0;
        (void)hipGetDevice(&dev); (void)hipDeviceGetAttribute(&cus, hipDeviceAttributeMultiprocessorCount, dev);
        bool okattr = true;
#if ONE_LAUNCH
        okattr = hipFuncSetAttribute((const void*)fwd_megakernel, hipFuncAttributeMaxDynamicSharedMemorySize, LDS_BYTES) == hipSuccess;
#endif
#if !ONE_LAUNCH
        okattr = okattr && hipFuncSetAttribute((const void*)phase_kernel<0>, hipFuncAttributeMaxDynamicSharedMemorySize, LDS_BYTES) == hipSuccess && hipFuncSetAttribute((const void*)phase_kernel<1>, hipFuncAttributeMaxDynamicSharedMemorySize, LDS_BYTES) == hipSuccess
              && hipFuncSetAttribute((const void*)phase_kernel<2>, hipFuncAttributeMaxDynamicSharedMemorySize, LDS_BYTES) == hipSuccess && hipFuncSetAttribute((const void*)phase_kernel<3>, hipFuncAttributeMaxDynamicSharedMemorySize, LDS_BYTES) == hipSuccess
              && hipFuncSetAttribute((const void*)phase_kernel<4>, hipFuncAttributeMaxDynamicSharedMemorySize, LDS_BYTES) == hipSuccess && hipFuncSetAttribute((const void*)phase_kernel<5>, hipFuncAttributeMaxDynamicSharedMemorySize, LDS_BYTES) == hipSuccess
              && hipFuncSetAttribute((const void*)phase_kernel<6>, hipFuncAttributeMaxDynamicSharedMemorySize, LDS_BYTES) == hipSuccess && hipFuncSetAttribute((const void*)phase_kernel<7>, hipFuncAttributeMaxDynamicSharedMemorySize, LDS_BYTES) == hipSuccess && hipFuncSetAttribute((const void*)phase_kernel<8>, hipFuncAttributeMaxDynamicSharedMemorySize, LDS_BYTES) == hipSuccess && hipFuncSetAttribute((const void*)phase_kernel<9>, hipFuncAttributeMaxDynamicSharedMemorySize, LDS_BYTES) == hipSuccess && hipFuncSetAttribute((const void*)phase_kernel<10>, hipFuncAttributeMaxDynamicSharedMemorySize, LDS_BYTES) == hipSuccess && hipFuncSetAttribute((const void*)phase_kernel<11>, hipFuncAttributeMaxDynamicSharedMemorySize, LDS_BYTES) == hipSuccess && hipFuncSetAttribute((const void*)phase_kernel<12>, hipFuncAttributeMaxDynamicSharedMemorySize, LDS_BYTES) == hipSuccess;
#endif
        if (!okattr) { fprintf(stderr, "kernel_launch: hipFuncSetAttribute failed\n"); grid = -1; return; }
        (void)hipGetLastError();
        grid = cus;
    }
    if (grid < 0) return;
    Args a{};
    a.x_prompt = (const float*)d_in[0]; a.x_sample = (const float*)d_in[1]; a.cache_k = (const float*)d_in[2]; a.cache_v = (const float*)d_in[3]; a.cache_logf = (const float*)d_in[4];
    a.state_ssm = (const float*)d_in[5]; a.state_conv = (const float*)d_in[6]; a.norm1_w = (const float*)d_in[7]; a.w_in = (const float*)d_in[8]; a.conv_w = (const float*)d_in[9];
    a.conv_b = (const float*)d_in[10]; a.dt_bias = (const float*)d_in[11]; a.A_log = (const float*)d_in[12]; a.D_skip = (const float*)d_in[13]; a.ssd_norm_w = (const float*)d_in[14];
    a.f_bias = (const float*)d_in[15]; a.q_norm_w = (const float*)d_in[16]; a.k_norm_w = (const float*)d_in[17]; a.w_out = (const float*)d_in[18]; a.norm2_w = (const float*)d_in[19];
    a.w_up = (const float*)d_in[20]; a.w_down = (const float*)d_in[21]; a.out = (float*)d_out; a.ws = (unsigned char*)d_ws;
#if ONE_LAUNCH
    if (hipMemsetAsync((char*)d_ws + WS_BARW, 0, 16384, stream) != hipSuccess) { fprintf(stderr, "kernel_launch: hipMemsetAsync failed\n"); return; }
    void* args[] = {&a};
    hipError_t e = hipLaunchCooperativeKernel((const void*)fwd_megakernel, dim3(grid), dim3(NWAVES * 64), args, LDS_BYTES, stream);
    if (e != hipSuccess) fprintf(stderr, "kernel_launch: cooperative launch failed: %s (grid %d)\n", hipGetErrorString(e), grid);
#else
    hipLaunchKernelGGL(phase_kernel<0>, dim3(grid), dim3(NWAVES * 64), LDS_BYTES, stream, a);
    hipLaunchKernelGGL(phase_kernel<1>, dim3(grid), dim3(NWAVES * 64), LDS_BYTES, stream, a);
    hipLaunchKernelGGL(phase_kernel<9>, dim3(grid), dim3(NWAVES * 64), LDS_BYTES, stream, a);
    hipLaunchKernelGGL(phase_kernel<2>, dim3(grid), dim3(NWAVES * 64), LDS_BYTES, stream, a);
    hipLaunchKernelGGL(phase_kernel<3>, dim3(grid), dim3(NWAVES * 64), LDS_BYTES, stream, a);
    hipLaunchKernelGGL(phase_kernel<4>, dim3(grid), dim3(NWAVES * 64), LDS_BYTES, stream, a);
    hipLaunchKernelGGL(phase_kernel<11>, dim3(grid), dim3(NWAVES * 64), LDS_BYTES, stream, a);
    hipLaunchKernelGGL(phase_kernel<8>, dim3(grid), dim3(NWAVES * 64), LDS_BYTES, stream, a);
    hipLaunchKernelGGL(phase_kernel<5>, dim3(grid), dim3(NWAVES * 64), LDS_BYTES, stream, a);
    hipLaunchKernelGGL(phase_kernel<6>, dim3(grid), dim3(NWAVES * 64), LDS_BYTES, stream, a);
    hipLaunchKernelGGL(phase_kernel<7>, dim3(grid), dim3(NWAVES * 64), LDS_BYTES, stream, a);
    hipLaunchKernelGGL(phase_kernel<10>, dim3(grid), dim3(NWAVES * 64), LDS_BYTES, stream, a);
    hipLaunchKernelGGL(phase_kernel<12>, dim3(grid), dim3(NWAVES * 64), LDS_BYTES, stream, a);
#endif
}
```

```cpp
#include <hip/hip_runtime.h>
#include <hip/hip_cooperative_groups.h>
#include <hip/hip_bf16.h>
#include <cstdio>
#include <cstdint>
#include <cmath>
namespace cg = cooperative_groups;

constexpr int DMODEL = 1024, PSEQ = 8192, PB = 8, MP = PB * PSEQ  , SBATCH = 32, SSEQ = 16, MS = SBATCH * SSEQ  , MT = MP + MS  ;
constexpr int PAST = 4096, NIN = 4352  , DFF = 4096, DMIX = 1536, DCONV = 1536;
constexpr float EPSN = 1e-6f, L2E = 1.4426950408889634f;
constexpr size_t O_Y = 0, O_PK = 67633152, O_PV = 101187584, O_PLF = 134742016, O_PSSM = 135266304, O_PCONV = 136314880, O_SK = 136351744, O_SV = 136613888,
                 O_SLF = 136876032, O_SSSM = 136880128, O_SCONV = 141074432, O_END = 141221888;
constexpr size_t MiB = 1u << 20;
constexpr size_t WS_BARW = 1152 * 1024, WS_CTR = 1120 * 1024, WS_SS1 = 0, WS_GSS = 512 * 1024, WS_DAT = 1088 * 1024, WS_CP = 2 * MiB, WS_WIN = 4 * MiB, WS_WOUT = WS_WIN + 8704 * 1024, WS_WUP = WS_WOUT + 3 * MiB, WS_WDN = WS_WUP + 8 * MiB;
constexpr size_t WS_XN = 32 * MiB, WS_DT = 161 * MiB, WS_SL = 166 * MiB, WS_ZS = 294 * MiB, WS_XBC = 423 * MiB, WS_QB = 617 * MiB, WS_KB = 682 * MiB, WS_VB = 747 * MiB, WS_MIX = 812 * MiB,
                 WS_H = 294 * MiB, WS_HIST = 1006 * MiB, WS_GSSP = 1012 * MiB, WS_SS1P = 1014 * MiB, WS_END = 1019 * MiB;
static_assert(WS_WDN + 8 * MiB <= WS_XN && WS_XN + (size_t)MT * 1024 * 2 <= WS_DT && WS_DT + (size_t)MT * 64 <= WS_SL && WS_SL + 128 * MiB <= WS_ZS, "ws map 1");
static_assert(WS_ZS + (size_t)MT * 2048 <= WS_XBC && WS_XBC + (size_t)(MT + 64) * 3072 <= WS_QB && WS_QB + (size_t)MT * 1024 <= WS_KB && WS_KB + (size_t)MT * 1024 <= WS_VB && WS_VB + (size_t)MT * 1024 <= WS_MIX, "ws map 2");
static_assert(WS_MIX + (size_t)MT * 3072 <= WS_END && WS_H + (size_t)MT * 8192 <= WS_MIX, "ws map 3");

typedef unsigned short bf16_t;
typedef short bf16x8 __attribute__((ext_vector_type(8)));
typedef float f32x4 __attribute__((ext_vector_type(4)));
typedef float f32x16 __attribute__((ext_vector_type(16)));
typedef unsigned u32x4 __attribute__((ext_vector_type(4)));
typedef unsigned u32x2 __attribute__((ext_vector_type(2)));
typedef float f32x2_t_ __attribute__((ext_vector_type(2)));
typedef __bf16 bf16x2_t_ __attribute__((ext_vector_type(2)));
__device__ __forceinline__ unsigned cvtpk(float lo, float hi) { f32x2_t_ v = {lo, hi}; bf16x2_t_ b = __builtin_convertvector(v, bf16x2_t_); return __builtin_bit_cast(unsigned, b); }
__device__ __forceinline__ float bf2f(unsigned u16) { return __uint_as_float(u16 << 16); }
__device__ __forceinline__ float silu_f(float v) { return v * __builtin_amdgcn_rcpf(1.0f + __expf(-v)); }
__device__ __forceinline__ float softplus_f(float v) { return v > 20.f ? v : log1pf(__expf(v)); }
__device__ __forceinline__ float logsigmoid_f(float v) { return fminf(v, 0.f) - log1pf(__expf(-fabsf(v))); }
__device__ __forceinline__ int crow_(int r, int hi) { return (r & 3) + 8 * (r >> 2) + 4 * hi; }
__device__ __forceinline__ void gatomic_add(float* p, float v) { (void)__builtin_amdgcn_global_atomic_fadd_f32((__attribute__((address_space(1))) float*)p, v); }
namespace pg8 {
#define PG8_LAS __attribute__((address_space(3)))
typedef unsigned short bf16_t;
typedef short bf16x8 __attribute__((ext_vector_type(8)));
typedef float f32x4 __attribute__((ext_vector_type(4)));
typedef unsigned u32x4 __attribute__((ext_vector_type(4)));
constexpr int BM = 256, BK = 64, HALF = 128, HTB = HALF * BK * 2  , STAGE_BYTES = 8 * HTB, NXCD = 8, WGM = 8;

__host__ __device__ __forceinline__ int lds_byte(int r, int c) { const int st = (r >> 4) * 2 + (c >> 5), rr = r & 15, cc = c & 31, ob = rr * 64 + cc * 2; return st * 1024 + (ob ^ (((ob >> 9) & 1) << 5)); }
__host__ __device__ __forceinline__ void stage_rc(int b, int& R, int& C) { const int st = b / 1024, sb = b % 1024, swz = sb ^ (((sb >> 9) & 1) << 5); R = (st >> 1) * 16 + swz / 64; C = (st & 1) * 32 + (swz % 64) / 2; }
__host__ __device__ __forceinline__ int perm32(int rho) { const int n = rho >> 4, i = rho & 15; return 8 * (i >> 2) + 4 * n + (i & 3); }

struct Unit { int pm, pn, k0; };
struct Gemm { const bf16_t* A; const bf16_t* Bt; int M, N, K, nt; };

struct StaticOrder {
    int nM, nN, nwg, G, c;
    __host__ __device__ void init(int M, int N, int G_, int c_) { nM = M / BM; nN = N / BM; nwg = nM * nN; G = G_; c = c_; }
    __host__ __device__ bool next(int i, Unit& u) const {
        const long L = (long)i * G + c; if (L >= nwg) return false;
        int wgid = (int)L; { const int q = nwg / NXCD, r = nwg % NXCD, xcd = wgid % NXCD, off = wgid / NXCD; wgid = (xcd < r ? xcd * (q + 1) : r * (q + 1) + (xcd - r) * q) + off; }
        const int nig = WGM * nN, gid = wgid / nig, fm = gid * WGM, gsz = (nM - fm) < WGM ? (nM - fm) : WGM;
        u.pm = fm + ((wgid % nig) % gsz); u.pn = (wgid % nig) / gsz; u.k0 = 0; return true;
    }
    __device__ __forceinline__ void a_ready(const Unit&) const {}
    __device__ __forceinline__ void done(const Unit&) const {}
};

struct ListOrder {
    int G, c, count, ntiles, pm0, npn, ksplit;
    __device__ __forceinline__ bool next(int i, Unit& u) const { const int L = i * G + c; if (L >= count) return false; const int tile = L % ntiles, ks = L / ntiles; u.pm = pm0 + tile / npn; u.pn = tile % npn; u.k0 = ks * ksplit; return true; }
    __device__ __forceinline__ void a_ready(const Unit&) const {}
    __device__ __forceinline__ void done(const Unit&) const {}
};

__device__ __forceinline__ void st_bf16x8(bf16_t* p, f32x4 a, f32x4 b) { u32x4 w; w.x = cvtpk(a[0], a[1]); w.y = cvtpk(a[2], a[3]); w.z = cvtpk(b[0], b[1]); w.w = cvtpk(b[2], b[3]); *(u32x4*)p = w; }
struct EpiIn {
    static constexpr bool PERM = true, AFTER_DRAIN = false, KHOOK = false;
    bf16_t *Zs, *XBC, *Qb, *Kb, *Vb; float* DT; float* out; const float *dt_bias, *f_bias, *qw, *kw; bf16_t* HIST;
    __device__ __forceinline__ void operator()(const f32x4 (&acc)[2][2][4][2], const Unit& u, int wr, int wc, int fr, int fq) const {
        const int pn = u.pn; const int lc = pn * 256 + wc * 64 + fq * 8;
        if (pn < 10) {
#pragma unroll
            for (int ai = 0; ai < 2; ++ai)
#pragma unroll
                for (int m = 0; m < 4; ++m) { const int row = u.pm * BM + ai * HALF + wr * 64 + m * 16 + fr;
#pragma unroll
                    for (int bj = 0; bj < 2; ++bj) { f32x4 v0 = acc[ai][bj][m][0], v1 = acc[ai][bj][m][1];
                        if (pn < 4) {
#pragma unroll
                            for (int e = 0; e < 4; ++e) { v0[e] = silu_f(v0[e]); v1[e] = silu_f(v1[e]); }
                            st_bf16x8(Zs + row * 1024 + lc + 32 * bj, v0, v1);
                        } else { const int c = lc - 1024 + 32 * bj;
                            st_bf16x8(XBC + row * 1536 + c, v0, v1);
                            if (row < MP && (row & 127) >= 125) st_bf16x8(HIST + ((row >> 7) * 3 + ((row & 127) - 125)) * DCONV + c, v0, v1);
                            float* cs = nullptr;
                            if (row < MP) { const int t = (int)(row & (PSEQ - 1)); if (t >= PSEQ - 3) cs = out + O_PCONV + ((row >> 13) * 3 + (t - (PSEQ - 3))) * DCONV + c; }
                            else { const int sr = (int)(row - MP), t = sr & 15; if (t >= 13) cs = out + O_SCONV + ((sr >> 4) * 3 + (t - 13)) * DCONV + c; }
                            if (cs) { *(f32x4*)cs = v0; *(f32x4*)(cs + 4) = v1; } } } }
        } else if (pn < 14) {
            const bool isq = pn < 12; const float* w = isq ? qw : kw; const int hcol = lc - (isq ? 2560 : 3072);
#pragma unroll
            for (int ai = 0; ai < 2; ++ai)
#pragma unroll
                for (int m = 0; m < 4; ++m) { const int row = u.pm * BM + ai * HALF + wr * 64 + m * 16 + fr; float ss = 0.f;
#pragma unroll
                    for (int bj = 0; bj < 2; ++bj)
#pragma unroll
                        for (int n = 0; n < 2; ++n) { const f32x4 x = acc[ai][bj][m][n]; ss += (x[0] * x[0] + x[1] * x[1]) + (x[2] * x[2] + x[3] * x[3]); }
                    ss += __shfl_xor(ss, 16); ss += __shfl_xor(ss, 32);
                    const float rs = rsqrtf(ss * (1.0f / 64.0f) + EPSN); const float rq = isq ? rs * (0.125f * L2E) : rs;
#pragma unroll
                    for (int bj = 0; bj < 2; ++bj) { const f32x4 o0 = acc[ai][bj][m][0] * *(const f32x4*)(w + 32 * bj + 8 * fq), o1 = acc[ai][bj][m][1] * *(const f32x4*)(w + 32 * bj + 8 * fq + 4);
                        st_bf16x8((isq ? Qb : Kb) + row * 512 + hcol + 32 * bj, o0 * rq, o1 * rq);
                        if (!isq) { float* kp = (row < MP ? out + O_PK + row * 512 : out + O_SK + (row - MP) * 512) + hcol + 32 * bj; __builtin_nontemporal_store(o0 * rs, (f32x4*)kp); __builtin_nontemporal_store(o1 * rs, (f32x4*)(kp + 4)); }     } }
        } else if (pn < 16) {
            const int hcol = lc - 3584;
#pragma unroll
            for (int ai = 0; ai < 2; ++ai)
#pragma unroll
                for (int m = 0; m < 4; ++m) { const int row = u.pm * BM + ai * HALF + wr * 64 + m * 16 + fr;
#pragma unroll
                    for (int bj = 0; bj < 2; ++bj) { const f32x4 v0 = acc[ai][bj][m][0], v1 = acc[ai][bj][m][1];
                        st_bf16x8(Vb + row * 512 + hcol + 32 * bj, v0, v1);
                        float* vp = (row < MP ? out + O_PV + row * 512 : out + O_SV + (row - MP) * 512) + hcol + 32 * bj; __builtin_nontemporal_store(v0, (f32x4*)vp); __builtin_nontemporal_store(v1, (f32x4*)(vp + 4)); } }
        } else {
            if (wc == 0 && fq < 3) {
                const f32x4 b0 = fq < 2 ? *(const f32x4*)(dt_bias + 8 * fq) : *(const f32x4*)(f_bias), b1 = fq < 2 ? *(const f32x4*)(dt_bias + 8 * fq + 4) : *(const f32x4*)(f_bias + 4);
#pragma unroll
                for (int ai = 0; ai < 2; ++ai)
#pragma unroll
                    for (int m = 0; m < 4; ++m) { const int row = u.pm * BM + ai * HALF + wr * 64 + m * 16 + fr;
                        f32x4 v0 = acc[ai][0][m][0] + b0, v1 = acc[ai][0][m][1] + b1;
                        if (fq < 2) {
#pragma unroll
                            for (int e = 0; e < 4; ++e) { v0[e] = softplus_f(v0[e]); v1[e] = softplus_f(v1[e]); }
                            float* dp = DT + row * 16 + 8 * fq; *(f32x4*)dp = v0; *(f32x4*)(dp + 4) = v1;
                        } else {
#pragma unroll
                            for (int e = 0; e < 4; ++e) { v0[e] = logsigmoid_f(v0[e]); v1[e] = logsigmoid_f(v1[e]); }
                            float* lp = (row < MP ? out + O_PLF + row * 8 : out + O_SLF + (row - MP) * 8); *(f32x4*)lp = v0; *(f32x4*)(lp + 4) = v1; } }
            }
        }
    }
};
struct EpiOut {
    static constexpr bool PERM = true, AFTER_DRAIN = false, KHOOK = true;
    const float *xp, *xs; float* Y; bf16_t* X1b; float* SS1; const float* GSS;
    __device__ __forceinline__ void khook(f32x4 (&acc)[2][2][4][2], const Unit& u, int t, int wr, int fr) const {
#pragma unroll
        for (int ai = 0; ai < 2; ++ai)
#pragma unroll
            for (int m = 0; m < 4; ++m) { const int row = u.pm * BM + ai * HALF + wr * 64 + m * 16 + fr;
                const f32x4 gp = *(const f32x4*)(GSS + (unsigned)(row * 4)); const float g0 = gp[0] + gp[1], g1 = gp[2] + gp[3];
                const float r0 = rsqrtf(g0 * (1.0f / 512.0f) + EPSN), r1 = rsqrtf(g1 * (1.0f / 512.0f) + EPSN);
                const float f = (t == 8) ? r0 / r1 : r1;
#pragma unroll
                for (int bj = 0; bj < 2; ++bj)
#pragma unroll
                    for (int n = 0; n < 2; ++n) acc[ai][bj][m][n] *= f; }
    }
    __device__ __forceinline__ void operator()(const f32x4 (&acc)[2][2][4][2], const Unit& u, int wr, int wc, int fr, int fq) const {
        const int col0 = u.pn * BM + wc * 32 + 8 * fq; float ssv[8];
#pragma unroll
        for (int ai = 0; ai < 2; ++ai)
#pragma unroll
            for (int m = 0; m < 4; ++m) { const int row = u.pm * BM + ai * HALF + wr * 64 + m * 16 + fr;
                const float* xr = row < MP ? xp + row * 1024 : xs + (row - MP) * 1024; float ss = 0.f;
#pragma unroll
                for (int bj = 0; bj < 2; ++bj) { const int c = col0 + bj * HALF;
                    const f32x4 o0 = __builtin_nontemporal_load((const f32x4*)(xr + c)) + acc[ai][bj][m][0], o1 = __builtin_nontemporal_load((const f32x4*)(xr + c + 4)) + acc[ai][bj][m][1];
                    *(f32x4*)(Y + row * 1024 + c) = o0; *(f32x4*)(Y + row * 1024 + c + 4) = o1; st_bf16x8(X1b + row * 1024 + c, o0, o1);
                    ss += (o0[0] * o0[0] + o0[1] * o0[1]) + (o0[2] * o0[2] + o0[3] * o0[3]) + (o1[0] * o1[0] + o1[1] * o1[1]) + (o1[2] * o1[2] + o1[3] * o1[3]); }
                ss += __shfl_xor(ss, 16); ss += __shfl_xor(ss, 32);
                ssv[ai * 4 + m] = ss; }
        if (fq == 0) {
#pragma unroll
            for (int ai = 0; ai < 2; ++ai)
#pragma unroll
                for (int m = 0; m < 4; ++m) SS1[(unsigned)((u.pm * BM + ai * HALF + wr * 64 + m * 16 + fr) * 16 + u.pn * 4 + wc)] = ssv[ai * 4 + m]; }
    }
};
struct EpiUp {
    static constexpr bool PERM = true, AFTER_DRAIN = false, KHOOK = false;
    const float* SS1; bf16_t* H;
    __device__ __forceinline__ void operator()(const f32x4 (&acc)[2][2][4][2], const Unit& u, int wr, int wc, int fr, int fq) const {
        const int col0 = u.pn * BM + wc * 32 + 8 * fq;
#pragma unroll
        for (int ai = 0; ai < 2; ++ai)
#pragma unroll
            for (int m = 0; m < 4; ++m) { const int row = u.pm * BM + ai * HALF + wr * 64 + m * 16 + fr;
                const f32x4 s0 = *(const f32x4*)(SS1 + (unsigned)(row * 16)), s1 = *(const f32x4*)(SS1 + (unsigned)(row * 16 + 4)), s2 = *(const f32x4*)(SS1 + (unsigned)(row * 16 + 8)), s3 = *(const f32x4*)(SS1 + (unsigned)(row * 16 + 12));
                const f32x4 st = (s0 + s1) + (s2 + s3); const float r2 = 1.0f / (((st[0] + st[1]) + (st[2] + st[3])) * (1.0f / 1024.0f) + EPSN);
#pragma unroll
                for (int bj = 0; bj < 2; ++bj) { f32x4 v0 = acc[ai][bj][m][0], v1 = acc[ai][bj][m][1];
#pragma unroll
                    for (int e = 0; e < 4; ++e) { const float a = fmaxf(v0[e], 0.f), b = fmaxf(v1[e], 0.f); v0[e] = a * a * r2; v1[e] = b * b * r2; }
                    st_bf16x8(H + row * DFF + col0 + bj * HALF, v0, v1); } }
    }
};
struct EpiDown {
    static constexpr bool PERM = true, AFTER_DRAIN = false, KHOOK = false;
    float* Y;
    __device__ __forceinline__ void operator()(const f32x4 (&acc)[2][2][4][2], const Unit& u, int wr, int wc, int fr, int fq) const {
        const int col0 = u.pn * BM + wc * 32 + 8 * fq;
#pragma unroll
        for (int ai = 0; ai < 2; ++ai)
#pragma unroll
            for (int m = 0; m < 4; ++m) { const int row = u.pm * BM + ai * HALF + wr * 64 + m * 16 + fr;
#pragma unroll
                for (int bj = 0; bj < 2; ++bj) { float* p = Y + row * 1024 + col0 + bj * HALF;
                    const f32x4 o0 = *(const f32x4*)p + acc[ai][bj][m][0], o1 = *(const f32x4*)(p + 4) + acc[ai][bj][m][1]; __builtin_nontemporal_store(o0, (f32x4*)p); __builtin_nontemporal_store(o1, (f32x4*)(p + 4)); } }
    }
};
struct EpiDownPartial {
    static constexpr bool PERM = true, AFTER_DRAIN = false, KHOOK = false;
    float* PART;
    __device__ __forceinline__ void operator()(const f32x4 (&acc)[2][2][4][2], const Unit& u, int wr, int wc, int fr, int fq) const {
        const int col0 = u.pn * BM + wc * 32 + 8 * fq;
#pragma unroll
        for (int ai = 0; ai < 2; ++ai)
#pragma unroll
            for (int m = 0; m < 4; ++m) { const int row = (u.pm - MP / 256) * BM + ai * HALF + wr * 64 + m * 16 + fr;
#pragma unroll
                for (int bj = 0; bj < 2; ++bj) { float* p = PART + (unsigned)(row * 1024 + col0 + bj * HALF); *(f32x4*)p = acc[ai][bj][m][0]; *(f32x4*)(p + 4) = acc[ai][bj][m][1]; } }
    }
};
template <class Epi, class Sched, bool ALIGN_EPI = false, bool SP2 = false>
__device__ __forceinline__ void gemm_phase(PG8_LAS unsigned char* lds, const Gemm g, const Sched& S, const Epi& E) {
    int tid_ = threadIdx.x; asm volatile("" : "+v"(tid_));
    const int tid = tid_, wid = __builtin_amdgcn_readfirstlane(tid >> 6), lane = tid & 63, wr = wid >> 2, wc = wid & 3, fr = lane & 15, fq = lane >> 4;
    const int K = g.K; int nt_ = g.nt ? g.nt : K / BK; asm volatile("" : "+s"(nt_)); const int nt = nt_;
    unsigned voffA[2], voffB[2];
#pragma unroll
    for (int i = 0; i < 2; ++i) { int R, C; stage_rc(tid * 16 + i * 8192, R, C); const int Rb = Epi::PERM ? ((R & ~31) + perm32(R & 31)) : R;
        voffA[i] = (unsigned)(R * K + C) * 2u; voffB[i] = (unsigned)(Rb * K + C) * 2u; }
    const size_t kstep = (size_t)(BK * 2);
    const size_t hstep = (size_t)HALF * K * 2;
    const size_t tstep = 2 * hstep;
    const unsigned ldsw = (unsigned)wid * 1024u;
    const int aoff = lds_byte(wr * 64 + fr, fq * 8), boff = lds_byte(wc * 32 + fr, fq * 8);
#define PG8_SA(b, h) (((b) * 2 + (h)) * HTB)
#define PG8_SB(b, h) ((4 + (b) * 2 + (h)) * HTB)
#define PG8_STAGE(bufoff, gbase, voff) do { _Pragma("unroll") for (int _i = 0; _i < 2; ++_i) \
        __builtin_amdgcn_global_load_lds((const unsigned*)((const char*)(gbase) + (voff)[_i]), (PG8_LAS unsigned*)(lds + (bufoff) + ldsw + _i * 8192), 16, 0, 0); } while (0)
#define PG8_LDA(dst, b, h) do { _Pragma("unroll") for (int m = 0; m < 4; ++m) _Pragma("unroll") for (int k = 0; k < 2; ++k) dst[m][k] = *(const PG8_LAS bf16x8*)(lds + PG8_SA(b, h) + aoff + m * 2048 + k * 1024); } while (0)
#define PG8_LDB(dst, b, h) do { _Pragma("unroll") for (int n = 0; n < 2; ++n) _Pragma("unroll") for (int k = 0; k < 2; ++k) dst[n][k] = *(const PG8_LAS bf16x8*)(lds + PG8_SB(b, h) + boff + n * 2048 + k * 1024); } while (0)
#define PG8_MMA(ai, bj, At, Bt) do { __builtin_amdgcn_s_setprio(1); _Pragma("unroll") for (int m = 0; m < 4; ++m) _Pragma("unroll") for (int n = 0; n < 2; ++n) _Pragma("unroll") for (int k = 0; k < 2; ++k) \
        acc[ai][bj][m][n] = __builtin_amdgcn_mfma_f32_16x16x32_bf16(Bt[n][k], At[m][k], acc[ai][bj][m][n], 0, 0, 0); __builtin_amdgcn_s_setprio(0); } while (0)
#define PG8_WAIT_V(n) asm volatile("s_waitcnt vmcnt(" #n ")" ::: "memory")
#define PG8_WAIT_L(n) asm volatile("s_waitcnt lgkmcnt(" #n ")" ::: "memory")
#define PG8_BAR __builtin_amdgcn_s_barrier()
#define PG8_SCHED __builtin_amdgcn_sched_barrier(0)
    Unit cur, nxt; int ui = 0;
    if (!S.next(0, cur)) return;
    f32x4 acc[2][2][4][2];
#pragma unroll
    for (int a = 0; a < 2; ++a)
#pragma unroll
        for (int b = 0; b < 2; ++b)
#pragma unroll
            for (int m = 0; m < 4; ++m)
#pragma unroll
                for (int n = 0; n < 2; ++n) acc[a][b][m][n] = (f32x4){0.f, 0.f, 0.f, 0.f};
    bf16x8 At[4][2], B0[2][2], B1[2][2];
    const char* cA = (const char*)g.A + (size_t)cur.pm * tstep + (size_t)cur.k0 * 2; const char* cB = (const char*)g.Bt + (size_t)cur.pn * tstep + (size_t)cur.k0 * 2;
    S.a_ready(cur);
    if constexpr (SP2) {
        PG8_STAGE(PG8_SB(0, 0), cB, voffB); PG8_STAGE(PG8_SB(0, 1), cB + hstep, voffB); PG8_STAGE(PG8_SA(0, 0), cA, voffA); PG8_STAGE(PG8_SA(0, 1), cA + hstep, voffA);
        if (wr == 1) PG8_BAR;
        PG8_WAIT_V(2); PG8_BAR;
        PG8_STAGE(PG8_SB(1, 0), cB + kstep, voffB); PG8_STAGE(PG8_SA(1, 0), cA + kstep, voffA); PG8_STAGE(PG8_SB(1, 1), cB + hstep + kstep, voffB);
        PG8_WAIT_V(6); PG8_BAR;
    } else {
        PG8_STAGE(PG8_SB(0, 0), cB, voffB); PG8_STAGE(PG8_SA(0, 0), cA, voffA); PG8_STAGE(PG8_SB(0, 1), cB + hstep, voffB); PG8_STAGE(PG8_SA(0, 1), cA + hstep, voffA);
        if (wr == 1) PG8_BAR;
        PG8_WAIT_V(4); PG8_BAR;
        PG8_STAGE(PG8_SB(1, 0), cB + kstep, voffB); PG8_STAGE(PG8_SA(1, 0), cA + kstep, voffA); PG8_STAGE(PG8_SB(1, 1), cB + hstep + kstep, voffB);
        PG8_WAIT_V(6); PG8_BAR;
    }
    for (;;) {
        const bool has_next = S.next(ui + 1, nxt);
        const char* nA = has_next ? (const char*)g.A + (size_t)nxt.pm * tstep + (size_t)nxt.k0 * 2 : cA; const char* nB = has_next ? (const char*)g.Bt + (size_t)nxt.pn * tstep + (size_t)nxt.k0 * 2 : cB;
        for (int t = 0; t < nt; t += 2) {
            if constexpr (Epi::KHOOK) { if (t == 8 || t == 16) E.khook(acc, cur, t, wr, fr); }
            const bool last = (t == nt - 2);
            const char* a1 = cA + (size_t)(t + 1) * kstep;
            const char* a2 = last ? nA : cA + (size_t)(t + 2) * kstep; const char* b2 = last ? nB : cB + (size_t)(t + 2) * kstep;
            const char* a3 = a2 + kstep; const char* b3 = b2 + kstep;
            if (last && has_next) S.a_ready(nxt);
            if constexpr (SP2) {
            PG8_LDB(B0, 0, 0); PG8_LDB(B1, 0, 1); PG8_SCHED; PG8_LDA(At, 0, 0); PG8_STAGE(PG8_SA(1, 1), a1 + hstep, voffA);
            PG8_WAIT_V(8); PG8_WAIT_L(0); PG8_BAR; PG8_MMA(0, 0, At, B0); PG8_MMA(0, 1, At, B1); PG8_BAR; PG8_SCHED;
            PG8_LDA(At, 0, 1); PG8_STAGE(PG8_SB(0, 0), b2, voffB); PG8_STAGE(PG8_SB(0, 1), b2 + hstep, voffB); PG8_STAGE(PG8_SA(0, 0), a2, voffA);
            PG8_WAIT_V(8); PG8_WAIT_L(0); PG8_BAR; PG8_MMA(1, 0, At, B0); PG8_MMA(1, 1, At, B1); PG8_BAR; PG8_SCHED;
            PG8_LDB(B0, 1, 0); PG8_LDB(B1, 1, 1); PG8_SCHED; PG8_LDA(At, 1, 0); PG8_STAGE(PG8_SA(0, 1), a2 + hstep, voffA);
            PG8_WAIT_V(8); PG8_WAIT_L(0); PG8_BAR; PG8_MMA(0, 0, At, B0); PG8_MMA(0, 1, At, B1); PG8_BAR; PG8_SCHED;
            PG8_LDA(At, 1, 1); PG8_STAGE(PG8_SB(1, 0), b3, voffB); PG8_STAGE(PG8_SB(1, 1), b3 + hstep, voffB); PG8_STAGE(PG8_SA(1, 0), a3, voffA);
            PG8_WAIT_V(8); PG8_WAIT_L(0); PG8_BAR; PG8_MMA(1, 0, At, B0); PG8_MMA(1, 1, At, B1); PG8_BAR; PG8_SCHED;
            } else {
            PG8_LDB(B0, 0, 0); PG8_SCHED; PG8_LDA(At, 0, 0); PG8_STAGE(PG8_SA(1, 1), a1 + hstep, voffA);
            PG8_WAIT_L(8); PG8_BAR; PG8_WAIT_L(0); PG8_MMA(0, 0, At, B0); PG8_BAR; PG8_SCHED;
            PG8_LDB(B1, 0, 1); PG8_STAGE(PG8_SB(0, 0), b2, voffB);
            PG8_BAR; PG8_WAIT_L(0); PG8_MMA(0, 1, At, B1); PG8_BAR;
            PG8_LDA(At, 0, 1); PG8_STAGE(PG8_SA(0, 0), a2, voffA);
            PG8_BAR; PG8_WAIT_L(0); PG8_MMA(1, 0, At, B0); PG8_BAR; PG8_SCHED;
            PG8_STAGE(PG8_SB(0, 1), b2 + hstep, voffB);
            PG8_WAIT_V(6); PG8_BAR; PG8_MMA(1, 1, At, B1); PG8_BAR;
            PG8_LDB(B0, 1, 0); PG8_SCHED; PG8_LDA(At, 1, 0); PG8_STAGE(PG8_SA(0, 1), a2 + hstep, voffA);
            PG8_WAIT_L(8); PG8_BAR; PG8_WAIT_L(0); PG8_MMA(0, 0, At, B0); PG8_BAR; PG8_SCHED;
            PG8_LDB(B1, 1, 1); PG8_STAGE(PG8_SB(1, 0), b3, voffB);
            PG8_BAR; PG8_WAIT_L(0); PG8_MMA(0, 1, At, B1); PG8_BAR;
            PG8_LDA(At, 1, 1); PG8_STAGE(PG8_SA(1, 0), a3, voffA);
            PG8_BAR; PG8_WAIT_L(0); PG8_MMA(1, 0, At, B0); PG8_BAR; PG8_SCHED;
            PG8_STAGE(PG8_SB(1, 1), b3 + hstep, voffB);
            PG8_WAIT_V(6); PG8_BAR; PG8_MMA(1, 1, At, B1); PG8_BAR;
            }
        }
        if constexpr (ALIGN_EPI) { if (wr == 0) PG8_BAR; }
        if constexpr (!Epi::AFTER_DRAIN) { E(acc, cur, wr, wc, fr, fq); S.done(cur); }
        if (!has_next) break;
#pragma unroll
        for (int a = 0; a < 2; ++a)
#pragma unroll
            for (int b = 0; b < 2; ++b)
#pragma unroll
                for (int m = 0; m < 4; ++m)
#pragma unroll
                    for (int n = 0; n < 2; ++n) acc[a][b][m][n] = (f32x4){0.f, 0.f, 0.f, 0.f};
        cur = nxt; cA = nA; cB = nB; ++ui;
        if constexpr (ALIGN_EPI) { if (wr == 1) PG8_BAR; }
    }
    PG8_WAIT_V(0);
    if constexpr (!ALIGN_EPI) { if (wr == 0) PG8_BAR; }
    PG8_BAR;
    if constexpr (Epi::AFTER_DRAIN) { E.fused(acc, cur, wr, wc, fr, fq, lds, wid, lane); S.done(cur); }
#undef PG8_SA
#undef PG8_SB
#undef PG8_STAGE
#undef PG8_LDA
#undef PG8_LDB
#undef PG8_MMA
#undef PG8_WAIT_V
#undef PG8_WAIT_L
#undef PG8_BAR
#undef PG8_SCHED
}
}
#include <hip/hip_bf16.h>
#include <cmath>
namespace attn_body {
using bf16=__hip_bfloat16;
using bf16x8=__attribute__((ext_vector_type(8)))short;
using s16x4=__attribute__((ext_vector_type(4)))short;
using f32x16=__attribute__((ext_vector_type(16)))float;
using u32x4=__attribute__((ext_vector_type(4)))unsigned;
constexpr int BATCH=8,NHEAD=8,SEQ=8192,D=64,DM=NHEAD*D,OP=1536;
constexpr int NW=8,QBLK=32,QB=QBLK*NW,KVBLK=64,NQB=SEQ/QB;
constexpr int ATTN_PITCH=DM, ATTN_UNIT_ROWS=QB;
__device__ __forceinline__ int crow(int r,int hi){return (r&3)+8*(r>>2)+4*hi;}
#define SBAR() __builtin_amdgcn_sched_barrier(0)
__device__ __forceinline__ void cmask(f32x16&p0,f32x16&p1,int jb,int qrel,int hi){
  const float NEG=-INFINITY; int kb=64*jb+4*hi;
  #pragma unroll
  for(int r=0;r<16;++r){int kv=kb+(r&3)+8*(r>>2); if(kv>qrel)p0[r]=NEG; if(kv+32>qrel)p1[r]=NEG;}
}

constexpr int NSLOT=3, SLOTB=8192;
constexpr int LDS_K=0, LDS_V=NSLOT*SLOTB, LDS_WS=2*NSLOT*SLOTB, LDS_OST=LDS_WS+NW*64*4, LDS_C=LDS_OST+NW*4096, LDS_BYTES=LDS_C+SEQ*4;
constexpr float SKIP_L2=64.0f*1.4426950408889634f;
constexpr float C2=0.125f*1.4426950408889634f;
__device__ __forceinline__ void glds16(const void*gsrc,unsigned lds_dst){unsigned keep;
  asm volatile("s_mov_b32 %0, m0\n\ts_mov_b32 m0, %2\n\ts_nop 0\n\tglobal_load_lds_dwordx4 %1, off\n\ts_mov_b32 m0, %0":"=&s"(keep):"v"(gsrc),"s"(lds_dst):"memory");}
__device__ __forceinline__ float max3f(float a,float b,float c){float r;asm("v_max3_f32 %0, %1, %2, %3":"=v"(r):"v"(a),"v"(b),"v"(c));return r;}
__device__ __forceinline__ float max2f(float a,float b){float r;asm("v_max_f32_e32 %0, %1, %2":"=v"(r):"v"(a),"v"(b));return r;}
__device__ __forceinline__ float fadd_s(float a,float b){float r;asm("v_add_f32_e32 %0, %1, %2":"=v"(r):"v"(a),"v"(b));return r;}
__device__ __forceinline__ float fsub_s(float a,float b){float r;asm("v_sub_f32_e32 %0, %1, %2":"=v"(r):"v"(a),"v"(b));return r;}
typedef float f32x2_t __attribute__((ext_vector_type(2))); typedef __bf16 bf16x2_t __attribute__((ext_vector_type(2)));
__device__ __forceinline__ unsigned cvtpk_s(float lo,float hi){f32x2_t v={lo,hi};bf16x2_t b=__builtin_convertvector(v,bf16x2_t);return __builtin_bit_cast(unsigned,b);}
#define WAIT_BAR(N) asm volatile("s_waitcnt vmcnt(" #N ") lgkmcnt(0)\n\ts_barrier":::"memory")

__device__ __forceinline__ void qkt(f32x16&p0,f32x16&p1,const char*Kslot,const bf16x8*qr,const f32x16&cin0,const f32x16&cin1,int r32,int hi){
  const char*kb=Kslot+hi*1024+r32*16;
  #pragma unroll
  for(int d0=0;d0<4;++d0){
    const bf16x8 b0=*reinterpret_cast<const bf16x8*>(kb+d0*2048);
    const bf16x8 b1=*reinterpret_cast<const bf16x8*>(kb+d0*2048+512);
    if(d0==0){p0=__builtin_amdgcn_mfma_f32_32x32x16_bf16(b0,qr[0],cin0,0,0,0);p1=__builtin_amdgcn_mfma_f32_32x32x16_bf16(b1,qr[0],cin1,0,0,0);}
    else{p0=__builtin_amdgcn_mfma_f32_32x32x16_bf16(b0,qr[d0],p0,0,0,0);p1=__builtin_amdgcn_mfma_f32_32x32x16_bf16(b1,qr[d0],p1,0,0,0);}}
}
typedef __attribute__((address_space(3))) const char* lds_cptr;
typedef short v4i16_t __attribute__((ext_vector_type(4)));
__device__ __forceinline__ void kload8(bf16x8*kf,lds_cptr kp){
  kf[0]=*(const __attribute__((address_space(3))) bf16x8*)(kp);      kf[1]=*(const __attribute__((address_space(3))) bf16x8*)(kp+512);
  kf[2]=*(const __attribute__((address_space(3))) bf16x8*)(kp+2048); kf[3]=*(const __attribute__((address_space(3))) bf16x8*)(kp+2560);
  kf[4]=*(const __attribute__((address_space(3))) bf16x8*)(kp+4096); kf[5]=*(const __attribute__((address_space(3))) bf16x8*)(kp+4608);
  kf[6]=*(const __attribute__((address_space(3))) bf16x8*)(kp+6144); kf[7]=*(const __attribute__((address_space(3))) bf16x8*)(kp+6656);
}
__device__ __forceinline__ void kload2(bf16x8*kf,lds_cptr kp,int j){ kf[2*j]=*(const __attribute__((address_space(3))) bf16x8*)(kp+j*2048); kf[2*j+1]=*(const __attribute__((address_space(3))) bf16x8*)(kp+j*2048+512); }
__device__ __forceinline__ s16x4 vtr(lds_cptr p){ return __builtin_bit_cast(s16x4,__builtin_amdgcn_ds_read_tr16_b64_v4i16((__attribute__((address_space(3))) v4i16_t*)p)); }
__device__ __forceinline__ float rowmax(const f32x16&p0,const f32x16&p1){
  float a=max3f(p0[0],p0[1],p1[0]),b=max3f(p0[2],p0[3],p1[1]);a=max3f(a,p1[2],p1[3]);
  #pragma unroll
  for(int r=4;r<16;r+=4){a=max3f(a,p0[r],p0[r+1]);b=max3f(b,p0[r+2],p0[r+3]);a=max3f(a,p1[r],p1[r+1]);b=max3f(b,p1[r+2],p1[r+3]);}
  const float m=max2f(a,b);
  auto rr=__builtin_amdgcn_permlane32_swap(__float_as_uint(m),__float_as_uint(m),false,false);
  return max2f(__uint_as_float(rr[0]),__uint_as_float(rr[1]));
}
__device__ __forceinline__ void pv(f32x16*o,int vb,bf16x8 pa0,bf16x8 pa1,bf16x8 pa2,bf16x8 pa3){
  #pragma unroll
  for(int d0=0;d0<2;++d0){s16x4 lo[4],hi[4];
    #pragma unroll
    for(int ks=0;ks<4;++ks){
      asm volatile("ds_read_b64_tr_b16 %0,%1 offset:%c2":"=&v"(lo[ks]):"v"(vb),"i"(d0*4096+ks*1024):"memory");
      asm volatile("ds_read_b64_tr_b16 %0,%1 offset:%c2":"=&v"(hi[ks]):"v"(vb),"i"(d0*4096+ks*1024+512):"memory");}
    asm volatile("s_waitcnt lgkmcnt(0)":::"memory");SBAR();
    #define PK(k) (bf16x8){lo[k][0],lo[k][1],lo[k][2],lo[k][3],hi[k][0],hi[k][1],hi[k][2],hi[k][3]}
    o[d0]=__builtin_amdgcn_mfma_f32_32x32x16_bf16(pa0,PK(0),o[d0],0,0,0);
    o[d0]=__builtin_amdgcn_mfma_f32_32x32x16_bf16(pa1,PK(1),o[d0],0,0,0);
    o[d0]=__builtin_amdgcn_mfma_f32_32x32x16_bf16(pa2,PK(2),o[d0],0,0,0);
    o[d0]=__builtin_amdgcn_mfma_f32_32x32x16_bf16(pa3,PK(3),o[d0],0,0,0);
    #undef PK
  }
}

#ifndef ATTN_STORE16
#define ATTN_STORE16(p,v) (*(u32x4*)(p)=(v))
#endif
template<int THRL> __device__ __forceinline__ void attn_unit(int b,int h,int qb,const bf16*Q,const bf16*__restrict__ K,const bf16*__restrict__ V,bf16*O,const float*__restrict__ CPL,float skipl2,char*shm){
  int tid_=threadIdx.x; asm volatile("":"+v"(tid_)); const int tid=tid_,lane=tid&63,r32=lane&31,hi=lane>>5; const int wid=__builtin_amdgcn_readfirstlane(tid>>6);
  const long rowbase=(long)b*SEQ; const int q0=qb*QB;
  const bf16*Qw=Q+(rowbase+q0+wid*QBLK)*DM+h*D;
  const float*cg=CPL+((long)(b*NHEAD+h))*SEQ; const int NTF=(q0+QB)/KVBLK; int tst;
  { const float c0=cg[q0]; const int t1=lane,t2=lane+64;
    const bool s1=(t1<NTF-4)&&((c0-cg[64*t1+63])<-skipl2), s2=(t2<NTF-4)&&((c0-cg[64*t2+63])<-skipl2);
    tst=(__builtin_popcountll(__ballot(s1))+__builtin_popcountll(__ballot(s2)))&~1; tst=__builtin_amdgcn_readfirstlane(tst); }
  const bf16*Kh=K+(rowbase+(long)tst*KVBLK)*DM+h*D,*Vh=V+(rowbase+(long)tst*KVBLK)*DM+h*D;
  const unsigned lds0=(unsigned)(uintptr_t)shm;
  float*wsf=(float*)(shm+LDS_WS)+wid*64;
  const bf16*ksrc=Kh+(long)lane*DM+wid*8;
  const bf16*vsrc=Vh+(long)(16*(wid&3)+(lane>>2))*DM+(wid>>2)*32+(lane&3)*8;
  const unsigned kdst=lds0+LDS_K+wid*1024, vdst=lds0+LDS_V+wid*1024;
  #define DMA_K(t,slot) glds16(ksrc+(long)(t)*KVBLK*DM,(unsigned)__builtin_amdgcn_readfirstlane(kdst+(slot)))
  #define DMA_V(t,slot) glds16(vsrc+(long)(t)*KVBLK*DM,(unsigned)__builtin_amdgcn_readfirstlane(vdst+(slot)))
  const int vb0=(int)(lds0+LDS_V)+((lane>>4)&1)*32+(lane&3)*8+(4*hi+((lane&15)>>2))*64;
  const char*Kbase=shm+LDS_K; bf16x8 kf[8];
  const lds_cptr shm3=(lds_cptr)shm; const lds_cptr kp0=shm3+LDS_K+hi*1024+r32*16; const lds_cptr vp0=shm3+LDS_V+((lane>>4)&1)*32+(lane&3)*8+(4*hi+((lane&15)>>2))*64;
  const int NT=NTF-tst;
  float*cL=(float*)(shm+LDS_C);
  for(int i=tid;i<NT*KVBLK/4;i+=NW*64){ *(float4*)(cL+4*i)=*(const float4*)(cg+tst*KVBLK+4*i); }
  const float cq=cg[q0+wid*QBLK+r32]; float qm=cq;
  asm volatile("s_waitcnt vmcnt(0) lgkmcnt(0)":::"memory");
  DMA_K(0,0);DMA_V(0,0);DMA_K(1,SLOTB);
  bf16x8 qr[4];
  #pragma unroll
  for(int d0=0;d0<4;++d0)qr[d0]=*reinterpret_cast<const bf16x8*>(&Qw[(long)r32*DM+d0*16+hi*8]);
  float mhat=0.f,l_reg=0.f;f32x16 o[2];o[0]=f32x16{};o[1]=f32x16{};f32x16 cb0,cb1;
  const int qrel=wid*QBLK+r32;
  #define CBIAS(t) do{ const float*cp_=cL+(t)*KVBLK+4*hi; \
    _Pragma("unroll") for(int i_=0;i_<4;++i_){ const float4 u0_=*(const float4*)(cp_+8*i_), u1_=*(const float4*)(cp_+32+8*i_); \
      cb0[4*i_]=qm-u0_.x;cb0[4*i_+1]=qm-u0_.y;cb0[4*i_+2]=qm-u0_.z;cb0[4*i_+3]=qm-u0_.w; \
      cb1[4*i_]=qm-u1_.x;cb1[4*i_+1]=qm-u1_.y;cb1[4*i_+2]=qm-u1_.z;cb1[4*i_+3]=qm-u1_.w; } }while(0)
  #define CMASK(P0,P1,t) do{int jb_=(t)-(NT-4); if(jb_>=0)cmask(P0,P1,jb_,qrel,hi);}while(0)
  bool resc=false;
  #define START(P0,P1) do{ const float rm=rowmax(P0,P1); resc=false; \
    { const float dl=rm; mhat=fadd_s(mhat,dl); \
      _Pragma("unroll") for(int r=0;r<16;++r){P0[r]=fsub_s(P0[r],dl);P1[r]=fsub_s(P1[r],dl);} \
      qm=cq-mhat; } \
    _Pragma("unroll") for(int r=0;r<16;++r)P0[r]=__builtin_amdgcn_exp2f(P0[r]); }while(0)
  #define RESC() do{ if(resc){ asm volatile("s_waitcnt lgkmcnt(0)":::"memory"); \
      _Pragma("unroll") for(int d_=0;d_<2;++d_) _Pragma("unroll") for(int r=0;r<16;++r)o[d_][r]*=wsf[crow(r,hi)]; } }while(0)
  f32x16 pA0,pA1,pB0,pB1;
  int sl_prev=0,sl_cur=0,sl_next=SLOTB;
  #define ROT() do{sl_prev=sl_cur;sl_cur=sl_next;sl_next=(sl_next==(NSLOT-1)*SLOTB)?0:sl_next+SLOTB;}while(0)
  DMA_K(2,2*SLOTB);
  WAIT_BAR(3);
  CBIAS(0); qkt(pA0,pA1,Kbase,qr,cb0,cb1,r32,hi);asm volatile("s_nop 15\n\ts_nop 7":"+v"(pA0),"+v"(pA1));CMASK(pA0,pA1,0);
  START(pA0,pA1);
  _Pragma("unroll") for(int r=0;r<16;++r)pA1[r]=__builtin_amdgcn_exp2f(pA1[r]);
  WAIT_BAR(0);
  DMA_K(3,0);DMA_V(1,SLOTB);
  ROT();
  kload8(kf,kp0+sl_cur);
  WAIT_BAR(2);
  s16x4 vlo[8],vhi[8]; u32x4 pw0,pw1,pw2,pw3;
  #define PKW(P,B) cvtpk_s(P[B],P[B+1])
  #define PAF(k) __builtin_bit_cast(bf16x8,pw##k)
  #define VFR(i) (bf16x8){vlo[i][0],vlo[i][1],vlo[i][2],vlo[i][3],vhi[i][0],vhi[i][1],vhi[i][2],vhi[i][3]}
  #define PIN(x) asm volatile("":"+v"(x))
  #define MX3(a,b,c) __builtin_fmaxf(__builtin_fmaxf((a),(b)),(c))
  #define GAPA(MF,A0,A1,A2,A3,W0,W1,PW) do{ MF; sacc+=A0; sacc+=A1; sacc+=A2; sacc+=A3; PIN(sacc); W0; W1; PIN(PW); SBAR(); }while(0)
  #define EX(v) __builtin_amdgcn_exp2f(v)
  #define GAPB(MF,X,B) do{ MF; X[B]=EX(X[B]); X[B+1]=EX(X[B+1]); X[B+2]=EX(X[B+2]); X[B+3]=EX(X[B+3]); PIN(X); SBAR(); }while(0)
  #define VRD(i) do{ vlo[i]=vtr(vp_+(((i)>>2)*4096+((i)&3)*1024)); vhi[i]=vtr(vp_+(((i)>>2)*4096+((i)&3)*1024+512)); }while(0)
  #define KRD(G,j) do{ if(G){ kload2(kf,kp0+sl_next,j); SBAR(); } }while(0)
  #define STEP(C0,C1,P0,P1,t,GK,GV,GL) do{ SBAR(); CBIAS(t); SBAR(); \
    const lds_cptr vp_=vp0+sl_prev; \
    VRD(0); SBAR(); float sacc=(P0[0]+P0[1]); \
    GAPA(C0=__builtin_amdgcn_mfma_f32_32x32x16_bf16(kf[0],qr[0],cb0,0,0,0), P0[2],P0[3],P0[4],P0[5],     pw0[0]=PKW(P0,0), pw0[1]=PKW(P0,2), pw0); \
    VRD(4); SBAR(); GAPA(C1=__builtin_amdgcn_mfma_f32_32x32x16_bf16(kf[1],qr[0],cb1,0,0,0), P0[6],P0[7],P0[8],P0[9],     pw0[2]=PKW(P0,4), pw0[3]=PKW(P0,6), pw0); \
    VRD(1); SBAR(); GAPA(C0=__builtin_amdgcn_mfma_f32_32x32x16_bf16(kf[2],qr[1],C0,0,0,0),   P0[10],P0[11],P0[12],P0[13], pw1[0]=PKW(P0,8), pw1[1]=PKW(P0,10), pw1); \
    VRD(5); SBAR(); GAPA(C1=__builtin_amdgcn_mfma_f32_32x32x16_bf16(kf[3],qr[1],C1,0,0,0),   P0[14],P0[15],P1[0],P1[1],   pw1[2]=PKW(P0,12),pw1[3]=PKW(P0,14), pw1); \
    VRD(2); SBAR(); GAPA(C0=__builtin_amdgcn_mfma_f32_32x32x16_bf16(kf[4],qr[2],C0,0,0,0),   P1[2],P1[3],P1[4],P1[5],     pw2[0]=PKW(P1,0), pw2[1]=PKW(P1,2), pw2); \
    VRD(6); SBAR(); GAPA(C1=__builtin_amdgcn_mfma_f32_32x32x16_bf16(kf[5],qr[2],C1,0,0,0),   P1[6],P1[7],P1[8],P1[9],     pw2[2]=PKW(P1,4), pw2[3]=PKW(P1,6), pw2); \
    VRD(3); SBAR(); GAPA(C0=__builtin_amdgcn_mfma_f32_32x32x16_bf16(kf[6],qr[3],C0,0,0,0),   P1[10],P1[11],P1[12],P1[13], pw3[0]=PKW(P1,8), pw3[1]=PKW(P1,10), pw3); \
    VRD(7); SBAR(); GAPA(C1=__builtin_amdgcn_mfma_f32_32x32x16_bf16(kf[7],qr[3],C1,0,0,0),   P1[14],P1[15],0.f,0.f,       pw3[2]=PKW(P1,12),pw3[3]=PKW(P1,14), pw3); \
    l_reg+=sacc; \
    if(GK){DMA_K((t)+3,sl_cur);} if(GV){DMA_V((t)+1,sl_next);} \
    CMASK(C0,C1,t); \
    { float a=MX3(C0[0],C0[1],C1[0]),b=MX3(C0[2],C0[3],C1[1]); a=MX3(a,C1[2],C1[3]); \
      _Pragma("unroll") for(int r=4;r<16;r+=4){a=MX3(a,C0[r],C0[r+1]);b=MX3(b,C0[r+2],C0[r+3]);a=MX3(a,C1[r],C1[r+1]);b=MX3(b,C1[r+2],C1[r+3]);} \
      float rm=__builtin_fmaxf(a,b); { auto rr=__builtin_amdgcn_permlane32_swap(__float_as_uint(rm),__float_as_uint(rm),false,false); rm=__builtin_fmaxf(__uint_as_float(rr[0]),__uint_as_float(rr[1])); } \
      resc=false; \
      if(__builtin_expect(__any(rm>(float)THRL),0)){ const float dl=__builtin_fmaxf(rm,0.f); mhat+=dl; \
        _Pragma("unroll") for(int r=0;r<16;++r){C0[r]-=dl;C1[r]-=dl;} \
        qm=cq-mhat; \
        const float f=__builtin_amdgcn_exp2f(-dl); l_reg*=f; if(hi==0)wsf[r32]=f; resc=true; } } \
    SBAR(); \
    GAPB(o[0]=__builtin_amdgcn_mfma_f32_32x32x16_bf16(PAF(0),VFR(0),o[0],0,0,0), C0,0); \
    GAPB(o[1]=__builtin_amdgcn_mfma_f32_32x32x16_bf16(PAF(0),VFR(4),o[1],0,0,0), C0,4); \
    KRD(GL,0); GAPB(o[0]=__builtin_amdgcn_mfma_f32_32x32x16_bf16(PAF(1),VFR(1),o[0],0,0,0), C0,8); \
    KRD(GL,1); GAPB(o[1]=__builtin_amdgcn_mfma_f32_32x32x16_bf16(PAF(1),VFR(5),o[1],0,0,0), C0,12); \
    KRD(GL,2); GAPB(o[0]=__builtin_amdgcn_mfma_f32_32x32x16_bf16(PAF(2),VFR(2),o[0],0,0,0), C1,0); \
    KRD(GL,3); GAPB(o[1]=__builtin_amdgcn_mfma_f32_32x32x16_bf16(PAF(2),VFR(6),o[1],0,0,0), C1,4); \
    GAPB(o[0]=__builtin_amdgcn_mfma_f32_32x32x16_bf16(PAF(3),VFR(3),o[0],0,0,0), C1,8); \
    GAPB(o[1]=__builtin_amdgcn_mfma_f32_32x32x16_bf16(PAF(3),VFR(7),o[1],0,0,0), C1,12); \
    }while(0)
  int t=1;
  #undef CMASK
  #define CMASK(P0,P1,t) do{}while(0)
  for(;t+5<NT;t+=2){
    STEP(pB0,pB1,pA0,pA1,t,true,true,true);     WAIT_BAR(2); RESC(); ROT();
    STEP(pA0,pA1,pB0,pB1,t+1,true,true,true);   WAIT_BAR(2); RESC(); ROT();
  }
  #undef CMASK
  #define CMASK(P0,P1,t) do{int jb_=(t)-(NT-4); if(jb_>=0)cmask(P0,P1,jb_,qrel,hi);}while(0)
  #define ENDW(tt) do{ if((tt)+3<NT){WAIT_BAR(2);} else if((tt)+2<NT){WAIT_BAR(1);} else {WAIT_BAR(0);} }while(0)
  for(;t+1<NT;t+=2){
    STEP(pB0,pB1,pA0,pA1,t,(t+3<NT),(t+1<NT),(t+1<NT));       ENDW(t);   RESC(); ROT();
    STEP(pA0,pA1,pB0,pB1,t+1,(t+4<NT),(t+2<NT),(t+2<NT));     ENDW(t+1); RESC(); ROT();
  }
  STEP(pB0,pB1,pA0,pA1,NT-1,false,false,false); RESC();
  { float sacc=pB0[0]+pB0[1]; _Pragma("unroll") for(int r=2;r<16;++r)sacc+=pB0[r]; _Pragma("unroll") for(int r=0;r<16;++r)sacc+=pB1[r]; l_reg+=sacc;
    pw0=(u32x4){PKW(pB0,0),PKW(pB0,2),PKW(pB0,4),PKW(pB0,6)};pw1=(u32x4){PKW(pB0,8),PKW(pB0,10),PKW(pB0,12),PKW(pB0,14)};pw2=(u32x4){PKW(pB1,0),PKW(pB1,2),PKW(pB1,4),PKW(pB1,6)};pw3=(u32x4){PKW(pB1,8),PKW(pB1,10),PKW(pB1,12),PKW(pB1,14)};
    SBAR(); pv(o,vb0+sl_cur,PAF(0),PAF(1),PAF(2),PAF(3)); }
  #undef PKW
  #undef PAF
  #undef VFR
  #undef PIN
  #undef MX3
  #undef GAPA
  #undef GAPB
  #undef EX
  #undef VRD
  #undef KRD
  #undef STEP
  #undef ENDW
  {auto rr=__builtin_amdgcn_permlane32_swap(__float_as_uint(l_reg),__float_as_uint(l_reg),false,false);l_reg=__uint_as_float(rr[0])+__uint_as_float(rr[1]);}
  if(hi==0)wsf[32+r32]=l_reg;asm volatile("s_waitcnt lgkmcnt(0)":::"memory");
  float rli[16];
  #pragma unroll
  for(int r=0;r<16;++r)rli[r]=__builtin_amdgcn_rcpf(wsf[32+crow(r,hi)]);
  bf16*Ow=O+(rowbase+q0+wid*QBLK)*OP+h*D;
  { bf16*stg=(bf16*)(shm+LDS_OST)+wid*2048;
    #pragma unroll
    for(int r=0;r<16;++r){const int orow=crow(r,hi);
      #pragma unroll
      for(int d0=0;d0<2;++d0)stg[orow*64+d0*32+r32]=__float2bfloat16(o[d0][r]*rli[r]);}
    asm volatile("s_waitcnt lgkmcnt(0)":::"memory");
    #pragma unroll
    for(int i=0;i<4;++i){const int row=i*8+(lane>>3),ch=lane&7; const u32x4 v=*(const u32x4*)(stg+row*64+ch*8); ATTN_STORE16(Ow+(long)row*OP+ch*8,v);} }
  asm volatile("s_waitcnt lgkmcnt(0)\n\ts_barrier":::"memory");
  #undef DMA_K
  #undef DMA_V
  #undef CMASK
  #undef START
  #undef RESC
  #undef ROT
  #undef CBIAS
}
constexpr int ATTN_LDS_BYTES=LDS_BYTES;
#undef SBAR
#undef WAIT_BAR
}

namespace ssd {
constexpr int SSD_BLK = 512, SSD_NBLK = PSEQ / SSD_BLK;
constexpr int BP = 136, TP = 72, CBP = 68, SP = 136;
constexpr int L_BC = 0, L_CC = 17408, L_BT = 34816, L_CB = 53248, L_ACS = 70656, L_DT = 71680, L_ST = 72704, ST_BYTES = 8704, L_RS = L_ST + 8 * ST_BYTES, L_END = L_RS + 2048;
struct Ptrs { const bf16_t* XBC; const bf16_t* Zs; const float* DT; const float* conv_w; const float* conv_b; const float* A_log; const float* D_skip;
              const float* state_conv; const float* state_ssm; float* SL; float* dAtot; float* GSS; bf16_t* Mix; float* out; };
#define MFMA32(a, b, c) __builtin_amdgcn_mfma_f32_32x32x16_bf16((a), (b), (c), 0, 0, 0)
#define LDSFENCE() asm volatile("s_waitcnt lgkmcnt(0)" ::: "memory")

template <int MODE> __device__ __forceinline__ void unit(const Ptrs& P, unsigned char* lds, int b, int blk, int hq) {
    int tid_ = threadIdx.x; asm volatile("" : "+v"(tid_));
    const int tid = tid_, lane = tid & 63, wid = __builtin_amdgcn_readfirstlane(tid >> 6), r32 = lane & 31, hi = lane >> 5;
    const int g = hq >> 1, hl = wid >> 1, ph = wid & 1, h = hq * 4 + hl;
    constexpr int NSUB = (MODE == 2) ? 1 : SSD_BLK / 64;
    constexpr int nvalid = (MODE == 2) ? 16 : SSD_BLK;
    const int row0 = (MODE == 2) ? MP + b * 16 : b * PSEQ + blk * SSD_BLK;
    bf16_t* Bc = (bf16_t*)(lds + L_BC); bf16_t* Cc = (bf16_t*)(lds + L_CC); bf16_t* BT = (bf16_t*)(lds + L_BT); float* CB = (float*)(lds + L_CB);
    float* rsL = (float*)(lds + L_RS); float* acsL = (float*)(lds + L_ACS); float* dtL = (float*)(lds + L_DT); bf16_t* St = (bf16_t*)(lds + L_ST + wid * ST_BYTES);
    const int xcol = h * 64 + ph * 32 + r32;
    const int cp = tid & 127, seg = tid >> 7, ch = 2 * cp; const int scol = (ch < 128) ? 1024 + 128 * g + ch : 1280 + 128 * g + (ch - 128);
    const float Asc = -__expf(P.A_log[hq * 4 + (wid & 3)]);
    const float Dh = P.D_skip[h];
    f32x16 st[4];
    if (MODE == 0) {
#pragma unroll
        for (int nb = 0; nb < 4; ++nb) st[nb] = f32x16{};
    } else if (MODE == 1) {
        const float* sp = P.SL + ((size_t)((b * SSD_NBLK + blk) * 16 + h)) * 8192 + (size_t)(ph * 4) * 1024 + lane;
#pragma unroll
        for (int nb = 0; nb < 4; ++nb)
#pragma unroll
            for (int r = 0; r < 16; ++r) st[nb][r] = sp[(nb * 16 + r) * 64];
    } else {
        const float* sp = P.state_ssm + ((size_t)(b * 16 + h) * 64 + ph * 32 + r32) * 128 + 4 * hi;
#pragma unroll
        for (int nb = 0; nb < 4; ++nb)
#pragma unroll
            for (int q4 = 0; q4 < 4; ++q4) { const f32x4 v = *(const f32x4*)(sp + 32 * nb + 8 * q4); st[nb][4 * q4] = v[0]; st[nb][4 * q4 + 1] = v[1]; st[nb][4 * q4 + 2] = v[2]; st[nb][4 * q4 + 3] = v[3]; }
    }
    float dasum = 0.f;
    unsigned uu[16]; float dtn = 0.f;
    auto load_stage = [&](int tbn) {
        if (MODE != 0 || ch < 128) { const int t0 = tbn + 16 * seg; const bf16_t* sp = P.XBC + (unsigned)((row0 + t0) * DCONV + scol);
#pragma unroll
            for (int i = 0; i < 16; ++i) { uu[i] = *(const unsigned*)(sp + i * DCONV); if (MODE == 2) { asm volatile("" : "+v"(uu[i])); if (t0 + i >= nvalid) uu[i] = 0u; } } }
        if (wid < 4) { const int t = tbn + lane; dtn = (t < nvalid) ? P.DT[(unsigned)((row0 + t) * 16 + hq * 4 + wid)] : 0.f; }
    };
    if (MODE == 0) load_stage(0);
#pragma unroll 1
    for (int sc = 0; sc < NSUB; ++sc) {
        const int tb = 64 * sc;
        unsigned xvp[4][4];
        {
            const bf16_t* xp = P.XBC + (unsigned)((row0 + tb + 8 * hi) * DCONV + xcol);
#pragma unroll
            for (int ks = 0; ks < 4; ++ks)
#pragma unroll
                for (int i = 0; i < 4; ++i) { unsigned lo = xp[(16 * ks + 2 * i) * DCONV], hi16 = xp[(16 * ks + 2 * i + 1) * DCONV];
                    if (MODE == 2) { asm volatile("" : "+v"(lo), "+v"(hi16));     if (tb + 16 * ks + 8 * hi + 2 * i >= nvalid) lo = 0u; if (tb + 16 * ks + 8 * hi + 2 * i + 1 >= nvalid) hi16 = 0u; }
                    xvp[ks][i] = lo | (hi16 << 16); }
        }
        if (MODE != 0) load_stage(tb);
        if (MODE != 0 || ch < 128) {
            bf16_t* nat = ((ch < 128) ? Bc : Cc) + (ch & 127);
#pragma unroll
            for (int i = 0; i < 16; ++i) *(unsigned*)(nat + (16 * seg + i) * BP) = uu[i];
            if (ch < 128) {
                unsigned bt0[8], bt1[8];
#pragma unroll
                for (int i = 0; i < 8; ++i) { bt0[i] = (uu[2 * i] & 0xffffu) | (uu[2 * i + 1] << 16); bt1[i] = (uu[2 * i] >> 16) | (uu[2 * i + 1] & 0xffff0000u); }
                *(u32x4*)(BT + ch * TP + 16 * seg) = (u32x4){bt0[0], bt0[1], bt0[2], bt0[3]}; *(u32x4*)(BT + ch * TP + 16 * seg + 8) = (u32x4){bt0[4], bt0[5], bt0[6], bt0[7]};
                *(u32x4*)(BT + (ch + 1) * TP + 16 * seg) = (u32x4){bt1[0], bt1[1], bt1[2], bt1[3]}; *(u32x4*)(BT + (ch + 1) * TP + 16 * seg + 8) = (u32x4){bt1[4], bt1[5], bt1[6], bt1[7]};
            }
        }
        if (wid < 4) {
            const float dt = dtn;
            float a = dt * Asc;
#pragma unroll
            for (int o = 1; o < 64; o <<= 1) { const float v = __shfl_up(a, o); if (lane >= o) a += v; }
            acsL[wid * 64 + lane] = a; dtL[wid * 64 + lane] = dt; dasum += __shfl(a, 63);
        }
#define XV(ks, j) (((j) & 1) ? __uint_as_float(xvp[ks][(j) >> 1] & 0xffff0000u) : __uint_as_float(xvp[ks][(j) >> 1] << 16))
        __syncthreads();
        if (MODE != 0) {
            if (wid < 3) { const int lb = wid > 0 ? 1 : 0, sb = wid > 1 ? 1 : 0; f32x16 cacc = f32x16{};
#pragma unroll
                for (int ks = 0; ks < 8; ++ks) { const bf16x8 av = *(const bf16x8*)(Cc + (32 * lb + r32) * BP + 16 * ks + 8 * hi), bv = *(const bf16x8*)(Bc + (32 * sb + r32) * BP + 16 * ks + 8 * hi); cacc = MFMA32(av, bv, cacc); }
#pragma unroll
                for (int r = 0; r < 16; ++r) CB[(32 * lb + crow_(r, hi)) * CBP + 32 * sb + r32] = cacc[r]; }
            __syncthreads();
        }
        const float* acsH = acsL + hl * 64; const float* dtH = dtL + hl * 64;
        const float acs_last = acsH[63];
        if (MODE != 0) {
#pragma unroll
            for (int nb = 0; nb < 4; ++nb)
#pragma unroll
                for (int q4 = 0; q4 < 4; ++q4) *(u32x2*)(St + r32 * SP + 32 * nb + 8 * q4 + 4 * hi) = (u32x2){cvtpk(st[nb][4 * q4], st[nb][4 * q4 + 1]), cvtpk(st[nb][4 * q4 + 2], st[nb][4 * q4 + 3])};
            LDSFENCE();
#pragma unroll 1
            for (int lb = 0; lb < 2; ++lb) { if (MODE == 2 && lb == 1) continue;
                f32x16 y = f32x16{};
                unsigned short zr[16];
#pragma unroll
                for (int q4 = 0; q4 < 4; ++q4)
#pragma unroll
                    for (int e = 0; e < 4; ++e) { const int lr = 32 * lb + 8 * q4 + 4 * hi + e; const int row = row0 + tb + lr; zr[4 * q4 + e] = P.Zs[(unsigned)(row * 1024 + xcol)]; }
#pragma unroll
                for (int ks = 0; ks < 8; ++ks) { const bf16x8 av = *(const bf16x8*)(Cc + (32 * lb + r32) * BP + 16 * ks + 8 * hi), bv = *(const bf16x8*)(St + r32 * SP + 16 * ks + 8 * hi); y = MFMA32(av, bv, y); }
#pragma unroll
                for (int q4 = 0; q4 < 4; ++q4) { const f32x4 a4 = *(const f32x4*)(acsH + 32 * lb + 8 * q4 + 4 * hi);
#pragma unroll
                    for (int e = 0; e < 4; ++e) y[4 * q4 + e] *= __expf(a4[e]); }
                const int l = 32 * lb + r32; const float al = acsH[l];
#pragma unroll
                for (int ks = 0; ks < 4; ++ks) { if (ks > 2 * lb + 1) continue;
                    const int s0 = 16 * ks + 8 * hi;
                    const f32x4 c0 = *(const f32x4*)(CB + l * CBP + s0), c1 = *(const f32x4*)(CB + l * CBP + s0 + 4);
                    const f32x4 s4a = *(const f32x4*)(acsH + s0), s4b = *(const f32x4*)(acsH + s0 + 4), d4a = *(const f32x4*)(dtH + s0), d4b = *(const f32x4*)(dtH + s0 + 4);
                    float gg[8], xa[8];
#pragma unroll
                    for (int j = 0; j < 8; ++j) { const float cbv = j < 4 ? c0[j] : c1[j - 4], as = j < 4 ? s4a[j] : s4b[j - 4], dv = j < 4 ? d4a[j] : d4b[j - 4];
                        gg[j] = (s0 + j <= l) ? cbv * __expf(al - as) : 0.f; xa[j] = XV(ks, j) * dv; }
                    const u32x4 gp = {cvtpk(gg[0], gg[1]), cvtpk(gg[2], gg[3]), cvtpk(gg[4], gg[5]), cvtpk(gg[6], gg[7])};
                    const u32x4 xp = {cvtpk(xa[0], xa[1]), cvtpk(xa[2], xa[3]), cvtpk(xa[4], xa[5]), cvtpk(xa[6], xa[7])};
                    y = MFMA32(__builtin_bit_cast(bf16x8, gp), __builtin_bit_cast(bf16x8, xp), y);
                    if (ks >= 2 * lb) { float di[8];
#pragma unroll
                        for (int j = 0; j < 8; ++j) di[j] = (s0 + j == l) ? Dh : 0.f;
                        const u32x4 dp = {cvtpk(di[0], di[1]), cvtpk(di[2], di[3]), cvtpk(di[4], di[5]), cvtpk(di[6], di[7])};
                        const u32x4 xr = {xvp[ks][0], xvp[ks][1], xvp[ks][2], xvp[ks][3]};
                        y = MFMA32(__builtin_bit_cast(bf16x8, dp), __builtin_bit_cast(bf16x8, xr), y); } }
                float s2v[16];
#pragma unroll
                for (int q4 = 0; q4 < 4; ++q4)
#pragma unroll
                    for (int e = 0; e < 4; ++e) { const int r = 4 * q4 + e; const int lr = 32 * lb + 8 * q4 + 4 * hi + e; const int row = row0 + tb + lr;
                        const float yv = y[r] * bf2f(zr[r]);
                        if (MODE != 2 || q4 < 2) P.Mix[(unsigned)(row * DMIX + xcol)] = (bf16_t)(cvtpk(yv, 0.f) & 0xffffu);
                        float s2 = yv * yv;
                        s2 += __shfl_xor(s2, 1); s2 += __shfl_xor(s2, 2); s2 += __shfl_xor(s2, 4); s2 += __shfl_xor(s2, 8); s2 += __shfl_xor(s2, 16);
                        s2v[r] = s2; }
                asm volatile("" ::: "memory");
                if (r32 == 0) {
#pragma unroll
                    for (int q4 = 0; q4 < 4; ++q4)
#pragma unroll
                        for (int e = 0; e < 4; ++e) rsL[wid * 64 + 32 * lb + 8 * q4 + 4 * hi + e] = s2v[4 * q4 + e];
                }
            }
        }
        if (MODE == 0 && sc + 1 < NSUB) load_stage(tb + 64);
        {
            const float dec = __expf(acs_last);
#pragma unroll
            for (int nb = 0; nb < 4; ++nb) st[nb] *= dec;
#pragma unroll
            for (int ks = 0; ks < 4; ++ks) { const int s0 = 16 * ks + 8 * hi;
                const f32x4 s4a = *(const f32x4*)(acsH + s0), s4b = *(const f32x4*)(acsH + s0 + 4), d4a = *(const f32x4*)(dtH + s0), d4b = *(const f32x4*)(dtH + s0 + 4);
                float xb[8];
#pragma unroll
                for (int j = 0; j < 8; ++j) { const float as = j < 4 ? s4a[j] : s4b[j - 4], dv = j < 4 ? d4a[j] : d4b[j - 4]; xb[j] = XV(ks, j) * dv * __expf(acs_last - as); }
                const u32x4 xp = {cvtpk(xb[0], xb[1]), cvtpk(xb[2], xb[3]), cvtpk(xb[4], xb[5]), cvtpk(xb[6], xb[7])};
#pragma unroll
                for (int nb = 0; nb < 4; ++nb) { const bf16x8 av = *(const bf16x8*)(BT + (32 * nb + r32) * TP + 16 * ks + 8 * hi); st[nb] = MFMA32(av, __builtin_bit_cast(bf16x8, xp), st[nb]); } }
        }
        __syncthreads();
        if (MODE != 0) { if (tid < ((MODE == 2) ? 16 : 64)) { float s = 0.f;
#pragma unroll
                for (int w = 0; w < 8; ++w) s += rsL[w * 64 + tid];
                P.GSS[(unsigned)((row0 + tb + tid) * 4 + hq)] = s; } }
    }
    if (MODE == 0) {
        float* sp = P.SL + ((size_t)((b * SSD_NBLK + blk) * 16 + h)) * 8192 + (size_t)(ph * 4) * 1024 + lane;
#pragma unroll
        for (int nb = 0; nb < 4; ++nb)
#pragma unroll
            for (int r = 0; r < 16; ++r) sp[(nb * 16 + r) * 64] = st[nb][r];
        if (wid < 4 && lane == 0) P.dAtot[(b * SSD_NBLK + blk) * 16 + hq * 4 + wid] = dasum;
    } else if (MODE == 2 || blk == SSD_NBLK - 1) {
        float* sp = P.out + (MODE == 2 ? O_SSSM : O_PSSM) + ((size_t)(b * 16 + h) * 64 + ph * 32 + r32) * 128 + 4 * hi;
#pragma unroll
        for (int nb = 0; nb < 4; ++nb)
#pragma unroll
            for (int q4 = 0; q4 < 4; ++q4) *(f32x4*)(sp + 32 * nb + 8 * q4) = (f32x4){st[nb][4 * q4], st[nb][4 * q4 + 1], st[nb][4 * q4 + 2], st[nb][4 * q4 + 3]};
    }
}
#undef XV
}

namespace sattn {
constexpr int L_C = 0, L_M = 16640, L_L = L_M + 512, L_O = L_L + 512, OPITCH = 17, L_SCAN = L_O + 8 * 64 * OPITCH * 4, L_END = L_SCAN + 64;
struct Ptrs { const float* cache_k; const float* cache_v; const float* cache_logf; const bf16_t* Qb; const bf16_t* Kb; const bf16_t* Vb; const float* out; bf16_t* Mix; };
__device__ __forceinline__ void unit(const Ptrs& P, unsigned char* lds, int b, int h) {
    int tid_ = threadIdx.x; asm volatile("" : "+v"(tid_));
    const int tid = tid_, lane = tid & 63, wid = __builtin_amdgcn_readfirstlane(tid >> 6), r32 = lane & 31, hi = lane >> 5;
    float* cL = (float*)(lds + L_C); float* mW = (float*)(lds + L_M); float* lW = (float*)(lds + L_L); float* OW = (float*)(lds + L_O); float* wtot = (float*)(lds + L_SCAN);
    constexpr int NK = PAST + SSEQ;
    {
        float v[16]; float run = 0.f; const int s0 = 16 * tid;
#pragma unroll
        for (int i = 0; i < 16; ++i) v[i] = 0.f;
        if (tid < PAST / 16) { const float* lp = P.cache_logf + ((size_t)b * PAST + s0) * 8 + h;
#pragma unroll
            for (int i = 0; i < 16; ++i) v[i] = lp[i * 8];
        } else if (tid == PAST / 16) { const float* lp = P.out + O_SLF + ((size_t)b * 16) * 8 + h;
#pragma unroll
            for (int i = 0; i < 16; ++i) v[i] = lp[i * 8];
        }
#pragma unroll
        for (int i = 0; i < 16; ++i) run += v[i];
        float inc = run;
#pragma unroll
        for (int o = 1; o < 64; o <<= 1) { const float t = __shfl_up(inc, o); if (lane >= o) inc += t; }
        if (lane == 63) wtot[wid] = inc;
        __syncthreads();
        float off = inc - run;
        for (int w = 0; w < wid; ++w) off += wtot[w];
#pragma unroll
        for (int i = 0; i < 16; ++i) { off += v[i]; const int s = s0 + i; if (s < NK + 16) cL[s] = off * L2E; }
        __syncthreads();
    }
    const int q = r32 & 15; const long qrow = (long)MP + b * 16 + q;
    bf16x8 qf[4];
#pragma unroll
    for (int ks = 0; ks < 4; ++ks) qf[ks] = *(const bf16x8*)(P.Qb + qrow * 512 + h * 64 + 16 * ks + 8 * hi);
    const float cq = cL[PAST + q];
    float m = -1e30f, l = 0.f; f32x16 o[2]; o[0] = f32x16{}; o[1] = f32x16{};
    int tile0;
    { const float c0 = cL[PAST]; const int t1 = lane, t2 = lane + 64;
      const bool s1 = (c0 - cL[32 * t1 + 31]) < -(64.0f * L2E), s2 = (c0 - cL[32 * t2 + 31]) < -(64.0f * L2E);
      tile0 = __builtin_amdgcn_readfirstlane(__builtin_popcountll(__ballot(s1)) + __builtin_popcountll(__ballot(s2))); }
    for (int tile = tile0 + wid; tile < 129; tile += 8) {
        const int key0 = 32 * tile; const bool isnew = tile == 128;
        bf16x8 kf[4];
        if (!isnew) { const float* kp = P.cache_k + (((size_t)b * PAST + key0 + r32) * 8 + h) * 64 + 8 * hi;
#pragma unroll
            for (int ks = 0; ks < 4; ++ks) { const f32x4 a = *(const f32x4*)(kp + 16 * ks), c = *(const f32x4*)(kp + 16 * ks + 4);
                const u32x4 w = {cvtpk(a[0], a[1]), cvtpk(a[2], a[3]), cvtpk(c[0], c[1]), cvtpk(c[2], c[3])}; kf[ks] = __builtin_bit_cast(bf16x8, w); }
        } else {
#pragma unroll
            for (int ks = 0; ks < 4; ++ks) kf[ks] = *(const bf16x8*)(P.Kb + ((long)MP + b * 16 + (r32 & 15)) * 512 + h * 64 + 16 * ks + 8 * hi);
        }
        float vall[2][2][8];
        if (!isnew) {
#pragma unroll
            for (int db = 0; db < 2; ++db)
#pragma unroll
                for (int s2 = 0; s2 < 2; ++s2)
#pragma unroll
                    for (int j = 0; j < 8; ++j) { const int kv = crow_(8 * s2 + j, hi); vall[db][s2][j] = P.cache_v[(((size_t)b * PAST + key0 + kv) * 8 + h) * 64 + 32 * db + r32]; }
        } else {
#pragma unroll
            for (int db = 0; db < 2; ++db)
#pragma unroll
                for (int s2 = 0; s2 < 2; ++s2)
#pragma unroll
                    for (int j = 0; j < 8; ++j) { const int kv = crow_(8 * s2 + j, hi); vall[db][s2][j] = bf2f(P.Vb[((long)MP + b * 16 + (kv & 15)) * 512 + h * 64 + 32 * db + r32]) * (kv < 16 ? 1.f : 0.f); }
        }
        f32x16 s = f32x16{};
#pragma unroll
        for (int ks = 0; ks < 4; ++ks) s = MFMA32(kf[ks], qf[ks], s);
        float mt = -1e30f;
#pragma unroll
        for (int q4 = 0; q4 < 4; ++q4) { const f32x4 c4 = *(const f32x4*)(cL + key0 + 8 * q4 + 4 * hi);
#pragma unroll
            for (int e = 0; e < 4; ++e) { const int r = 4 * q4 + e; const int kv = 8 * q4 + 4 * hi + e; float x = s[r] + (cq - c4[e]);
                if (isnew && (kv >= 16 || kv > q)) x = -1e30f;
                s[r] = x; mt = fmaxf(mt, x); } }
        mt = fmaxf(mt, __shfl_xor(mt, 32));
        const float mn = fmaxf(m, mt), alpha = __builtin_amdgcn_exp2f(m - mn); m = mn;
        float ls = 0.f;
#pragma unroll
        for (int r = 0; r < 16; ++r) { const float p = __builtin_amdgcn_exp2f(s[r] - mn); s[r] = p; ls += p; }
        l = l * alpha + ls;
#pragma unroll
        for (int db = 0; db < 2; ++db) o[db] *= alpha;
        bf16x8 pf[2];
#pragma unroll
        for (int s2 = 0; s2 < 2; ++s2) { const u32x4 w = {cvtpk(s[8 * s2], s[8 * s2 + 1]), cvtpk(s[8 * s2 + 2], s[8 * s2 + 3]), cvtpk(s[8 * s2 + 4], s[8 * s2 + 5]), cvtpk(s[8 * s2 + 6], s[8 * s2 + 7])}; pf[s2] = __builtin_bit_cast(bf16x8, w); }
#pragma unroll
        for (int db = 0; db < 2; ++db)
#pragma unroll
            for (int s2 = 0; s2 < 2; ++s2) { const float* vv = vall[db][s2];
                const u32x4 w = {cvtpk(vv[0], vv[1]), cvtpk(vv[2], vv[3]), cvtpk(vv[4], vv[5]), cvtpk(vv[6], vv[7])};
                o[db] = MFMA32(__builtin_bit_cast(bf16x8, w), pf[s2], o[db]); }
    }
    l += __shfl_xor(l, 32);
    if (r32 < 16) { if (hi == 0) { mW[wid * 16 + r32] = m; lW[wid * 16 + r32] = l; }
#pragma unroll
        for (int db = 0; db < 2; ++db)
#pragma unroll
            for (int r = 0; r < 16; ++r) OW[(wid * 64 + 32 * db + crow_(r, hi)) * OPITCH + r32] = o[db][r]; }
    __syncthreads();
#pragma unroll
    for (int it = 0; it < 2; ++it) { const int idx = tid + 512 * it, d = idx & 63, qq = idx >> 6;
        float M = -1e30f;
#pragma unroll
        for (int w = 0; w < 8; ++w) M = fmaxf(M, mW[w * 16 + qq]);
        float L = 0.f, acc = 0.f;
#pragma unroll
        for (int w = 0; w < 8; ++w) { const float f = __builtin_amdgcn_exp2f(mW[w * 16 + qq] - M); L += lW[w * 16 + qq] * f; acc += OW[(w * 64 + d) * OPITCH + qq] * f; }
        P.Mix[((long)MP + b * 16 + qq) * DMIX + 1024 + h * 64 + d] = (bf16_t)(cvtpk(acc / L, 0.f) & 0xffffu); }
    __syncthreads();
}
}

constexpr int NWAVES = 8, LDS_BYTES = 147456;
#define LAS __attribute__((address_space(3)))
struct Args {
    const float *x_prompt, *x_sample, *cache_k, *cache_v, *cache_logf, *state_ssm, *state_conv, *norm1_w, *w_in, *conv_w, *conv_b, *dt_bias, *A_log, *D_skip, *ssd_norm_w, *f_bias,
                *q_norm_w, *k_norm_w, *w_out, *norm2_w, *w_up, *w_down;
    float* out; unsigned char* ws;
};
__device__ __forceinline__ unsigned pk2(float lo, float hi) { return cvtpk(lo, hi); }
template <int MAP> __device__ __forceinline__ void transpose_item(const float* W, int K, int Nsrc, int Nphys, bf16_t* WT, const float* ksc, int ksc_n, float* scr, int item, int lane) {
    const int nblk = Nphys / 32, kb = item / nblk, nb = item % nblk, k0 = 64 * kb, n0 = 32 * nb;
    const int n = n0 + (lane & 31); int src = n;
    if (MAP == 1) { const int L = (n & ~255) + ((n >> 5) & 3) * 64 + ((n >> 7) & 1) * 32 + (n & 31);
        if (L < 2560) src = L; else if (L < 4096) src = L + 16; else if (L < 4112) src = 2560 + (L - 4096); else if (L < 4120) src = L; else src = -1; }
#pragma unroll
    for (int i = 0; i < 32; ++i) { const int kk = 2 * i + (lane >> 5); float v = (src >= 0) ? W[(size_t)(k0 + kk) * Nsrc + src] : 0.f; if (ksc && (k0 + kk) < ksc_n) v *= ksc[k0 + kk]; scr[kk * 33 + (lane & 31)] = v; }
    asm volatile("s_waitcnt lgkmcnt(0)" ::: "memory");
    const int c = lane & 7;
#pragma unroll
    for (int j = 0; j < 4; ++j) { const int nn = (lane >> 3) + 8 * j; const float* s = scr + (8 * c) * 33 + nn;
        u32x4 o; o.x = pk2(s[0 * 33], s[1 * 33]); o.y = pk2(s[2 * 33], s[3 * 33]); o.z = pk2(s[4 * 33], s[5 * 33]); o.w = pk2(s[6 * 33], s[7 * 33]);
        *(u32x4*)(WT + (size_t)(n0 + nn) * K + k0 + 8 * c) = o; }
    asm volatile("s_waitcnt lgkmcnt(0)" ::: "memory");
}
__device__ __forceinline__ float wave_sum(float v) {
#pragma unroll
    for (int o = 1; o < 64; o <<= 1) v += __shfl_xor(v, o);
    return v;
}
__device__ __forceinline__ void rms_row_to_bf16(const float* xrow, bf16_t* orow, int lane) {
    const f32x4* xr = (const f32x4*)xrow + lane; f32x4 v[4]; float s = 0.f;
#pragma unroll
    for (int j = 0; j < 4; ++j) { v[j] = xr[64 * j]; s += (v[j][0] * v[j][0] + v[j][1] * v[j][1]) + (v[j][2] * v[j][2] + v[j][3] * v[j][3]); }
    const float rs = rsqrtf(wave_sum(s) * (1.0f / 1024.0f) + EPSN);
    u32x2* o8 = (u32x2*)orow + lane;
#pragma unroll
    for (int j = 0; j < 4; ++j) o8[64 * j] = (u32x2){pk2(v[j][0] * rs, v[j][1] * rs), pk2(v[j][2] * rs, v[j][3] * rs)};
}

#define XB_TMO      128
#define XB_XCNT(j)  (256  + 64 * (j))
#define XB_XSUB(j)  (1280 + 64 * (j))
#define XB_XGEN(j)  (2304 + 64 * (j))
#define XB_TOP      3328
#define XB_TOPGEN   3392
#define XCD_BAR_WORDS 3456
#define XB_SPIN_CAP (1u << 18)

__device__ __forceinline__ unsigned xb_ld(unsigned* p)              { return __hip_atomic_load(p, __ATOMIC_RELAXED, __HIP_MEMORY_SCOPE_AGENT); }
__device__ __forceinline__ unsigned xb_add(unsigned* p, unsigned v) { return __hip_atomic_fetch_add(p, v, __ATOMIC_RELAXED, __HIP_MEMORY_SCOPE_AGENT); }
__device__ __forceinline__ unsigned xb_xcc_id() { return (unsigned)__builtin_amdgcn_s_getreg((3 << 11) | 20) & 0xFu; }
#define XB_SPIN(cond, bar) do { unsigned _sp = 0; while (cond) { __builtin_amdgcn_s_sleep(1); \
    if ((++_sp & 255u) == 0u) { if (xb_ld(&(bar)[XB_TMO])) break; if (_sp > XB_SPIN_CAP) { atomicAdd(&(bar)[XB_TMO], 1u); break; } } } } while (0)

struct XcdBarrier {
    unsigned* bar; unsigned x;
    volatile LAS unsigned* st;
};

__device__ __forceinline__ XcdBarrier xcd_barrier_post(unsigned* bar, volatile LAS unsigned* st) {
    XcdBarrier b; b.bar = bar; b.x = xb_xcc_id(); b.st = st;
    if (threadIdx.x == 0) (void)xb_add(&bar[XB_XCNT(b.x)], 1u);
    return b;
}
__device__ __forceinline__ void xcd_barrier_complete(unsigned* bar, unsigned x, unsigned& nloc, unsigned& nx) {
    const unsigned G = gridDim.x * gridDim.y * gridDim.z;
    unsigned sum, cnt, mine, sp = 0u;
    for (;;) {
        sum = 0u; cnt = 0u; mine = 0u;
#pragma unroll
        for (unsigned j = 0; j < 16; ++j) { const unsigned c = xb_ld(&bar[XB_XCNT(j)]); sum += c; cnt += (c > 0u) ? 1u : 0u; mine = (j == x) ? c : mine; }
        if (sum == G) break;
        __builtin_amdgcn_s_sleep(1);
        if ((++sp & 255u) == 0u) { if (xb_ld(&bar[XB_TMO])) break; if (sp > XB_SPIN_CAP) { atomicAdd(&bar[XB_TMO], 1u); break; } }
    }
    nloc = mine > 0u ? mine : 1u; nx = cnt > 0u ? cnt : 1u;
}

__device__ __forceinline__ void xcd_barrier(const XcdBarrier& b) {
    asm volatile("s_waitcnt vmcnt(0)" ::: "memory");
    __syncthreads();
    if (threadIdx.x == 0) {
        unsigned* bar = b.bar;
        __builtin_amdgcn_s_waitcnt(0);
        unsigned nloc = b.st[0], nx = b.st[1];
        if (nloc == 0u) { xcd_barrier_complete(bar, b.x, nloc, nx); b.st[0] = nloc; b.st[1] = nx; }
        const unsigned old = xb_add(&bar[XB_XSUB(b.x)], 1u);
        const unsigned gen = old / nloc;
        if (old + 1u == (gen + 1u) * nloc) {
            __builtin_amdgcn_fence(__ATOMIC_RELEASE, "agent");
            asm volatile("s_waitcnt vmcnt(0)" ::: "memory");
            const unsigned og = xb_add(&bar[XB_TOP], 1u);
            const unsigned tg = og / nx;
            if (og + 1u == (tg + 1u) * nx) xb_add(&bar[XB_TOPGEN], 1u);
            else XB_SPIN(xb_ld(&bar[XB_TOPGEN]) == tg, bar);
            __builtin_amdgcn_fence(__ATOMIC_ACQUIRE, "agent");
            xb_add(&bar[XB_XGEN(b.x)], 1u);
            asm volatile("s_waitcnt vmcnt(0)" ::: "memory");
        } else {
            XB_SPIN(xb_ld(&bar[XB_XGEN(b.x)]) == gen, bar);
            __builtin_amdgcn_fence(__ATOMIC_ACQUIRE, "agent");
            asm volatile("s_waitcnt vmcnt(0)" ::: "memory");
        }
    }
    __syncthreads();
}

template <int PH> __device__ __forceinline__ void run_phase(const Args& a, unsigned char* lds) {
    int tid_ = threadIdx.x; asm volatile("" : "+v"(tid_));
    const int tid = tid_, lane = tid & 63, wave = __builtin_amdgcn_readfirstlane(tid >> 6);
    int G_ = gridDim.x, bx_ = blockIdx.x; asm volatile("" : "+s"(G_), "+s"(bx_));
    const int G = G_, bx = bx_;
    unsigned char* ws = a.ws; float* out = a.out;
    float* SS1 = (float*)(ws + WS_SS1P); float* GSS = (float*)(ws + WS_GSSP); float* DAT = (float*)(ws + WS_DAT); float* CP = (float*)(ws + WS_CP);
    bf16_t* WinT = (bf16_t*)(ws + WS_WIN); bf16_t* WoutT = (bf16_t*)(ws + WS_WOUT); bf16_t* WupT = (bf16_t*)(ws + WS_WUP); bf16_t* WdnT = (bf16_t*)(ws + WS_WDN);
    bf16_t* XN = (bf16_t*)(ws + WS_XN); float* DT = (float*)(ws + WS_DT); float* SL = (float*)(ws + WS_SL); bf16_t* Zs = (bf16_t*)(ws + WS_ZS); bf16_t* XBC = (bf16_t*)(ws + WS_XBC);
    bf16_t* Qb = (bf16_t*)(ws + WS_QB); bf16_t* Kb = (bf16_t*)(ws + WS_KB); bf16_t* Vb = (bf16_t*)(ws + WS_VB); bf16_t* Mix = (bf16_t*)(ws + WS_MIX); bf16_t* Hb = (bf16_t*)(ws + WS_H);
    (void)tid; (void)lane; (void)wave; (void)SS1; (void)GSS; (void)DAT; (void)CP; (void)WinT; (void)WoutT; (void)WupT; (void)WdnT; (void)XN; (void)DT; (void)SL; (void)Zs; (void)XBC; (void)Qb; (void)Kb; (void)Vb; (void)Mix; (void)Hb; (void)out;
    if constexpr (PH == 0) {
    {
        float* scr = (float*)(lds + wave * 16384);
        const int gw = bx * NWAVES + wave, NGW = G * NWAVES;
        constexpr int I_IN = (1024 / 64) * (NIN / 32), I_OUT = (1536 / 64) * (1024 / 32), I_UP = (1024 / 64) * (4096 / 32), I_DN = (4096 / 64) * (1024 / 32);
        for (int it = gw; it < I_IN + I_OUT + I_UP + I_DN; it += NGW) {
            int r = it;
            if (r < I_IN) { transpose_item<1>(a.w_in, 1024, 4120, NIN, WinT, a.norm1_w, 1024, scr, r, lane); continue; } r -= I_IN;
            if (r < I_OUT) { transpose_item<0>(a.w_out, 1536, 1024, 1024, WoutT, a.ssd_norm_w, 1024, scr, r, lane); continue; } r -= I_OUT;
            if (r < I_UP) { transpose_item<0>(a.w_up, 1024, 4096, 4096, WupT, a.norm2_w, 1024, scr, r, lane); continue; } r -= I_UP;
            transpose_item<0>(a.w_down, 4096, 1024, 1024, WdnT, nullptr, 0, scr, r, lane);
        }
        for (int m0 = gw; m0 < MT; m0 += 4 * NGW) {
            f32x4 v[4][4]; float s[4];
#pragma unroll
            for (int r = 0; r < 4; ++r) { const int m = m0 + r * NGW; const int mc = m < MT ? m : MT - 1;
                const f32x4* xr = (const f32x4*)(mc < MP ? a.x_prompt + (size_t)mc * 1024 : a.x_sample + (size_t)(mc - MP) * 1024) + lane; s[r] = 0.f;
#pragma unroll
                for (int j = 0; j < 4; ++j) { v[r][j] = __builtin_nontemporal_load(xr + 64 * j); } }
#pragma unroll
            for (int r = 0; r < 4; ++r) {
#pragma unroll
                for (int j = 0; j < 4; ++j) s[r] += (v[r][j][0] * v[r][j][0] + v[r][j][1] * v[r][j][1]) + (v[r][j][2] * v[r][j][2] + v[r][j][3] * v[r][j][3]);
                const float rs = rsqrtf(wave_sum(s[r]) * (1.0f / 1024.0f) + EPSN); const int m = m0 + r * NGW;
                if (m < MT) { u32x2* o8 = (u32x2*)(XN + (size_t)m * 1024) + lane;
#pragma unroll
                    for (int j = 0; j < 4; ++j) o8[64 * j] = (u32x2){pk2(v[r][j][0] * rs, v[r][j][1] * rs), pk2(v[r][j][2] * rs, v[r][j][3] * rs)}; } }
        }
        if (bx == 0 && tid < 64) ((unsigned*)(ws + WS_CTR))[tid] = 0u;
    }
    }
    if constexpr (PH == 1) {
    {
        pg8::Gemm g{XN, WinT, MT, NIN, 1024, 0}; pg8::StaticOrder S; S.init(MT, NIN, G, bx);
        pg8::EpiIn E{Zs, XBC, Qb, Kb, Vb, DT, out, a.dt_bias, a.f_bias, a.q_norm_w, a.k_norm_w, (bf16_t*)(ws + WS_HIST)};
        pg8::gemm_phase<pg8::EpiIn, pg8::StaticOrder, true, true>((PG8_LAS unsigned char*)lds, g, S, E);
    }
    }
    if constexpr (PH == 9) {
    {
        const bf16_t* HIST = (const bf16_t*)(ws + WS_HIST);
        constexpr int NSEG = MP / 128, NPAIR = DCONV / 2, NTASK = (NSEG + SBATCH) * NPAIR;
        for (int task = bx * 512 + tid; task < NTASK; task += G * 512) {
            const int seg = task / NPAIR, col = 2 * (task - seg * NPAIR);
            float w0[4], w1[4];
#pragma unroll
            for (int k = 0; k < 4; ++k) { w0[k] = a.conv_w[k * DCONV + col]; w1[k] = a.conv_w[k * DCONV + col + 1]; }
            const float b0 = a.conv_b[col], b1 = a.conv_b[col + 1];
            float a3 = 0.f, c3 = 0.f, a2 = 0.f, c2 = 0.f, a1 = 0.f, c1 = 0.f; int row0, n;
            if (seg < NSEG) { row0 = seg * 128; n = 128;
                if (seg & 63) { const bf16_t* hp = HIST + (unsigned)((seg - 1) * 3 * DCONV + col);
                    const unsigned u3 = *(const unsigned*)hp, u2 = *(const unsigned*)(hp + DCONV), u1 = *(const unsigned*)(hp + 2 * DCONV);
                    a3 = bf2f(u3 & 0xffffu); c3 = bf2f(u3 >> 16); a2 = bf2f(u2 & 0xffffu); c2 = bf2f(u2 >> 16); a1 = bf2f(u1 & 0xffffu); c1 = bf2f(u1 >> 16); }
            } else { const int s = seg - NSEG; row0 = MP + s * 16; n = 16; const float* hp = a.state_conv + (unsigned)(s * 3 * DCONV + col);
                a3 = hp[0]; c3 = hp[1]; a2 = hp[DCONV]; c2 = hp[DCONV + 1]; a1 = hp[2 * DCONV]; c1 = hp[2 * DCONV + 1]; }
            bf16_t* xp = XBC + (unsigned)(row0 * DCONV + col);
            for (int i0 = 0; i0 < n; i0 += 16) {
                unsigned uu[16];
#pragma unroll
                for (int i = 0; i < 16; ++i) uu[i] = *(const unsigned*)(xp + (i0 + i) * DCONV);
#pragma unroll
                for (int i = 0; i < 16; ++i) { const float a0 = bf2f(uu[i] & 0xffffu), c0 = bf2f(uu[i] >> 16);
                    const float o0 = silu_f(b0 + w0[0] * a3 + w0[1] * a2 + w0[2] * a1 + w0[3] * a0), o1 = silu_f(b1 + w1[0] * c3 + w1[1] * c2 + w1[2] * c1 + w1[3] * c0);
                    *(unsigned*)(xp + (i0 + i) * DCONV) = cvtpk(o0, o1);
                    a3 = a2; c3 = c2; a2 = a1; c2 = c1; a1 = a0; c1 = c0; }
            }
        }
        sattn::Ptrs Q{a.cache_k, a.cache_v, a.cache_logf, Qb, Kb, Vb, out, Mix};
        for (int u = G - 1 - bx; u < SBATCH * 8; u += G) sattn::unit(Q, lds, u >> 3, u & 7);
    }
    }
    if constexpr (PH == 12) {
    {
        if (G >= 128) { const f32x4* part = (const f32x4*)(ws + WS_MIX); f32x4* y = (f32x4*)(out + O_Y + (size_t)MP * 1024);
            for (int i = bx * 512 + tid; i < MS * 1024 / 4; i += G * 512) { f32x4 s = y[i];
#pragma unroll
                for (int k = 0; k < 16; ++k) s += part[(size_t)k * (MS * 1024 / 4) + i];
                y[i] = s; } }
    }
    }
    if constexpr (PH == 10) {
    {
        const int ks = bx >> 3;
        pg8::Gemm g2{Hb + ks * 256, WdnT + ks * 256, MT, 1024, DFF, 4}; pg8::ListOrder S2{G, bx, G >= 128 ? 128 : 0, 8, MP / 256, 4, 0};
        pg8::EpiDownPartial E2{(float*)(ws + WS_MIX) + (size_t)ks * (MS * 1024)};
        pg8::gemm_phase<pg8::EpiDownPartial, pg8::ListOrder, true, true>((PG8_LAS unsigned char*)lds, g2, S2, E2);
    }
    }
    if constexpr (PH == 11) {
    {
        {
            pg8::Gemm g{Mix, WoutT, MT, 1024, DMIX, 0}; pg8::ListOrder S{G, bx, 8, 8, MP / 256, 4, 0};
            pg8::EpiOut E{a.x_prompt, a.x_sample, out + O_Y, XN, SS1, GSS};
            pg8::gemm_phase<pg8::EpiOut, pg8::ListOrder, true, true>((PG8_LAS unsigned char*)lds, g, S, E);
        }
    }
    }
    if constexpr (PH == 2) {
    {
        ssd::Ptrs P{XBC, Zs, DT, a.conv_w, a.conv_b, a.A_log, a.D_skip, a.state_conv, a.state_ssm, SL, DAT, GSS, Mix, out};
        for (int u = bx; u < PB * ssd::SSD_NBLK * 4; u += G) ssd::unit<0>(P, lds, u / (ssd::SSD_NBLK * 4), (u >> 2) % ssd::SSD_NBLK, u & 3);
        for (int u = bx; u < SBATCH * 4; u += G) ssd::unit<2>(P, lds, u >> 2, 0, u & 3);
    }
    }
    if constexpr (PH == 3) {
    {
        for (int item = bx * 512 + tid; item < PB * 16 * 8192; item += G * 512) {
            const int bh = item >> 13, b = bh >> 4, h = bh & 15, e = item & 8191; float s = 0.f;
            constexpr int NB = ssd::SSD_NBLK; float* sp = SL + ((size_t)(b * NB * 16 + h)) * 8192 + e; const float* dp = DAT + b * NB * 16 + h; float loc[NB], dec[NB];
#pragma unroll
            for (int blk = 0; blk < NB; ++blk) { loc[blk] = sp[(size_t)blk * 16 * 8192]; dec[blk] = dp[blk * 16]; }
#pragma unroll
            for (int blk = 0; blk < NB; ++blk) { sp[(size_t)blk * 16 * 8192] = s; s = s * __expf(dec[blk]) + loc[blk]; } }
        float* wtot = (float*)lds;
        for (int bh = bx; bh < PB * 8; bh += G) { const int b = bh >> 3, h = bh & 7;
            float v[16]; float run = 0.f; const int s0 = 16 * tid;
#pragma unroll
            for (int i = 0; i < 16; ++i) { v[i] = out[O_PLF + ((size_t)b * PSEQ + s0 + i) * 8 + h]; run += v[i]; }
            float inc = run;
#pragma unroll
            for (int o = 1; o < 64; o <<= 1) { const float t = __shfl_up(inc, o); if (lane >= o) inc += t; }
            __syncthreads();
            if (lane == 63) wtot[wave] = inc;
            __syncthreads();
            float off = inc - run;
            for (int w = 0; w < wave; ++w) off += wtot[w];
#pragma unroll
            for (int i = 0; i < 16; ++i) { off += v[i]; CP[(size_t)bh * PSEQ + s0 + i] = off * L2E; } }
    }
    }
    if constexpr (PH == 4) {
    {
        ssd::Ptrs P{XBC, Zs, DT, a.conv_w, a.conv_b, a.A_log, a.D_skip, a.state_conv, a.state_ssm, SL, DAT, GSS, Mix, out};
        for (int u = bx; u < PB * ssd::SSD_NBLK * 4; u += G) ssd::unit<1>(P, lds, u / (ssd::SSD_NBLK * 4), (u >> 2) % ssd::SSD_NBLK, u & 3);
    }
    }
    if constexpr (PH == 8) {
    {
        const attn_body::bf16* Qa = (const attn_body::bf16*)Qb; const attn_body::bf16* Ka = (const attn_body::bf16*)Kb; const attn_body::bf16* Va = (const attn_body::bf16*)Vb;
        attn_body::bf16* Oa = (attn_body::bf16*)(Mix + 1024);
        unsigned* ctr = (unsigned*)(ws + WS_CTR); int* slot = (int*)(lds + 147000);
        float skipl2;
        { float mq = fabsf(a.q_norm_w[lane]), mk = fabsf(a.k_norm_w[lane]);
#pragma unroll
          for (int o = 1; o < 64; o <<= 1) { mq = fmaxf(mq, __shfl_xor(mq, o)); mk = fmaxf(mk, __shfl_xor(mk, o)); }
          skipl2 = (16.0f * mq * mk + 33.0f) * L2E; }
        if (tid == 0) *slot = (int)atomicAdd(ctr, 1u);
        __syncthreads();
        int u = *slot;
        __syncthreads();
        while (u < PB * 8 * 32) {
            int nx = 0; if (tid == 0) nx = (int)atomicAdd(ctr, 1u);
            const int qb = 31 - (u >> 6), bh = u & 63;
            attn_body::attn_unit<8>(bh >> 3, bh & 7, qb, Qa, Ka, Va, Oa, CP, skipl2, (char*)lds);
            if (tid == 0) *slot = nx;
            __syncthreads();
            u = *slot;
            __syncthreads();
        }
    }
    }
    if constexpr (PH == 5) {
    {
        pg8::Gemm g{Mix, WoutT, MP, 1024, DMIX, 0}; pg8::StaticOrder S; S.init(MP, 1024, G, bx);
        pg8::EpiOut E{a.x_prompt, a.x_sample, out + O_Y, XN, SS1, GSS};
        pg8::gemm_phase<pg8::EpiOut, pg8::StaticOrder, true, true>((PG8_LAS unsigned char*)lds, g, S, E);
    }
    }
    if constexpr (PH == 6) {
    {
        pg8::Gemm g{XN, WupT, MT, DFF, 1024, 0}; pg8::StaticOrder S; S.init(MT, DFF, G, bx);
        pg8::EpiUp E{SS1, Hb};
        pg8::gemm_phase<pg8::EpiUp, pg8::StaticOrder, true, true>((PG8_LAS unsigned char*)lds, g, S, E);
    }
    }
    if constexpr (PH == 7) {
    {
        const int Mrows = G >= 128 ? MP : MT;
        pg8::Gemm g{Hb, WdnT, Mrows, 1024, DFF, 0}; pg8::StaticOrder S; S.init(Mrows, 1024, G, bx);
        pg8::EpiDown E{out + O_Y};
        pg8::gemm_phase<pg8::EpiDown, pg8::StaticOrder, true, true>((PG8_LAS unsigned char*)lds, g, S, E);
    }
    }
}
template <int PH> __global__ void __launch_bounds__(NWAVES * 64, 2) phase_kernel(Args a) {
    extern __shared__ __attribute__((aligned(16))) unsigned char lds[];
    run_phase<PH>(a, lds);
}
#ifndef ONE_LAUNCH
#define ONE_LAUNCH 1
#endif
#if ONE_LAUNCH
#define RUN_PHASE(k) do { const __attribute__((address_space(4))) Args* p_ = (const __attribute__((address_space(4))) Args*)__builtin_amdgcn_kernarg_segment_ptr(); asm volatile("" : "+s"(p_)); Args la_; { const __attribute__((address_space(4))) unsigned long long* q_ = (const __attribute__((address_space(4))) unsigned long long*)p_; unsigned long long* d_ = (unsigned long long*)&la_; _Pragma("unroll") for (int i_ = 0; i_ < (int)(sizeof(Args) / 8); ++i_) d_[i_] = q_[i_]; } run_phase<k>(la_, lds); } while (0)
__global__ void __launch_bounds__(NWAVES * 64, 2) fwd_megakernel(Args a) {
    extern __shared__ __attribute__((aligned(16))) unsigned char lds[];
    cg::grid_group grid = cg::this_grid();
    if (threadIdx.x < 2) ((volatile LAS unsigned*)(lds + 147016))[threadIdx.x] = 0u;
    __syncthreads();
    XcdBarrier xbar;
    { const __attribute__((address_space(4))) Args* p_ = (const __attribute__((address_space(4))) Args*)__builtin_amdgcn_kernarg_segment_ptr();
      xbar = xcd_barrier_post((unsigned*)(p_->ws + WS_BARW), (volatile LAS unsigned*)(lds + 147016)); }
    RUN_PHASE(0); grid.sync();
    RUN_PHASE(1); xcd_barrier(xbar);
    RUN_PHASE(9); xcd_barrier(xbar);
    RUN_PHASE(2); xcd_barrier(xbar);
    RUN_PHASE(3); xcd_barrier(xbar);
    RUN_PHASE(4); __syncthreads(); RUN_PHASE(11); __syncthreads(); RUN_PHASE(8); xcd_barrier(xbar);
    RUN_PHASE(5); xcd_barrier(xbar);
    RUN_PHASE(6); xcd_barrier(xbar);
    RUN_PHASE(7); __syncthreads(); RUN_PHASE(10); xcd_barrier(xbar);
    RUN_PHASE(12);
}
#endif
extern "C" void kernel_launch(void* const* d_in, const int* in_sizes, int n_in, void* d_out, int out_size, void* d_ws, size_t ws_size, hipStream_t stream) {
    static int grid = 0;
    if (grid == 0) {
        if (n_in != 22 || (size_t)out_size != O_END || ws_size < WS_END) { fprintf(stderr, "kernel_launch: unexpected shapes: n_in %d out %d ws %zu (need %zu)\n", n_in, out_size, ws_size, (size_t)WS_END); grid = -1; return; }
        int dev = 0, cus = 0, per_cu = 0;
        (void)hipGetDevice(&dev); (void)hipDeviceGetAttribute(&cus, hipDeviceAttributeMultiprocessorCount, dev);
        bool okattr = true;
#if ONE_LAUNCH
        okattr = hipFuncSetAttribute((const void*)fwd_megakernel, hipFuncAttributeMaxDynamicSharedMemorySize, LDS_BYTES) == hipSuccess;
#endif
#if !ONE_LAUNCH
        okattr = okattr && hipFuncSetAttribute((const void*)phase_kernel<0>, hipFuncAttributeMaxDynamicSharedMemorySize, LDS_BYTES) == hipSuccess && hipFuncSetAttribute((const void*)phase_kernel<1>, hipFuncAttributeMaxDynamicSharedMemorySize, LDS_BYTES) == hipSuccess
              && hipFuncSetAttribute((const void*)phase_kernel<2>, hipFuncAttributeMaxDynamicSharedMemorySize, LDS_BYTES) == hipSuccess && hipFuncSetAttribute((const void*)phase_kernel<3>, hipFuncAttributeMaxDynamicSharedMemorySize, LDS_BYTES) == hipSuccess
              && hipFuncSetAttribute((const void*)phase_kernel<4>, hipFuncAttributeMaxDynamicSharedMemorySize, LDS_BYTES) == hipSuccess && hipFuncSetAttribute((const void*)phase_kernel<5>, hipFuncAttributeMaxDynamicSharedMemorySize, LDS_BYTES) == hipSuccess
              && hipFuncSetAttribute((const void*)phase_kernel<6>, hipFuncAttributeMaxDynamicSharedMemorySize, LDS_BYTES) == hipSuccess && hipFuncSetAttribute((const void*)phase_kernel<7>, hipFuncAttributeMaxDynamicSharedMemorySize, LDS_BYTES) == hipSuccess && hipFuncSetAttribute((const void*)phase_kernel<8>, hipFuncAttributeMaxDynamicSharedMemorySize, LDS_BYTES) == hipSuccess && hipFuncSetAttribute((const void*)phase_kernel<9>, hipFuncAttributeMaxDynamicSharedMemorySize, LDS_BYTES) == hipSuccess && hipFuncSetAttribute((const void*)phase_kernel<10>, hipFuncAttributeMaxDynamicSharedMemorySize, LDS_BYTES) == hipSuccess && hipFuncSetAttribute((const void*)phase_kernel<11>, hipFuncAttributeMaxDynamicSharedMemorySize, LDS_BYTES) == hipSuccess && hipFuncSetAttribute((const void*)phase_kernel<12>, hipFuncAttributeMaxDynamicSharedMemorySize, LDS_BYTES) == hipSuccess;
#endif
        if (!okattr) { fprintf(stderr, "kernel_launch: hipFuncSetAttribute failed\n"); grid = -1; return; }
        (void)hipGetLastError();
        grid = cus;
    }
    if (grid < 0) return;
    Args a{};
    a.x_prompt = (const float*)d_in[0]; a.x_sample = (const float*)d_in[1]; a.cache_k = (const float*)d_in[2]; a.cache_v = (const float*)d_in[3]; a.cache_logf = (const float*)d_in[4];
    a.state_ssm = (const float*)d_in[5]; a.state_conv = (const float*)d_in[6]; a.norm1_w = (const float*)d_in[7]; a.w_in = (const float*)d_in[8]; a.conv_w = (const float*)d_in[9];
    a.conv_b = (const float*)d_in[10]; a.dt_bias = (const float*)d_in[11]; a.A_log = (const float*)d_in[12]; a.D_skip = (const float*)d_in[13]; a.ssd_norm_w = (const float*)d_in[14];
    a.f_bias = (const float*)d_in[15]; a.q_norm_w = (const float*)d_in[16]; a.k_norm_w = (const float*)d_in[17]; a.w_out = (const float*)d_in[18]; a.norm2_w = (const float*)d_in[19];
    a.w_up = (const float*)d_in[20]; a.w_down = (const float*)d_in[21]; a.out = (float*)d_out; a.ws = (unsigned char*)d_ws;
#if ONE_LAUNCH
    if (hipMemsetAsync((char*)d_ws + WS_BARW, 0, 16384, stream) != hipSuccess) { fprintf(stderr, "kernel_launch: hipMemsetAsync failed\n"); return; }
    void* args[] = {&a};
    hipError_t e = hipLaunchCooperativeKernel((const void*)fwd_megakernel, dim3(grid), dim3(NWAVES * 64), args, LDS_BYTES, stream);
    if (e != hipSuccess) fprintf(stderr, "kernel_launch: cooperative launch failed: %s (grid %d)\n", hipGetErrorString(e), grid);
#else
    hipLaunchKernelGGL(phase_kernel<0>, dim3(grid), dim3(NWAVES * 64), LDS_BYTES, stream, a);
    hipLaunchKernelGGL(phase_kernel<1>, dim3(grid), dim3(NWAVES * 64), LDS_BYTES, stream, a);
    hipLaunchKernelGGL(phase_kernel<9>, dim3(grid), dim3(NWAVES * 64), LDS_BYTES, stream, a);
    hipLaunchKernelGGL(phase_kernel<2>, dim3(grid), dim3(NWAVES * 64), LDS_BYTES, stream, a);
    hipLaunchKernelGGL(phase_kernel<3>, dim3(grid), dim3(NWAVES * 64), LDS_BYTES, stream, a);
    hipLaunchKernelGGL(phase_kernel<4>, dim3(grid), dim3(NWAVES * 64), LDS_BYTES, stream, a);
    hipLaunchKernelGGL(phase_kernel<11>, dim3(grid), dim3(NWAVES * 64), LDS_BYTES, stream, a);
    hipLaunchKernelGGL(phase_kernel<8>, dim3(grid), dim3(NWAVES * 64), LDS_BYTES, stream, a);
    hipLaunchKernelGGL(phase_kernel<5>, dim3(grid), dim3(NWAVES * 64), LDS_BYTES, stream, a);
    hipLaunchKernelGGL(phase_kernel<6>, dim3(grid), dim3(NWAVES * 64), LDS_BYTES, stream, a);
    hipLaunchKernelGGL(phase_kernel<7>, dim3(grid), dim3(NWAVES * 64), LDS_BYTES, stream, a);
    hipLaunchKernelGGL(phase_kernel<10>, dim3(grid), dim3(NWAVES * 64), LDS_BYTES, stream, a);
    hipLaunchKernelGGL(phase_kernel<12>, dim3(grid), dim3(NWAVES * 64), LDS_BYTES, stream, a);
#endif
}
```

```cpp
#include <hip/hip_runtime.h>
#include <hip/hip_cooperative_groups.h>
#include <hip/hip_bf16.h>
#include <cstdio>
#include <cstdint>
#include <cmath>
namespace cg = cooperative_groups;

constexpr int DMODEL = 1024, PSEQ = 8192, PB = 8, MP = PB * PSEQ  , SBATCH = 32, SSEQ = 16, MS = SBATCH * SSEQ  , MT = MP + MS  ;
constexpr int PAST = 4096, NIN = 4352  , DFF = 4096, DMIX = 1536, DCONV = 1536;
constexpr float EPSN = 1e-6f, L2E = 1.4426950408889634f;
constexpr size_t O_Y = 0, O_PK = 67633152, O_PV = 101187584, O_PLF = 134742016, O_PSSM = 135266304, O_PCONV = 136314880, O_SK = 136351744, O_SV = 136613888,
                 O_SLF = 136876032, O_SSSM = 136880128, O_SCONV = 141074432, O_END = 141221888;
constexpr size_t MiB = 1u << 20;
constexpr size_t WS_BARW = 1152 * 1024, WS_CTR = 1120 * 1024, WS_SS1 = 0, WS_GSS = 512 * 1024, WS_DAT = 1088 * 1024, WS_CP = 2 * MiB, WS_WIN = 4 * MiB, WS_WOUT = WS_WIN + 8704 * 1024, WS_WUP = WS_WOUT + 3 * MiB, WS_WDN = WS_WUP + 8 * MiB;
constexpr size_t WS_XN = 32 * MiB, WS_DT = 161 * MiB, WS_SL = 166 * MiB, WS_ZS = 294 * MiB, WS_XBC = 423 * MiB, WS_QB = 617 * MiB, WS_KB = 682 * MiB, WS_VB = 747 * MiB, WS_MIX = 812 * MiB,
                 WS_H = 294 * MiB, WS_HIST = 1006 * MiB, WS_GSSP = 1012 * MiB, WS_SS1P = 1014 * MiB, WS_END = 1019 * MiB;
static_assert(WS_WDN + 8 * MiB <= WS_XN && WS_XN + (size_t)MT * 1024 * 2 <= WS_DT && WS_DT + (size_t)MT * 64 <= WS_SL && WS_SL + 128 * MiB <= WS_ZS, "ws map 1");
static_assert(WS_ZS + (size_t)MT * 2048 <= WS_XBC && WS_XBC + (size_t)(MT + 64) * 3072 <= WS_QB && WS_QB + (size_t)MT * 1024 <= WS_KB && WS_KB + (size_t)MT * 1024 <= WS_VB && WS_VB + (size_t)MT * 1024 <= WS_MIX, "ws map 2");
static_assert(WS_MIX + (size_t)MT * 3072 <= WS_END && WS_H + (size_t)MT * 8192 <= WS_MIX, "ws map 3");

typedef unsigned short bf16_t;
typedef short bf16x8 __attribute__((ext_vector_type(8)));
typedef float f32x4 __attribute__((ext_vector_type(4)));
typedef float f32x16 __attribute__((ext_vector_type(16)));
typedef unsigned u32x4 __attribute__((ext_vector_type(4)));
typedef unsigned u32x2 __attribute__((ext_vector_type(2)));
typedef float f32x2_t_ __attribute__((ext_vector_type(2)));
typedef __bf16 bf16x2_t_ __attribute__((ext_vector_type(2)));
__device__ __forceinline__ unsigned cvtpk(float lo, float hi) { f32x2_t_ v = {lo, hi}; bf16x2_t_ b = __builtin_convertvector(v, bf16x2_t_); return __builtin_bit_cast(unsigned, b); }
__device__ __forceinline__ float bf2f(unsigned u16) { return __uint_as_float(u16 << 16); }
__device__ __forceinline__ float silu_f(float v) { return v * __builtin_amdgcn_rcpf(1.0f + __expf(-v)); }
__device__ __forceinline__ float softplus_f(float v) { return v > 20.f ? v : log1pf(__expf(v)); }
__device__ __forceinline__ float logsigmoid_f(float v) { return fminf(v, 0.f) - log1pf(__expf(-fabsf(v))); }
__device__ __forceinline__ int crow_(int r, int hi) { return (r & 3) + 8 * (r >> 2) + 4 * hi; }
__device__ __forceinline__ void gatomic_add(float* p, float v) { (void)__builtin_amdgcn_global_atomic_fadd_f32((__attribute__((address_space(1))) float*)p, v); }
namespace pg8 {
#define PG8_LAS __attribute__((address_space(3)))
typedef unsigned short bf16_t;
typedef short bf16x8 __attribute__((ext_vector_type(8)));
typedef float f32x4 __attribute__((ext_vector_type(4)));
typedef unsigned u32x4 __attribute__((ext_vector_type(4)));
constexpr int BM = 256, BK = 64, HALF = 128, HTB = HALF * BK * 2  , STAGE_BYTES = 8 * HTB, NXCD = 8, WGM = 8;

__host__ __device__ __forceinline__ int lds_byte(int r, int c) { const int st = (r >> 4) * 2 + (c >> 5), rr = r & 15, cc = c & 31, ob = rr * 64 + cc * 2; return st * 1024 + (ob ^ (((ob >> 9) & 1) << 5)); }
__host__ __device__ __forceinline__ void stage_rc(int b, int& R, int& C) { const int st = b / 1024, sb = b % 1024, swz = sb ^ (((sb >> 9) & 1) << 5); R = (st >> 1) * 16 + swz / 64; C = (st & 1) * 32 + (swz % 64) / 2; }
__host__ __device__ __forceinline__ int perm32(int rho) { const int n = rho >> 4, i = rho & 15; return 8 * (i >> 2) + 4 * n + (i & 3); }

struct Unit { int pm, pn, k0; };
struct Gemm { const bf16_t* A; const bf16_t* Bt; int M, N, K, nt; };

struct StaticOrder {
    int nM, nN, nwg, G, c;
    __host__ __device__ void init(int M, int N, int G_, int c_) { nM = M / BM; nN = N / BM; nwg = nM * nN; G = G_; c = c_; }
    __host__ __device__ bool next(int i, Unit& u) const {
        const long L = (long)i * G + c; if (L >= nwg) return false;
        int wgid = (int)L; { const int q = nwg / NXCD, r = nwg % NXCD, xcd = wgid % NXCD, off = wgid / NXCD; wgid = (xcd < r ? xcd * (q + 1) : r * (q + 1) + (xcd - r) * q) + off; }
        const int nig = WGM * nN, gid = wgid / nig, fm = gid * WGM, gsz = (nM - fm) < WGM ? (nM - fm) : WGM;
        u.pm = fm + ((wgid % nig) % gsz); u.pn = (wgid % nig) / gsz; u.k0 = 0; return true;
    }
    __device__ __forceinline__ void a_ready(const Unit&) const {}
    __device__ __forceinline__ void done(const Unit&) const {}
};

struct ListOrder {
    int G, c, count, ntiles, pm0, npn, ksplit;
    __device__ __forceinline__ bool next(int i, Unit& u) const { const int L = i * G + c; if (L >= count) return false; const int tile = L % ntiles, ks = L / ntiles; u.pm = pm0 + tile / npn; u.pn = tile % npn; u.k0 = ks * ksplit; return true; }
    __device__ __forceinline__ void a_ready(const Unit&) const {}
    __device__ __forceinline__ void done(const Unit&) const {}
};

__device__ __forceinline__ void st_bf16x8(bf16_t* p, f32x4 a, f32x4 b) { u32x4 w; w.x = cvtpk(a[0], a[1]); w.y = cvtpk(a[2], a[3]); w.z = cvtpk(b[0], b[1]); w.w = cvtpk(b[2], b[3]); *(u32x4*)p = w; }
struct EpiIn {
    static constexpr bool PERM = true, AFTER_DRAIN = false, KHOOK = false;
    bf16_t *Zs, *XBC, *Qb, *Kb, *Vb; float* DT; float* out; const float *dt_bias, *f_bias, *qw, *kw; bf16_t* HIST;
    __device__ __forceinline__ void operator()(const f32x4 (&acc)[2][2][4][2], const Unit& u, int wr, int wc, int fr, int fq) const {
        const int pn = u.pn; const int lc = pn * 256 + wc * 64 + fq * 8;
        if (pn < 10) {
#pragma unroll
            for (int ai = 0; ai < 2; ++ai)
#pragma unroll
                for (int m = 0; m < 4; ++m) { const int row = u.pm * BM + ai * HALF + wr * 64 + m * 16 + fr;
#pragma unroll
                    for (int bj = 0; bj < 2; ++bj) { f32x4 v0 = acc[ai][bj][m][0], v1 = acc[ai][bj][m][1];
                        if (pn < 4) {
#pragma unroll
                            for (int e = 0; e < 4; ++e) { v0[e] = silu_f(v0[e]); v1[e] = silu_f(v1[e]); }
                            st_bf16x8(Zs + row * 1024 + lc + 32 * bj, v0, v1);
                        } else { const int c = lc - 1024 + 32 * bj;
                            st_bf16x8(XBC + row * 1536 + c, v0, v1);
                            if (row < MP && (row & 127) >= 125) st_bf16x8(HIST + ((row >> 7) * 3 + ((row & 127) - 125)) * DCONV + c, v0, v1);
                            float* cs = nullptr;
                            if (row < MP) { const int t = (int)(row & (PSEQ - 1)); if (t >= PSEQ - 3) cs = out + O_PCONV + ((row >> 13) * 3 + (t - (PSEQ - 3))) * DCONV + c; }
                            else { const int sr = (int)(row - MP), t = sr & 15; if (t >= 13) cs = out + O_SCONV + ((sr >> 4) * 3 + (t - 13)) * DCONV + c; }
                            if (cs) { *(f32x4*)cs = v0; *(f32x4*)(cs + 4) = v1; } } } }
        } else if (pn < 14) {
            const bool isq = pn < 12; const float* w = isq ? qw : kw; const int hcol = lc - (isq ? 2560 : 3072);
#pragma unroll
            for (int ai = 0; ai < 2; ++ai)
#pragma unroll
                for (int m = 0; m < 4; ++m) { const int row = u.pm * BM + ai * HALF + wr * 64 + m * 16 + fr; float ss = 0.f;
#pragma unroll
                    for (int bj = 0; bj < 2; ++bj)
#pragma unroll
                        for (int n = 0; n < 2; ++n) { const f32x4 x = acc[ai][bj][m][n]; ss += (x[0] * x[0] + x[1] * x[1]) + (x[2] * x[2] + x[3] * x[3]); }
                    ss += __shfl_xor(ss, 16); ss += __shfl_xor(ss, 32);
                    const float rs = rsqrtf(ss * (1.0f / 64.0f) + EPSN); const float rq = isq ? rs * (0.125f * L2E) : rs;
#pragma unroll
                    for (int bj = 0; bj < 2; ++bj) { const f32x4 o0 = acc[ai][bj][m][0] * *(const f32x4*)(w + 32 * bj + 8 * fq), o1 = acc[ai][bj][m][1] * *(const f32x4*)(w + 32 * bj + 8 * fq + 4);
                        st_bf16x8((isq ? Qb : Kb) + row * 512 + hcol + 32 * bj, o0 * rq, o1 * rq);
                        if (!isq) { float* kp = (row < MP ? out + O_PK + row * 512 : out + O_SK + (row - MP) * 512) + hcol + 32 * bj; __builtin_nontemporal_store(o0 * rs, (f32x4*)kp); __builtin_nontemporal_store(o1 * rs, (f32x4*)(kp + 4)); }     } }
        } else if (pn < 16) {
            const int hcol = lc - 3584;
#pragma unroll
            for (int ai = 0; ai < 2; ++ai)
#pragma unroll
                for (int m = 0; m < 4; ++m) { const int row = u.pm * BM + ai * HALF + wr * 64 + m * 16 + fr;
#pragma unroll
                    for (int bj = 0; bj < 2; ++bj) { const f32x4 v0 = acc[ai][bj][m][0], v1 = acc[ai][bj][m][1];
                        st_bf16x8(Vb + row * 512 + hcol + 32 * bj, v0, v1);
                        float* vp = (row < MP ? out + O_PV + row * 512 : out + O_SV + (row - MP) * 512) + hcol + 32 * bj; __builtin_nontemporal_store(v0, (f32x4*)vp); __builtin_nontemporal_store(v1, (f32x4*)(vp + 4)); } }
        } else {
            if (wc == 0 && fq < 3) {
                const f32x4 b0 = fq < 2 ? *(const f32x4*)(dt_bias + 8 * fq) : *(const f32x4*)(f_bias), b1 = fq < 2 ? *(const f32x4*)(dt_bias + 8 * fq + 4) : *(const f32x4*)(f_bias + 4);
#pragma unroll
                for (int ai = 0; ai < 2; ++ai)
#pragma unroll
                    for (int m = 0; m < 4; ++m) { const int row = u.pm * BM + ai * HALF + wr * 64 + m * 16 + fr;
                        f32x4 v0 = acc[ai][0][m][0] + b0, v1 = acc[ai][0][m][1] + b1;
                        if (fq < 2) {
#pragma unroll
                            for (int e = 0; e < 4; ++e) { v0[e] = softplus_f(v0[e]); v1[e] = softplus_f(v1[e]); }
                            float* dp = DT + row * 16 + 8 * fq; *(f32x4*)dp = v0; *(f32x4*)(dp + 4) = v1;
                        } else {
#pragma unroll
                            for (int e = 0; e < 4; ++e) { v0[e] = logsigmoid_f(v0[e]); v1[e] = logsigmoid_f(v1[e]); }
                            float* lp = (row < MP ? out + O_PLF + row * 8 : out + O_SLF + (row - MP) * 8); *(f32x4*)lp = v0; *(f32x4*)(lp + 4) = v1; } }
            }
        }
    }
};
struct EpiOut {
    static constexpr bool PERM = true, AFTER_DRAIN = false, KHOOK = true;
    const float *xp, *xs; float* Y; bf16_t* X1b; float* SS1; const float* GSS;
    __device__ __forceinline__ void khook(f32x4 (&acc)[2][2][4][2], const Unit& u, int t, int wr, int fr) const {
#pragma unroll
        for (int ai = 0; ai < 2; ++ai)
#pragma unroll
            for (int m = 0; m < 4; ++m) { const int row = u.pm * BM + ai * HALF + wr * 64 + m * 16 + fr;
                const f32x4 gp = *(const f32x4*)(GSS + (unsigned)(row * 4)); const float g0 = gp[0] + gp[1], g1 = gp[2] + gp[3];
                const float r0 = rsqrtf(g0 * (1.0f / 512.0f) + EPSN), r1 = rsqrtf(g1 * (1.0f / 512.0f) + EPSN);
                const float f = (t == 8) ? r0 / r1 : r1;
#pragma unroll
                for (int bj = 0; bj < 2; ++bj)
#pragma unroll
                    for (int n = 0; n < 2; ++n) acc[ai][bj][m][n] *= f; }
    }
    __device__ __forceinline__ void operator()(const f32x4 (&acc)[2][2][4][2], const Unit& u, int wr, int wc, int fr, int fq) const {
        const int col0 = u.pn * BM + wc * 32 + 8 * fq; float ssv[8];
#pragma unroll
        for (int ai = 0; ai < 2; ++ai)
#pragma unroll
            for (int m = 0; m < 4; ++m) { const int row = u.pm * BM + ai * HALF + wr * 64 + m * 16 + fr;
                const float* xr = row < MP ? xp + row * 1024 : xs + (row - MP) * 1024; float ss = 0.f;
#pragma unroll
                for (int bj = 0; bj < 2; ++bj) { const int c = col0 + bj * HALF;
                    const f32x4 o0 = __builtin_nontemporal_load((const f32x4*)(xr + c)) + acc[ai][bj][m][0], o1 = __builtin_nontemporal_load((const f32x4*)(xr + c + 4)) + acc[ai][bj][m][1];
                    *(f32x4*)(Y + row * 1024 + c) = o0; *(f32x4*)(Y + row * 1024 + c + 4) = o1; st_bf16x8(X1b + row * 1024 + c, o0, o1);
                    ss += (o0[0] * o0[0] + o0[1] * o0[1]) + (o0[2] * o0[2] + o0[3] * o0[3]) + (o1[0] * o1[0] + o1[1] * o1[1]) + (o1[2] * o1[2] + o1[3] * o1[3]); }
                ss += __shfl_xor(ss, 16); ss += __shfl_xor(ss, 32);
                ssv[ai * 4 + m] = ss; }
        if (fq == 0) {
#pragma unroll
            for (int ai = 0; ai < 2; ++ai)
#pragma unroll
                for (int m = 0; m < 4; ++m) SS1[(unsigned)((u.pm * BM + ai * HALF + wr * 64 + m * 16 + fr) * 16 + u.pn * 4 + wc)] = ssv[ai * 4 + m]; }
    }
};
struct EpiUp {
    static constexpr bool PERM = true, AFTER_DRAIN = false, KHOOK = false;
    const float* SS1; bf16_t* H;
    __device__ __forceinline__ void operator()(const f32x4 (&acc)[2][2][4][2], const Unit& u, int wr, int wc, int fr, int fq) const {
        const int col0 = u.pn * BM + wc * 32 + 8 * fq;
#pragma unroll
        for (int ai = 0; ai < 2; ++ai)
#pragma unroll
            for (int m = 0; m < 4; ++m) { const int row = u.pm * BM + ai * HALF + wr * 64 + m * 16 + fr;
                const f32x4 s0 = *(const f32x4*)(SS1 + (unsigned)(row * 16)), s1 = *(const f32x4*)(SS1 + (unsigned)(row * 16 + 4)), s2 = *(const f32x4*)(SS1 + (unsigned)(row * 16 + 8)), s3 = *(const f32x4*)(SS1 + (unsigned)(row * 16 + 12));
                const f32x4 st = (s0 + s1) + (s2 + s3); const float r2 = 1.0f / (((st[0] + st[1]) + (st[2] + st[3])) * (1.0f / 1024.0f) + EPSN);
#pragma unroll
                for (int bj = 0; bj < 2; ++bj) { f32x4 v0 = acc[ai][bj][m][0], v1 = acc[ai][bj][m][1];
#pragma unroll
                    for (int e = 0; e < 4; ++e) { const float a = fmaxf(v0[e], 0.f), b = fmaxf(v1[e], 0.f); v0[e] = a * a * r2; v1[e] = b * b * r2; }
                    st_bf16x8(H + row * DFF + col0 + bj * HALF, v0, v1); } }
    }
};
struct EpiDown {
    static constexpr bool PERM = true, AFTER_DRAIN = false, KHOOK = false;
    float* Y;
    __device__ __forceinline__ void operator()(const f32x4 (&acc)[2][2][4][2], const Unit& u, int wr, int wc, int fr, int fq) const {
        const int col0 = u.pn * BM + wc * 32 + 8 * fq;
#pragma unroll
        for (int ai = 0; ai < 2; ++ai)
#pragma unroll
            for (int m = 0; m < 4; ++m) { const int row = u.pm * BM + ai * HALF + wr * 64 + m * 16 + fr;
#pragma unroll
                for (int bj = 0; bj < 2; ++bj) { float* p = Y + row * 1024 + col0 + bj * HALF;
                    const f32x4 o0 = *(const f32x4*)p + acc[ai][bj][m][0], o1 = *(const f32x4*)(p + 4) + acc[ai][bj][m][1]; __builtin_nontemporal_store(o0, (f32x4*)p); __builtin_nontemporal_store(o1, (f32x4*)(p + 4)); } }
    }
};
struct EpiDownPartial {
    static constexpr bool PERM = true, AFTER_DRAIN = false, KHOOK = false;
    float* PART;
    __device__ __forceinline__ void operator()(const f32x4 (&acc)[2][2][4][2], const Unit& u, int wr, int wc, int fr, int fq) const {
        const int col0 = u.pn * BM + wc * 32 + 8 * fq;
#pragma unroll
        for (int ai = 0; ai < 2; ++ai)
#pragma unroll
            for (int m = 0; m < 4; ++m) { const int row = (u.pm - MP / 256) * BM + ai * HALF + wr * 64 + m * 16 + fr;
#pragma unroll
                for (int bj = 0; bj < 2; ++bj) { float* p = PART + (unsigned)(row * 1024 + col0 + bj * HALF); *(f32x4*)p = acc[ai][bj][m][0]; *(f32x4*)(p + 4) = acc[ai][bj][m][1]; } }
    }
};
template <class Epi, class Sched, bool ALIGN_EPI = false, bool SP2 = false>
__device__ __forceinline__ void gemm_phase(PG8_LAS unsigned char* lds, const Gemm g, const Sched& S, const Epi& E) {
    int tid_ = threadIdx.x; asm volatile("" : "+v"(tid_));
    const int tid = tid_, wid = __builtin_amdgcn_readfirstlane(tid >> 6), lane = tid & 63, wr = wid >> 2, wc = wid & 3, fr = lane & 15, fq = lane >> 4;
    const int K = g.K; int nt_ = g.nt ? g.nt : K / BK; asm volatile("" : "+s"(nt_)); const int nt = nt_;
    unsigned voffA[2], voffB[2];
#pragma unroll
    for (int i = 0; i < 2; ++i) { int R, C; stage_rc(tid * 16 + i * 8192, R, C); const int Rb = Epi::PERM ? ((R & ~31) + perm32(R & 31)) : R;
        voffA[i] = (unsigned)(R * K + C) * 2u; voffB[i] = (unsigned)(Rb * K + C) * 2u; }
    const size_t kstep = (size_t)(BK * 2);
    const size_t hstep = (size_t)HALF * K * 2;
    const size_t tstep = 2 * hstep;
    const unsigned ldsw = (unsigned)wid * 1024u;
    const int aoff = lds_byte(wr * 64 + fr, fq * 8), boff = lds_byte(wc * 32 + fr, fq * 8);
#define PG8_SA(b, h) (((b) * 2 + (h)) * HTB)
#define PG8_SB(b, h) ((4 + (b) * 2 + (h)) * HTB)
#define PG8_STAGE(bufoff, gbase, voff) do { _Pragma("unroll") for (int _i = 0; _i < 2; ++_i) \
        __builtin_amdgcn_global_load_lds((const unsigned*)((const char*)(gbase) + (voff)[_i]), (PG8_LAS unsigned*)(lds + (bufoff) + ldsw + _i * 8192), 16, 0, 0); } while (0)
#define PG8_LDA(dst, b, h) do { _Pragma("unroll") for (int m = 0; m < 4; ++m) _Pragma("unroll") for (int k = 0; k < 2; ++k) dst[m][k] = *(const PG8_LAS bf16x8*)(lds + PG8_SA(b, h) + aoff + m * 2048 + k * 1024); } while (0)
#define PG8_LDB(dst, b, h) do { _Pragma("unroll") for (int n = 0; n < 2; ++n) _Pragma("unroll") for (int k = 0; k < 2; ++k) dst[n][k] = *(const PG8_LAS bf16x8*)(lds + PG8_SB(b, h) + boff + n * 2048 + k * 1024); } while (0)
#define PG8_MMA(ai, bj, At, Bt) do { __builtin_amdgcn_s_setprio(1); _Pragma("unroll") for (int m = 0; m < 4; ++m) _Pragma("unroll") for (int n = 0; n < 2; ++n) _Pragma("unroll") for (int k = 0; k < 2; ++k) \
        acc[ai][bj][m][n] = __builtin_amdgcn_mfma_f32_16x16x32_bf16(Bt[n][k], At[m][k], acc[ai][bj][m][n], 0, 0, 0); __builtin_amdgcn_s_setprio(0); } while (0)
#define PG8_WAIT_V(n) asm volatile("s_waitcnt vmcnt(" #n ")" ::: "memory")
#define PG8_WAIT_L(n) asm volatile("s_waitcnt lgkmcnt(" #n ")" ::: "memory")
#define PG8_BAR __builtin_amdgcn_s_barrier()
#define PG8_SCHED __builtin_amdgcn_sched_barrier(0)
    Unit cur, nxt; int ui = 0;
    if (!S.next(0, cur)) return;
    f32x4 acc[2][2][4][2];
#pragma unroll
    for (int a = 0; a < 2; ++a)
#pragma unroll
        for (int b = 0; b < 2; ++b)
#pragma unroll
            for (int m = 0; m < 4; ++m)
#pragma unroll
                for (int n = 0; n < 2; ++n) acc[a][b][m][n] = (f32x4){0.f, 0.f, 0.f, 0.f};
    bf16x8 At[4][2], B0[2][2], B1[2][2];
    const char* cA = (const char*)g.A + (size_t)cur.pm * tstep + (size_t)cur.k0 * 2; const char* cB = (const char*)g.Bt + (size_t)cur.pn * tstep + (size_t)cur.k0 * 2;
    S.a_ready(cur);
    if constexpr (SP2) {
        PG8_STAGE(PG8_SB(0, 0), cB, voffB); PG8_STAGE(PG8_SB(0, 1), cB + hstep, voffB); PG8_STAGE(PG8_SA(0, 0), cA, voffA); PG8_STAGE(PG8_SA(0, 1), cA + hstep, voffA);
        if (wr == 1) PG8_BAR;
        PG8_WAIT_V(2); PG8_BAR;
        PG8_STAGE(PG8_SB(1, 0), cB + kstep, voffB); PG8_STAGE(PG8_SA(1, 0), cA + kstep, voffA); PG8_STAGE(PG8_SB(1, 1), cB + hstep + kstep, voffB);
        PG8_WAIT_V(6); PG8_BAR;
    } else {
        PG8_STAGE(PG8_SB(0, 0), cB, voffB); PG8_STAGE(PG8_SA(0, 0), cA, voffA); PG8_STAGE(PG8_SB(0, 1), cB + hstep, voffB); PG8_STAGE(PG8_SA(0, 1), cA + hstep, voffA);
        if (wr == 1) PG8_BAR;
        PG8_WAIT_V(4); PG8_BAR;
        PG8_STAGE(PG8_SB(1, 0), cB + kstep, voffB); PG8_STAGE(PG8_SA(1, 0), cA + kstep, voffA); PG8_STAGE(PG8_SB(1, 1), cB + hstep + kstep, voffB);
        PG8_WAIT_V(6); PG8_BAR;
    }
    for (;;) {
        const bool has_next = S.next(ui + 1, nxt);
        const char* nA = has_next ? (const char*)g.A + (size_t)nxt.pm * tstep + (size_t)nxt.k0 * 2 : cA; const char* nB = has_next ? (const char*)g.Bt + (size_t)nxt.pn * tstep + (size_t)nxt.k0 * 2 : cB;
        for (int t = 0; t < nt; t += 2) {
            if constexpr (Epi::KHOOK) { if (t == 8 || t == 16) E.khook(acc, cur, t, wr, fr); }
            const bool last = (t == nt - 2);
            const char* a1 = cA + (size_t)(t + 1) * kstep;
            const char* a2 = last ? nA : cA + (size_t)(t + 2) * kstep; const char* b2 = last ? nB : cB + (size_t)(t + 2) * kstep;
            const char* a3 = a2 + kstep; const char* b3 = b2 + kstep;
            if (last && has_next) S.a_ready(nxt);
            if constexpr (SP2) {
            PG8_LDB(B0, 0, 0); PG8_LDB(B1, 0, 1); PG8_SCHED; PG8_LDA(At, 0, 0); PG8_STAGE(PG8_SA(1, 1), a1 + hstep, voffA);
            PG8_WAIT_V(8); PG8_WAIT_L(0); PG8_BAR; PG8_MMA(0, 0, At, B0); PG8_MMA(0, 1, At, B1); PG8_BAR; PG8_SCHED;
            PG8_LDA(At, 0, 1); PG8_STAGE(PG8_SB(0, 0), b2, voffB); PG8_STAGE(PG8_SB(0, 1), b2 + hstep, voffB); PG8_STAGE(PG8_SA(0, 0), a2, voffA);
            PG8_WAIT_V(8); PG8_WAIT_L(0); PG8_BAR; PG8_MMA(1, 0, At, B0); PG8_MMA(1, 1, At, B1); PG8_BAR; PG8_SCHED;
            PG8_LDB(B0, 1, 0); PG8_LDB(B1, 1, 1); PG8_SCHED; PG8_LDA(At, 1, 0); PG8_STAGE(PG8_SA(0, 1), a2 + hstep, voffA);
            PG8_WAIT_V(8); PG8_WAIT_L(0); PG8_BAR; PG8_MMA(0, 0, At, B0); PG8_MMA(0, 1, At, B1); PG8_BAR; PG8_SCHED;
            PG8_LDA(At, 1, 1); PG8_STAGE(PG8_SB(1, 0), b3, voffB); PG8_STAGE(PG8_SB(1, 1), b3 + hstep, voffB); PG8_STAGE(PG8_SA(1, 0), a3, voffA);
            PG8_WAIT_V(8); PG8_WAIT_L(0); PG8_BAR; PG8_MMA(1, 0, At, B0); PG8_MMA(1, 1, At, B1); PG8_BAR; PG8_SCHED;
            } else {
            PG8_LDB(B0, 0, 0); PG8_SCHED; PG8_LDA(At, 0, 0); PG8_STAGE(PG8_SA(1, 1), a1 + hstep, voffA);
            PG8_WAIT_L(8); PG8_BAR; PG8_WAIT_L(0); PG8_MMA(0, 0, At, B0); PG8_BAR; PG8_SCHED;
            PG8_LDB(B1, 0, 1); PG8_STAGE(PG8_SB(0, 0), b2, voffB);
            PG8_BAR; PG8_WAIT_L(0); PG8_MMA(0, 1, At, B1); PG8_BAR;
            PG8_LDA(At, 0, 1); PG8_STAGE(PG8_SA(0, 0), a2, voffA);
            PG8_BAR; PG8_WAIT_L(0); PG8_MMA(1, 0, At, B0); PG8_BAR; PG8_SCHED;
            PG8_STAGE(PG8_SB(0, 1), b2 + hstep, voffB);
            PG8_WAIT_V(6); PG8_BAR; PG8_MMA(1, 1, At, B1); PG8_BAR;
            PG8_LDB(B0, 1, 0); PG8_SCHED; PG8_LDA(At, 1, 0); PG8_STAGE(PG8_SA(0, 1), a2 + hstep, voffA);
            PG8_WAIT_L(8); PG8_BAR; PG8_WAIT_L(0); PG8_MMA(0, 0, At, B0); PG8_BAR; PG8_SCHED;
            PG8_LDB(B1, 1, 1); PG8_STAGE(PG8_SB(1, 0), b3, voffB);
            PG8_BAR; PG8_WAIT_L(0); PG8_MMA(0, 1, At, B1); PG8_BAR;
            PG8_LDA(At, 1, 1); PG8_STAGE(PG8_SA(1, 0), a3, voffA);
            PG8_BAR; PG8_WAIT_L(0); PG8_MMA(1, 0, At, B0); PG8_BAR; PG8_SCHED;
            PG8_STAGE(PG8_SB(1, 1), b3 + hstep, voffB);
            PG8_WAIT_V(6); PG8_BAR; PG8_MMA(1, 1, At, B1); PG8_BAR;
            }
        }
        if constexpr (ALIGN_EPI) { if (wr == 0) PG8_BAR; }
        if constexpr (!Epi::AFTER_DRAIN) { E(acc, cur, wr, wc, fr, fq); S.done(cur); }
        if (!has_next) break;
#pragma unroll
        for (int a = 0; a < 2; ++a)
#pragma unroll
            for (int b = 0; b < 2; ++b)
#pragma unroll
                for (int m = 0; m < 4; ++m)
#pragma unroll
                    for (int n = 0; n < 2; ++n) acc[a][b][m][n] = (f32x4){0.f, 0.f, 0.f, 0.f};
        cur = nxt; cA = nA; cB = nB; ++ui;
        if constexpr (ALIGN_EPI) { if (wr == 1) PG8_BAR; }
    }
    PG8_WAIT_V(0);
    if constexpr (!ALIGN_EPI) { if (wr == 0) PG8_BAR; }
    PG8_BAR;
    if constexpr (Epi::AFTER_DRAIN) { E.fused(acc, cur, wr, wc, fr, fq, lds, wid, lane); S.done(cur); }
#undef PG8_SA
#undef PG8_SB
#undef PG8_STAGE
#undef PG8_LDA
#undef PG8_LDB
#undef PG8_MMA
#undef PG8_WAIT_V
#undef PG8_WAIT_L
#undef PG8_BAR
#undef PG8_SCHED
}
}
#include <hip/hip_bf16.h>
#include <cmath>
namespace attn_body {
using bf16=__hip_bfloat16;
using bf16x8=__attribute__((ext_vector_type(8)))short;
using s16x4=__attribute__((ext_vector_type(4)))short;
using f32x16=__attribute__((ext_vector_type(16)))float;
using u32x4=__attribute__((ext_vector_type(4)))unsigned;
constexpr int BATCH=8,NHEAD=8,SEQ=8192,D=64,DM=NHEAD*D,OP=1536;
constexpr int NW=8,QBLK=32,QB=QBLK*NW,KVBLK=64,NQB=SEQ/QB;
constexpr int ATTN_PITCH=DM, ATTN_UNIT_ROWS=QB;
__device__ __forceinline__ int crow(int r,int hi){return (r&3)+8*(r>>2)+4*hi;}
#define SBAR() __builtin_amdgcn_sched_barrier(0)
__device__ __forceinline__ void cmask(f32x16&p0,f32x16&p1,int jb,int qrel,int hi){
  const float NEG=-INFINITY; int kb=64*jb+4*hi;
  #pragma unroll
  for(int r=0;r<16;++r){int kv=kb+(r&3)+8*(r>>2); if(kv>qrel)p0[r]=NEG; if(kv+32>qrel)p1[r]=NEG;}
}

constexpr int NSLOT=3, SLOTB=8192;
constexpr int LDS_K=0, LDS_V=NSLOT*SLOTB, LDS_WS=2*NSLOT*SLOTB, LDS_OST=LDS_WS+NW*64*4, LDS_C=LDS_OST+NW*4096, LDS_BYTES=LDS_C+SEQ*4;
constexpr float SKIP_L2=64.0f*1.4426950408889634f;
constexpr float C2=0.125f*1.4426950408889634f;
__device__ __forceinline__ void glds16(const void*gsrc,unsigned lds_dst){unsigned keep;
  asm volatile("s_mov_b32 %0, m0\n\ts_mov_b32 m0, %2\n\ts_nop 0\n\tglobal_load_lds_dwordx4 %1, off\n\ts_mov_b32 m0, %0":"=&s"(keep):"v"(gsrc),"s"(lds_dst):"memory");}
__device__ __forceinline__ float max3f(float a,float b,float c){float r;asm("v_max3_f32 %0, %1, %2, %3":"=v"(r):"v"(a),"v"(b),"v"(c));return r;}
__device__ __forceinline__ float max2f(float a,float b){float r;asm("v_max_f32_e32 %0, %1, %2":"=v"(r):"v"(a),"v"(b));return r;}
__device__ __forceinline__ float fadd_s(float a,float b){float r;asm("v_add_f32_e32 %0, %1, %2":"=v"(r):"v"(a),"v"(b));return r;}
__device__ __forceinline__ float fsub_s(float a,float b){float r;asm("v_sub_f32_e32 %0, %1, %2":"=v"(r):"v"(a),"v"(b));return r;}
typedef float f32x2_t __attribute__((ext_vector_type(2))); typedef __bf16 bf16x2_t __attribute__((ext_vector_type(2)));
__device__ __forceinline__ unsigned cvtpk_s(float lo,float hi){f32x2_t v={lo,hi};bf16x2_t b=__builtin_convertvector(v,bf16x2_t);return __builtin_bit_cast(unsigned,b);}
#define WAIT_BAR(N) asm volatile("s_waitcnt vmcnt(" #N ") lgkmcnt(0)\n\ts_barrier":::"memory")

__device__ __forceinline__ void qkt(f32x16&p0,f32x16&p1,const char*Kslot,const bf16x8*qr,const f32x16&cin0,const f32x16&cin1,int r32,int hi){
  const char*kb=Kslot+hi*1024+r32*16;
  #pragma unroll
  for(int d0=0;d0<4;++d0){
    const bf16x8 b0=*reinterpret_cast<const bf16x8*>(kb+d0*2048);
    const bf16x8 b1=*reinterpret_cast<const bf16x8*>(kb+d0*2048+512);
    if(d0==0){p0=__builtin_amdgcn_mfma_f32_32x32x16_bf16(b0,qr[0],cin0,0,0,0);p1=__builtin_amdgcn_mfma_f32_32x32x16_bf16(b1,qr[0],cin1,0,0,0);}
    else{p0=__builtin_amdgcn_mfma_f32_32x32x16_bf16(b0,qr[d0],p0,0,0,0);p1=__builtin_amdgcn_mfma_f32_32x32x16_bf16(b1,qr[d0],p1,0,0,0);}}
}
typedef __attribute__((address_space(3))) const char* lds_cptr;
typedef short v4i16_t __attribute__((ext_vector_type(4)));
__device__ __forceinline__ void kload8(bf16x8*kf,lds_cptr kp){
  kf[0]=*(const __attribute__((address_space(3))) bf16x8*)(kp);      kf[1]=*(const __attribute__((address_space(3))) bf16x8*)(kp+512);
  kf[2]=*(const __attribute__((address_space(3))) bf16x8*)(kp+2048); kf[3]=*(const __attribute__((address_space(3))) bf16x8*)(kp+2560);
  kf[4]=*(const __attribute__((address_space(3))) bf16x8*)(kp+4096); kf[5]=*(const __attribute__((address_space(3))) bf16x8*)(kp+4608);
  kf[6]=*(const __attribute__((address_space(3))) bf16x8*)(kp+6144); kf[7]=*(const __attribute__((address_space(3))) bf16x8*)(kp+6656);
}
__device__ __forceinline__ void kload2(bf16x8*kf,lds_cptr kp,int j){ kf[2*j]=*(const __attribute__((address_space(3))) bf16x8*)(kp+j*2048); kf[2*j+1]=*(const __attribute__((address_space(3))) bf16x8*)(kp+j*2048+512); }
__device__ __forceinline__ s16x4 vtr(lds_cptr p){ return __builtin_bit_cast(s16x4,__builtin_amdgcn_ds_read_tr16_b64_v4i16((__attribute__((address_space(3))) v4i16_t*)p)); }
__device__ __forceinline__ float rowmax(const f32x16&p0,const f32x16&p1){
  float a=max3f(p0[0],p0[1],p1[0]),b=max3f(p0[2],p0[3],p1[1]);a=max3f(a,p1[2],p1[3]);
  #pragma unroll
  for(int r=4;r<16;r+=4){a=max3f(a,p0[r],p0[r+1]);b=max3f(b,p0[r+2],p0[r+3]);a=max3f(a,p1[r],p1[r+1]);b=max3f(b,p1[r+2],p1[r+3]);}
  const float m=max2f(a,b);
  auto rr=__builtin_amdgcn_permlane32_swap(__float_as_uint(m),__float_as_uint(m),false,false);
  return max2f(__uint_as_float(rr[0]),__uint_as_float(rr[1]));
}
__device__ __forceinline__ void pv(f32x16*o,int vb,bf16x8 pa0,bf16x8 pa1,bf16x8 pa2,bf16x8 pa3){
  #pragma unroll
  for(int d0=0;d0<2;++d0){s16x4 lo[4],hi[4];
    #pragma unroll
    for(int ks=0;ks<4;++ks){
      asm volatile("ds_read_b64_tr_b16 %0,%1 offset:%c2":"=&v"(lo[ks]):"v"(vb),"i"(d0*4096+ks*1024):"memory");
      asm volatile("ds_read_b64_tr_b16 %0,%1 offset:%c2":"=&v"(hi[ks]):"v"(vb),"i"(d0*4096+ks*1024+512):"memory");}
    asm volatile("s_waitcnt lgkmcnt(0)":::"memory");SBAR();
    #define PK(k) (bf16x8){lo[k][0],lo[k][1],lo[k][2],lo[k][3],hi[k][0],hi[k][1],hi[k][2],hi[k][3]}
    o[d0]=__builtin_amdgcn_mfma_f32_32x32x16_bf16(pa0,PK(0),o[d0],0,0,0);
    o[d0]=__builtin_amdgcn_mfma_f32_32x32x16_bf16(pa1,PK(1),o[d0],0,0,0);
    o[d0]=__builtin_amdgcn_mfma_f32_32x32x16_bf16(pa2,PK(2),o[d0],0,0,0);
    o[d0]=__builtin_amdgcn_mfma_f32_32x32x16_bf16(pa3,PK(3),o[d0],0,0,0);
    #undef PK
  }
}

#ifndef ATTN_STORE16
#define ATTN_STORE16(p,v) (*(u32x4*)(p)=(v))
#endif
template<int THRL> __device__ __forceinline__ void attn_unit(int b,int h,int qb,const bf16*Q,const bf16*__restrict__ K,const bf16*__restrict__ V,bf16*O,const float*__restrict__ CPL,float skipl2,char*shm){
  int tid_=threadIdx.x; asm volatile("":"+v"(tid_)); const int tid=tid_,lane=tid&63,r32=lane&31,hi=lane>>5; const int wid=__builtin_amdgcn_readfirstlane(tid>>6);
  const long rowbase=(long)b*SEQ; const int q0=qb*QB;
  const bf16*Qw=Q+(rowbase+q0+wid*QBLK)*DM+h*D;
  const float*cg=CPL+((long)(b*NHEAD+h))*SEQ; const int NTF=(q0+QB)/KVBLK; int tst;
  { const float c0=cg[q0]; const int t1=lane,t2=lane+64;
    const bool s1=(t1<NTF-4)&&((c0-cg[64*t1+63])<-skipl2), s2=(t2<NTF-4)&&((c0-cg[64*t2+63])<-skipl2);
    tst=(__builtin_popcountll(__ballot(s1))+__builtin_popcountll(__ballot(s2)))&~1; tst=__builtin_amdgcn_readfirstlane(tst); }
  const bf16*Kh=K+(rowbase+(long)tst*KVBLK)*DM+h*D,*Vh=V+(rowbase+(long)tst*KVBLK)*DM+h*D;
  const unsigned lds0=(unsigned)(uintptr_t)shm;
  float*wsf=(float*)(shm+LDS_WS)+wid*64;
  const bf16*ksrc=Kh+(long)lane*DM+wid*8;
  const bf16*vsrc=Vh+(long)(16*(wid&3)+(lane>>2))*DM+(wid>>2)*32+(lane&3)*8;
  const unsigned kdst=lds0+LDS_K+wid*1024, vdst=lds0+LDS_V+wid*1024;
  #define DMA_K(t,slot) glds16(ksrc+(long)(t)*KVBLK*DM,(unsigned)__builtin_amdgcn_readfirstlane(kdst+(slot)))
  #define DMA_V(t,slot) glds16(vsrc+(long)(t)*KVBLK*DM,(unsigned)__builtin_amdgcn_readfirstlane(vdst+(slot)))
  const int vb0=(int)(lds0+LDS_V)+((lane>>4)&1)*32+(lane&3)*8+(4*hi+((lane&15)>>2))*64;
  const char*Kbase=shm+LDS_K; bf16x8 kf[8];
  const lds_cptr shm3=(lds_cptr)shm; const lds_cptr kp0=shm3+LDS_K+hi*1024+r32*16; const lds_cptr vp0=shm3+LDS_V+((lane>>4)&1)*32+(lane&3)*8+(4*hi+((lane&15)>>2))*64;
  const int NT=NTF-tst;
  float*cL=(float*)(shm+LDS_C);
  for(int i=tid;i<NT*KVBLK/4;i+=NW*64){ *(float4*)(cL+4*i)=*(const float4*)(cg+tst*KVBLK+4*i); }
  const float cq=cg[q0+wid*QBLK+r32]; float qm=cq;
  asm volatile("s_waitcnt vmcnt(0) lgkmcnt(0)":::"memory");
  DMA_K(0,0);DMA_V(0,0);DMA_K(1,SLOTB);
  bf16x8 qr[4];
  #pragma unroll
  for(int d0=0;d0<4;++d0)qr[d0]=*reinterpret_cast<const bf16x8*>(&Qw[(long)r32*DM+d0*16+hi*8]);
  float mhat=0.f,l_reg=0.f;f32x16 o[2];o[0]=f32x16{};o[1]=f32x16{};f32x16 cb0,cb1;
  const int qrel=wid*QBLK+r32;
  #define CBIAS(t) do{ const float*cp_=cL+(t)*KVBLK+4*hi; \
    _Pragma("unroll") for(int i_=0;i_<4;++i_){ const float4 u0_=*(const float4*)(cp_+8*i_), u1_=*(const float4*)(cp_+32+8*i_); \
      cb0[4*i_]=qm-u0_.x;cb0[4*i_+1]=qm-u0_.y;cb0[4*i_+2]=qm-u0_.z;cb0[4*i_+3]=qm-u0_.w; \
      cb1[4*i_]=qm-u1_.x;cb1[4*i_+1]=qm-u1_.y;cb1[4*i_+2]=qm-u1_.z;cb1[4*i_+3]=qm-u1_.w; } }while(0)
  #define CMASK(P0,P1,t) do{int jb_=(t)-(NT-4); if(jb_>=0)cmask(P0,P1,jb_,qrel,hi);}while(0)
  bool resc=false;
  #define START(P0,P1) do{ const float rm=rowmax(P0,P1); resc=false; \
    { const float dl=rm; mhat=fadd_s(mhat,dl); \
      _Pragma("unroll") for(int r=0;r<16;++r){P0[r]=fsub_s(P0[r],dl);P1[r]=fsub_s(P1[r],dl);} \
      qm=cq-mhat; } \
    _Pragma("unroll") for(int r=0;r<16;++r)P0[r]=__builtin_amdgcn_exp2f(P0[r]); }while(0)
  #define RESC() do{ if(resc){ asm volatile("s_waitcnt lgkmcnt(0)":::"memory"); \
      _Pragma("unroll") for(int d_=0;d_<2;++d_) _Pragma("unroll") for(int r=0;r<16;++r)o[d_][r]*=wsf[crow(r,hi)]; } }while(0)
  f32x16 pA0,pA1,pB0,pB1;
  int sl_prev=0,sl_cur=0,sl_next=SLOTB;
  #define ROT() do{sl_prev=sl_cur;sl_cur=sl_next;sl_next=(sl_next==(NSLOT-1)*SLOTB)?0:sl_next+SLOTB;}while(0)
  DMA_K(2,2*SLOTB);
  WAIT_BAR(3);
  CBIAS(0); qkt(pA0,pA1,Kbase,qr,cb0,cb1,r32,hi);asm volatile("s_nop 15\n\ts_nop 7":"+v"(pA0),"+v"(pA1));CMASK(pA0,pA1,0);
  START(pA0,pA1);
  _Pragma("unroll") for(int r=0;r<16;++r)pA1[r]=__builtin_amdgcn_exp2f(pA1[r]);
  WAIT_BAR(0);
  DMA_K(3,0);DMA_V(1,SLOTB);
  ROT();
  kload8(kf,kp0+sl_cur);
  WAIT_BAR(2);
  s16x4 vlo[8],vhi[8]; u32x4 pw0,pw1,pw2,pw3;
  #define PKW(P,B) cvtpk_s(P[B],P[B+1])
  #define PAF(k) __builtin_bit_cast(bf16x8,pw##k)
  #define VFR(i) (bf16x8){vlo[i][0],vlo[i][1],vlo[i][2],vlo[i][3],vhi[i][0],vhi[i][1],vhi[i][2],vhi[i][3]}
  #define PIN(x) asm volatile("":"+v"(x))
  #define MX3(a,b,c) __builtin_fmaxf(__builtin_fmaxf((a),(b)),(c))
  #define GAPA(MF,A0,A1,A2,A3,W0,W1,PW) do{ MF; sacc+=A0; sacc+=A1; sacc+=A2; sacc+=A3; PIN(sacc); W0; W1; PIN(PW); SBAR(); }while(0)
  #define EX(v) __builtin_amdgcn_exp2f(v)
  #define GAPB(MF,X,B) do{ MF; X[B]=EX(X[B]); X[B+1]=EX(X[B+1]); X[B+2]=EX(X[B+2]); X[B+3]=EX(X[B+3]); PIN(X); SBAR(); }while(0)
  #define VRD(i) do{ vlo[i]=vtr(vp_+(((i)>>2)*4096+((i)&3)*1024)); vhi[i]=vtr(vp_+(((i)>>2)*4096+((i)&3)*1024+512)); }while(0)
  #define KRD(G,j) do{ if(G){ kload2(kf,kp0+sl_next,j); SBAR(); } }while(0)
  #define STEP(C0,C1,P0,P1,t,GK,GV,GL) do{ SBAR(); CBIAS(t); SBAR(); \
    const lds_cptr vp_=vp0+sl_prev; \
    VRD(0); SBAR(); float sacc=(P0[0]+P0[1]); \
    GAPA(C0=__builtin_amdgcn_mfma_f32_32x32x16_bf16(kf[0],qr[0],cb0,0,0,0), P0[2],P0[3],P0[4],P0[5],     pw0[0]=PKW(P0,0), pw0[1]=PKW(P0,2), pw0); \
    VRD(4); SBAR(); GAPA(C1=__builtin_amdgcn_mfma_f32_32x32x16_bf16(kf[1],qr[0],cb1,0,0,0), P0[6],P0[7],P0[8],P0[9],     pw0[2]=PKW(P0,4), pw0[3]=PKW(P0,6), pw0); \
    VRD(1); SBAR(); GAPA(C0=__builtin_amdgcn_mfma_f32_32x32x16_bf16(kf[2],qr[1],C0,0,0,0),   P0[10],P0[11],P0[12],P0[13], pw1[0]=PKW(P0,8), pw1[1]=PKW(P0,10), pw1); \
    VRD(5); SBAR(); GAPA(C1=__builtin_amdgcn_mfma_f32_32x32x16_bf16(kf[3],qr[1],C1,0,0,0),   P0[14],P0[15],P1[0],P1[1],   pw1[2]=PKW(P0,12),pw1[3]=PKW(P0,14), pw1); \
    VRD(2); SBAR(); GAPA(C0=__builtin_amdgcn_mfma_f32_32x32x16_bf16(kf[4],qr[2],C0,0,0,0),   P1[2],P1[3],P1[4],P1[5],     pw2[0]=PKW(P1,0), pw2[1]=PKW(P1,2), pw2); \
    VRD(6); SBAR(); GAPA(C1=__builtin_amdgcn_mfma_f32_32x32x16_bf16(kf[5],qr[2],C1,0,0,0),   P1[6],P1[7],P1[8],P1[9],     pw2[2]=PKW(P1,4), pw2[3]=PKW(P1,6), pw2); \
    VRD(3); SBAR(); GAPA(C0=__builtin_amdgcn_mfma_f32_32x32x16_bf16(kf[6],qr[3],C0,0,0,0),   P1[10],P1[11],P1[12],P1[13], pw3[0]=PKW(P1,8), pw3[1]=PKW(P1,10), pw3); \
    VRD(7); SBAR(); GAPA(C1=__builtin_amdgcn_mfma_f32_32x32x16_bf16(kf[7],qr[3],C1,0,0,0),   P1[14],P1[15],0.f,0.f,       pw3[2]=PKW(P1,12),pw3[3]=PKW(P1,14), pw3); \
    l_reg+=sacc; \
    if(GK){DMA_K((t)+3,sl_cur);} if(GV){DMA_V((t)+1,sl_next);} \
    CMASK(C0,C1,t); \
    { float a=MX3(C0[0],C0[1],C1[0]),b=MX3(C0[2],C0[3],C1[1]); a=MX3(a,C1[2],C1[3]); \
      _Pragma("unroll") for(int r=4;r<16;r+=4){a=MX3(a,C0[r],C0[r+1]);b=MX3(b,C0[r+2],C0[r+3]);a=MX3(a,C1[r],C1[r+1]);b=MX3(b,C1[r+2],C1[r+3]);} \
      float rm=__builtin_fmaxf(a,b); { auto rr=__builtin_amdgcn_permlane32_swap(__float_as_uint(rm),__float_as_uint(rm),false,false); rm=__builtin_fmaxf(__uint_as_float(rr[0]),__uint_as_float(rr[1])); } \
      resc=false; \
      if(__builtin_expect(__any(rm>(float)THRL),0)){ const float dl=__builtin_fmaxf(rm,0.f); mhat+=dl; \
        _Pragma("unroll") for(int r=0;r<16;++r){C0[r]-=dl;C1[r]-=dl;} \
        qm=cq-mhat; \
        const float f=__builtin_amdgcn_exp2f(-dl); l_reg*=f; if(hi==0)wsf[r32]=f; resc=true; } } \
    SBAR(); \
    GAPB(o[0]=__builtin_amdgcn_mfma_f32_32x32x16_bf16(PAF(0),VFR(0),o[0],0,0,0), C0,0); \
    GAPB(o[1]=__builtin_amdgcn_mfma_f32_32x32x16_bf16(PAF(0),VFR(4),o[1],0,0,0), C0,4); \
    KRD(GL,0); GAPB(o[0]=__builtin_amdgcn_mfma_f32_32x32x16_bf16(PAF(1),VFR(1),o[0],0,0,0), C0,8); \
    KRD(GL,1); GAPB(o[1]=__builtin_amdgcn_mfma_f32_32x32x16_bf16(PAF(1),VFR(5),o[1],0,0,0), C0,12); \
    KRD(GL,2); GAPB(o[0]=__builtin_amdgcn_mfma_f32_32x32x16_bf16(PAF(2),VFR(2),o[0],0,0,0), C1,0); \
    KRD(GL,3); GAPB(o[1]=__builtin_amdgcn_mfma_f32_32x32x16_bf16(PAF(2),VFR(6),o[1],0,0,0), C1,4); \
    GAPB(o[0]=__builtin_amdgcn_mfma_f32_32x32x16_bf16(PAF(3),VFR(3),o[0],0,0,0), C1,8); \
    GAPB(o[1]=__builtin_amdgcn_mfma_f32_32x32x16_bf16(PAF(3),VFR(7),o[1],0,0,0), C1,12); \
    }while(0)
  int t=1;
  #undef CMASK
  #define CMASK(P0,P1,t) do{}while(0)
  for(;t+5<NT;t+=2){
    STEP(pB0,pB1,pA0,pA1,t,true,true,true);     WAIT_BAR(2); RESC(); ROT();
    STEP(pA0,pA1,pB0,pB1,t+1,true,true,true);   WAIT_BAR(2); RESC(); ROT();
  }
  #undef CMASK
  #define CMASK(P0,P1,t) do{int jb_=(t)-(NT-4); if(jb_>=0)cmask(P0,P1,jb_,qrel,hi);}while(0)
  #define ENDW(tt) do{ if((tt)+3<NT){WAIT_BAR(2);} else if((tt)+2<NT){WAIT_BAR(1);} else {WAIT_BAR(0);} }while(0)
  for(;t+1<NT;t+=2){
    STEP(pB0,pB1,pA0,pA1,t,(t+3<NT),(t+1<NT),(t+1<NT));       ENDW(t);   RESC(); ROT();
    STEP(pA0,pA1,pB0,pB1,t+1,(t+4<NT),(t+2<NT),(t+2<NT));     ENDW(t+1); RESC(); ROT();
  }
  STEP(pB0,pB1,pA0,pA1,NT-1,false,false,false); RESC();
  { float sacc=pB0[0]+pB0[1]; _Pragma("unroll") for(int r=2;r<16;++r)sacc+=pB0[r]; _Pragma("unroll") for(int r=0;r<16;++r)sacc+=pB1[r]; l_reg+=sacc;
    pw0=(u32x4){PKW(pB0,0),PKW(pB0,2),PKW(pB0,4),PKW(pB0,6)};pw1=(u32x4){PKW(pB0,8),PKW(pB0,10),PKW(pB0,12),PKW(pB0,14)};pw2=(u32x4){PKW(pB1,0),PKW(pB1,2),PKW(pB1,4),PKW(pB1,6)};pw3=(u32x4){PKW(pB1,8),PKW(pB1,10),PKW(pB1,12),PKW(pB1,14)};
    SBAR(); pv(o,vb0+sl_cur,PAF(0),PAF(1),PAF(2),PAF(3)); }
  #undef PKW
  #undef PAF
  #undef VFR
  #undef PIN
  #undef MX3
  #undef GAPA
  #undef GAPB
  #undef EX
  #undef VRD
  #undef KRD
  #undef STEP
  #undef ENDW
  {auto rr=__builtin_amdgcn_permlane32_swap(__float_as_uint(l_reg),__float_as_uint(l_reg),false,false);l_reg=__uint_as_float(rr[0])+__uint_as_float(rr[1]);}
  if(hi==0)wsf[32+r32]=l_reg;asm volatile("s_waitcnt lgkmcnt(0)":::"memory");
  float rli[16];
  #pragma unroll
  for(int r=0;r<16;++r)rli[r]=__builtin_amdgcn_rcpf(wsf[32+crow(r,hi)]);
  bf16*Ow=O+(rowbase+q0+wid*QBLK)*OP+h*D;
  { bf16*stg=(bf16*)(shm+LDS_OST)+wid*2048;
    #pragma unroll
    for(int r=0;r<16;++r){const int orow=crow(r,hi);
      #pragma unroll
      for(int d0=0;d0<2;++d0)stg[orow*64+d0*32+r32]=__float2bfloat16(o[d0][r]*rli[r]);}
    asm volatile("s_waitcnt lgkmcnt(0)":::"memory");
    #pragma unroll
    for(int i=0;i<4;++i){const int row=i*8+(lane>>3),ch=lane&7; const u32x4 v=*(const u32x4*)(stg+row*64+ch*8); ATTN_STORE16(Ow+(long)row*OP+ch*8,v);} }
  asm volatile("s_waitcnt lgkmcnt(0)\n\ts_barrier":::"memory");
  #undef DMA_K
  #undef DMA_V
  #undef CMASK
  #undef START
  #undef RESC
  #undef ROT
  #undef CBIAS
}
constexpr int ATTN_LDS_BYTES=LDS_BYTES;
#undef SBAR
#undef WAIT_BAR
}

namespace ssd {
constexpr int SSD_BLK = 1024, SSD_NBLK = PSEQ / SSD_BLK;
constexpr int BP = 136, TP = 72, CBP = 68, SP = 136;
constexpr int L_BC = 0, L_CC = 17408, L_BT = 34816, L_CB = 53248, L_ACS = 70656, L_DT = 71680, L_ST = 72704, ST_BYTES = 8704, L_RS = L_ST + 8 * ST_BYTES, L_END = L_RS + 2048;
struct Ptrs { const bf16_t* XBC; const bf16_t* Zs; const float* DT; const float* conv_w; const float* conv_b; const float* A_log; const float* D_skip;
              const float* state_conv; const float* state_ssm; float* SL; float* dAtot; float* GSS; bf16_t* Mix; float* out; };
#define MFMA32(a, b, c) __builtin_amdgcn_mfma_f32_32x32x16_bf16((a), (b), (c), 0, 0, 0)
#define LDSFENCE() asm volatile("s_waitcnt lgkmcnt(0)" ::: "memory")

template <int MODE> __device__ __forceinline__ void unit(const Ptrs& P, unsigned char* lds, int b, int blk, int hq) {
    int tid_ = threadIdx.x; asm volatile("" : "+v"(tid_));
    const int tid = tid_, lane = tid & 63, wid = __builtin_amdgcn_readfirstlane(tid >> 6), r32 = lane & 31, hi = lane >> 5;
    const int g = hq >> 1, hl = wid >> 1, ph = wid & 1, h = hq * 4 + hl;
    constexpr int NSUB = (MODE == 2) ? 1 : SSD_BLK / 64;
    constexpr int nvalid = (MODE == 2) ? 16 : SSD_BLK;
    const int row0 = (MODE == 2) ? MP + b * 16 : b * PSEQ + blk * SSD_BLK;
    bf16_t* Bc = (bf16_t*)(lds + L_BC); bf16_t* Cc = (bf16_t*)(lds + L_CC); bf16_t* BT = (bf16_t*)(lds + L_BT); float* CB = (float*)(lds + L_CB);
    float* rsL = (float*)(lds + L_RS); float* acsL = (float*)(lds + L_ACS); float* dtL = (float*)(lds + L_DT); bf16_t* St = (bf16_t*)(lds + L_ST + wid * ST_BYTES);
    const int xcol = h * 64 + ph * 32 + r32;
    const int cp = tid & 127, seg = tid >> 7, ch = 2 * cp; const int scol = (ch < 128) ? 1024 + 128 * g + ch : 1280 + 128 * g + (ch - 128);
    const float Asc = -__expf(P.A_log[hq * 4 + (wid & 3)]);
    const float Dh = P.D_skip[h];
    f32x16 st[4];
    if (MODE == 0) {
#pragma unroll
        for (int nb = 0; nb < 4; ++nb) st[nb] = f32x16{};
    } else if (MODE == 1) {
        const float* sp = P.SL + ((size_t)((b * SSD_NBLK + blk) * 16 + h)) * 8192 + (size_t)(ph * 4) * 1024 + lane;
#pragma unroll
        for (int nb = 0; nb < 4; ++nb)
#pragma unroll
            for (int r = 0; r < 16; ++r) st[nb][r] = sp[(nb * 16 + r) * 64];
    } else {
        const float* sp = P.state_ssm + ((size_t)(b * 16 + h) * 64 + ph * 32 + r32) * 128 + 4 * hi;
#pragma unroll
        for (int nb = 0; nb < 4; ++nb)
#pragma unroll
            for (int q4 = 0; q4 < 4; ++q4) { const f32x4 v = *(const f32x4*)(sp + 32 * nb + 8 * q4); st[nb][4 * q4] = v[0]; st[nb][4 * q4 + 1] = v[1]; st[nb][4 * q4 + 2] = v[2]; st[nb][4 * q4 + 3] = v[3]; }
    }
    float dasum = 0.f;
    unsigned uu[16]; float dtn = 0.f;
    auto load_stage = [&](int tbn) {
        if (MODE != 0 || ch < 128) { const int t0 = tbn + 16 * seg; const bf16_t* sp = P.XBC + (unsigned)((row0 + t0) * DCONV + scol);
#pragma unroll
            for (int i = 0; i < 16; ++i) { uu[i] = *(const unsigned*)(sp + i * DCONV); if (MODE == 2) { asm volatile("" : "+v"(uu[i])); if (t0 + i >= nvalid) uu[i] = 0u; } } }
        if (wid < 4) { const int t = tbn + lane; dtn = (t < nvalid) ? P.DT[(unsigned)((row0 + t) * 16 + hq * 4 + wid)] : 0.f; }
    };
    if (MODE == 0) load_stage(0);
#pragma unroll 1
    for (int sc = 0; sc < NSUB; ++sc) {
        const int tb = 64 * sc;
        unsigned xvp[4][4];
        {
            const bf16_t* xp = P.XBC + (unsigned)((row0 + tb + 8 * hi) * DCONV + xcol);
#pragma unroll
            for (int ks = 0; ks < 4; ++ks)
#pragma unroll
                for (int i = 0; i < 4; ++i) { unsigned lo = xp[(16 * ks + 2 * i) * DCONV], hi16 = xp[(16 * ks + 2 * i + 1) * DCONV];
                    if (MODE == 2) { asm volatile("" : "+v"(lo), "+v"(hi16));     if (tb + 16 * ks + 8 * hi + 2 * i >= nvalid) lo = 0u; if (tb + 16 * ks + 8 * hi + 2 * i + 1 >= nvalid) hi16 = 0u; }
                    xvp[ks][i] = lo | (hi16 << 16); }
        }
        if (MODE != 0) load_stage(tb);
        if (MODE != 0 || ch < 128) {
            bf16_t* nat = ((ch < 128) ? Bc : Cc) + (ch & 127);
#pragma unroll
            for (int i = 0; i < 16; ++i) *(unsigned*)(nat + (16 * seg + i) * BP) = uu[i];
            if (ch < 128) {
                unsigned bt0[8], bt1[8];
#pragma unroll
                for (int i = 0; i < 8; ++i) { bt0[i] = (uu[2 * i] & 0xffffu) | (uu[2 * i + 1] << 16); bt1[i] = (uu[2 * i] >> 16) | (uu[2 * i + 1] & 0xffff0000u); }
                *(u32x4*)(BT + ch * TP + 16 * seg) = (u32x4){bt0[0], bt0[1], bt0[2], bt0[3]}; *(u32x4*)(BT + ch * TP + 16 * seg + 8) = (u32x4){bt0[4], bt0[5], bt0[6], bt0[7]};
                *(u32x4*)(BT + (ch + 1) * TP + 16 * seg) = (u32x4){bt1[0], bt1[1], bt1[2], bt1[3]}; *(u32x4*)(BT + (ch + 1) * TP + 16 * seg + 8) = (u32x4){bt1[4], bt1[5], bt1[6], bt1[7]};
            }
        }
        if (wid < 4) {
            const float dt = dtn;
            float a = dt * Asc;
#pragma unroll
            for (int o = 1; o < 64; o <<= 1) { const float v = __shfl_up(a, o); if (lane >= o) a += v; }
            acsL[wid * 64 + lane] = a; dtL[wid * 64 + lane] = dt; dasum += __shfl(a, 63);
        }
#define XV(ks, j) (((j) & 1) ? __uint_as_float(xvp[ks][(j) >> 1] & 0xffff0000u) : __uint_as_float(xvp[ks][(j) >> 1] << 16))
        __syncthreads();
        if (MODE != 0) {
            if (wid < 3) { const int lb = wid > 0 ? 1 : 0, sb = wid > 1 ? 1 : 0; f32x16 cacc = f32x16{};
#pragma unroll
                for (int ks = 0; ks < 8; ++ks) { const bf16x8 av = *(const bf16x8*)(Cc + (32 * lb + r32) * BP + 16 * ks + 8 * hi), bv = *(const bf16x8*)(Bc + (32 * sb + r32) * BP + 16 * ks + 8 * hi); cacc = MFMA32(av, bv, cacc); }
#pragma unroll
                for (int r = 0; r < 16; ++r) CB[(32 * lb + crow_(r, hi)) * CBP + 32 * sb + r32] = cacc[r]; }
            __syncthreads();
        }
        const float* acsH = acsL + hl * 64; const float* dtH = dtL + hl * 64;
        const float acs_last = acsH[63];
        if (MODE != 0) {
#pragma unroll
            for (int nb = 0; nb < 4; ++nb)
#pragma unroll
                for (int q4 = 0; q4 < 4; ++q4) *(u32x2*)(St + r32 * SP + 32 * nb + 8 * q4 + 4 * hi) = (u32x2){cvtpk(st[nb][4 * q4], st[nb][4 * q4 + 1]), cvtpk(st[nb][4 * q4 + 2], st[nb][4 * q4 + 3])};
            LDSFENCE();
#pragma unroll 1
            for (int lb = 0; lb < 2; ++lb) { if (MODE == 2 && lb == 1) continue;
                f32x16 y = f32x16{};
                unsigned short zr[16];
#pragma unroll
                for (int q4 = 0; q4 < 4; ++q4)
#pragma unroll
                    for (int e = 0; e < 4; ++e) { const int lr = 32 * lb + 8 * q4 + 4 * hi + e; const int row = row0 + tb + lr; zr[4 * q4 + e] = P.Zs[(unsigned)(row * 1024 + xcol)]; }
#pragma unroll
                for (int ks = 0; ks < 8; ++ks) { const bf16x8 av = *(const bf16x8*)(Cc + (32 * lb + r32) * BP + 16 * ks + 8 * hi), bv = *(const bf16x8*)(St + r32 * SP + 16 * ks + 8 * hi); y = MFMA32(av, bv, y); }
#pragma unroll
                for (int q4 = 0; q4 < 4; ++q4) { const f32x4 a4 = *(const f32x4*)(acsH + 32 * lb + 8 * q4 + 4 * hi);
#pragma unroll
                    for (int e = 0; e < 4; ++e) y[4 * q4 + e] *= __expf(a4[e]); }
                const int l = 32 * lb + r32; const float al = acsH[l];
#pragma unroll
                for (int ks = 0; ks < 4; ++ks) { if (ks > 2 * lb + 1) continue;
                    const int s0 = 16 * ks + 8 * hi;
                    const f32x4 c0 = *(const f32x4*)(CB + l * CBP + s0), c1 = *(const f32x4*)(CB + l * CBP + s0 + 4);
                    const f32x4 s4a = *(const f32x4*)(acsH + s0), s4b = *(const f32x4*)(acsH + s0 + 4), d4a = *(const f32x4*)(dtH + s0), d4b = *(const f32x4*)(dtH + s0 + 4);
                    float gg[8], xa[8];
#pragma unroll
                    for (int j = 0; j < 8; ++j) { const float cbv = j < 4 ? c0[j] : c1[j - 4], as = j < 4 ? s4a[j] : s4b[j - 4], dv = j < 4 ? d4a[j] : d4b[j - 4];
                        gg[j] = (s0 + j <= l) ? cbv * __expf(al - as) : 0.f; xa[j] = XV(ks, j) * dv; }
                    const u32x4 gp = {cvtpk(gg[0], gg[1]), cvtpk(gg[2], gg[3]), cvtpk(gg[4], gg[5]), cvtpk(gg[6], gg[7])};
                    const u32x4 xp = {cvtpk(xa[0], xa[1]), cvtpk(xa[2], xa[3]), cvtpk(xa[4], xa[5]), cvtpk(xa[6], xa[7])};
                    y = MFMA32(__builtin_bit_cast(bf16x8, gp), __builtin_bit_cast(bf16x8, xp), y);
                    if (ks >= 2 * lb) { float di[8];
#pragma unroll
                        for (int j = 0; j < 8; ++j) di[j] = (s0 + j == l) ? Dh : 0.f;
                        const u32x4 dp = {cvtpk(di[0], di[1]), cvtpk(di[2], di[3]), cvtpk(di[4], di[5]), cvtpk(di[6], di[7])};
                        const u32x4 xr = {xvp[ks][0], xvp[ks][1], xvp[ks][2], xvp[ks][3]};
                        y = MFMA32(__builtin_bit_cast(bf16x8, dp), __builtin_bit_cast(bf16x8, xr), y); } }
                float s2v[16];
#pragma unroll
                for (int q4 = 0; q4 < 4; ++q4)
#pragma unroll
                    for (int e = 0; e < 4; ++e) { const int r = 4 * q4 + e; const int lr = 32 * lb + 8 * q4 + 4 * hi + e; const int row = row0 + tb + lr;
                        const float yv = y[r] * bf2f(zr[r]);
                        if (MODE != 2 || q4 < 2) P.Mix[(unsigned)(row * DMIX + xcol)] = (bf16_t)(cvtpk(yv, 0.f) & 0xffffu);
                        float s2 = yv * yv;
                        s2 += __shfl_xor(s2, 1); s2 += __shfl_xor(s2, 2); s2 += __shfl_xor(s2, 4); s2 += __shfl_xor(s2, 8); s2 += __shfl_xor(s2, 16);
                        s2v[r] = s2; }
                asm volatile("" ::: "memory");
                if (r32 == 0) {
#pragma unroll
                    for (int q4 = 0; q4 < 4; ++q4)
#pragma unroll
                        for (int e = 0; e < 4; ++e) rsL[wid * 64 + 32 * lb + 8 * q4 + 4 * hi + e] = s2v[4 * q4 + e];
                }
            }
        }
        if (MODE == 0 && sc + 1 < NSUB) load_stage(tb + 64);
        {
            const float dec = __expf(acs_last);
#pragma unroll
            for (int nb = 0; nb < 4; ++nb) st[nb] *= dec;
#pragma unroll
            for (int ks = 0; ks < 4; ++ks) { const int s0 = 16 * ks + 8 * hi;
                const f32x4 s4a = *(const f32x4*)(acsH + s0), s4b = *(const f32x4*)(acsH + s0 + 4), d4a = *(const f32x4*)(dtH + s0), d4b = *(const f32x4*)(dtH + s0 + 4);
                float xb[8];
#pragma unroll
                for (int j = 0; j < 8; ++j) { const float as = j < 4 ? s4a[j] : s4b[j - 4], dv = j < 4 ? d4a[j] : d4b[j - 4]; xb[j] = XV(ks, j) * dv * __expf(acs_last - as); }
                const u32x4 xp = {cvtpk(xb[0], xb[1]), cvtpk(xb[2], xb[3]), cvtpk(xb[4], xb[5]), cvtpk(xb[6], xb[7])};
#pragma unroll
                for (int nb = 0; nb < 4; ++nb) { const bf16x8 av = *(const bf16x8*)(BT + (32 * nb + r32) * TP + 16 * ks + 8 * hi); st[nb] = MFMA32(av, __builtin_bit_cast(bf16x8, xp), st[nb]); } }
        }
        __syncthreads();
        if (MODE != 0) { if (tid < ((MODE == 2) ? 16 : 64)) { float s = 0.f;
#pragma unroll
                for (int w = 0; w < 8; ++w) s += rsL[w * 64 + tid];
                P.GSS[(unsigned)((row0 + tb + tid) * 4 + hq)] = s; } }
    }
    if (MODE == 0) {
        float* sp = P.SL + ((size_t)((b * SSD_NBLK + blk) * 16 + h)) * 8192 + (size_t)(ph * 4) * 1024 + lane;
#pragma unroll
        for (int nb = 0; nb < 4; ++nb)
#pragma unroll
            for (int r = 0; r < 16; ++r) sp[(nb * 16 + r) * 64] = st[nb][r];
        if (wid < 4 && lane == 0) P.dAtot[(b * SSD_NBLK + blk) * 16 + hq * 4 + wid] = dasum;
    } else if (MODE == 2 || blk == SSD_NBLK - 1) {
        float* sp = P.out + (MODE == 2 ? O_SSSM : O_PSSM) + ((size_t)(b * 16 + h) * 64 + ph * 32 + r32) * 128 + 4 * hi;
#pragma unroll
        for (int nb = 0; nb < 4; ++nb)
#pragma unroll
            for (int q4 = 0; q4 < 4; ++q4) *(f32x4*)(sp + 32 * nb + 8 * q4) = (f32x4){st[nb][4 * q4], st[nb][4 * q4 + 1], st[nb][4 * q4 + 2], st[nb][4 * q4 + 3]};
    }
}
#undef XV
}

namespace sattn {
constexpr int L_C = 0, L_M = 16640, L_L = L_M + 512, L_O = L_L + 512, OPITCH = 17, L_SCAN = L_O + 8 * 64 * OPITCH * 4, L_END = L_SCAN + 64;
struct Ptrs { const float* cache_k; const float* cache_v; const float* cache_logf; const bf16_t* Qb; const bf16_t* Kb; const bf16_t* Vb; const float* out; bf16_t* Mix; };
__device__ __forceinline__ void unit(const Ptrs& P, unsigned char* lds, int b, int h) {
    int tid_ = threadIdx.x; asm volatile("" : "+v"(tid_));
    const int tid = tid_, lane = tid & 63, wid = __builtin_amdgcn_readfirstlane(tid >> 6), r32 = lane & 31, hi = lane >> 5;
    float* cL = (float*)(lds + L_C); float* mW = (float*)(lds + L_M); float* lW = (float*)(lds + L_L); float* OW = (float*)(lds + L_O); float* wtot = (float*)(lds + L_SCAN);
    constexpr int NK = PAST + SSEQ;
    {
        float v[16]; float run = 0.f; const int s0 = 16 * tid;
#pragma unroll
        for (int i = 0; i < 16; ++i) v[i] = 0.f;
        if (tid < PAST / 16) { const float* lp = P.cache_logf + ((size_t)b * PAST + s0) * 8 + h;
#pragma unroll
            for (int i = 0; i < 16; ++i) v[i] = lp[i * 8];
        } else if (tid == PAST / 16) { const float* lp = P.out + O_SLF + ((size_t)b * 16) * 8 + h;
#pragma unroll
            for (int i = 0; i < 16; ++i) v[i] = lp[i * 8];
        }
#pragma unroll
        for (int i = 0; i < 16; ++i) run += v[i];
        float inc = run;
#pragma unroll
        for (int o = 1; o < 64; o <<= 1) { const float t = __shfl_up(inc, o); if (lane >= o) inc += t; }
        if (lane == 63) wtot[wid] = inc;
        __syncthreads();
        float off = inc - run;
        for (int w = 0; w < wid; ++w) off += wtot[w];
#pragma unroll
        for (int i = 0; i < 16; ++i) { off += v[i]; const int s = s0 + i; if (s < NK + 16) cL[s] = off * L2E; }
        __syncthreads();
    }
    const int q = r32 & 15; const long qrow = (long)MP + b * 16 + q;
    bf16x8 qf[4];
#pragma unroll
    for (int ks = 0; ks < 4; ++ks) qf[ks] = *(const bf16x8*)(P.Qb + qrow * 512 + h * 64 + 16 * ks + 8 * hi);
    const float cq = cL[PAST + q];
    float m = -1e30f, l = 0.f; f32x16 o[2]; o[0] = f32x16{}; o[1] = f32x16{};
    int tile0;
    { const float c0 = cL[PAST]; const int t1 = lane, t2 = lane + 64;
      const bool s1 = (c0 - cL[32 * t1 + 31]) < -(64.0f * L2E), s2 = (c0 - cL[32 * t2 + 31]) < -(64.0f * L2E);
      tile0 = __builtin_amdgcn_readfirstlane(__builtin_popcountll(__ballot(s1)) + __builtin_popcountll(__ballot(s2))); }
    for (int tile = tile0 + wid; tile < 129; tile += 8) {
        const int key0 = 32 * tile; const bool isnew = tile == 128;
        bf16x8 kf[4];
        if (!isnew) { const float* kp = P.cache_k + (((size_t)b * PAST + key0 + r32) * 8 + h) * 64 + 8 * hi;
#pragma unroll
            for (int ks = 0; ks < 4; ++ks) { const f32x4 a = *(const f32x4*)(kp + 16 * ks), c = *(const f32x4*)(kp + 16 * ks + 4);
                const u32x4 w = {cvtpk(a[0], a[1]), cvtpk(a[2], a[3]), cvtpk(c[0], c[1]), cvtpk(c[2], c[3])}; kf[ks] = __builtin_bit_cast(bf16x8, w); }
        } else {
#pragma unroll
            for (int ks = 0; ks < 4; ++ks) kf[ks] = *(const bf16x8*)(P.Kb + ((long)MP + b * 16 + (r32 & 15)) * 512 + h * 64 + 16 * ks + 8 * hi);
        }
        float vall[2][2][8];
        if (!isnew) {
#pragma unroll
            for (int db = 0; db < 2; ++db)
#pragma unroll
                for (int s2 = 0; s2 < 2; ++s2)
#pragma unroll
                    for (int j = 0; j < 8; ++j) { const int kv = crow_(8 * s2 + j, hi); vall[db][s2][j] = P.cache_v[(((size_t)b * PAST + key0 + kv) * 8 + h) * 64 + 32 * db + r32]; }
        } else {
#pragma unroll
            for (int db = 0; db < 2; ++db)
#pragma unroll
                for (int s2 = 0; s2 < 2; ++s2)
#pragma unroll
                    for (int j = 0; j < 8; ++j) { const int kv = crow_(8 * s2 + j, hi); vall[db][s2][j] = bf2f(P.Vb[((long)MP + b * 16 + (kv & 15)) * 512 + h * 64 + 32 * db + r32]) * (kv < 16 ? 1.f : 0.f); }
        }
        f32x16 s = f32x16{};
#pragma unroll
        for (int ks = 0; ks < 4; ++ks) s = MFMA32(kf[ks], qf[ks], s);
        float mt = -1e30f;
#pragma unroll
        for (int q4 = 0; q4 < 4; ++q4) { const f32x4 c4 = *(const f32x4*)(cL + key0 + 8 * q4 + 4 * hi);
#pragma unroll
            for (int e = 0; e < 4; ++e) { const int r = 4 * q4 + e; const int kv = 8 * q4 + 4 * hi + e; float x = s[r] + (cq - c4[e]);
                if (isnew && (kv >= 16 || kv > q)) x = -1e30f;
                s[r] = x; mt = fmaxf(mt, x); } }
        mt = fmaxf(mt, __shfl_xor(mt, 32));
        const float mn = fmaxf(m, mt), alpha = __builtin_amdgcn_exp2f(m - mn); m = mn;
        float ls = 0.f;
#pragma unroll
        for (int r = 0; r < 16; ++r) { const float p = __builtin_amdgcn_exp2f(s[r] - mn); s[r] = p; ls += p; }
        l = l * alpha + ls;
#pragma unroll
        for (int db = 0; db < 2; ++db) o[db] *= alpha;
        bf16x8 pf[2];
#pragma unroll
        for (int s2 = 0; s2 < 2; ++s2) { const u32x4 w = {cvtpk(s[8 * s2], s[8 * s2 + 1]), cvtpk(s[8 * s2 + 2], s[8 * s2 + 3]), cvtpk(s[8 * s2 + 4], s[8 * s2 + 5]), cvtpk(s[8 * s2 + 6], s[8 * s2 + 7])}; pf[s2] = __builtin_bit_cast(bf16x8, w); }
#pragma unroll
        for (int db = 0; db < 2; ++db)
#pragma unroll
            for (int s2 = 0; s2 < 2; ++s2) { const float* vv = vall[db][s2];
                const u32x4 w = {cvtpk(vv[0], vv[1]), cvtpk(vv[2], vv[3]), cvtpk(vv[4], vv[5]), cvtpk(vv[6], vv[7])};
                o[db] = MFMA32(__builtin_bit_cast(bf16x8, w), pf[s2], o[db]); }
    }
    l += __shfl_xor(l, 32);
    if (r32 < 16) { if (hi == 0) { mW[wid * 16 + r32] = m; lW[wid * 16 + r32] = l; }
#pragma unroll
        for (int db = 0; db < 2; ++db)
#pragma unroll
            for (int r = 0; r < 16; ++r) OW[(wid * 64 + 32 * db + crow_(r, hi)) * OPITCH + r32] = o[db][r]; }
    __syncthreads();
#pragma unroll
    for (int it = 0; it < 2; ++it) { const int idx = tid + 512 * it, d = idx & 63, qq = idx >> 6;
        float M = -1e30f;
#pragma unroll
        for (int w = 0; w < 8; ++w) M = fmaxf(M, mW[w * 16 + qq]);
        float L = 0.f, acc = 0.f;
#pragma unroll
        for (int w = 0; w < 8; ++w) { const float f = __builtin_amdgcn_exp2f(mW[w * 16 + qq] - M); L += lW[w * 16 + qq] * f; acc += OW[(w * 64 + d) * OPITCH + qq] * f; }
        P.Mix[((long)MP + b * 16 + qq) * DMIX + 1024 + h * 64 + d] = (bf16_t)(cvtpk(acc / L, 0.f) & 0xffffu); }
    __syncthreads();
}
}

constexpr int NWAVES = 8, LDS_BYTES = 147456;
#define LAS __attribute__((address_space(3)))
struct Args {
    const float *x_prompt, *x_sample, *cache_k, *cache_v, *cache_logf, *state_ssm, *state_conv, *norm1_w, *w_in, *conv_w, *conv_b, *dt_bias, *A_log, *D_skip, *ssd_norm_w, *f_bias,
                *q_norm_w, *k_norm_w, *w_out, *norm2_w, *w_up, *w_down;
    float* out; unsigned char* ws;
};
__device__ __forceinline__ unsigned pk2(float lo, float hi) { return cvtpk(lo, hi); }
template <int MAP> __device__ __forceinline__ void transpose_item(const float* W, int K, int Nsrc, int Nphys, bf16_t* WT, const float* ksc, int ksc_n, float* scr, int item, int lane) {
    const int nblk = Nphys / 32, kb = item / nblk, nb = item % nblk, k0 = 64 * kb, n0 = 32 * nb;
    const int n = n0 + (lane & 31); int src = n;
    if (MAP == 1) { const int L = (n & ~255) + ((n >> 5) & 3) * 64 + ((n >> 7) & 1) * 32 + (n & 31);
        if (L < 2560) src = L; else if (L < 4096) src = L + 16; else if (L < 4112) src = 2560 + (L - 4096); else if (L < 4120) src = L; else src = -1; }
#pragma unroll
    for (int i = 0; i < 32; ++i) { const int kk = 2 * i + (lane >> 5); float v = (src >= 0) ? W[(size_t)(k0 + kk) * Nsrc + src] : 0.f; if (ksc && (k0 + kk) < ksc_n) v *= ksc[k0 + kk]; scr[kk * 33 + (lane & 31)] = v; }
    asm volatile("s_waitcnt lgkmcnt(0)" ::: "memory");
    const int c = lane & 7;
#pragma unroll
    for (int j = 0; j < 4; ++j) { const int nn = (lane >> 3) + 8 * j; const float* s = scr + (8 * c) * 33 + nn;
        u32x4 o; o.x = pk2(s[0 * 33], s[1 * 33]); o.y = pk2(s[2 * 33], s[3 * 33]); o.z = pk2(s[4 * 33], s[5 * 33]); o.w = pk2(s[6 * 33], s[7 * 33]);
        *(u32x4*)(WT + (size_t)(n0 + nn) * K + k0 + 8 * c) = o; }
    asm volatile("s_waitcnt lgkmcnt(0)" ::: "memory");
}
__device__ __forceinline__ float wave_sum(float v) {
#pragma unroll
    for (int o = 1; o < 64; o <<= 1) v += __shfl_xor(v, o);
    return v;
}
__device__ __forceinline__ void rms_row_to_bf16(const float* xrow, bf16_t* orow, int lane) {
    const f32x4* xr = (const f32x4*)xrow + lane; f32x4 v[4]; float s = 0.f;
#pragma unroll
    for (int j = 0; j < 4; ++j) { v[j] = xr[64 * j]; s += (v[j][0] * v[j][0] + v[j][1] * v[j][1]) + (v[j][2] * v[j][2] + v[j][3] * v[j][3]); }
    const float rs = rsqrtf(wave_sum(s) * (1.0f / 1024.0f) + EPSN);
    u32x2* o8 = (u32x2*)orow + lane;
#pragma unroll
    for (int j = 0; j < 4; ++j) o8[64 * j] = (u32x2){pk2(v[j][0] * rs, v[j][1] * rs), pk2(v[j][2] * rs, v[j][3] * rs)};
}

#define XB_TMO      128
#define XB_XCNT(j)  (256  + 64 * (j))
#define XB_XSUB(j)  (1280 + 64 * (j))
#define XB_XGEN(j)  (2304 + 64 * (j))
#define XB_TOP      3328
#define XB_TOPGEN   3392
#define XCD_BAR_WORDS 3456
#define XB_SPIN_CAP (1u << 18)

__device__ __forceinline__ unsigned xb_ld(unsigned* p)              { return __hip_atomic_load(p, __ATOMIC_RELAXED, __HIP_MEMORY_SCOPE_AGENT); }
__device__ __forceinline__ unsigned xb_add(unsigned* p, unsigned v) { return __hip_atomic_fetch_add(p, v, __ATOMIC_RELAXED, __HIP_MEMORY_SCOPE_AGENT); }
__device__ __forceinline__ unsigned xb_xcc_id() { return (unsigned)__builtin_amdgcn_s_getreg((3 << 11) | 20) & 0xFu; }
#define XB_SPIN(cond, bar) do { unsigned _sp = 0; while (cond) { __builtin_amdgcn_s_sleep(1); \
    if ((++_sp & 255u) == 0u) { if (xb_ld(&(bar)[XB_TMO])) break; if (_sp > XB_SPIN_CAP) { atomicAdd(&(bar)[XB_TMO], 1u); break; } } } } while (0)

struct XcdBarrier {
    unsigned* bar; unsigned x;
    volatile LAS unsigned* st;
};

__device__ __forceinline__ XcdBarrier xcd_barrier_post(unsigned* bar, volatile LAS unsigned* st) {
    XcdBarrier b; b.bar = bar; b.x = xb_xcc_id(); b.st = st;
    if (threadIdx.x == 0) (void)xb_add(&bar[XB_XCNT(b.x)], 1u);
    return b;
}
__device__ __forceinline__ void xcd_barrier_complete(unsigned* bar, unsigned x, unsigned& nloc, unsigned& nx) {
    const unsigned G = gridDim.x * gridDim.y * gridDim.z;
    unsigned sum, cnt, mine, sp = 0u;
    for (;;) {
        sum = 0u; cnt = 0u; mine = 0u;
#pragma unroll
        for (unsigned j = 0; j < 16; ++j) { const unsigned c = xb_ld(&bar[XB_XCNT(j)]); sum += c; cnt += (c > 0u) ? 1u : 0u; mine = (j == x) ? c : mine; }
        if (sum == G) break;
        __builtin_amdgcn_s_sleep(1);
        if ((++sp & 255u) == 0u) { if (xb_ld(&bar[XB_TMO])) break; if (sp > XB_SPIN_CAP) { atomicAdd(&bar[XB_TMO], 1u); break; } }
    }
    nloc = mine > 0u ? mine : 1u; nx = cnt > 0u ? cnt : 1u;
}

__device__ __forceinline__ void xcd_barrier(const XcdBarrier& b) {
    asm volatile("s_waitcnt vmcnt(0)" ::: "memory");
    __syncthreads();
    if (threadIdx.x == 0) {
        unsigned* bar = b.bar;
        __builtin_amdgcn_s_waitcnt(0);
        unsigned nloc = b.st[0], nx = b.st[1];
        if (nloc == 0u) { xcd_barrier_complete(bar, b.x, nloc, nx); b.st[0] = nloc; b.st[1] = nx; }
        const unsigned old = xb_add(&bar[XB_XSUB(b.x)], 1u);
        const unsigned gen = old / nloc;
        if (old + 1u == (gen + 1u) * nloc) {
            __builtin_amdgcn_fence(__ATOMIC_RELEASE, "agent");
            asm volatile("s_waitcnt vmcnt(0)" ::: "memory");
            const unsigned og = xb_add(&bar[XB_TOP], 1u);
            const unsigned tg = og / nx;
            if (og + 1u == (tg + 1u) * nx) xb_add(&bar[XB_TOPGEN], 1u);
            else XB_SPIN(xb_ld(&bar[XB_TOPGEN]) == tg, bar);
            __builtin_amdgcn_fence(__ATOMIC_ACQUIRE, "agent");
            xb_add(&bar[XB_XGEN(b.x)], 1u);
            asm volatile("s_waitcnt vmcnt(0)" ::: "memory");
        } else {
            XB_SPIN(xb_ld(&bar[XB_XGEN(b.x)]) == gen, bar);
            __builtin_amdgcn_fence(__ATOMIC_ACQUIRE, "agent");
            asm volatile("s_waitcnt vmcnt(0)" ::: "memory");
        }
    }
    __syncthreads();
}

template <int PH> __device__ __forceinline__ void run_phase(const Args& a, unsigned char* lds) {
    int tid_ = threadIdx.x; asm volatile("" : "+v"(tid_));
    const int tid = tid_, lane = tid & 63, wave = __builtin_amdgcn_readfirstlane(tid >> 6);
    int G_ = gridDim.x, bx_ = blockIdx.x; asm volatile("" : "+s"(G_), "+s"(bx_));
    const int G = G_, bx = bx_;
    unsigned char* ws = a.ws; float* out = a.out;
    float* SS1 = (float*)(ws + WS_SS1P); float* GSS = (float*)(ws + WS_GSSP); float* DAT = (float*)(ws + WS_DAT); float* CP = (float*)(ws + WS_CP);
    bf16_t* WinT = (bf16_t*)(ws + WS_WIN); bf16_t* WoutT = (bf16_t*)(ws + WS_WOUT); bf16_t* WupT = (bf16_t*)(ws + WS_WUP); bf16_t* WdnT = (bf16_t*)(ws + WS_WDN);
    bf16_t* XN = (bf16_t*)(ws + WS_XN); float* DT = (float*)(ws + WS_DT); float* SL = (float*)(ws + WS_SL); bf16_t* Zs = (bf16_t*)(ws + WS_ZS); bf16_t* XBC = (bf16_t*)(ws + WS_XBC);
    bf16_t* Qb = (bf16_t*)(ws + WS_QB); bf16_t* Kb = (bf16_t*)(ws + WS_KB); bf16_t* Vb = (bf16_t*)(ws + WS_VB); bf16_t* Mix = (bf16_t*)(ws + WS_MIX); bf16_t* Hb = (bf16_t*)(ws + WS_H);
    (void)tid; (void)lane; (void)wave; (void)SS1; (void)GSS; (void)DAT; (void)CP; (void)WinT; (void)WoutT; (void)WupT; (void)WdnT; (void)XN; (void)DT; (void)SL; (void)Zs; (void)XBC; (void)Qb; (void)Kb; (void)Vb; (void)Mix; (void)Hb; (void)out;
    if constexpr (PH == 0) {
    {
        float* scr = (float*)(lds + wave * 16384);
        const int gw = bx * NWAVES + wave, NGW = G * NWAVES;
        constexpr int I_IN = (1024 / 64) * (NIN / 32), I_OUT = (1536 / 64) * (1024 / 32), I_UP = (1024 / 64) * (4096 / 32), I_DN = (4096 / 64) * (1024 / 32);
        for (int it = gw; it < I_IN + I_OUT + I_UP + I_DN; it += NGW) {
            int r = it;
            if (r < I_IN) { transpose_item<1>(a.w_in, 1024, 4120, NIN, WinT, a.norm1_w, 1024, scr, r, lane); continue; } r -= I_IN;
            if (r < I_OUT) { transpose_item<0>(a.w_out, 1536, 1024, 1024, WoutT, a.ssd_norm_w, 1024, scr, r, lane); continue; } r -= I_OUT;
            if (r < I_UP) { transpose_item<0>(a.w_up, 1024, 4096, 4096, WupT, a.norm2_w, 1024, scr, r, lane); continue; } r -= I_UP;
            transpose_item<0>(a.w_down, 4096, 1024, 1024, WdnT, nullptr, 0, scr, r, lane);
        }
        for (int m0 = gw; m0 < MT; m0 += 4 * NGW) {
            f32x4 v[4][4]; float s[4];
#pragma unroll
            for (int r = 0; r < 4; ++r) { const int m = m0 + r * NGW; const int mc = m < MT ? m : MT - 1;
                const f32x4* xr = (const f32x4*)(mc < MP ? a.x_prompt + (size_t)mc * 1024 : a.x_sample + (size_t)(mc - MP) * 1024) + lane; s[r] = 0.f;
#pragma unroll
                for (int j = 0; j < 4; ++j) { v[r][j] = __builtin_nontemporal_load(xr + 64 * j); } }
#pragma unroll
            for (int r = 0; r < 4; ++r) {
#pragma unroll
                for (int j = 0; j < 4; ++j) s[r] += (v[r][j][0] * v[r][j][0] + v[r][j][1] * v[r][j][1]) + (v[r][j][2] * v[r][j][2] + v[r][j][3] * v[r][j][3]);
                const float rs = rsqrtf(wave_sum(s[r]) * (1.0f / 1024.0f) + EPSN); const int m = m0 + r * NGW;
                if (m < MT) { u32x2* o8 = (u32x2*)(XN + (size_t)m * 1024) + lane;
#pragma unroll
                    for (int j = 0; j < 4; ++j) o8[64 * j] = (u32x2){pk2(v[r][j][0] * rs, v[r][j][1] * rs), pk2(v[r][j][2] * rs, v[r][j][3] * rs)}; } }
        }
        if (bx == 0 && tid < 64) ((unsigned*)(ws + WS_CTR))[tid] = 0u;
    }
    }
    if constexpr (PH == 1) {
    {
        pg8::Gemm g{XN, WinT, MT, NIN, 1024, 0}; pg8::StaticOrder S; S.init(MT, NIN, G, bx);
        pg8::EpiIn E{Zs, XBC, Qb, Kb, Vb, DT, out, a.dt_bias, a.f_bias, a.q_norm_w, a.k_norm_w, (bf16_t*)(ws + WS_HIST)};
        pg8::gemm_phase<pg8::EpiIn, pg8::StaticOrder, true, true>((PG8_LAS unsigned char*)lds, g, S, E);
    }
    }
    if constexpr (PH == 9) {
    {
        const bf16_t* HIST = (const bf16_t*)(ws + WS_HIST);
        constexpr int NSEG = MP / 128, NPAIR = DCONV / 2, NTASK = (NSEG + SBATCH) * NPAIR;
        for (int task = bx * 512 + tid; task < NTASK; task += G * 512) {
            const int seg = task / NPAIR, col = 2 * (task - seg * NPAIR);
            float w0[4], w1[4];
#pragma unroll
            for (int k = 0; k < 4; ++k) { w0[k] = a.conv_w[k * DCONV + col]; w1[k] = a.conv_w[k * DCONV + col + 1]; }
            const float b0 = a.conv_b[col], b1 = a.conv_b[col + 1];
            float a3 = 0.f, c3 = 0.f, a2 = 0.f, c2 = 0.f, a1 = 0.f, c1 = 0.f; int row0, n;
            if (seg < NSEG) { row0 = seg * 128; n = 128;
                if (seg & 63) { const bf16_t* hp = HIST + (unsigned)((seg - 1) * 3 * DCONV + col);
                    const unsigned u3 = *(const unsigned*)hp, u2 = *(const unsigned*)(hp + DCONV), u1 = *(const unsigned*)(hp + 2 * DCONV);
                    a3 = bf2f(u3 & 0xffffu); c3 = bf2f(u3 >> 16); a2 = bf2f(u2 & 0xffffu); c2 = bf2f(u2 >> 16); a1 = bf2f(u1 & 0xffffu); c1 = bf2f(u1 >> 16); }
            } else { const int s = seg - NSEG; row0 = MP + s * 16; n = 16; const float* hp = a.state_conv + (unsigned)(s * 3 * DCONV + col);
                a3 = hp[0]; c3 = hp[1]; a2 = hp[DCONV]; c2 = hp[DCONV + 1]; a1 = hp[2 * DCONV]; c1 = hp[2 * DCONV + 1]; }
            bf16_t* xp = XBC + (unsigned)(row0 * DCONV + col);
            for (int i0 = 0; i0 < n; i0 += 16) {
                unsigned uu[16];
#pragma unroll
                for (int i = 0; i < 16; ++i) uu[i] = *(const unsigned*)(xp + (i0 + i) * DCONV);
#pragma unroll
                for (int i = 0; i < 16; ++i) { const float a0 = bf2f(uu[i] & 0xffffu), c0 = bf2f(uu[i] >> 16);
                    const float o0 = silu_f(b0 + w0[0] * a3 + w0[1] * a2 + w0[2] * a1 + w0[3] * a0), o1 = silu_f(b1 + w1[0] * c3 + w1[1] * c2 + w1[2] * c1 + w1[3] * c0);
                    *(unsigned*)(xp + (i0 + i) * DCONV) = cvtpk(o0, o1);
                    a3 = a2; c3 = c2; a2 = a1; c2 = c1; a1 = a0; c1 = c0; }
            }
        }
        sattn::Ptrs Q{a.cache_k, a.cache_v, a.cache_logf, Qb, Kb, Vb, out, Mix};
        for (int u = G - 1 - bx; u < SBATCH * 8; u += G) sattn::unit(Q, lds, u >> 3, u & 7);
    }
    }
    if constexpr (PH == 12) {
    {
        if (G >= 128) { const f32x4* part = (const f32x4*)(ws + WS_MIX); f32x4* y = (f32x4*)(out + O_Y + (size_t)MP * 1024);
            for (int i = bx * 512 + tid; i < MS * 1024 / 4; i += G * 512) { f32x4 s = y[i];
#pragma unroll
                for (int k = 0; k < 16; ++k) s += part[(size_t)k * (MS * 1024 / 4) + i];
                y[i] = s; } }
    }
    }
    if constexpr (PH == 10) {
    {
        const int ks = bx >> 3;
        pg8::Gemm g2{Hb + ks * 256, WdnT + ks * 256, MT, 1024, DFF, 4}; pg8::ListOrder S2{G, bx, G >= 128 ? 128 : 0, 8, MP / 256, 4, 0};
        pg8::EpiDownPartial E2{(float*)(ws + WS_MIX) + (size_t)ks * (MS * 1024)};
        pg8::gemm_phase<pg8::EpiDownPartial, pg8::ListOrder, true, true>((PG8_LAS unsigned char*)lds, g2, S2, E2);
    }
    }
    if constexpr (PH == 11) {
    {
        {
            pg8::Gemm g{Mix, WoutT, MT, 1024, DMIX, 0}; pg8::ListOrder S{G, bx, 8, 8, MP / 256, 4, 0};
            pg8::EpiOut E{a.x_prompt, a.x_sample, out + O_Y, XN, SS1, GSS};
            pg8::gemm_phase<pg8::EpiOut, pg8::ListOrder, true, true>((PG8_LAS unsigned char*)lds, g, S, E);
        }
    }
    }
    if constexpr (PH == 2) {
    {
        ssd::Ptrs P{XBC, Zs, DT, a.conv_w, a.conv_b, a.A_log, a.D_skip, a.state_conv, a.state_ssm, SL, DAT, GSS, Mix, out};
        for (int u = bx; u < PB * ssd::SSD_NBLK * 4; u += G) ssd::unit<0>(P, lds, u / (ssd::SSD_NBLK * 4), (u >> 2) % ssd::SSD_NBLK, u & 3);
        for (int u = bx; u < SBATCH * 4; u += G) ssd::unit<2>(P, lds, u >> 2, 0, u & 3);
    }
    }
    if constexpr (PH == 3) {
    {
        for (int item = bx * 512 + tid; item < PB * 16 * 8192; item += G * 512) {
            const int bh = item >> 13, b = bh >> 4, h = bh & 15, e = item & 8191; float s = 0.f;
            constexpr int NB = ssd::SSD_NBLK; float* sp = SL + ((size_t)(b * NB * 16 + h)) * 8192 + e; const float* dp = DAT + b * NB * 16 + h; float loc[NB], dec[NB];
#pragma unroll
            for (int blk = 0; blk < NB; ++blk) { loc[blk] = sp[(size_t)blk * 16 * 8192]; dec[blk] = dp[blk * 16]; }
#pragma unroll
            for (int blk = 0; blk < NB; ++blk) { sp[(size_t)blk * 16 * 8192] = s; s = s * __expf(dec[blk]) + loc[blk]; } }
        float* wtot = (float*)lds;
        for (int bh = bx; bh < PB * 8; bh += G) { const int b = bh >> 3, h = bh & 7;
            float v[16]; float run = 0.f; const int s0 = 16 * tid;
#pragma unroll
            for (int i = 0; i < 16; ++i) { v[i] = out[O_PLF + ((size_t)b * PSEQ + s0 + i) * 8 + h]; run += v[i]; }
            float inc = run;
#pragma unroll
            for (int o = 1; o < 64; o <<= 1) { const float t = __shfl_up(inc, o); if (lane >= o) inc += t; }
            __syncthreads();
            if (lane == 63) wtot[wave] = inc;
            __syncthreads();
            float off = inc - run;
            for (int w = 0; w < wave; ++w) off += wtot[w];
#pragma unroll
            for (int i = 0; i < 16; ++i) { off += v[i]; CP[(size_t)bh * PSEQ + s0 + i] = off * L2E; } }
    }
    }
    if constexpr (PH == 4) {
    {
        ssd::Ptrs P{XBC, Zs, DT, a.conv_w, a.conv_b, a.A_log, a.D_skip, a.state_conv, a.state_ssm, SL, DAT, GSS, Mix, out};
        for (int u = bx; u < PB * ssd::SSD_NBLK * 4; u += G) ssd::unit<1>(P, lds, u / (ssd::SSD_NBLK * 4), (u >> 2) % ssd::SSD_NBLK, u & 3);
    }
    }
    if constexpr (PH == 8) {
    {
        const attn_body::bf16* Qa = (const attn_body::bf16*)Qb; const attn_body::bf16* Ka = (const attn_body::bf16*)Kb; const attn_body::bf16* Va = (const attn_body::bf16*)Vb;
        attn_body::bf16* Oa = (attn_body::bf16*)(Mix + 1024);
        unsigned* ctr = (unsigned*)(ws + WS_CTR); int* slot = (int*)(lds + 147000);
        float skipl2;
        { float mq = fabsf(a.q_norm_w[lane]), mk = fabsf(a.k_norm_w[lane]);
#pragma unroll
          for (int o = 1; o < 64; o <<= 1) { mq = fmaxf(mq, __shfl_xor(mq, o)); mk = fmaxf(mk, __shfl_xor(mk, o)); }
          skipl2 = (16.0f * mq * mk + 33.0f) * L2E; }
        if (tid == 0) *slot = (int)atomicAdd(ctr, 1u);
        __syncthreads();
        int u = *slot;
        __syncthreads();
        while (u < PB * 8 * 32) {
            int nx = 0; if (tid == 0) nx = (int)atomicAdd(ctr, 1u);
            const int qb = 31 - (u >> 6), bh = u & 63;
            attn_body::attn_unit<8>(bh >> 3, bh & 7, qb, Qa, Ka, Va, Oa, CP, skipl2, (char*)lds);
            if (tid == 0) *slot = nx;
            __syncthreads();
            u = *slot;
            __syncthreads();
        }
    }
    }
    if constexpr (PH == 5) {
    {
        pg8::Gemm g{Mix, WoutT, MP, 1024, DMIX, 0}; pg8::StaticOrder S; S.init(MP, 1024, G, bx);
        pg8::EpiOut E{a.x_prompt, a.x_sample, out + O_Y, XN, SS1, GSS};
        pg8::gemm_phase<pg8::EpiOut, pg8::StaticOrder, true, true>((PG8_LAS unsigned char*)lds, g, S, E);
    }
    }
    if constexpr (PH == 6) {
    {
        pg8::Gemm g{XN, WupT, MT, DFF, 1024, 0}; pg8::StaticOrder S; S.init(MT, DFF, G, bx);
        pg8::EpiUp E{SS1, Hb};
        pg8::gemm_phase<pg8::EpiUp, pg8::StaticOrder, true, true>((PG8_LAS unsigned char*)lds, g, S, E);
    }
    }
    if constexpr (PH == 7) {
    {
        const int Mrows = G >= 128 ? MP : MT;
        pg8::Gemm g{Hb, WdnT, Mrows, 1024, DFF, 0}; pg8::StaticOrder S; S.init(Mrows, 1024, G, bx);
        pg8::EpiDown E{out + O_Y};
        pg8::gemm_phase<pg8::EpiDown, pg8::StaticOrder, true, true>((PG8_LAS unsigned char*)lds, g, S, E);
    }
    }
}
template <int PH> __global__ void __launch_bounds__(NWAVES * 64, 2) phase_kernel(Args a) {
    extern __shared__ __attribute__((aligned(16))) unsigned char lds[];
    run_phase<PH>(a, lds);
}
#ifndef ONE_LAUNCH
#define ONE_LAUNCH 1
#endif
#if ONE_LAUNCH
#define RUN_PHASE(k) do { const __attribute__((address_space(4))) Args* p_ = (const __attribute__((address_space(4))) Args*)__builtin_amdgcn_kernarg_segment_ptr(); asm volatile("" : "+s"(p_)); Args la_; { const __attribute__((address_space(4))) unsigned long long* q_ = (const __attribute__((address_space(4))) unsigned long long*)p_; unsigned long long* d_ = (unsigned long long*)&la_; _Pragma("unroll") for (int i_ = 0; i_ < (int)(sizeof(Args) / 8); ++i_) d_[i_] = q_[i_]; } run_phase<k>(la_, lds); } while (0)
__global__ void __launch_bounds__(NWAVES * 64, 2) fwd_megakernel(Args a) {
    extern __shared__ __attribute__((aligned(16))) unsigned char lds[];
    cg::grid_group grid = cg::this_grid();
    if (threadIdx.x < 2) ((volatile LAS unsigned*)(lds + 147016))[threadIdx.x] = 0u;
    __syncthreads();
    XcdBarrier xbar;
    { const __attribute__((address_space(4))) Args* p_ = (const __attribute__((address_space(4))) Args*)__builtin_amdgcn_kernarg_segment_ptr();
      xbar = xcd_barrier_post((unsigned*)(p_->ws + WS_BARW), (volatile LAS unsigned*)(lds + 147016)); }
    RUN_PHASE(0); grid.sync();
    RUN_PHASE(1); xcd_barrier(xbar);
    RUN_PHASE(9); xcd_barrier(xbar);
    RUN_PHASE(2); xcd_barrier(xbar);
    RUN_PHASE(3); xcd_barrier(xbar);
    RUN_PHASE(4); __syncthreads(); RUN_PHASE(11); __syncthreads(); RUN_PHASE(8); xcd_barrier(xbar);
    RUN_PHASE(5); xcd_barrier(xbar);
    RUN_PHASE(6); xcd_barrier(xbar);
    RUN_PHASE(7); __syncthreads(); RUN_PHASE(10); xcd_barrier(xbar);
    RUN_PHASE(12);
}
#endif
extern "C" void kernel_launch(void* const* d_in, const int* in_sizes, int n_in, void* d_out, int out_size, void* d_ws, size_t ws_size, hipStream_t stream) {
    static int grid = 0;
    if (grid == 0) {
        if (n_in != 22 || (size_t)out_size != O_END || ws_size < WS_END) { fprintf(stderr, "kernel_launch: unexpected shapes: n_in %d out %d ws %zu (need %zu)\n", n_in, out_size, ws_size, (size_t)WS_END); grid = -1; return; }
        int dev = 0, cus = 0, per_cu = 0;
        (void)hipGetDevice(&dev); (void)hipDeviceGetAttribute(&cus, hipDeviceAttributeMultiprocessorCount, dev);
        bool okattr = true;
#if ONE_LAUNCH
        okattr = hipFuncSetAttribute((const void*)fwd_megakernel, hipFuncAttributeMaxDynamicSharedMemorySize, LDS_BYTES) == hipSuccess;
#endif
#if !ONE_LAUNCH
        okattr = okattr && hipFuncSetAttribute((const void*)phase_kernel<0>, hipFuncAttributeMaxDynamicSharedMemorySize, LDS_BYTES) == hipSuccess && hipFuncSetAttribute((const void*)phase_kernel<1>, hipFuncAttributeMaxDynamicSharedMemorySize, LDS_BYTES) == hipSuccess
              && hipFuncSetAttribute((const void*)phase_kernel<2>, hipFuncAttributeMaxDynamicSharedMemorySize, LDS_BYTES) == hipSuccess && hipFuncSetAttribute((const void*)phase_kernel<3>, hipFuncAttributeMaxDynamicSharedMemorySize, LDS_BYTES) == hipSuccess
              && hipFuncSetAttribute((const void*)phase_kernel<4>, hipFuncAttributeMaxDynamicSharedMemorySize, LDS_BYTES) == hipSuccess && hipFuncSetAttribute((const void*)phase_kernel<5>, hipFuncAttributeMaxDynamicSharedMemorySize, LDS_BYTES) == hipSuccess
              && hipFuncSetAttribute((const void*)phase_kernel<6>, hipFuncAttributeMaxDynamicSharedMemorySize, LDS_BYTES) == hipSuccess && hipFuncSetAttribute((const void*)phase_kernel<7>, hipFuncAttributeMaxDynamicSharedMemorySize, LDS_BYTES) == hipSuccess && hipFuncSetAttribute((const void*)phase_kernel<8>, hipFuncAttributeMaxDynamicSharedMemorySize, LDS_BYTES) == hipSuccess && hipFuncSetAttribute((const void*)phase_kernel<9>, hipFuncAttributeMaxDynamicSharedMemorySize, LDS_BYTES) == hipSuccess && hipFuncSetAttribute((const void*)phase_kernel<10>, hipFuncAttributeMaxDynamicSharedMemorySize, LDS_BYTES) == hipSuccess && hipFuncSetAttribute((const void*)phase_kernel<11>, hipFuncAttributeMaxDynamicSharedMemorySize, LDS_BYTES) == hipSuccess && hipFuncSetAttribute((const void*)phase_kernel<12>, hipFuncAttributeMaxDynamicSharedMemorySize, LDS_BYTES) == hipSuccess;
#endif
        if (!okattr) { fprintf(stderr, "kernel_launch: hipFuncSetAttribute failed\n"); grid = -1; return; }
        (void)hipGetLastError();
        grid = cus;
    }
    if (grid < 0) return;
    Args a{};
    a.x_prompt = (const float*)d_in[0]; a.x_sample = (const float*)d_in[1]; a.cache_k = (const float*)d_in[2]; a.cache_v = (const float*)d_in[3]; a.cache_logf = (const float*)d_in[4];
    a.state_ssm = (const float*)d_in[5]; a.state_conv = (const float*)d_in[6]; a.norm1_w = (const float*)d_in[7]; a.w_in = (const float*)d_in[8]; a.conv_w = (const float*)d_in[9];
    a.conv_b = (const float*)d_in[10]; a.dt_bias = (const float*)d_in[11]; a.A_log = (const float*)d_in[12]; a.D_skip = (const float*)d_in[13]; a.ssd_norm_w = (const float*)d_in[14];
    a.f_bias = (const float*)d_in[15]; a.q_norm_w = (const float*)d_in[16]; a.k_norm_w = (const float*)d_in[17]; a.w_out = (const float*)d_in[18]; a.norm2_w = (const float*)d_in[19];
    a.w_up = (const float*)d_in[20]; a.w_down = (const float*)d_in[21]; a.out = (float*)d_out; a.ws = (unsigned char*)d_ws;
#if ONE_LAUNCH
    if (hipMemsetAsync((char*)d_ws + WS_BARW, 0, 16384, stream) != hipSuccess) { fprintf(stderr, "kernel_launch: hipMemsetAsync failed\n"); return; }
    void* args[] = {&a};
    hipError_t e = hipLaunchCooperativeKernel((const void*)fwd_megakernel, dim3(grid), dim3(NWAVES * 64), args, LDS_BYTES, stream);
    if (e != hipSuccess) fprintf(stderr, "kernel_launch: cooperative launch failed: %s (grid %d)\n", hipGetErrorString(e), grid);
#else
    hipLaunchKernelGGL(phase_kernel<0>, dim3(grid), dim3(NWAVES * 64), LDS_BYTES, stream, a);
    hipLaunchKernelGGL(phase_kernel<1>, dim3(grid), dim3(NWAVES * 64), LDS_BYTES, stream, a);
    hipLaunchKernelGGL(phase_kernel<9>, dim3(grid), dim3(NWAVES * 64), LDS_BYTES, stream, a);
    hipLaunchKernelGGL(phase_kernel<2>, dim3(grid), dim3(NWAVES * 64), LDS_BYTES, stream, a);
    hipLaunchKernelGGL(phase_kernel<3>, dim3(grid), dim3(NWAVES * 64), LDS_BYTES, stream, a);
    hipLaunchKernelGGL(phase_kernel<4>, dim3(grid), dim3(NWAVES * 64), LDS_BYTES, stream, a);
    hipLaunchKernelGGL(phase_kernel<11>, dim3(grid), dim3(NWAVES * 64), LDS_BYTES, stream, a);
    hipLaunchKernelGGL(phase_kernel<8>, dim3(grid), dim3(NWAVES * 64), LDS_BYTES, stream, a);
    hipLaunchKernelGGL(phase_kernel<5>, dim3(grid), dim3(NWAVES * 64), LDS_BYTES, stream, a);
    hipLaunchKernelGGL(phase_kernel<6>, dim3(grid), dim3(NWAVES * 64), LDS_BYTES, stream, a);
    hipLaunchKernelGGL(phase_kernel<7>, dim3(grid), dim3(NWAVES * 64), LDS_BYTES, stream, a);
    hipLaunchKernelGGL(phase_kernel<10>, dim3(grid), dim3(NWAVES * 64), LDS_BYTES, stream, a);
    hipLaunchKernelGGL(phase_kernel<12>, dim3(grid), dim3(NWAVES * 64), LDS_BYTES, stream, a);
#endif
}
```
